# Optimizing an MI355X kernel written in HIP

```python
import jax
import jax.numpy as jnp
from jax import lax
import numpy as np

D_MODEL = 1024
BATCH = 4
SEQ = 4096
DEPTH = 1

ATTN_HEADS = 8
ATTN_HEAD_DIM = 64
ATTN_WIDTH = ATTN_HEADS * ATTN_HEAD_DIM
DILATED_PATTERNS = ((128, 1), (512, 4), (2048, 16))
ATTN_BLOCK = 128
DN_HEADS = 4
DN_HEAD_DIM = 128
DN_WIDTH = DN_HEADS * DN_HEAD_DIM
DN_CHUNK = 64
CONV_WIDTH = 4
MIX_WIDTH = ATTN_WIDTH + DN_WIDTH
IN_SECTIONS = (ATTN_WIDTH, ATTN_WIDTH, ATTN_WIDTH, DN_WIDTH, DN_WIDTH, DN_WIDTH, DN_HEADS, DN_HEADS, DN_WIDTH)
IN_COLS = sum(IN_SECTIONS)
D_FF = 2816
NORM_EPS = 1e-6
L2_EPS = 1e-6
INIT_NOISE = 0.02

kernel_name = "hybrid_dilated_attn_gated_deltanet_macaron"


def rms_norm(x, gain):
    xf = x.astype(jnp.float32)
    y = xf * lax.rsqrt(jnp.mean(xf * xf, axis=-1, keepdims=True) + NORM_EPS)
    return (y * gain.astype(jnp.float32)).astype(x.dtype)


def swiglu(h, w_gate, w_up, w_down):
    return (jax.nn.silu(h @ w_gate) * (h @ w_up)) @ w_down


def alibi_slopes(n_heads):
    return jnp.asarray(np.array([2.0 ** (-8.0 * (i + 1) / n_heads) for i in range(n_heads)], dtype=np.float32))


def dilated_window_attention(q, k, v, slopes, window, dilation):
    B, S, H, Dh = q.shape
    L = S // dilation
    W = window // dilation
    nb = -(-L // ATTN_BLOCK)
    Lp = nb * ATTN_BLOCK

    def residues(t):
        return t.reshape(B, L, dilation, H, Dh).transpose(0, 2, 3, 1, 4).reshape(B * dilation, H, L, Dh)

    qr = jnp.pad(residues(q), ((0, 0), (0, 0), (0, Lp - L), (0, 0))).reshape(B * dilation, H, nb, ATTN_BLOCK, Dh)

    def band(t):
        t = jnp.pad(residues(t), ((0, 0), (0, 0), (ATTN_BLOCK, Lp - L), (0, 0)))
        t = t.reshape(B * dilation, H, nb + 1, ATTN_BLOCK, Dh)
        return jnp.concatenate([t[:, :, :-1], t[:, :, 1:]], axis=3)

    kb, vb = band(k), band(v)
    s = jnp.einsum('zhnqd,zhnkd->zhnqk', qr, kb) * (Dh ** -0.5)
    qi = jnp.arange(ATTN_BLOCK)[:, None]
    kj = jnp.arange(2 * ATTN_BLOCK)[None, :]
    steps = qi + ATTN_BLOCK - kj
    key_idx = jnp.arange(nb)[:, None, None] * ATTN_BLOCK + kj - ATTN_BLOCK
    valid = (steps >= 0) & (steps <= W) & (key_idx >= 0)
    bias = -slopes[:, None, None, None] * (steps * dilation).astype(jnp.float32)
    s = jnp.where(valid, s + bias, -jnp.inf)
    m = jnp.max(s, axis=-1)
    p = jnp.exp(s - m[..., None])
    l = jnp.sum(p, axis=-1)
    o = jnp.einsum('zhnqk,zhnkd->zhnqd', p, vb) / l[..., None]

    def back(t):
        extra = t.shape[4:]
        t = t.reshape(B, dilation, H, Lp, *extra)[:, :, :, :L]
        perm = (0, 3, 1, 2) + tuple(range(4, 4 + len(extra)))
        return t.transpose(perm).reshape(B, S, H, *extra)

    return back(o), back(m), back(l)


def dilated_attention(q, k, v):
    slopes = alibi_slopes(q.shape[2])
    outs, maxes, denoms = [], [], []
    for window, dilation in DILATED_PATTERNS:
        o, m, l = dilated_window_attention(q, k, v, slopes, window, dilation)
        outs.append(o)
        maxes.append(m)
        denoms.append(l)
    m_all = jnp.stack(maxes)
    wts = jnp.stack(denoms) * jnp.exp(m_all - jnp.max(m_all, axis=0, keepdims=True))
    return jnp.einsum('pbsh,pbshd->bshd', wts, jnp.stack(outs)) / jnp.sum(wts, axis=0)[..., None]


def gated_delta_rule(q, k, v, beta, g):
    B, S, H, Dk = q.shape
    Dv = v.shape[-1]
    C = DN_CHUNK
    N = S // C

    def chunks(t):
        return jnp.moveaxis(t.reshape(B, N, C, H, *t.shape[3:]), 3, 1)

    q = chunks(q) * (Dk ** -0.5)
    k, v, beta = chunks(k), chunks(v), chunks(beta)
    g = jnp.cumsum(chunks(g), axis=-1)
    causal = jnp.tril(jnp.ones((C, C), dtype=bool))
    strict = jnp.tril(jnp.ones((C, C), dtype=bool), k=-1)
    decay = jnp.exp(jnp.where(causal, g[..., :, None] - g[..., None, :], -jnp.inf))
    k_beta = k * beta[..., None]
    a_mat = jnp.where(strict, jnp.einsum('bhnck,bhnjk->bhncj', k_beta, k) * decay, 0.0)
    eye = jnp.eye(C, dtype=q.dtype)
    rhs = jnp.concatenate([v * beta[..., None], k_beta * jnp.exp(g)[..., None]], axis=-1)
    sol = lax.linalg.triangular_solve(eye + a_mat, rhs, left_side=True, lower=True)
    u, w = sol[..., :Dv], sol[..., Dv:]
    attn_intra = jnp.where(causal, jnp.einsum('bhnck,bhnjk->bhncj', q, k) * decay, 0.0)

    def step(state, xs):
        q_n, k_n, u_n, w_n, g_n, a_n = xs
        v_new = u_n - jnp.einsum('bhck,bhkv->bhcv', w_n, state)
        o_n = (jnp.einsum('bhck,bhkv->bhcv', q_n * jnp.exp(g_n)[..., None], state)
               + jnp.einsum('bhcj,bhjv->bhcv', a_n, v_new))
        g_last = g_n[..., -1]
        k_dec = k_n * jnp.exp(g_last[..., None] - g_n)[..., None]
        state = state * jnp.exp(g_last)[..., None, None] + jnp.einsum('bhck,bhcv->bhkv', k_dec, v_new)
        return state, o_n

    xs = tuple(jnp.moveaxis(t, 2, 0) for t in (q, k, u, w, g, attn_intra))
    state0 = jnp.zeros((B, H, Dk, Dv), q.dtype)
    _, o = lax.scan(step, state0, xs)
    return o.transpose(1, 0, 3, 2, 4).reshape(B, S, H, Dv)


def hybrid_mixer(h, w_in, conv_w, a_log, dt_bias, dn_norm, w_out):
    B, S, _ = h.shape
    f32 = jnp.float32
    split_points = np.cumsum(IN_SECTIONS)[:-1].tolist()
    aq, ak, av, dq, dk, dv, beta_raw, decay_raw, gate = jnp.split(h @ w_in, split_points, axis=-1)

    def attn_heads(t):
        return t.reshape(B, S, ATTN_HEADS, ATTN_HEAD_DIM).astype(f32)

    attn = dilated_attention(attn_heads(aq), attn_heads(ak), attn_heads(av))
    attn = attn.reshape(B, S, ATTN_WIDTH).astype(h.dtype)

    qkv = jnp.concatenate([dq, dk, dv], axis=-1)
    qkv_pad = jnp.pad(qkv, ((0, 0), (CONV_WIDTH - 1, 0), (0, 0)))
    conv = qkv_pad[:, 0:S] * conv_w[0]
    for j in range(1, CONV_WIDTH):
        conv = conv + qkv_pad[:, j:j + S] * conv_w[j]
    dq, dk, dv = jnp.split(jax.nn.silu(conv).astype(f32), 3, axis=-1)

    def dn_heads(t):
        return t.reshape(B, S, DN_HEADS, DN_HEAD_DIM)

    def l2n(t):
        return t * lax.rsqrt(jnp.sum(t * t, axis=-1, keepdims=True) + L2_EPS)

    beta = jax.nn.sigmoid(beta_raw.astype(f32))
    g = -jnp.exp(a_log.astype(f32)) * jax.nn.softplus(decay_raw.astype(f32) + dt_bias.astype(f32))
    o = gated_delta_rule(l2n(dn_heads(dq)), l2n(dn_heads(dk)), dn_heads(dv), beta, g)
    o = (o * lax.rsqrt(jnp.mean(o * o, axis=-1, keepdims=True) + NORM_EPS) * dn_norm.astype(f32)
         * jax.nn.silu(dn_heads(gate.astype(f32))))
    dn = o.reshape(B, S, DN_WIDTH).astype(h.dtype)

    return jnp.concatenate([attn, dn], axis=-1) @ w_out


def setup_inputs(seed: int = 0) -> dict:
    key = jax.random.key(seed)
    ks = jax.random.split(key, 17)
    f32 = jnp.float32
    L = DEPTH

    def normal(k, shape, scale):
        return jax.random.normal(k, shape, f32) * scale

    def gain(k, shape):
        return 1.0 + INIT_NOISE * jax.random.normal(k, shape, f32)

    dt = jnp.exp(jax.random.uniform(ks[9], (L, DN_HEADS), f32, float(np.log(1e-3)), float(np.log(1e-1))))
    return {
        "x": normal(ks[0], (BATCH, SEQ, D_MODEL), 1.0),
        "norm_ffn1": gain(ks[1], (L, D_MODEL)),
        "ffn1_gate": normal(ks[2], (L, D_MODEL, D_FF), D_MODEL ** -0.5),
        "ffn1_up": normal(ks[3], (L, D_MODEL, D_FF), D_MODEL ** -0.5),
        "ffn1_down": normal(ks[4], (L, D_FF, D_MODEL), D_FF ** -0.5),
        "norm_mix": gain(ks[5], (L, D_MODEL)),
        "w_in": normal(ks[6], (L, D_MODEL, IN_COLS), D_MODEL ** -0.5),
        "conv_w": normal(ks[7], (L, CONV_WIDTH, 3 * DN_WIDTH), CONV_WIDTH ** -0.5),
        "a_log": jnp.log(jax.random.uniform(ks[8], (L, DN_HEADS), f32, 1.0, 16.0)),
        "dt_bias": dt + jnp.log(-jnp.expm1(-dt)),
        "dn_norm": gain(ks[10], (L, DN_HEAD_DIM)),
        "w_out": normal(ks[11], (L, MIX_WIDTH, D_MODEL), MIX_WIDTH ** -0.5),
        "norm_ffn2": gain(ks[12], (L, D_MODEL)),
        "ffn2_gate": normal(ks[13], (L, D_MODEL, D_FF), D_MODEL ** -0.5),
        "ffn2_up": normal(ks[14], (L, D_MODEL, D_FF), D_MODEL ** -0.5),
        "ffn2_down": normal(ks[15], (L, D_FF, D_MODEL), D_FF ** -0.5),
        "norm_final": gain(ks[16], (D_MODEL,)),
    }


def reference(x, norm_ffn1, ffn1_gate, ffn1_up, ffn1_down, norm_mix, w_in, conv_w, a_log, dt_bias,
              dn_norm, w_out, norm_ffn2, ffn2_gate, ffn2_up, ffn2_down, norm_final):
    for i in range(DEPTH):
        x = x + 0.5 * swiglu(rms_norm(x, norm_ffn1[i]), ffn1_gate[i], ffn1_up[i], ffn1_down[i])
        x = x + hybrid_mixer(rms_norm(x, norm_mix[i]), w_in[i], conv_w[i], a_log[i], dt_bias[i],
                             dn_norm[i], w_out[i])
        x = x + 0.5 * swiglu(rms_norm(x, norm_ffn2[i]), ffn2_gate[i], ffn2_up[i], ffn2_down[i])
    return rms_norm(x, norm_final)
```

```cpp
#include <hip/hip_runtime.h>
#include <hip/hip_cooperative_groups.h>
#include <cstdio>
#include <cstdint>
namespace cg = cooperative_groups;
namespace pg8 {
#define PG8_LAS __attribute__((address_space(3)))
typedef unsigned short bf16_t;
typedef short bf16x8 __attribute__((ext_vector_type(8)));
typedef float f32x4 __attribute__((ext_vector_type(4)));
typedef unsigned u32x4 __attribute__((ext_vector_type(4)));
constexpr int BM = 256, BK = 64, HALF = 128, HTB = HALF * BK * 2  , STAGE_BYTES = 8 * HTB, NXCD = 8, WGM = 8;

__host__ __device__ __forceinline__ int lds_byte(int r, int c) { const int st = (r >> 4) * 2 + (c >> 5), rr = r & 15, cc = c & 31, ob = rr * 64 + cc * 2; return st * 1024 + (ob ^ (((ob >> 9) & 1) << 5)); }
__host__ __device__ __forceinline__ void stage_rc(int b, int& R, int& C) { const int st = b / 1024, sb = b % 1024, swz = sb ^ (((sb >> 9) & 1) << 5); R = (st >> 1) * 16 + swz / 64; C = (st & 1) * 32 + (swz % 64) / 2; }
__host__ __device__ __forceinline__ int perm32(int rho) { const int n = rho >> 4, i = rho & 15; return 8 * (i >> 2) + 4 * n + (i & 3); }

struct Unit { int pm, pn; };
struct Gemm { const bf16_t* A; const bf16_t* Bt; int M, N, K; };

struct StaticOrder {
    int nM, nN, nwg, G, c;
    __host__ __device__ void init(int M, int N, int G_, int c_) { nM = M / BM; nN = N / BM; nwg = nM * nN; G = G_; c = c_; }
    __host__ __device__ bool next(int i, Unit& u) const {
        const long L = (long)i * G + c; if (L >= nwg) return false;
        int wgid = (int)L; { const int q = nwg / NXCD, r = nwg % NXCD, xcd = wgid % NXCD, off = wgid / NXCD; wgid = (xcd < r ? xcd * (q + 1) : r * (q + 1) + (xcd - r) * q) + off; }
        const int nig = WGM * nN, gid = wgid / nig, fm = gid * WGM, gsz = (nM - fm) < WGM ? (nM - fm) : WGM;
        u.pm = fm + ((wgid % nig) % gsz); u.pn = (wgid % nig) / gsz; return true;
    }
    __device__ __forceinline__ void a_ready(const Unit&) const {}
    __device__ __forceinline__ void done(const Unit&) const {}
};

__device__ __forceinline__ unsigned cvt_pk_bf16(float lo, float hi) { unsigned r; asm volatile("v_cvt_pk_bf16_f32 %0, %1, %2" : "=v"(r) : "v"(lo), "v"(hi)); return r; }
__device__ __forceinline__ float silu_f(float g) { return g * __builtin_amdgcn_rcpf(1.0f + __expf(-g)); }
struct EpiSwiGLU {
    static constexpr bool PERM = true, AFTER_DRAIN = false;
    bf16_t* O; int ldc;
    __device__ __forceinline__ void operator()(const f32x4 (&acc)[2][2][4][2], const Unit& u, int wr, int wc, int fr, int fq) const {
        const int row0 = u.pm * BM + wr * 64 + fr; const int col0 = u.pn * 128 + wc * 32 + 8 * fq;
#pragma unroll
        for (int ai = 0; ai < 2; ++ai)
#pragma unroll
            for (int m = 0; m < 4; ++m) { bf16_t* rowp = O + (size_t)(row0 + ai * HALF + m * 16) * ldc + col0;
                const f32x4 g0 = acc[ai][0][m][0], g1 = acc[ai][0][m][1], u0 = acc[ai][1][m][0], u1 = acc[ai][1][m][1];
                u32x4 w;
                w.x = cvt_pk_bf16(silu_f(g0[0]) * u0[0], silu_f(g0[1]) * u0[1]); w.y = cvt_pk_bf16(silu_f(g0[2]) * u0[2], silu_f(g0[3]) * u0[3]);
                w.z = cvt_pk_bf16(silu_f(g1[0]) * u1[0], silu_f(g1[1]) * u1[1]); w.w = cvt_pk_bf16(silu_f(g1[2]) * u1[2], silu_f(g1[3]) * u1[3]);
                *(u32x4*)rowp = w; }
    }
};
struct EpiRes {
    static constexpr bool PERM = false, AFTER_DRAIN = false;
    const float* base; float* out; int ldc; float scale;
    __device__ __forceinline__ void operator()(const f32x4 (&acc)[2][2][4][2], const Unit& u, int wr, int wc, int fr, int fq) const {
        const int row0 = u.pm * BM + wr * 64 + fr; const int col0 = u.pn * BM + wc * 32 + 4 * fq;
#pragma unroll
        for (int ai = 0; ai < 2; ++ai)
#pragma unroll
            for (int m = 0; m < 4; ++m) { const size_t off = (size_t)(row0 + ai * HALF + m * 16) * ldc + col0;
#pragma unroll
                for (int bj = 0; bj < 2; ++bj)
#pragma unroll
                    for (int n = 0; n < 2; ++n) { const f32x4 b = *(const f32x4*)(base + off + bj * HALF + n * 16); *(f32x4*)(out + off + bj * HALF + n * 16) = b + acc[ai][bj][m][n] * scale; }
                asm volatile("" ::: "memory"); }
    }
};
struct EpiStoreBf16 {
    static constexpr bool PERM = true, AFTER_DRAIN = false;
    bf16_t* O; int ldc;
    __device__ __forceinline__ void operator()(const f32x4 (&acc)[2][2][4][2], const Unit& u, int wr, int wc, int fr, int fq) const {
        const int row0 = u.pm * BM + wr * 64 + fr; const int col0 = u.pn * BM + wc * 32 + 8 * fq;
#pragma unroll
        for (int ai = 0; ai < 2; ++ai)
#pragma unroll
            for (int m = 0; m < 4; ++m) { bf16_t* rowp = O + (size_t)(row0 + ai * HALF + m * 16) * ldc + col0;
#pragma unroll
                for (int bj = 0; bj < 2; ++bj) { const f32x4 v0 = acc[ai][bj][m][0], v1 = acc[ai][bj][m][1]; u32x4 w;
                    w.x = cvt_pk_bf16(v0[0], v0[1]); w.y = cvt_pk_bf16(v0[2], v0[3]); w.z = cvt_pk_bf16(v1[0], v1[1]); w.w = cvt_pk_bf16(v1[2], v1[3]);
                    *(u32x4*)(rowp + bj * HALF) = w; } }
    }
};
template <class Epi, class Sched, bool ALIGN_EPI = false, bool SP2 = false>
__device__ __forceinline__ void gemm_phase(PG8_LAS unsigned char* lds, const Gemm g, const Sched& S, const Epi& E) {
    const int tid = threadIdx.x, wid = __builtin_amdgcn_readfirstlane(tid >> 6), lane = tid & 63, wr = wid >> 2, wc = wid & 3, fr = lane & 15, fq = lane >> 4;
    const int K = g.K, nt = K / BK;
    unsigned voffA[2], voffB[2];
#pragma unroll
    for (int i = 0; i < 2; ++i) { int R, C; stage_rc(tid * 16 + i * 8192, R, C); const int Rb = Epi::PERM ? ((R & ~31) + perm32(R & 31)) : R;
        voffA[i] = (unsigned)(R * K + C) * 2u; voffB[i] = (unsigned)(Rb * K + C) * 2u; }
    const size_t kstep = (size_t)(BK * 2);
    const size_t hstep = (size_t)HALF * K * 2;
    const size_t tstep = 2 * hstep;
    const unsigned ldsw = (unsigned)wid * 1024u;
    const int aoff = lds_byte(wr * 64 + fr, fq * 8), boff = lds_byte(wc * 32 + fr, fq * 8);
#define PG8_SA(b, h) (((b) * 2 + (h)) * HTB)
#define PG8_SB(b, h) ((4 + (b) * 2 + (h)) * HTB)
#define PG8_STAGE(bufoff, gbase, voff) do { _Pragma("unroll") for (int _i = 0; _i < 2; ++_i) \
        __builtin_amdgcn_global_load_lds((const unsigned*)((const char*)(gbase) + (voff)[_i]), (PG8_LAS unsigned*)(lds + (bufoff) + ldsw + _i * 8192), 16, 0, 0); } while (0)
#define PG8_LDA(dst, b, h) do { _Pragma("unroll") for (int m = 0; m < 4; ++m) _Pragma("unroll") for (int k = 0; k < 2; ++k) dst[m][k] = *(const PG8_LAS bf16x8*)(lds + PG8_SA(b, h) + aoff + m * 2048 + k * 1024); } while (0)
#define PG8_LDB(dst, b, h) do { _Pragma("unroll") for (int n = 0; n < 2; ++n) _Pragma("unroll") for (int k = 0; k < 2; ++k) dst[n][k] = *(const PG8_LAS bf16x8*)(lds + PG8_SB(b, h) + boff + n * 2048 + k * 1024); } while (0)
#define PG8_MMA(ai, bj, At, Bt) do { __builtin_amdgcn_s_setprio(1); _Pragma("unroll") for (int m = 0; m < 4; ++m) _Pragma("unroll") for (int n = 0; n < 2; ++n) _Pragma("unroll") for (int k = 0; k < 2; ++k) \
        acc[ai][bj][m][n] = __builtin_amdgcn_mfma_f32_16x16x32_bf16(Bt[n][k], At[m][k], acc[ai][bj][m][n], 0, 0, 0); __builtin_amdgcn_s_setprio(0); } while (0)
#define PG8_WAIT_V(n) asm volatile("s_waitcnt vmcnt(" #n ")" ::: "memory")
#define PG8_WAIT_L(n) asm volatile("s_waitcnt lgkmcnt(" #n ")" ::: "memory")
#define PG8_BAR __builtin_amdgcn_s_barrier()
#define PG8_SCHED __builtin_amdgcn_sched_barrier(0)
    Unit cur, nxt; int ui = 0;
    if (!S.next(0, cur)) return;
    f32x4 acc[2][2][4][2];
#pragma unroll
    for (int a = 0; a < 2; ++a)
#pragma unroll
        for (int b = 0; b < 2; ++b)
#pragma unroll
            for (int m = 0; m < 4; ++m)
#pragma unroll
                for (int n = 0; n < 2; ++n) acc[a][b][m][n] = (f32x4){0.f, 0.f, 0.f, 0.f};
    bf16x8 At[4][2], B0[2][2], B1[2][2];
    const char* cA = (const char*)g.A + (size_t)cur.pm * tstep; const char* cB = (const char*)g.Bt + (size_t)cur.pn * tstep;
    S.a_ready(cur);
    if constexpr (SP2) {
        PG8_STAGE(PG8_SB(0, 0), cB, voffB); PG8_STAGE(PG8_SB(0, 1), cB + hstep, voffB); PG8_STAGE(PG8_SA(0, 0), cA, voffA); PG8_STAGE(PG8_SA(0, 1), cA + hstep, voffA);
        if (wr == 1) PG8_BAR;
        PG8_WAIT_V(2); PG8_BAR;
        PG8_STAGE(PG8_SB(1, 0), cB + kstep, voffB); PG8_STAGE(PG8_SA(1, 0), cA + kstep, voffA); PG8_STAGE(PG8_SB(1, 1), cB + hstep + kstep, voffB);
        PG8_WAIT_V(6); PG8_BAR;
    } else {
        PG8_STAGE(PG8_SB(0, 0), cB, voffB); PG8_STAGE(PG8_SA(0, 0), cA, voffA); PG8_STAGE(PG8_SB(0, 1), cB + hstep, voffB); PG8_STAGE(PG8_SA(0, 1), cA + hstep, voffA);
        if (wr == 1) PG8_BAR;
        PG8_WAIT_V(4); PG8_BAR;
        PG8_STAGE(PG8_SB(1, 0), cB + kstep, voffB); PG8_STAGE(PG8_SA(1, 0), cA + kstep, voffA); PG8_STAGE(PG8_SB(1, 1), cB + hstep + kstep, voffB);
        PG8_WAIT_V(6); PG8_BAR;
    }
    for (;;) {
        const bool has_next = S.next(ui + 1, nxt);
        const char* nA = has_next ? (const char*)g.A + (size_t)nxt.pm * tstep : cA; const char* nB = has_next ? (const char*)g.Bt + (size_t)nxt.pn * tstep : cB;
        for (int t = 0; t < nt; t += 2) {
            const bool last = (t == nt - 2);
            const char* a1 = cA + (size_t)(t + 1) * kstep;
            const char* a2 = last ? nA : cA + (size_t)(t + 2) * kstep; const char* b2 = last ? nB : cB + (size_t)(t + 2) * kstep;
            const char* a3 = a2 + kstep; const char* b3 = b2 + kstep;
            if (last && has_next) S.a_ready(nxt);
            if constexpr (SP2) {
            PG8_LDB(B0, 0, 0); PG8_LDB(B1, 0, 1); PG8_SCHED; PG8_LDA(At, 0, 0); PG8_STAGE(PG8_SA(1, 1), a1 + hstep, voffA);
            PG8_WAIT_V(8); PG8_WAIT_L(0); PG8_BAR; PG8_MMA(0, 0, At, B0); PG8_MMA(0, 1, At, B1); PG8_BAR; PG8_SCHED;
            PG8_LDA(At, 0, 1); PG8_STAGE(PG8_SB(0, 0), b2, voffB); PG8_STAGE(PG8_SB(0, 1), b2 + hstep, voffB); PG8_STAGE(PG8_SA(0, 0), a2, voffA);
            PG8_WAIT_V(8); PG8_WAIT_L(0); PG8_BAR; PG8_MMA(1, 0, At, B0); PG8_MMA(1, 1, At, B1); PG8_BAR; PG8_SCHED;
            PG8_LDB(B0, 1, 0); PG8_LDB(B1, 1, 1); PG8_SCHED; PG8_LDA(At, 1, 0); PG8_STAGE(PG8_SA(0, 1), a2 + hstep, voffA);
            PG8_WAIT_V(8); PG8_WAIT_L(0); PG8_BAR; PG8_MMA(0, 0, At, B0); PG8_MMA(0, 1, At, B1); PG8_BAR; PG8_SCHED;
            PG8_LDA(At, 1, 1); PG8_STAGE(PG8_SB(1, 0), b3, voffB); PG8_STAGE(PG8_SB(1, 1), b3 + hstep, voffB); PG8_STAGE(PG8_SA(1, 0), a3, voffA);
            PG8_WAIT_V(8); PG8_WAIT_L(0); PG8_BAR; PG8_MMA(1, 0, At, B0); PG8_MMA(1, 1, At, B1); PG8_BAR; PG8_SCHED;
            } else {
            PG8_LDB(B0, 0, 0); PG8_SCHED; PG8_LDA(At, 0, 0); PG8_STAGE(PG8_SA(1, 1), a1 + hstep, voffA);
            PG8_WAIT_L(8); PG8_BAR; PG8_WAIT_L(0); PG8_MMA(0, 0, At, B0); PG8_BAR; PG8_SCHED;
            PG8_LDB(B1, 0, 1); PG8_STAGE(PG8_SB(0, 0), b2, voffB);
            PG8_BAR; PG8_WAIT_L(0); PG8_MMA(0, 1, At, B1); PG8_BAR;
            PG8_LDA(At, 0, 1); PG8_STAGE(PG8_SA(0, 0), a2, voffA);
            PG8_BAR; PG8_WAIT_L(0); PG8_MMA(1, 0, At, B0); PG8_BAR; PG8_SCHED;
            PG8_STAGE(PG8_SB(0, 1), b2 + hstep, voffB);
            PG8_WAIT_V(6); PG8_BAR; PG8_MMA(1, 1, At, B1); PG8_BAR;
            PG8_LDB(B0, 1, 0); PG8_SCHED; PG8_LDA(At, 1, 0); PG8_STAGE(PG8_SA(0, 1), a2 + hstep, voffA);
            PG8_WAIT_L(8); PG8_BAR; PG8_WAIT_L(0); PG8_MMA(0, 0, At, B0); PG8_BAR; PG8_SCHED;
            PG8_LDB(B1, 1, 1); PG8_STAGE(PG8_SB(1, 0), b3, voffB);
            PG8_BAR; PG8_WAIT_L(0); PG8_MMA(0, 1, At, B1); PG8_BAR;
            PG8_LDA(At, 1, 1); PG8_STAGE(PG8_SA(1, 0), a3, voffA);
            PG8_BAR; PG8_WAIT_L(0); PG8_MMA(1, 0, At, B0); PG8_BAR; PG8_SCHED;
            PG8_STAGE(PG8_SB(1, 1), b3 + hstep, voffB);
            PG8_WAIT_V(6); PG8_BAR; PG8_MMA(1, 1, At, B1); PG8_BAR;
            }
        }
        if constexpr (ALIGN_EPI) { if (wr == 0) PG8_BAR; }
        if constexpr (!Epi::AFTER_DRAIN) { E(acc, cur, wr, wc, fr, fq); S.done(cur); }
        if (!has_next) break;
#pragma unroll
        for (int a = 0; a < 2; ++a)
#pragma unroll
            for (int b = 0; b < 2; ++b)
#pragma unroll
                for (int m = 0; m < 4; ++m)
#pragma unroll
                    for (int n = 0; n < 2; ++n) acc[a][b][m][n] = (f32x4){0.f, 0.f, 0.f, 0.f};
        cur = nxt; cA = nA; cB = nB; ++ui;
        if constexpr (ALIGN_EPI) { if (wr == 1) PG8_BAR; }
    }
    PG8_WAIT_V(0);
    if constexpr (!ALIGN_EPI) { if (wr == 0) PG8_BAR; }
    PG8_BAR;
    if constexpr (Epi::AFTER_DRAIN) { E.fused(acc, cur, wr, wc, fr, fq, lds, wid, lane); S.done(cur); }
#undef PG8_SA
#undef PG8_SB
#undef PG8_STAGE
#undef PG8_LDA
#undef PG8_LDB
#undef PG8_MMA
#undef PG8_WAIT_V
#undef PG8_WAIT_L
#undef PG8_BAR
#undef PG8_SCHED
}
}
constexpr int M = 16384, D = 1024, FF = 2816, NGU = 5632, NIN = 3584, SEQ = 4096;
constexpr int WIN_COLS = 3592;
constexpr size_t MiB = 1u << 20;
constexpr size_t WS_CTL = 0, CTL_BYTES = 4096;
constexpr size_t WS_WIN = 1 * MiB, WS_WOUT = 8 * MiB, WS_WGU2 = 10 * MiB, WS_WD2 = 21 * MiB;
constexpr size_t WS_XN = 27 * MiB;
constexpr size_t WS_ACT = 59 * MiB;
constexpr size_t WS_BD = 171 * MiB;
constexpr size_t WS_EG = 172 * MiB;
constexpr size_t WS_DN = 184 * MiB;
constexpr size_t WS_WGU1 = 184 * MiB, WS_WD1 = 195 * MiB;
constexpr size_t WS_QG = WS_DN, WS_KD = WS_DN + 16 * MiB, WS_U = WS_DN + 32 * MiB, WS_W = WS_DN + 48 * MiB, WS_A = WS_DN + 64 * MiB;
constexpr size_t WS_END = 256 * MiB;
constexpr int LDS_BYTES = 147456;
constexpr int NWAVES = 8;

#define GAS __attribute__((address_space(1)))
#define LAS __attribute__((address_space(3)))
typedef unsigned short bf16;
typedef unsigned v4u __attribute__((ext_vector_type(4)));
typedef unsigned v2u __attribute__((ext_vector_type(2)));
typedef float f32x4 __attribute__((ext_vector_type(4)));
typedef float f32x2 __attribute__((ext_vector_type(2)));
#define LDS_WAIT() asm volatile("s_waitcnt lgkmcnt(0)" ::: "memory")
__device__ __forceinline__ unsigned f2bf(float f) { unsigned u = __builtin_bit_cast(unsigned, f); return (u + 0x7fffu + ((u >> 16) & 1u)) >> 16; }
__device__ __forceinline__ unsigned pk2(float lo, float hi) { return f2bf(lo) | (f2bf(hi) << 16); }
__device__ __forceinline__ float bflo(unsigned u) { return __uint_as_float(u << 16); }
__device__ __forceinline__ float bfhi(unsigned u) { return __uint_as_float(u & 0xffff0000u); }
__device__ __forceinline__ float bf2f(bf16 v) { return __uint_as_float(((unsigned)v) << 16); }
__device__ __forceinline__ float wave_sum(float v) {
#pragma unroll
    for (int o = 1; o < 64; o <<= 1) v += __shfl_xor(v, o);
    return v;
}
__device__ __forceinline__ float wave_max(float v) {
#pragma unroll
    for (int o = 1; o < 64; o <<= 1) v = fmaxf(v, __shfl_xor(v, o));
    return v;
}

struct Args { const float* in[17]; float* out; unsigned char* ws; };

__device__ __forceinline__ void transpose_item(const float* src, int srcN, int srccol0, bf16* dst, int dstK, int dstrow0, int k0, LAS float* scr, int lane) {
#pragma unroll 8
    for (int i = 0; i < 32; ++i) { const int kk = 2 * i + (lane >> 5); scr[kk * 33 + (lane & 31)] = src[(size_t)(k0 + kk) * srcN + srccol0 + (lane & 31)]; }
    LDS_WAIT(); asm volatile("" ::: "memory");
    const int c = lane & 7;
#pragma unroll
    for (int j = 0; j < 4; ++j) { const int n = (lane >> 3) + 8 * j; const LAS float* s = scr + (8 * c) * 33 + n;
        v4u o; o.x = pk2(s[0 * 33], s[1 * 33]); o.y = pk2(s[2 * 33], s[3 * 33]); o.z = pk2(s[4 * 33], s[5 * 33]); o.w = pk2(s[6 * 33], s[7 * 33]);
        *(v4u*)(dst + (size_t)(dstrow0 + n) * dstK + k0 + 8 * c) = o; }
    LDS_WAIT(); asm volatile("" ::: "memory");
}
__device__ __forceinline__ void tr_gu(const float* gate, const float* up, bf16* dst, int r, LAS float* scr, int lane) {
    const int nblk = NGU / 32, kb = r / nblk, nb = r % nblk, dstrow0 = nb * 32, pn = dstrow0 >> 8, within = dstrow0 & 255;
    transpose_item(within < 128 ? gate : up, FF, pn * 128 + (within & 127), dst, D, dstrow0, kb * 64, scr, lane);
}
__device__ __forceinline__ void tr_plain(const float* src, int K, int N, bf16* dst, int r, LAS float* scr, int lane) {
    const int nblk = N / 32, kb = r / nblk, nb = r % nblk;
    transpose_item(src, N, nb * 32, dst, K, nb * 32, kb * 64, scr, lane);
}
__device__ __forceinline__ void tr_win(const float* src, bf16* dst, int r, LAS float* scr, int lane) {
    const int nblk = NIN / 32, kb = r / nblk, nb = r % nblk, dstrow0 = nb * 32;
    transpose_item(src, WIN_COLS, dstrow0 + (dstrow0 >= 3072 ? 8 : 0), dst, D, dstrow0, kb * 64, scr, lane);
}

__device__ __forceinline__ void rms_row(const float* xrow, const float* gain, int lane, f32x4 (&v)[4]) {
    const f32x4* xr = (const f32x4*)xrow + lane; const f32x4* gr = (const f32x4*)gain + lane;
    float s = 0.f;
#pragma unroll
    for (int j = 0; j < 4; ++j) { v[j] = xr[64 * j]; s += (v[j].x * v[j].x + v[j].y * v[j].y) + (v[j].z * v[j].z + v[j].w * v[j].w); }
    const float rs = 1.0f / sqrtf(wave_sum(s) * (1.f / D) + 1e-6f);
#pragma unroll
    for (int j = 0; j < 4; ++j) { const f32x4 g = gr[64 * j]; v[j] = v[j] * rs * g; }
}
__device__ __forceinline__ void store_row_bf16(bf16* orow, int lane, const f32x4 (&v)[4]) {
    v2u* o8 = (v2u*)orow + lane;
#pragma unroll
    for (int j = 0; j < 4; ++j) { v2u w; w.x = pk2(v[j].x, v[j].y); w.y = pk2(v[j].z, v[j].w); o8[64 * j] = w; }
}

constexpr int LP = 132;
__device__ __forceinline__ void dn_prep_item(const Args& a, LAS float* L, int ch, int tid, int lane, int wave) {
    unsigned char* ws = a.ws;
    const bf16* PROJ = (const bf16*)(ws + WS_ACT);
    const float* BD = (const float*)(ws + WS_BD);
    const float* conv_w = a.in[7]; const float* a_log = a.in[8]; const float* dt_bias = a.in[9];
    const int bh = ch >> 6, n = ch & 63, b = bh >> 2, h = bh & 3;
    const int tok0 = b * SEQ + n * 64;
    LAS float* qs = L; LAS float* ks = L + 64 * LP; LAS float* vs = L + 2 * 64 * LP; LAS float* As = L + 3 * 64 * LP; LAS float* gcs = As + 64 * 65; LAS float* bts = gcs + 64;
    {
        float cw[3][4][2];
#pragma unroll
        for (int sec = 0; sec < 3; ++sec)
#pragma unroll
            for (int j = 0; j < 4; ++j) { const f32x2 w = *(const f32x2*)(conv_w + j * 1536 + sec * 512 + h * 128 + 2 * lane); cw[sec][j][0] = w.x; cw[sec][j][1] = w.y; }
        for (int rr = 0; rr < 8; ++rr) {
            const int r = wave * 8 + rr, tok = tok0 + r, s = n * 64 + r;
            float val[3][2] = {{0.f, 0.f}, {0.f, 0.f}, {0.f, 0.f}};
#pragma unroll
            for (int j = 0; j < 4; ++j) {
                if (s - 3 + j >= 0) {
#pragma unroll
                    for (int sec = 0; sec < 3; ++sec) { const unsigned w = *(const unsigned*)(PROJ + (size_t)(tok - 3 + j) * NIN + 1536 + sec * 512 + h * 128 + 2 * lane);
                        val[sec][0] += bflo(w) * cw[sec][j][0]; val[sec][1] += bfhi(w) * cw[sec][j][1]; }
                }
            }
#pragma unroll
            for (int sec = 0; sec < 3; ++sec) { val[sec][0] = val[sec][0] / (1.f + __expf(-val[sec][0])); val[sec][1] = val[sec][1] / (1.f + __expf(-val[sec][1])); }
            const float ssq = wave_sum(val[0][0] * val[0][0] + val[0][1] * val[0][1]);
            const float ssk = wave_sum(val[1][0] * val[1][0] + val[1][1] * val[1][1]);
            const float rq = (1.0f / sqrtf(ssq + 1e-6f)) * 0.08838834764831845f, rk = 1.0f / sqrtf(ssk + 1e-6f);
            *(LAS f32x2*)(qs + r * LP + 2 * lane) = (f32x2){val[0][0] * rq, val[0][1] * rq};
            *(LAS f32x2*)(ks + r * LP + 2 * lane) = (f32x2){val[1][0] * rk, val[1][1] * rk};
            *(LAS f32x2*)(vs + r * LP + 2 * lane) = (f32x2){val[2][0], val[2][1]};
        }
    }
    if (wave == 0) {
        const int tok = tok0 + lane;
        const float braw = BD[(size_t)tok * 8 + h], draw = BD[(size_t)tok * 8 + 4 + h] + dt_bias[h];
        const float sp = fmaxf(draw, 0.f) + log1pf(__expf(-fabsf(draw)));
        float g = -expf(a_log[h]) * sp;
#pragma unroll
        for (int o = 1; o < 64; o <<= 1) { const float t = __shfl_up(g, o); if (lane >= o) g += t; }
        gcs[lane] = g; bts[lane] = 1.0f / (1.0f + __expf(-braw));
        if (lane == 63) ((float*)(ws + WS_EG))[ch] = expf(g);
    }
    __syncthreads();
    {
        const int c = tid >> 3, jg = tid & 7;
        float accA[8], accP[8];
#pragma unroll
        for (int jj = 0; jj < 8; ++jj) { accA[jj] = 0.f; accP[jj] = 0.f; }
        for (int d4 = 0; d4 < 32; ++d4) {
            const f32x4 kc = *(const LAS f32x4*)(ks + c * LP + 4 * d4), qc = *(const LAS f32x4*)(qs + c * LP + 4 * d4);
#pragma unroll
            for (int jj = 0; jj < 8; ++jj) { const f32x4 kj = *(const LAS f32x4*)(ks + (jg + 8 * jj) * LP + 4 * d4);
                accA[jj] += (kc.x * kj.x + kc.y * kj.y) + (kc.z * kj.z + kc.w * kj.w);
                accP[jj] += (qc.x * kj.x + qc.y * kj.y) + (qc.z * kj.z + qc.w * kj.w); }
        }
        const float gcc = gcs[c], bc = bts[c];
        bf16* Aout = (bf16*)(ws + WS_A) + (size_t)ch * 4096;
#pragma unroll
        for (int jj = 0; jj < 8; ++jj) { const int j = jg + 8 * jj; const float dec = (j <= c) ? __expf(gcc - gcs[j]) : 0.f;
            As[c * 65 + j] = (j < c) ? bc * accA[jj] * dec : 0.f;
            Aout[c * 64 + j] = (bf16)f2bf((j <= c) ? accP[jj] * dec : 0.f); }
        const float glast = gcs[63];
        bf16* QG = (bf16*)(ws + WS_QG) + (size_t)ch * 8192; bf16* KD = (bf16*)(ws + WS_KD) + (size_t)ch * 8192;
#pragma unroll
        for (int i = 0; i < 8; ++i) { const int idx2 = tid + 512 * i, cc = idx2 >> 6, d = (idx2 & 63) * 2;
            const float eq = __expf(gcs[cc]), ek = __expf(glast - gcs[cc]);
            const f32x2 qv = *(const LAS f32x2*)(qs + cc * LP + d), kv = *(const LAS f32x2*)(ks + cc * LP + d);
            *(unsigned*)(QG + cc * 128 + d) = pk2(qv.x * eq, qv.y * eq); *(unsigned*)(KD + cc * 128 + d) = pk2(kv.x * ek, kv.y * ek); }
    }
    __syncthreads();
#pragma unroll
    for (int i = 0; i < 8; ++i) { const int idx2 = tid + 512 * i, cc = idx2 >> 6, d = (idx2 & 63) * 2;
        const float be = bts[cc], bek = be * __expf(gcs[cc]);
        const f32x2 vv = *(const LAS f32x2*)(vs + cc * LP + d), kv = *(const LAS f32x2*)(ks + cc * LP + d);
        *(LAS f32x2*)(vs + cc * LP + d) = (f32x2){vv.x * be, vv.y * be}; *(LAS f32x2*)(qs + cc * LP + d) = (f32x2){kv.x * bek, kv.y * bek}; }
    __syncthreads();
    if (tid < 256) {
        LAS float* buf = (tid < 128 ? vs : qs) + (tid & 127);
        for (int c = 1; c < 64; ++c) {
            float acc = buf[c * LP];
            for (int j = 0; j < c; ++j) acc -= As[c * 65 + j] * buf[j * LP];
            buf[c * LP] = acc;
        }
    }
    __syncthreads();
    {
        bf16* U = (bf16*)(ws + WS_U) + (size_t)ch * 8192; bf16* W = (bf16*)(ws + WS_W) + (size_t)ch * 8192;
#pragma unroll
        for (int i = 0; i < 8; ++i) { const int idx2 = tid + 512 * i, cc = idx2 >> 6, d = (idx2 & 63) * 2;
            const f32x2 uv = *(const LAS f32x2*)(vs + cc * LP + d), wv = *(const LAS f32x2*)(qs + cc * LP + d);
            *(unsigned*)(U + cc * 128 + d) = pk2(uv.x, uv.y); *(unsigned*)(W + cc * 128 + d) = pk2(wv.x, wv.y); }
    }
    __syncthreads();
}

__device__ __forceinline__ void ld8_to_lds(const bf16* g, LAS float* d) {
    const v4u w = *(const v4u*)g;
    *(LAS f32x4*)d = (f32x4){bflo(w.x), bfhi(w.x), bflo(w.y), bfhi(w.y)}; *(LAS f32x4*)(d + 4) = (f32x4){bflo(w.z), bfhi(w.z), bflo(w.w), bfhi(w.w)};
}
__device__ __forceinline__ void dn_scan_block(const Args& a, LAS float* L, int item, int tid) {
    unsigned char* ws = a.ws;
    const int bh = item >> 3, sl = item & 7, b = bh >> 2, h = bh & 3;
    LAS float* S = L;
    LAS float* wS = L + 2176;
    LAS float* qS = wS + 64 * LP; LAS float* kS = qS + 64 * LP;
    LAS float* aS = kS + 64 * LP;
    LAS float* uS = aS + 64 * 68;
    LAS float* vN = uS + 64 * 17;
    bf16* MIX = (bf16*)(ws + WS_XN);
    const float* EG = (const float*)(ws + WS_EG);
    for (int i = tid; i < 128 * 17; i += 512) S[i] = 0.f;
    for (int n = 0; n < 64; ++n) {
        const int ch = bh * 64 + n;
        const bf16* QG = (const bf16*)(ws + WS_QG) + (size_t)ch * 8192; const bf16* KD = (const bf16*)(ws + WS_KD) + (size_t)ch * 8192;
        const bf16* U = (const bf16*)(ws + WS_U) + (size_t)ch * 8192; const bf16* W = (const bf16*)(ws + WS_W) + (size_t)ch * 8192;
        const bf16* Ag = (const bf16*)(ws + WS_A) + (size_t)ch * 4096;
#pragma unroll
        for (int i = 0; i < 2; ++i) { const int p = tid + 512 * i, row = p >> 4, c8 = (p & 15) * 8;
            ld8_to_lds(W + row * 128 + c8, wS + row * LP + c8); ld8_to_lds(QG + row * 128 + c8, qS + row * LP + c8); ld8_to_lds(KD + row * 128 + c8, kS + row * LP + c8); }
        { const int row = tid >> 3, c8 = (tid & 7) * 8; ld8_to_lds(Ag + row * 64 + c8, aS + row * 68 + c8); }
        if (tid < 128) { const int row = tid >> 1, c8 = (tid & 1) * 8; const v4u w = *(const v4u*)(U + row * 128 + sl * 16 + c8); LAS float* d = uS + row * 17 + c8;
            d[0] = bflo(w.x); d[1] = bfhi(w.x); d[2] = bflo(w.y); d[3] = bfhi(w.y); d[4] = bflo(w.z); d[5] = bfhi(w.z); d[6] = bflo(w.w); d[7] = bfhi(w.w); }
        const float eg = EG[ch];
        __syncthreads();
        const int c = tid >> 3, j = (tid & 7) * 2;
        {
            float a0 = uS[c * 17 + j], a1 = uS[c * 17 + j + 1];
            for (int k4 = 0; k4 < 32; ++k4) { const f32x4 wv = *(const LAS f32x4*)(wS + c * LP + 4 * k4); const LAS float* sp = S + (4 * k4) * 17 + j;
                a0 -= wv.x * sp[0] + wv.y * sp[17] + wv.z * sp[34] + wv.w * sp[51]; a1 -= wv.x * sp[1] + wv.y * sp[18] + wv.z * sp[35] + wv.w * sp[52]; }
            vN[c * 17 + j] = a0; vN[c * 17 + j + 1] = a1;
        }
        __syncthreads();
        {
            float o0 = 0.f, o1 = 0.f;
            for (int k4 = 0; k4 < 32; ++k4) { const f32x4 qv = *(const LAS f32x4*)(qS + c * LP + 4 * k4); const LAS float* sp = S + (4 * k4) * 17 + j;
                o0 += qv.x * sp[0] + qv.y * sp[17] + qv.z * sp[34] + qv.w * sp[51]; o1 += qv.x * sp[1] + qv.y * sp[18] + qv.z * sp[35] + qv.w * sp[52]; }
            for (int i4 = 0; i4 < 16; ++i4) { const f32x4 av = *(const LAS f32x4*)(aS + c * 68 + 4 * i4); const LAS float* vp = vN + (4 * i4) * 17 + j;
                o0 += av.x * vp[0] + av.y * vp[17] + av.z * vp[34] + av.w * vp[51]; o1 += av.x * vp[1] + av.y * vp[18] + av.z * vp[35] + av.w * vp[52]; }
            *(unsigned*)(MIX + (size_t)(b * SEQ + n * 64 + c) * 1024 + 512 + h * 128 + sl * 16 + j) = pk2(o0, o1);
        }
        const int k = tid >> 2, j4 = (tid & 3) * 4;
        float s0 = S[k * 17 + j4] * eg, s1 = S[k * 17 + j4 + 1] * eg, s2 = S[k * 17 + j4 + 2] * eg, s3 = S[k * 17 + j4 + 3] * eg;
        for (int cc = 0; cc < 64; ++cc) { const float kv = kS[cc * LP + k]; const LAS float* vp = vN + cc * 17 + j4;
            s0 += kv * vp[0]; s1 += kv * vp[1]; s2 += kv * vp[2]; s3 += kv * vp[3]; }
        __syncthreads();
        S[k * 17 + j4] = s0; S[k * 17 + j4 + 1] = s1; S[k * 17 + j4 + 2] = s2; S[k * 17 + j4 + 3] = s3;
    }
    __syncthreads();
}

__device__ __forceinline__ void attn_naive_tokens(const bf16* PROJ, bf16* MIX, LAS float* sP, int tok_begin, int ntok, int h, int lane) {
    const float slope = exp2f(-(float)(h + 1));
    for (int tt = 0; tt < ntok; ++tt) {
        const int tok = tok_begin + tt, s = tok & (SEQ - 1);
        const bf16* qrow = PROJ + (size_t)tok * NIN + h * 64;
        float q[64];
#pragma unroll
        for (int i = 0; i < 8; ++i) { const v4u w = *(const v4u*)(qrow + 8 * i);
            q[8 * i + 0] = bflo(w.x); q[8 * i + 1] = bfhi(w.x); q[8 * i + 2] = bflo(w.y); q[8 * i + 3] = bfhi(w.y);
            q[8 * i + 4] = bflo(w.z); q[8 * i + 5] = bfhi(w.z); q[8 * i + 6] = bflo(w.w); q[8 * i + 7] = bfhi(w.w); }
        float mx = -INFINITY;
        for (int e = 0; e < 9; ++e) {
            const int p = e / 3, r = e - 3 * p, dil = 1 << (2 * p), j = r * 64 + lane;
            float sc = -INFINITY;
            if (j <= 128 && s - j * dil >= 0) {
                const bf16* krow = PROJ + (size_t)(tok - j * dil) * NIN + 512 + h * 64;
                float acc = 0.f;
#pragma unroll
                for (int i = 0; i < 8; ++i) { const v4u w = *(const v4u*)(krow + 8 * i);
                    acc += q[8 * i + 0] * bflo(w.x) + q[8 * i + 1] * bfhi(w.x) + q[8 * i + 2] * bflo(w.y) + q[8 * i + 3] * bfhi(w.y)
                         + q[8 * i + 4] * bflo(w.z) + q[8 * i + 5] * bfhi(w.z) + q[8 * i + 6] * bflo(w.w) + q[8 * i + 7] * bfhi(w.w); }
                sc = acc * 0.125f - slope * (float)(j * dil);
            }
            sP[e * 64 + lane] = sc; mx = fmaxf(mx, sc);
        }
        mx = wave_max(mx);
        float lsum = 0.f;
        for (int e = 0; e < 9; ++e) { const float pv = __expf(sP[e * 64 + lane] - mx); sP[e * 64 + lane] = pv; lsum += pv; }
        lsum = wave_sum(lsum);
        LDS_WAIT(); asm volatile("" ::: "memory");
        float o = 0.f;
        for (int p = 0; p < 3; ++p) {
            const int dil = 1 << (2 * p); int jmax = s >> (2 * p); jmax = jmax < 128 ? jmax : 128;
            const bf16* vbase = PROJ + (size_t)tok * NIN + 1024 + h * 64 + lane;
#pragma unroll 4
            for (int j = 0; j <= jmax; ++j) o += sP[p * 192 + j] * bf2f(*(vbase - (size_t)(j * dil) * NIN));
        }
        MIX[(size_t)tok * 1024 + h * 64 + lane] = (bf16)f2bf(o / lsum);
        LDS_WAIT(); asm volatile("" ::: "memory");
    }
}

__global__ void __launch_bounds__(NWAVES * 64, 2) fwd_megakernel(Args a) {
    extern __shared__ __attribute__((aligned(16))) unsigned char lds[];
    cg::grid_group grid = cg::this_grid();
    LAS unsigned char* L8 = (LAS unsigned char*)lds;
    LAS float* L = (LAS float*)lds;
    const int tid = threadIdx.x, lane = tid & 63, wave = __builtin_amdgcn_readfirstlane(tid >> 6);
    const int G = gridDim.x, gw = blockIdx.x * NWAVES + wave, NGW = G * NWAVES;
    unsigned char* ws = a.ws;
    unsigned* ctl = (unsigned*)(ws + WS_CTL);
    const float* x = a.in[0];
    bf16* XN = (bf16*)(ws + WS_XN); bf16* ACT = (bf16*)(ws + WS_ACT); bf16* PROJ = ACT; bf16* MIX = XN;
    bf16* Wgu1 = (bf16*)(ws + WS_WGU1); bf16* Wd1 = (bf16*)(ws + WS_WD1); bf16* Win = (bf16*)(ws + WS_WIN); bf16* Wout = (bf16*)(ws + WS_WOUT);
    bf16* Wgu2 = (bf16*)(ws + WS_WGU2); bf16* Wd2 = (bf16*)(ws + WS_WD2);
    float* out = a.out;

    {
        LAS float* scr = L + wave * 4096;
        constexpr int I_GU = (D / 64) * (NGU / 32), I_D = (FF / 64) * (D / 32), I_IN = (D / 64) * (NIN / 32), I_O = (D / 64) * (D / 32);
        constexpr int NITEMS = 2 * I_GU + 2 * I_D + I_IN + I_O;
        for (int it = gw; it < NITEMS; it += NGW) {
            int r = it;
            if (r < I_GU) { tr_gu(a.in[2], a.in[3], Wgu1, r, scr, lane); continue; } r -= I_GU;
            if (r < I_D) { tr_plain(a.in[4], FF, D, Wd1, r, scr, lane); continue; } r -= I_D;
            if (r < I_IN) { tr_win(a.in[6], Win, r, scr, lane); continue; } r -= I_IN;
            if (r < I_O) { tr_plain(a.in[11], D, D, Wout, r, scr, lane); continue; } r -= I_O;
            if (r < I_GU) { tr_gu(a.in[13], a.in[14], Wgu2, r, scr, lane); continue; } r -= I_GU;
            tr_plain(a.in[15], FF, D, Wd2, r, scr, lane);
        }
        for (int m = gw; m < M; m += NGW) { f32x4 v[4]; rms_row(x + (size_t)m * D, a.in[1], lane, v); store_row_bf16(XN + (size_t)m * D, lane, v); }
    }
    grid.sync();
    {
        pg8::Gemm g{XN, Wgu1, M, NGU, D}; pg8::StaticOrder S; S.init(M, NGU, G, (int)blockIdx.x);
        pg8::EpiSwiGLU E{ACT, FF};
        pg8::gemm_phase<pg8::EpiSwiGLU, pg8::StaticOrder, true, true>(L8, g, S, E);
    }
    grid.sync();
    {
        pg8::Gemm g{ACT, Wd1, M, D, FF}; pg8::StaticOrder S; S.init(M, D, G, (int)blockIdx.x);
        pg8::EpiRes E{x, out, D, 0.5f};
        pg8::gemm_phase<pg8::EpiRes, pg8::StaticOrder, true, true>(L8, g, S, E);
    }
    grid.sync();
    {
        const float* w_in = a.in[6]; float* BD = (float*)(ws + WS_BD);
        for (int m = gw; m < M; m += NGW) {
            f32x4 v[4]; rms_row(out + (size_t)m * D, a.in[5], lane, v); store_row_bf16(XN + (size_t)m * D, lane, v);
            float acc[8];
#pragma unroll
            for (int o = 0; o < 8; ++o) acc[o] = 0.f;
#pragma unroll
            for (int j = 0; j < 4; ++j)
#pragma unroll
                for (int i = 0; i < 4; ++i) { const int k = 4 * (lane + 64 * j) + i; const f32x4 w0 = *(const f32x4*)(w_in + (size_t)k * WIN_COLS + 3072), w1 = *(const f32x4*)(w_in + (size_t)k * WIN_COLS + 3076);
                    const float hv = v[j][i];
                    acc[0] += hv * w0.x; acc[1] += hv * w0.y; acc[2] += hv * w0.z; acc[3] += hv * w0.w; acc[4] += hv * w1.x; acc[5] += hv * w1.y; acc[6] += hv * w1.z; acc[7] += hv * w1.w; }
#pragma unroll
            for (int o = 0; o < 8; ++o) acc[o] = wave_sum(acc[o]);
            if (lane == 0) { *(f32x4*)(BD + (size_t)m * 8) = (f32x4){acc[0], acc[1], acc[2], acc[3]}; *(f32x4*)(BD + (size_t)m * 8 + 4) = (f32x4){acc[4], acc[5], acc[6], acc[7]}; }
        }
    }
    grid.sync();
    {
        pg8::Gemm g{XN, Win, M, NIN, D}; pg8::StaticOrder S; S.init(M, NIN, G, (int)blockIdx.x);
        pg8::EpiStoreBf16 E{PROJ, NIN};
        pg8::gemm_phase<pg8::EpiStoreBf16, pg8::StaticOrder, true, true>(L8, g, S, E);
    }
    grid.sync();
    for (int ch = blockIdx.x; ch < 1024; ch += G) dn_prep_item(a, L, ch, tid, lane, wave);
    grid.sync();
    {
        for (int it = blockIdx.x; it < 128; it += G) dn_scan_block(a, L, it, tid);
        LAS unsigned* bc = (LAS unsigned*)(L + 8 * 576);
        LAS float* sP = L + wave * 576;
        for (;;) {
            if (tid == 0) bc[0] = atomicAdd(ctl + 64, 1u);
            __syncthreads();
            const unsigned item = bc[0];
            __syncthreads();
            if (item >= 1024u) break;
            attn_naive_tokens(PROJ, MIX, sP, (int)item * 16, 16, wave, lane);
        }
    }
    grid.sync();
    {
        const float* dn_norm = a.in[10];
        for (int m = gw; m < M; m += NGW) {
            bf16* op = MIX + (size_t)m * 1024 + 512 + 8 * lane; const bf16* gp = PROJ + (size_t)m * NIN + 3072 + 8 * lane;
            const v4u ow = *(const v4u*)op, gwv = *(const v4u*)gp;
            float o[8] = {bflo(ow.x), bfhi(ow.x), bflo(ow.y), bfhi(ow.y), bflo(ow.z), bfhi(ow.z), bflo(ow.w), bfhi(ow.w)};
            float gt[8] = {bflo(gwv.x), bfhi(gwv.x), bflo(gwv.y), bfhi(gwv.y), bflo(gwv.z), bfhi(gwv.z), bflo(gwv.w), bfhi(gwv.w)};
            float ss = 0.f;
#pragma unroll
            for (int i = 0; i < 8; ++i) ss += o[i] * o[i];
            ss += __shfl_xor(ss, 1); ss += __shfl_xor(ss, 2); ss += __shfl_xor(ss, 4); ss += __shfl_xor(ss, 8);
            const float rs = 1.0f / sqrtf(ss * (1.f / 128.f) + 1e-6f);
            const int d0 = (8 * lane) & 127;
            float r[8];
#pragma unroll
            for (int i = 0; i < 8; ++i) r[i] = o[i] * rs * dn_norm[d0 + i] * (gt[i] / (1.f + __expf(-gt[i])));
            v4u w; w.x = pk2(r[0], r[1]); w.y = pk2(r[2], r[3]); w.z = pk2(r[4], r[5]); w.w = pk2(r[6], r[7]);
            *(v4u*)op = w;
        }
    }
    grid.sync();
    {
        pg8::Gemm g{MIX, Wout, M, D, D}; pg8::StaticOrder S; S.init(M, D, G, (int)blockIdx.x);
        pg8::EpiRes E{out, out, D, 1.0f};
        pg8::gemm_phase<pg8::EpiRes, pg8::StaticOrder, true, true>(L8, g, S, E);
    }
    grid.sync();
    for (int m = gw; m < M; m += NGW) { f32x4 v[4]; rms_row(out + (size_t)m * D, a.in[12], lane, v); store_row_bf16(XN + (size_t)m * D, lane, v); }
    grid.sync();
    {
        pg8::Gemm g{XN, Wgu2, M, NGU, D}; pg8::StaticOrder S; S.init(M, NGU, G, (int)blockIdx.x);
        pg8::EpiSwiGLU E{ACT, FF};
        pg8::gemm_phase<pg8::EpiSwiGLU, pg8::StaticOrder, true, true>(L8, g, S, E);
    }
    grid.sync();
    {
        pg8::Gemm g{ACT, Wd2, M, D, FF}; pg8::StaticOrder S; S.init(M, D, G, (int)blockIdx.x);
        pg8::EpiRes E{out, out, D, 0.5f};
        pg8::gemm_phase<pg8::EpiRes, pg8::StaticOrder, true, true>(L8, g, S, E);
    }
    grid.sync();
    for (int m = gw; m < M; m += NGW) {
        f32x4 v[4]; rms_row(out + (size_t)m * D, a.in[16], lane, v);
        f32x4* o = (f32x4*)(out + (size_t)m * D) + lane;
#pragma unroll
        for (int j = 0; j < 4; ++j) o[64 * j] = v[j];
    }
}

extern "C" void kernel_launch(void* const* d_in, const int* in_sizes, int n_in, void* d_out, int out_size, void* d_ws, size_t ws_size, hipStream_t stream) {
    static int grid = 0;
    if (grid == 0) {
        if (n_in != 17 || in_sizes[0] != M * D || out_size != M * D || ws_size < WS_END) { fprintf(stderr, "kernel_launch: unexpected shapes (n_in %d in0 %d out %d ws %zu)\n", n_in, n_in > 0 ? in_sizes[0] : -1, out_size, ws_size); grid = -1; return; }
        int dev = 0, cus = 0, per_cu = 0;
        hipGetDevice(&dev); hipDeviceGetAttribute(&cus, hipDeviceAttributeMultiprocessorCount, dev);
        if (hipFuncSetAttribute((const void*)fwd_megakernel, hipFuncAttributeMaxDynamicSharedMemorySize, LDS_BYTES) != hipSuccess) { fprintf(stderr, "kernel_launch: hipFuncSetAttribute failed\n"); grid = -1; return; }
        if (hipOccupancyMaxActiveBlocksPerMultiprocessor(&per_cu, (const void*)fwd_megakernel, NWAVES * 64, LDS_BYTES) != hipSuccess || per_cu < 1) { fprintf(stderr, "kernel_launch: occupancy query says %d blocks/CU\n", per_cu); (void)hipGetLastError(); per_cu = 1; }
        grid = cus * 1;
        fprintf(stderr, "kernel_launch: cus %d per_cu %d grid %d\n", cus, per_cu, grid);
    }
    if (grid < 0) return;
    hipMemsetAsync((char*)d_ws + WS_CTL, 0, CTL_BYTES, stream);
    Args a{};
    for (int i = 0; i < 17; ++i) a.in[i] = (const float*)d_in[i];
    a.out = (float*)d_out; a.ws = (unsigned char*)d_ws;
    void* args[] = {&a};
    hipError_t e = hipLaunchCooperativeKernel((const void*)fwd_megakernel, dim3(grid), dim3(NWAVES * 64), args, LDS_BYTES, stream);
    if (e != hipSuccess) fprintf(stderr, "cooperative launch failed: %s (grid %d)\n", hipGetErrorString(e), grid);
}
```

```cpp
#include <hip/hip_runtime.h>
#include <hip/hip_cooperative_groups.h>
#include <cstdio>
#include <cstdint>
namespace cg = cooperative_groups;
namespace pg8 {
#define PG8_LAS __attribute__((address_space(3)))
typedef unsigned short bf16_t;
typedef short bf16x8 __attribute__((ext_vector_type(8)));
typedef float f32x4 __attribute__((ext_vector_type(4)));
typedef unsigned u32x4 __attribute__((ext_vector_type(4)));
constexpr int BM = 256, BK = 64, HALF = 128, HTB = HALF * BK * 2  , STAGE_BYTES = 8 * HTB, NXCD = 8, WGM = 8;

__host__ __device__ __forceinline__ int lds_byte(int r, int c) { const int st = (r >> 4) * 2 + (c >> 5), rr = r & 15, cc = c & 31, ob = rr * 64 + cc * 2; return st * 1024 + (ob ^ (((ob >> 9) & 1) << 5)); }
__host__ __device__ __forceinline__ void stage_rc(int b, int& R, int& C) { const int st = b / 1024, sb = b % 1024, swz = sb ^ (((sb >> 9) & 1) << 5); R = (st >> 1) * 16 + swz / 64; C = (st & 1) * 32 + (swz % 64) / 2; }
__host__ __device__ __forceinline__ int perm32(int rho) { const int n = rho >> 4, i = rho & 15; return 8 * (i >> 2) + 4 * n + (i & 3); }

struct Unit { int pm, pn; };
struct Gemm { const bf16_t* A; const bf16_t* Bt; int M, N, K; };

struct StaticOrder {
    int nM, nN, nwg, G, c;
    __host__ __device__ void init(int M, int N, int G_, int c_) { nM = M / BM; nN = N / BM; nwg = nM * nN; G = G_; c = c_; }
    __host__ __device__ bool next(int i, Unit& u) const {
        const long L = (long)i * G + c; if (L >= nwg) return false;
        int wgid = (int)L; { const int q = nwg / NXCD, r = nwg % NXCD, xcd = wgid % NXCD, off = wgid / NXCD; wgid = (xcd < r ? xcd * (q + 1) : r * (q + 1) + (xcd - r) * q) + off; }
        const int nig = WGM * nN, gid = wgid / nig, fm = gid * WGM, gsz = (nM - fm) < WGM ? (nM - fm) : WGM;
        u.pm = fm + ((wgid % nig) % gsz); u.pn = (wgid % nig) / gsz; return true;
    }
    __device__ __forceinline__ void a_ready(const Unit&) const {}
    __device__ __forceinline__ void done(const Unit&) const {}
};

__device__ __forceinline__ unsigned cvt_pk_bf16(float lo, float hi) { unsigned r; asm volatile("v_cvt_pk_bf16_f32 %0, %1, %2" : "=v"(r) : "v"(lo), "v"(hi)); return r; }
__device__ __forceinline__ float silu_f(float g) { return g * __builtin_amdgcn_rcpf(1.0f + __expf(-g)); }
struct EpiSwiGLU {
    static constexpr bool PERM = true, AFTER_DRAIN = false;
    bf16_t* O; int ldc;
    __device__ __forceinline__ void operator()(const f32x4 (&acc)[2][2][4][2], const Unit& u, int wr, int wc, int fr, int fq) const {
        const int row0 = u.pm * BM + wr * 64 + fr; const int col0 = u.pn * 128 + wc * 32 + 8 * fq;
#pragma unroll
        for (int ai = 0; ai < 2; ++ai)
#pragma unroll
            for (int m = 0; m < 4; ++m) { bf16_t* rowp = O + (size_t)(row0 + ai * HALF + m * 16) * ldc + col0;
                const f32x4 g0 = acc[ai][0][m][0], g1 = acc[ai][0][m][1], u0 = acc[ai][1][m][0], u1 = acc[ai][1][m][1];
                u32x4 w;
                w.x = cvt_pk_bf16(silu_f(g0[0]) * u0[0], silu_f(g0[1]) * u0[1]); w.y = cvt_pk_bf16(silu_f(g0[2]) * u0[2], silu_f(g0[3]) * u0[3]);
                w.z = cvt_pk_bf16(silu_f(g1[0]) * u1[0], silu_f(g1[1]) * u1[1]); w.w = cvt_pk_bf16(silu_f(g1[2]) * u1[2], silu_f(g1[3]) * u1[3]);
                *(u32x4*)rowp = w; }
    }
};
struct EpiRes {
    static constexpr bool PERM = false, AFTER_DRAIN = false;
    const float* base; float* out; int ldc; float scale;
    __device__ __forceinline__ void operator()(const f32x4 (&acc)[2][2][4][2], const Unit& u, int wr, int wc, int fr, int fq) const {
        const int row0 = u.pm * BM + wr * 64 + fr; const int col0 = u.pn * BM + wc * 32 + 4 * fq;
#pragma unroll
        for (int ai = 0; ai < 2; ++ai)
#pragma unroll
            for (int m = 0; m < 4; ++m) { const size_t off = (size_t)(row0 + ai * HALF + m * 16) * ldc + col0;
#pragma unroll
                for (int bj = 0; bj < 2; ++bj)
#pragma unroll
                    for (int n = 0; n < 2; ++n) { const f32x4 b = *(const f32x4*)(base + off + bj * HALF + n * 16); *(f32x4*)(out + off + bj * HALF + n * 16) = b + acc[ai][bj][m][n] * scale; }
                asm volatile("" ::: "memory"); }
    }
};
struct EpiStoreBf16 {
    static constexpr bool PERM = true, AFTER_DRAIN = false;
    bf16_t* O; int ldc;
    __device__ __forceinline__ void operator()(const f32x4 (&acc)[2][2][4][2], const Unit& u, int wr, int wc, int fr, int fq) const {
        const int row0 = u.pm * BM + wr * 64 + fr; const int col0 = u.pn * BM + wc * 32 + 8 * fq;
#pragma unroll
        for (int ai = 0; ai < 2; ++ai)
#pragma unroll
            for (int m = 0; m < 4; ++m) { bf16_t* rowp = O + (size_t)(row0 + ai * HALF + m * 16) * ldc + col0;
#pragma unroll
                for (int bj = 0; bj < 2; ++bj) { const f32x4 v0 = acc[ai][bj][m][0], v1 = acc[ai][bj][m][1]; u32x4 w;
                    w.x = cvt_pk_bf16(v0[0], v0[1]); w.y = cvt_pk_bf16(v0[2], v0[3]); w.z = cvt_pk_bf16(v1[0], v1[1]); w.w = cvt_pk_bf16(v1[2], v1[3]);
                    *(u32x4*)(rowp + bj * HALF) = w; } }
    }
};
template <class Epi, class Sched, bool ALIGN_EPI = false, bool SP2 = false>
__device__ __forceinline__ void gemm_phase(PG8_LAS unsigned char* lds, const Gemm g, const Sched& S, const Epi& E) {
    const int tid = threadIdx.x, wid = __builtin_amdgcn_readfirstlane(tid >> 6), lane = tid & 63, wr = wid >> 2, wc = wid & 3, fr = lane & 15, fq = lane >> 4;
    const int K = g.K, nt = K / BK;
    unsigned voffA[2], voffB[2];
#pragma unroll
    for (int i = 0; i < 2; ++i) { int R, C; stage_rc(tid * 16 + i * 8192, R, C); const int Rb = Epi::PERM ? ((R & ~31) + perm32(R & 31)) : R;
        voffA[i] = (unsigned)(R * K + C) * 2u; voffB[i] = (unsigned)(Rb * K + C) * 2u; }
    const size_t kstep = (size_t)(BK * 2);
    const size_t hstep = (size_t)HALF * K * 2;
    const size_t tstep = 2 * hstep;
    const unsigned ldsw = (unsigned)wid * 1024u;
    const int aoff = lds_byte(wr * 64 + fr, fq * 8), boff = lds_byte(wc * 32 + fr, fq * 8);
#define PG8_SA(b, h) (((b) * 2 + (h)) * HTB)
#define PG8_SB(b, h) ((4 + (b) * 2 + (h)) * HTB)
#define PG8_STAGE(bufoff, gbase, voff) do { _Pragma("unroll") for (int _i = 0; _i < 2; ++_i) \
        __builtin_amdgcn_global_load_lds((const unsigned*)((const char*)(gbase) + (voff)[_i]), (PG8_LAS unsigned*)(lds + (bufoff) + ldsw + _i * 8192), 16, 0, 0); } while (0)
#define PG8_LDA(dst, b, h) do { _Pragma("unroll") for (int m = 0; m < 4; ++m) _Pragma("unroll") for (int k = 0; k < 2; ++k) dst[m][k] = *(const PG8_LAS bf16x8*)(lds + PG8_SA(b, h) + aoff + m * 2048 + k * 1024); } while (0)
#define PG8_LDB(dst, b, h) do { _Pragma("unroll") for (int n = 0; n < 2; ++n) _Pragma("unroll") for (int k = 0; k < 2; ++k) dst[n][k] = *(const PG8_LAS bf16x8*)(lds + PG8_SB(b, h) + boff + n * 2048 + k * 1024); } while (0)
#define PG8_MMA(ai, bj, At, Bt) do { __builtin_amdgcn_s_setprio(1); _Pragma("unroll") for (int m = 0; m < 4; ++m) _Pragma("unroll") for (int n = 0; n < 2; ++n) _Pragma("unroll") for (int k = 0; k < 2; ++k) \
        acc[ai][bj][m][n] = __builtin_amdgcn_mfma_f32_16x16x32_bf16(Bt[n][k], At[m][k], acc[ai][bj][m][n], 0, 0, 0); __builtin_amdgcn_s_setprio(0); } while (0)
#define PG8_WAIT_V(n) asm volatile("s_waitcnt vmcnt(" #n ")" ::: "memory")
#define PG8_WAIT_L(n) asm volatile("s_waitcnt lgkmcnt(" #n ")" ::: "memory")
#define PG8_BAR __builtin_amdgcn_s_barrier()
#define PG8_SCHED __builtin_amdgcn_sched_barrier(0)
    Unit cur, nxt; int ui = 0;
    if (!S.next(0, cur)) return;
    f32x4 acc[2][2][4][2];
#pragma unroll
    for (int a = 0; a < 2; ++a)
#pragma unroll
        for (int b = 0; b < 2; ++b)
#pragma unroll
            for (int m = 0; m < 4; ++m)
#pragma unroll
                for (int n = 0; n < 2; ++n) acc[a][b][m][n] = (f32x4){0.f, 0.f, 0.f, 0.f};
    bf16x8 At[4][2], B0[2][2], B1[2][2];
    const char* cA = (const char*)g.A + (size_t)cur.pm * tstep; const char* cB = (const char*)g.Bt + (size_t)cur.pn * tstep;
    S.a_ready(cur);
    if constexpr (SP2) {
        PG8_STAGE(PG8_SB(0, 0), cB, voffB); PG8_STAGE(PG8_SB(0, 1), cB + hstep, voffB); PG8_STAGE(PG8_SA(0, 0), cA, voffA); PG8_STAGE(PG8_SA(0, 1), cA + hstep, voffA);
        if (wr == 1) PG8_BAR;
        PG8_WAIT_V(2); PG8_BAR;
        PG8_STAGE(PG8_SB(1, 0), cB + kstep, voffB); PG8_STAGE(PG8_SA(1, 0), cA + kstep, voffA); PG8_STAGE(PG8_SB(1, 1), cB + hstep + kstep, voffB);
        PG8_WAIT_V(6); PG8_BAR;
    } else {
        PG8_STAGE(PG8_SB(0, 0), cB, voffB); PG8_STAGE(PG8_SA(0, 0), cA, voffA); PG8_STAGE(PG8_SB(0, 1), cB + hstep, voffB); PG8_STAGE(PG8_SA(0, 1), cA + hstep, voffA);
        if (wr == 1) PG8_BAR;
        PG8_WAIT_V(4); PG8_BAR;
        PG8_STAGE(PG8_SB(1, 0), cB + kstep, voffB); PG8_STAGE(PG8_SA(1, 0), cA + kstep, voffA); PG8_STAGE(PG8_SB(1, 1), cB + hstep + kstep, voffB);
        PG8_WAIT_V(6); PG8_BAR;
    }
    for (;;) {
        const bool has_next = S.next(ui + 1, nxt);
        const char* nA = has_next ? (const char*)g.A + (size_t)nxt.pm * tstep : cA; const char* nB = has_next ? (const char*)g.Bt + (size_t)nxt.pn * tstep : cB;
        for (int t = 0; t < nt; t += 2) {
            const bool last = (t == nt - 2);
            const char* a1 = cA + (size_t)(t + 1) * kstep;
            const char* a2 = last ? nA : cA + (size_t)(t + 2) * kstep; const char* b2 = last ? nB : cB + (size_t)(t + 2) * kstep;
            const char* a3 = a2 + kstep; const char* b3 = b2 + kstep;
            if (last && has_next) S.a_ready(nxt);
            if constexpr (SP2) {
            PG8_LDB(B0, 0, 0); PG8_LDB(B1, 0, 1); PG8_SCHED; PG8_LDA(At, 0, 0); PG8_STAGE(PG8_SA(1, 1), a1 + hstep, voffA);
            PG8_WAIT_V(8); PG8_WAIT_L(0); PG8_BAR; PG8_MMA(0, 0, At, B0); PG8_MMA(0, 1, At, B1); PG8_BAR; PG8_SCHED;
            PG8_LDA(At, 0, 1); PG8_STAGE(PG8_SB(0, 0), b2, voffB); PG8_STAGE(PG8_SB(0, 1), b2 + hstep, voffB); PG8_STAGE(PG8_SA(0, 0), a2, voffA);
            PG8_WAIT_V(8); PG8_WAIT_L(0); PG8_BAR; PG8_MMA(1, 0, At, B0); PG8_MMA(1, 1, At, B1); PG8_BAR; PG8_SCHED;
            PG8_LDB(B0, 1, 0); PG8_LDB(B1, 1, 1); PG8_SCHED; PG8_LDA(At, 1, 0); PG8_STAGE(PG8_SA(0, 1), a2 + hstep, voffA);
            PG8_WAIT_V(8); PG8_WAIT_L(0); PG8_BAR; PG8_MMA(0, 0, At, B0); PG8_MMA(0, 1, At, B1); PG8_BAR; PG8_SCHED;
            PG8_LDA(At, 1, 1); PG8_STAGE(PG8_SB(1, 0), b3, voffB); PG8_STAGE(PG8_SB(1, 1), b3 + hstep, voffB); PG8_STAGE(PG8_SA(1, 0), a3, voffA);
            PG8_WAIT_V(8); PG8_WAIT_L(0); PG8_BAR; PG8_MMA(1, 0, At, B0); PG8_MMA(1, 1, At, B1); PG8_BAR; PG8_SCHED;
            } else {
            PG8_LDB(B0, 0, 0); PG8_SCHED; PG8_LDA(At, 0, 0); PG8_STAGE(PG8_SA(1, 1), a1 + hstep, voffA);
            PG8_WAIT_L(8); PG8_BAR; PG8_WAIT_L(0); PG8_MMA(0, 0, At, B0); PG8_BAR; PG8_SCHED;
            PG8_LDB(B1, 0, 1); PG8_STAGE(PG8_SB(0, 0), b2, voffB);
            PG8_BAR; PG8_WAIT_L(0); PG8_MMA(0, 1, At, B1); PG8_BAR;
            PG8_LDA(At, 0, 1); PG8_STAGE(PG8_SA(0, 0), a2, voffA);
            PG8_BAR; PG8_WAIT_L(0); PG8_MMA(1, 0, At, B0); PG8_BAR; PG8_SCHED;
            PG8_STAGE(PG8_SB(0, 1), b2 + hstep, voffB);
            PG8_WAIT_V(6); PG8_BAR; PG8_MMA(1, 1, At, B1); PG8_BAR;
            PG8_LDB(B0, 1, 0); PG8_SCHED; PG8_LDA(At, 1, 0); PG8_STAGE(PG8_SA(0, 1), a2 + hstep, voffA);
            PG8_WAIT_L(8); PG8_BAR; PG8_WAIT_L(0); PG8_MMA(0, 0, At, B0); PG8_BAR; PG8_SCHED;
            PG8_LDB(B1, 1, 1); PG8_STAGE(PG8_SB(1, 0), b3, voffB);
            PG8_BAR; PG8_WAIT_L(0); PG8_MMA(0, 1, At, B1); PG8_BAR;
            PG8_LDA(At, 1, 1); PG8_STAGE(PG8_SA(1, 0), a3, voffA);
            PG8_BAR; PG8_WAIT_L(0); PG8_MMA(1, 0, At, B0); PG8_BAR; PG8_SCHED;
            PG8_STAGE(PG8_SB(1, 1), b3 + hstep, voffB);
            PG8_WAIT_V(6); PG8_BAR; PG8_MMA(1, 1, At, B1); PG8_BAR;
            }
        }
        if constexpr (ALIGN_EPI) { if (wr == 0) PG8_BAR; }
        if constexpr (!Epi::AFTER_DRAIN) { E(acc, cur, wr, wc, fr, fq); S.done(cur); }
        if (!has_next) break;
#pragma unroll
        for (int a = 0; a < 2; ++a)
#pragma unroll
            for (int b = 0; b < 2; ++b)
#pragma unroll
                for (int m = 0; m < 4; ++m)
#pragma unroll
                    for (int n = 0; n < 2; ++n) acc[a][b][m][n] = (f32x4){0.f, 0.f, 0.f, 0.f};
        cur = nxt; cA = nA; cB = nB; ++ui;
        if constexpr (ALIGN_EPI) { if (wr == 1) PG8_BAR; }
    }
    PG8_WAIT_V(0);
    if constexpr (!ALIGN_EPI) { if (wr == 0) PG8_BAR; }
    PG8_BAR;
    if constexpr (Epi::AFTER_DRAIN) { E.fused(acc, cur, wr, wc, fr, fq, lds, wid, lane); S.done(cur); }
#undef PG8_SA
#undef PG8_SB
#undef PG8_STAGE
#undef PG8_LDA
#undef PG8_LDB
#undef PG8_MMA
#undef PG8_WAIT_V
#undef PG8_WAIT_L
#undef PG8_BAR
#undef PG8_SCHED
}
}
constexpr int M = 16384, D = 1024, FF = 2816, NGU = 5632, NIN = 3584, SEQ = 4096;
constexpr int WIN_COLS = 3592;
constexpr size_t MiB = 1u << 20;
constexpr size_t WS_CTL = 0, CTL_BYTES = 4096;
constexpr size_t WS_WIN = 1 * MiB, WS_WOUT = 8 * MiB, WS_WGU2 = 10 * MiB, WS_WD2 = 21 * MiB;
constexpr size_t WS_XN = 27 * MiB;
constexpr size_t WS_ACT = 59 * MiB;
constexpr size_t WS_BD = 171 * MiB;
constexpr size_t WS_EG = 172 * MiB;
constexpr size_t WS_DN = 184 * MiB;
constexpr size_t WS_WGU1 = 184 * MiB, WS_WD1 = 195 * MiB;
constexpr size_t WS_QG = WS_DN, WS_KD = WS_DN + 16 * MiB, WS_U = WS_DN + 32 * MiB, WS_W = WS_DN + 48 * MiB, WS_A = WS_DN + 64 * MiB;
constexpr size_t WS_END = 256 * MiB;
constexpr int LDS_BYTES = 147456;
constexpr int NWAVES = 8;

#define GAS __attribute__((address_space(1)))
#define LAS __attribute__((address_space(3)))
typedef unsigned short bf16;
typedef unsigned v4u __attribute__((ext_vector_type(4)));
typedef unsigned v2u __attribute__((ext_vector_type(2)));
typedef float f32x4 __attribute__((ext_vector_type(4)));
typedef float f32x2 __attribute__((ext_vector_type(2)));
#define LDS_WAIT() asm volatile("s_waitcnt lgkmcnt(0)" ::: "memory")
__device__ __forceinline__ unsigned f2bf(float f) { unsigned u = __builtin_bit_cast(unsigned, f); return (u + 0x7fffu + ((u >> 16) & 1u)) >> 16; }
__device__ __forceinline__ unsigned pk2(float lo, float hi) { return f2bf(lo) | (f2bf(hi) << 16); }
__device__ __forceinline__ float bflo(unsigned u) { return __uint_as_float(u << 16); }
__device__ __forceinline__ float bfhi(unsigned u) { return __uint_as_float(u & 0xffff0000u); }
__device__ __forceinline__ float bf2f(bf16 v) { return __uint_as_float(((unsigned)v) << 16); }
__device__ __forceinline__ float wave_sum(float v) {
#pragma unroll
    for (int o = 1; o < 64; o <<= 1) v += __shfl_xor(v, o);
    return v;
}
__device__ __forceinline__ float wave_max(float v) {
#pragma unroll
    for (int o = 1; o < 64; o <<= 1) v = fmaxf(v, __shfl_xor(v, o));
    return v;
}

struct Args { const float* in[17]; float* out; unsigned char* ws; };

__device__ __forceinline__ void transpose_item(const float* src, int srcN, int srccol0, bf16* dst, int dstK, int dstrow0, int k0, LAS float* scr, int lane) {
#pragma unroll 8
    for (int i = 0; i < 32; ++i) { const int kk = 2 * i + (lane >> 5); scr[kk * 33 + (lane & 31)] = src[(size_t)(k0 + kk) * srcN + srccol0 + (lane & 31)]; }
    LDS_WAIT(); asm volatile("" ::: "memory");
    const int c = lane & 7;
#pragma unroll
    for (int j = 0; j < 4; ++j) { const int n = (lane >> 3) + 8 * j; const LAS float* s = scr + (8 * c) * 33 + n;
        v4u o; o.x = pk2(s[0 * 33], s[1 * 33]); o.y = pk2(s[2 * 33], s[3 * 33]); o.z = pk2(s[4 * 33], s[5 * 33]); o.w = pk2(s[6 * 33], s[7 * 33]);
        *(v4u*)(dst + (size_t)(dstrow0 + n) * dstK + k0 + 8 * c) = o; }
    LDS_WAIT(); asm volatile("" ::: "memory");
}
__device__ __forceinline__ void tr_gu(const float* gate, const float* up, bf16* dst, int r, LAS float* scr, int lane) {
    const int nblk = NGU / 32, kb = r / nblk, nb = r % nblk, dstrow0 = nb * 32, pn = dstrow0 >> 8, within = dstrow0 & 255;
    transpose_item(within < 128 ? gate : up, FF, pn * 128 + (within & 127), dst, D, dstrow0, kb * 64, scr, lane);
}
__device__ __forceinline__ void tr_plain(const float* src, int K, int N, bf16* dst, int r, LAS float* scr, int lane) {
    const int nblk = N / 32, kb = r / nblk, nb = r % nblk;
    transpose_item(src, N, nb * 32, dst, K, nb * 32, kb * 64, scr, lane);
}
__device__ __forceinline__ void tr_win(const float* src, bf16* dst, int r, LAS float* scr, int lane) {
    const int nblk = NIN / 32, kb = r / nblk, nb = r % nblk, dstrow0 = nb * 32;
    transpose_item(src, WIN_COLS, dstrow0 + (dstrow0 >= 3072 ? 8 : 0), dst, D, dstrow0, kb * 64, scr, lane);
}

__device__ __forceinline__ void rms_row(const float* xrow, const float* gain, int lane, f32x4 (&v)[4]) {
    const f32x4* xr = (const f32x4*)xrow + lane; const f32x4* gr = (const f32x4*)gain + lane;
    float s = 0.f;
#pragma unroll
    for (int j = 0; j < 4; ++j) { v[j] = xr[64 * j]; s += (v[j].x * v[j].x + v[j].y * v[j].y) + (v[j].z * v[j].z + v[j].w * v[j].w); }
    const float rs = 1.0f / sqrtf(wave_sum(s) * (1.f / D) + 1e-6f);
#pragma unroll
    for (int j = 0; j < 4; ++j) { const f32x4 g = gr[64 * j]; v[j] = v[j] * rs * g; }
}
__device__ __forceinline__ void store_row_bf16(bf16* orow, int lane, const f32x4 (&v)[4]) {
    v2u* o8 = (v2u*)orow + lane;
#pragma unroll
    for (int j = 0; j < 4; ++j) { v2u w; w.x = pk2(v[j].x, v[j].y); w.y = pk2(v[j].z, v[j].w); o8[64 * j] = w; }
}

constexpr int LP = 132;
__device__ __forceinline__ void dn_prep_item(const Args& a, LAS float* L, int ch, int tid, int lane, int wave) {
    unsigned char* ws = a.ws;
    const bf16* PROJ = (const bf16*)(ws + WS_ACT);
    const float* BD = (const float*)(ws + WS_BD);
    const float* conv_w = a.in[7]; const float* a_log = a.in[8]; const float* dt_bias = a.in[9];
    const int bh = ch >> 6, n = ch & 63, b = bh >> 2, h = bh & 3;
    const int tok0 = b * SEQ + n * 64;
    LAS float* qs = L; LAS float* ks = L + 64 * LP; LAS float* vs = L + 2 * 64 * LP; LAS float* As = L + 3 * 64 * LP; LAS float* gcs = As + 64 * 65; LAS float* bts = gcs + 64;
    {
        float cw[3][4][2];
#pragma unroll
        for (int sec = 0; sec < 3; ++sec)
#pragma unroll
            for (int j = 0; j < 4; ++j) { const f32x2 w = *(const f32x2*)(conv_w + j * 1536 + sec * 512 + h * 128 + 2 * lane); cw[sec][j][0] = w.x; cw[sec][j][1] = w.y; }
        for (int rr = 0; rr < 8; ++rr) {
            const int r = wave * 8 + rr, tok = tok0 + r, s = n * 64 + r;
            float val[3][2] = {{0.f, 0.f}, {0.f, 0.f}, {0.f, 0.f}};
#pragma unroll
            for (int j = 0; j < 4; ++j) {
                if (s - 3 + j >= 0) {
#pragma unroll
                    for (int sec = 0; sec < 3; ++sec) { const unsigned w = *(const unsigned*)(PROJ + (size_t)(tok - 3 + j) * NIN + 1536 + sec * 512 + h * 128 + 2 * lane);
                        val[sec][0] += bflo(w) * cw[sec][j][0]; val[sec][1] += bfhi(w) * cw[sec][j][1]; }
                }
            }
#pragma unroll
            for (int sec = 0; sec < 3; ++sec) { val[sec][0] = val[sec][0] / (1.f + __expf(-val[sec][0])); val[sec][1] = val[sec][1] / (1.f + __expf(-val[sec][1])); }
            const float ssq = wave_sum(val[0][0] * val[0][0] + val[0][1] * val[0][1]);
            const float ssk = wave_sum(val[1][0] * val[1][0] + val[1][1] * val[1][1]);
            const float rq = (1.0f / sqrtf(ssq + 1e-6f)) * 0.08838834764831845f, rk = 1.0f / sqrtf(ssk + 1e-6f);
            *(LAS f32x2*)(qs + r * LP + 2 * lane) = (f32x2){val[0][0] * rq, val[0][1] * rq};
            *(LAS f32x2*)(ks + r * LP + 2 * lane) = (f32x2){val[1][0] * rk, val[1][1] * rk};
            *(LAS f32x2*)(vs + r * LP + 2 * lane) = (f32x2){val[2][0], val[2][1]};
        }
    }
    if (wave == 0) {
        const int tok = tok0 + lane;
        const float braw = BD[(size_t)tok * 8 + h], draw = BD[(size_t)tok * 8 + 4 + h] + dt_bias[h];
        const float sp = fmaxf(draw, 0.f) + log1pf(__expf(-fabsf(draw)));
        float g = -expf(a_log[h]) * sp;
#pragma unroll
        for (int o = 1; o < 64; o <<= 1) { const float t = __shfl_up(g, o); if (lane >= o) g += t; }
        gcs[lane] = g; bts[lane] = 1.0f / (1.0f + __expf(-braw));
        if (lane == 63) ((float*)(ws + WS_EG))[ch] = expf(g);
    }
    __syncthreads();
    {
        const int c = tid >> 3, jg = tid & 7;
        float accA[8], accP[8];
#pragma unroll
        for (int jj = 0; jj < 8; ++jj) { accA[jj] = 0.f; accP[jj] = 0.f; }
        for (int d4 = 0; d4 < 32; ++d4) {
            const f32x4 kc = *(const LAS f32x4*)(ks + c * LP + 4 * d4), qc = *(const LAS f32x4*)(qs + c * LP + 4 * d4);
#pragma unroll
            for (int jj = 0; jj < 8; ++jj) { const f32x4 kj = *(const LAS f32x4*)(ks + (jg + 8 * jj) * LP + 4 * d4);
                accA[jj] += (kc.x * kj.x + kc.y * kj.y) + (kc.z * kj.z + kc.w * kj.w);
                accP[jj] += (qc.x * kj.x + qc.y * kj.y) + (qc.z * kj.z + qc.w * kj.w); }
        }
        const float gcc = gcs[c], bc = bts[c];
        bf16* Aout = (bf16*)(ws + WS_A) + (size_t)ch * 4096;
#pragma unroll
        for (int jj = 0; jj < 8; ++jj) { const int j = jg + 8 * jj; const float dec = (j <= c) ? __expf(gcc - gcs[j]) : 0.f;
            As[c * 65 + j] = (j < c) ? bc * accA[jj] * dec : 0.f;
            Aout[c * 64 + j] = (bf16)f2bf((j <= c) ? accP[jj] * dec : 0.f); }
        const float glast = gcs[63];
        bf16* QG = (bf16*)(ws + WS_QG) + (size_t)ch * 8192; bf16* KD = (bf16*)(ws + WS_KD) + (size_t)ch * 8192;
#pragma unroll
        for (int i = 0; i < 8; ++i) { const int idx2 = tid + 512 * i, cc = idx2 >> 6, d = (idx2 & 63) * 2;
            const float eq = __expf(gcs[cc]), ek = __expf(glast - gcs[cc]);
            const f32x2 qv = *(const LAS f32x2*)(qs + cc * LP + d), kv = *(const LAS f32x2*)(ks + cc * LP + d);
            *(unsigned*)(QG + cc * 128 + d) = pk2(qv.x * eq, qv.y * eq); *(unsigned*)(KD + cc * 128 + d) = pk2(kv.x * ek, kv.y * ek); }
    }
    __syncthreads();
#pragma unroll
    for (int i = 0; i < 8; ++i) { const int idx2 = tid + 512 * i, cc = idx2 >> 6, d = (idx2 & 63) * 2;
        const float be = bts[cc], bek = be * __expf(gcs[cc]);
        const f32x2 vv = *(const LAS f32x2*)(vs + cc * LP + d), kv = *(const LAS f32x2*)(ks + cc * LP + d);
        *(LAS f32x2*)(vs + cc * LP + d) = (f32x2){vv.x * be, vv.y * be}; *(LAS f32x2*)(qs + cc * LP + d) = (f32x2){kv.x * bek, kv.y * bek}; }
    __syncthreads();
    if (tid < 256) {
        LAS float* buf = (tid < 128 ? vs : qs) + (tid & 127);
        for (int c = 1; c < 64; ++c) {
            float acc = buf[c * LP];
            for (int j = 0; j < c; ++j) acc -= As[c * 65 + j] * buf[j * LP];
            buf[c * LP] = acc;
        }
    }
    __syncthreads();
    {
        bf16* U = (bf16*)(ws + WS_U) + (size_t)ch * 8192; bf16* W = (bf16*)(ws + WS_W) + (size_t)ch * 8192;
#pragma unroll
        for (int i = 0; i < 8; ++i) { const int idx2 = tid + 512 * i, cc = idx2 >> 6, d = (idx2 & 63) * 2;
            const f32x2 uv = *(const LAS f32x2*)(vs + cc * LP + d), wv = *(const LAS f32x2*)(qs + cc * LP + d);
            *(unsigned*)(U + cc * 128 + d) = pk2(uv.x, uv.y); *(unsigned*)(W + cc * 128 + d) = pk2(wv.x, wv.y); }
    }
    __syncthreads();
}

__device__ __forceinline__ void ld8_to_lds(const bf16* g, LAS float* d) {
    const v4u w = *(const v4u*)g;
    *(LAS f32x4*)d = (f32x4){bflo(w.x), bfhi(w.x), bflo(w.y), bfhi(w.y)}; *(LAS f32x4*)(d + 4) = (f32x4){bflo(w.z), bfhi(w.z), bflo(w.w), bfhi(w.w)};
}
__device__ __forceinline__ void dn_scan_block(const Args& a, LAS float* L, int item, int tid) {
    unsigned char* ws = a.ws;
    const int bh = item >> 3, sl = item & 7, b = bh >> 2, h = bh & 3;
    LAS float* S = L;
    LAS float* wS = L + 2176;
    LAS float* qS = wS + 64 * LP; LAS float* kS = qS + 64 * LP;
    LAS float* aS = kS + 64 * LP;
    LAS float* uS = aS + 64 * 68;
    LAS float* vN = uS + 64 * 17;
    bf16* MIX = (bf16*)(ws + WS_XN);
    const float* EG = (const float*)(ws + WS_EG);
    for (int i = tid; i < 128 * 17; i += 512) S[i] = 0.f;
    for (int n = 0; n < 64; ++n) {
        const int ch = bh * 64 + n;
        const bf16* QG = (const bf16*)(ws + WS_QG) + (size_t)ch * 8192; const bf16* KD = (const bf16*)(ws + WS_KD) + (size_t)ch * 8192;
        const bf16* U = (const bf16*)(ws + WS_U) + (size_t)ch * 8192; const bf16* W = (const bf16*)(ws + WS_W) + (size_t)ch * 8192;
        const bf16* Ag = (const bf16*)(ws + WS_A) + (size_t)ch * 4096;
#pragma unroll
        for (int i = 0; i < 2; ++i) { const int p = tid + 512 * i, row = p >> 4, c8 = (p & 15) * 8;
            ld8_to_lds(W + row * 128 + c8, wS + row * LP + c8); ld8_to_lds(QG + row * 128 + c8, qS + row * LP + c8); ld8_to_lds(KD + row * 128 + c8, kS + row * LP + c8); }
        { const int row = tid >> 3, c8 = (tid & 7) * 8; ld8_to_lds(Ag + row * 64 + c8, aS + row * 68 + c8); }
        if (tid < 128) { const int row = tid >> 1, c8 = (tid & 1) * 8; const v4u w = *(const v4u*)(U + row * 128 + sl * 16 + c8); LAS float* d = uS + row * 17 + c8;
            d[0] = bflo(w.x); d[1] = bfhi(w.x); d[2] = bflo(w.y); d[3] = bfhi(w.y); d[4] = bflo(w.z); d[5] = bfhi(w.z); d[6] = bflo(w.w); d[7] = bfhi(w.w); }
        const float eg = EG[ch];
        __syncthreads();
        const int c = tid >> 3, j = (tid & 7) * 2;
        {
            float a0 = uS[c * 17 + j], a1 = uS[c * 17 + j + 1];
            for (int k4 = 0; k4 < 32; ++k4) { const f32x4 wv = *(const LAS f32x4*)(wS + c * LP + 4 * k4); const LAS float* sp = S + (4 * k4) * 17 + j;
                a0 -= wv.x * sp[0] + wv.y * sp[17] + wv.z * sp[34] + wv.w * sp[51]; a1 -= wv.x * sp[1] + wv.y * sp[18] + wv.z * sp[35] + wv.w * sp[52]; }
            vN[c * 17 + j] = a0; vN[c * 17 + j + 1] = a1;
        }
        __syncthreads();
        {
            float o0 = 0.f, o1 = 0.f;
            for (int k4 = 0; k4 < 32; ++k4) { const f32x4 qv = *(const LAS f32x4*)(qS + c * LP + 4 * k4); const LAS float* sp = S + (4 * k4) * 17 + j;
                o0 += qv.x * sp[0] + qv.y * sp[17] + qv.z * sp[34] + qv.w * sp[51]; o1 += qv.x * sp[1] + qv.y * sp[18] + qv.z * sp[35] + qv.w * sp[52]; }
            for (int i4 = 0; i4 < 16; ++i4) { const f32x4 av = *(const LAS f32x4*)(aS + c * 68 + 4 * i4); const LAS float* vp = vN + (4 * i4) * 17 + j;
                o0 += av.x * vp[0] + av.y * vp[17] + av.z * vp[34] + av.w * vp[51]; o1 += av.x * vp[1] + av.y * vp[18] + av.z * vp[35] + av.w * vp[52]; }
            *(unsigned*)(MIX + (size_t)(b * SEQ + n * 64 + c) * 1024 + 512 + h * 128 + sl * 16 + j) = pk2(o0, o1);
        }
        const int k = tid >> 2, j4 = (tid & 3) * 4;
        float s0 = S[k * 17 + j4] * eg, s1 = S[k * 17 + j4 + 1] * eg, s2 = S[k * 17 + j4 + 2] * eg, s3 = S[k * 17 + j4 + 3] * eg;
        for (int cc = 0; cc < 64; ++cc) { const float kv = kS[cc * LP + k]; const LAS float* vp = vN + cc * 17 + j4;
            s0 += kv * vp[0]; s1 += kv * vp[1]; s2 += kv * vp[2]; s3 += kv * vp[3]; }
        __syncthreads();
        S[k * 17 + j4] = s0; S[k * 17 + j4 + 1] = s1; S[k * 17 + j4 + 2] = s2; S[k * 17 + j4 + 3] = s3;
    }
    __syncthreads();
}

typedef float f32x16 __attribute__((ext_vector_type(16)));
typedef short bf16x8 __attribute__((ext_vector_type(8)));
typedef short s16x4 __attribute__((ext_vector_type(4)));
typedef __bf16 bf16x2_t __attribute__((ext_vector_type(2)));
__device__ __forceinline__ unsigned cvtpk(float lo, float hi) { f32x2 v = {lo, hi}; bf16x2_t b = __builtin_convertvector(v, bf16x2_t); return __builtin_bit_cast(unsigned, b); }
__device__ __forceinline__ s16x4 vtr(const LAS unsigned char* p) { return __builtin_bit_cast(s16x4, __builtin_amdgcn_ds_read_tr16_b64_v4i16((LAS s16x4*)p)); }
constexpr int KVP = 144;
constexpr int KV_BYTES = 384 * KVP;
constexpr size_t WS_ML = 173 * MiB;
__device__ __forceinline__ void attn_item(bf16* PROJ, float* ML, LAS unsigned char* L8, int item, int tid, int lane, int wave) {
    asm volatile("" : "+v"(lane));
    const int bh = item / 48, rem = item - bh * 48, p = rem >> 4, sub = rem & 15;
    const int b = bh >> 3, h = bh & 7;
    const int dsh = 2 * p, dil = 1 << dsh, nsh = 4 - dsh;
    const int r = sub >> nsh, qb = sub & ((1 << nsh) - 1);
    const int base = 256 * qb;
    const size_t tokb = (size_t)b * SEQ + r;
#pragma unroll
    for (int i = 0; i < 6; ++i) { const int id = tid + 512 * i, row = id >> 3, ch = id & 7, idx = base - 128 + row;
        v4u kv = (v4u){0u, 0u, 0u, 0u}, vv = (v4u){0u, 0u, 0u, 0u};
        if (idx >= 0) { const bf16* src = PROJ + (tokb + (size_t)dil * idx) * NIN + h * 64 + ch * 8; kv = *(const v4u*)(src + 512); vv = *(const v4u*)(src + 1024); }
        *(LAS v4u*)(L8 + row * KVP + ch * 16) = kv; *(LAS v4u*)(L8 + KV_BYTES + row * KVP + ch * 16) = vv; }
    const int ql = lane & 31, kh = lane >> 5;
    const size_t tokq = tokb + (size_t)dil * (base + 32 * wave + ql);
    bf16x8 qf[4];
#pragma unroll
    for (int s = 0; s < 4; ++s) qf[s] = *(const bf16x8*)(PROJ + tokq * NIN + h * 64 + 16 * s + 8 * kh);
    __syncthreads();
    f32x16 sc[5];
#pragma unroll
    for (int kt = 0; kt < 5; ++kt) { f32x16 acc = {};
#pragma unroll
        for (int s = 0; s < 4; ++s) { const bf16x8 kf = *(const LAS bf16x8*)(L8 + (32 * (wave + kt) + ql) * KVP + (16 * s + 8 * kh) * 2); acc = __builtin_amdgcn_mfma_f32_32x32x16_bf16(kf, qf[s], acc, 0, 0, 0); }
        sc[kt] = acc; }
    const float LOG2E = 1.4426950408889634f;
    const float c1 = 0.125f * LOG2E, c2 = exp2f(-(float)(h + 1)) * (float)dil * LOG2E;
    float mx = -INFINITY;
#pragma unroll
    for (int kt = 0; kt < 5; ++kt)
#pragma unroll
        for (int rr = 0; rr < 16; ++rr) { const int kk = (rr & 3) + 8 * (rr >> 2) + 4 * kh; const int dist = 128 + ql - 32 * kt - kk; const int kidx = base - 128 + 32 * (wave + kt) + kk;
            const bool valid = (dist >= 0) && (dist <= 128) && (kidx >= 0);
            const float v = valid ? sc[kt][rr] * c1 - c2 * (float)dist : -INFINITY; sc[kt][rr] = v; mx = fmaxf(mx, v); }
    mx = fmaxf(mx, __shfl_xor(mx, 32));
    float lsum = 0.f;
#pragma unroll
    for (int kt = 0; kt < 5; ++kt)
#pragma unroll
        for (int rr = 0; rr < 16; ++rr) { const float pv = __builtin_amdgcn_exp2f(sc[kt][rr] - mx); sc[kt][rr] = pv; lsum += pv; }
    lsum += __shfl_xor(lsum, 32);
    f32x16 o[2]; o[0] = (f32x16){}; o[1] = (f32x16){};
    const int q4 = (lane & 15) >> 2, pp = lane & 3, blk = (lane >> 4) & 1;
    const LAS unsigned char* Vb = L8 + KV_BYTES + (4 * kh + q4) * KVP + (16 * blk + 4 * pp) * 2;
#pragma unroll
    for (int kt = 0; kt < 5; ++kt)
#pragma unroll
        for (int s2 = 0; s2 < 2; ++s2) {
            v4u pw; pw.x = cvtpk(sc[kt][8 * s2 + 0], sc[kt][8 * s2 + 1]); pw.y = cvtpk(sc[kt][8 * s2 + 2], sc[kt][8 * s2 + 3]); pw.z = cvtpk(sc[kt][8 * s2 + 4], sc[kt][8 * s2 + 5]); pw.w = cvtpk(sc[kt][8 * s2 + 6], sc[kt][8 * s2 + 7]);
            const bf16x8 pb = __builtin_bit_cast(bf16x8, pw);
            const LAS unsigned char* vr = Vb + (32 * (wave + kt) + 16 * s2) * KVP;
#pragma unroll
            for (int c = 0; c < 2; ++c) { const s16x4 lo = vtr(vr + c * 64), hi = vtr(vr + 8 * KVP + c * 64);
                const bf16x8 va = (bf16x8){lo[0], lo[1], lo[2], lo[3], hi[0], hi[1], hi[2], hi[3]};
                o[c] = __builtin_amdgcn_mfma_f32_32x32x16_bf16(va, pb, o[c], 0, 0, 0); }
        }
    const float inv = 1.0f / lsum;
    bf16* dst = PROJ + tokq * NIN + 1536 + p * 512 + h * 64 + 4 * kh;
#pragma unroll
    for (int c = 0; c < 2; ++c)
#pragma unroll
        for (int g = 0; g < 4; ++g) { v2u w; w.x = cvtpk(o[c][4 * g + 0] * inv, o[c][4 * g + 1] * inv); w.y = cvtpk(o[c][4 * g + 2] * inv, o[c][4 * g + 3] * inv);
            *(v2u*)(dst + 32 * c + 8 * g) = w; }
    if (kh == 0) { float* ml = ML + ((tokq * 8 + h) * 3 + p) * 2; *(f32x2*)ml = (f32x2){mx, lsum}; }
    __syncthreads();
}

__global__ void __launch_bounds__(NWAVES * 64, 2) fwd_megakernel(Args a) {
    extern __shared__ __attribute__((aligned(16))) unsigned char lds[];
    cg::grid_group grid = cg::this_grid();
    LAS unsigned char* L8 = (LAS unsigned char*)lds;
    LAS float* L = (LAS float*)lds;
    const int tid = threadIdx.x, lane = tid & 63, wave = __builtin_amdgcn_readfirstlane(tid >> 6);
    const int G = gridDim.x, gw = blockIdx.x * NWAVES + wave, NGW = G * NWAVES;
    unsigned char* ws = a.ws;
    unsigned* ctl = (unsigned*)(ws + WS_CTL);
    const float* x = a.in[0];
    bf16* XN = (bf16*)(ws + WS_XN); bf16* ACT = (bf16*)(ws + WS_ACT); bf16* PROJ = ACT; bf16* MIX = XN;
    bf16* Wgu1 = (bf16*)(ws + WS_WGU1); bf16* Wd1 = (bf16*)(ws + WS_WD1); bf16* Win = (bf16*)(ws + WS_WIN); bf16* Wout = (bf16*)(ws + WS_WOUT);
    bf16* Wgu2 = (bf16*)(ws + WS_WGU2); bf16* Wd2 = (bf16*)(ws + WS_WD2);
    float* out = a.out;

    {
        LAS float* scr = L + wave * 4096;
        constexpr int I_GU = (D / 64) * (NGU / 32), I_D = (FF / 64) * (D / 32), I_IN = (D / 64) * (NIN / 32), I_O = (D / 64) * (D / 32);
        constexpr int NITEMS = 2 * I_GU + 2 * I_D + I_IN + I_O;
        for (int it = gw; it < NITEMS; it += NGW) {
            int r = it;
            if (r < I_GU) { tr_gu(a.in[2], a.in[3], Wgu1, r, scr, lane); continue; } r -= I_GU;
            if (r < I_D) { tr_plain(a.in[4], FF, D, Wd1, r, scr, lane); continue; } r -= I_D;
            if (r < I_IN) { tr_win(a.in[6], Win, r, scr, lane); continue; } r -= I_IN;
            if (r < I_O) { tr_plain(a.in[11], D, D, Wout, r, scr, lane); continue; } r -= I_O;
            if (r < I_GU) { tr_gu(a.in[13], a.in[14], Wgu2, r, scr, lane); continue; } r -= I_GU;
            tr_plain(a.in[15], FF, D, Wd2, r, scr, lane);
        }
        for (int m = gw; m < M; m += NGW) { f32x4 v[4]; rms_row(x + (size_t)m * D, a.in[1], lane, v); store_row_bf16(XN + (size_t)m * D, lane, v); }
    }
    grid.sync();
    {
        pg8::Gemm g{XN, Wgu1, M, NGU, D}; pg8::StaticOrder S; S.init(M, NGU, G, (int)blockIdx.x);
        pg8::EpiSwiGLU E{ACT, FF};
        pg8::gemm_phase<pg8::EpiSwiGLU, pg8::StaticOrder, true, true>(L8, g, S, E);
    }
    grid.sync();
    {
        pg8::Gemm g{ACT, Wd1, M, D, FF}; pg8::StaticOrder S; S.init(M, D, G, (int)blockIdx.x);
        pg8::EpiRes E{x, out, D, 0.5f};
        pg8::gemm_phase<pg8::EpiRes, pg8::StaticOrder, true, true>(L8, g, S, E);
    }
    grid.sync();
    {
        const float* w_in = a.in[6]; float* BD = (float*)(ws + WS_BD);
        for (int m = gw; m < M; m += NGW) {
            f32x4 v[4]; rms_row(out + (size_t)m * D, a.in[5], lane, v); store_row_bf16(XN + (size_t)m * D, lane, v);
            float acc[8];
#pragma unroll
            for (int o = 0; o < 8; ++o) acc[o] = 0.f;
#pragma unroll
            for (int j = 0; j < 4; ++j)
#pragma unroll
                for (int i = 0; i < 4; ++i) { const int k = 4 * (lane + 64 * j) + i; const f32x4 w0 = *(const f32x4*)(w_in + (size_t)k * WIN_COLS + 3072), w1 = *(const f32x4*)(w_in + (size_t)k * WIN_COLS + 3076);
                    const float hv = v[j][i];
                    acc[0] += hv * w0.x; acc[1] += hv * w0.y; acc[2] += hv * w0.z; acc[3] += hv * w0.w; acc[4] += hv * w1.x; acc[5] += hv * w1.y; acc[6] += hv * w1.z; acc[7] += hv * w1.w; }
#pragma unroll
            for (int o = 0; o < 8; ++o) acc[o] = wave_sum(acc[o]);
            if (lane == 0) { *(f32x4*)(BD + (size_t)m * 8) = (f32x4){acc[0], acc[1], acc[2], acc[3]}; *(f32x4*)(BD + (size_t)m * 8 + 4) = (f32x4){acc[4], acc[5], acc[6], acc[7]}; }
        }
    }
    grid.sync();
    {
        pg8::Gemm g{XN, Win, M, NIN, D}; pg8::StaticOrder S; S.init(M, NIN, G, (int)blockIdx.x);
        pg8::EpiStoreBf16 E{PROJ, NIN};
        pg8::gemm_phase<pg8::EpiStoreBf16, pg8::StaticOrder, true, true>(L8, g, S, E);
    }
    grid.sync();
    for (int ch = blockIdx.x; ch < 1024; ch += G) dn_prep_item(a, L, ch, tid, lane, wave);
    grid.sync();
    {
        for (int it = blockIdx.x; it < 128; it += G) dn_scan_block(a, L, it, tid);
        LAS unsigned* bc = (LAS unsigned*)(L8 + 2 * KV_BYTES);
        float* ML = (float*)(ws + WS_ML);
        for (;;) {
            if (tid == 0) bc[0] = atomicAdd(ctl + 64, 1u);
            __syncthreads();
            const unsigned item = bc[0];
            __syncthreads();
            if (item >= 1536u) break;
            attn_item(PROJ, ML, L8, (int)item, tid, lane, wave);
        }
    }
    grid.sync();
    {
        const float* dn_norm = a.in[10];
        for (int m = gw; m < M; m += NGW) {
            bf16* op = MIX + (size_t)m * 1024 + 512 + 8 * lane; const bf16* gp = PROJ + (size_t)m * NIN + 3072 + 8 * lane;
            const v4u ow = *(const v4u*)op, gwv = *(const v4u*)gp;
            float o[8] = {bflo(ow.x), bfhi(ow.x), bflo(ow.y), bfhi(ow.y), bflo(ow.z), bfhi(ow.z), bflo(ow.w), bfhi(ow.w)};
            float gt[8] = {bflo(gwv.x), bfhi(gwv.x), bflo(gwv.y), bfhi(gwv.y), bflo(gwv.z), bfhi(gwv.z), bflo(gwv.w), bfhi(gwv.w)};
            float ss = 0.f;
#pragma unroll
            for (int i = 0; i < 8; ++i) ss += o[i] * o[i];
            ss += __shfl_xor(ss, 1); ss += __shfl_xor(ss, 2); ss += __shfl_xor(ss, 4); ss += __shfl_xor(ss, 8);
            const float rs = 1.0f / sqrtf(ss * (1.f / 128.f) + 1e-6f);
            const int d0 = (8 * lane) & 127;
            float r[8];
#pragma unroll
            for (int i = 0; i < 8; ++i) r[i] = o[i] * rs * dn_norm[d0 + i] * (gt[i] / (1.f + __expf(-gt[i])));
            v4u w; w.x = pk2(r[0], r[1]); w.y = pk2(r[2], r[3]); w.z = pk2(r[4], r[5]); w.w = pk2(r[6], r[7]);
            *(v4u*)op = w;
            {
                const int ha = lane >> 3;
                const float* ml = (const float*)(ws + WS_ML) + ((size_t)m * 8 + ha) * 6;
                const f32x2 a0 = *(const f32x2*)ml, a1 = *(const f32x2*)(ml + 2), a2 = *(const f32x2*)(ml + 4);
                const float mm = fmaxf(a0.x, fmaxf(a1.x, a2.x));
                const float w0 = a0.y * __builtin_amdgcn_exp2f(a0.x - mm), w1 = a1.y * __builtin_amdgcn_exp2f(a1.x - mm), w2 = a2.y * __builtin_amdgcn_exp2f(a2.x - mm);
                const float iw = 1.0f / (w0 + w1 + w2);
                const bf16* pp = PROJ + (size_t)m * NIN + 1536 + 8 * lane;
                const v4u p0 = *(const v4u*)pp, p1 = *(const v4u*)(pp + 512), p2 = *(const v4u*)(pp + 1024);
                float rr[8];
                rr[0] = w0 * bflo(p0.x) + w1 * bflo(p1.x) + w2 * bflo(p2.x); rr[1] = w0 * bfhi(p0.x) + w1 * bfhi(p1.x) + w2 * bfhi(p2.x);
                rr[2] = w0 * bflo(p0.y) + w1 * bflo(p1.y) + w2 * bflo(p2.y); rr[3] = w0 * bfhi(p0.y) + w1 * bfhi(p1.y) + w2 * bfhi(p2.y);
                rr[4] = w0 * bflo(p0.z) + w1 * bflo(p1.z) + w2 * bflo(p2.z); rr[5] = w0 * bfhi(p0.z) + w1 * bfhi(p1.z) + w2 * bfhi(p2.z);
                rr[6] = w0 * bflo(p0.w) + w1 * bflo(p1.w) + w2 * bflo(p2.w); rr[7] = w0 * bfhi(p0.w) + w1 * bfhi(p1.w) + w2 * bfhi(p2.w);
                v4u wa; wa.x = pk2(rr[0] * iw, rr[1] * iw); wa.y = pk2(rr[2] * iw, rr[3] * iw); wa.z = pk2(rr[4] * iw, rr[5] * iw); wa.w = pk2(rr[6] * iw, rr[7] * iw);
                *(v4u*)(MIX + (size_t)m * 1024 + 8 * lane) = wa;
            }
        }
    }
    grid.sync();
    {
        pg8::Gemm g{MIX, Wout, M, D, D}; pg8::StaticOrder S; S.init(M, D, G, (int)blockIdx.x);
        pg8::EpiRes E{out, out, D, 1.0f};
        pg8::gemm_phase<pg8::EpiRes, pg8::StaticOrder, true, true>(L8, g, S, E);
    }
    grid.sync();
    for (int m = gw; m < M; m += NGW) { f32x4 v[4]; rms_row(out + (size_t)m * D, a.in[12], lane, v); store_row_bf16(XN + (size_t)m * D, lane, v); }
    grid.sync();
    {
        pg8::Gemm g{XN, Wgu2, M, NGU, D}; pg8::StaticOrder S; S.init(M, NGU, G, (int)blockIdx.x);
        pg8::EpiSwiGLU E{ACT, FF};
        pg8::gemm_phase<pg8::EpiSwiGLU, pg8::StaticOrder, true, true>(L8, g, S, E);
    }
    grid.sync();
    {
        pg8::Gemm g{ACT, Wd2, M, D, FF}; pg8::StaticOrder S; S.init(M, D, G, (int)blockIdx.x);
        pg8::EpiRes E{out, out, D, 0.5f};
        pg8::gemm_phase<pg8::EpiRes, pg8::StaticOrder, true, true>(L8, g, S, E);
    }
    grid.sync();
    for (int m = gw; m < M; m += NGW) {
        f32x4 v[4]; rms_row(out + (size_t)m * D, a.in[16], lane, v);
        f32x4* o = (f32x4*)(out + (size_t)m * D) + lane;
#pragma unroll
        for (int j = 0; j < 4; ++j) o[64 * j] = v[j];
    }
}

extern "C" void kernel_launch(void* const* d_in, const int* in_sizes, int n_in, void* d_out, int out_size, void* d_ws, size_t ws_size, hipStream_t stream) {
    static int grid = 0;
    if (grid == 0) {
        if (n_in != 17 || in_sizes[0] != M * D || out_size != M * D || ws_size < WS_END) { fprintf(stderr, "kernel_launch: unexpected shapes (n_in %d in0 %d out %d ws %zu)\n", n_in, n_in > 0 ? in_sizes[0] : -1, out_size, ws_size); grid = -1; return; }
        int dev = 0, cus = 0, per_cu = 0;
        hipGetDevice(&dev); hipDeviceGetAttribute(&cus, hipDeviceAttributeMultiprocessorCount, dev);
        if (hipFuncSetAttribute((const void*)fwd_megakernel, hipFuncAttributeMaxDynamicSharedMemorySize, LDS_BYTES) != hipSuccess) { fprintf(stderr, "kernel_launch: hipFuncSetAttribute failed\n"); grid = -1; return; }
        if (hipOccupancyMaxActiveBlocksPerMultiprocessor(&per_cu, (const void*)fwd_megakernel, NWAVES * 64, LDS_BYTES) != hipSuccess || per_cu < 1) { fprintf(stderr, "kernel_launch: occupancy query says %d blocks/CU\n", per_cu); (void)hipGetLastError(); per_cu = 1; }
        grid = cus * 1;
        fprintf(stderr, "kernel_launch: cus %d per_cu %d grid %d\n", cus, per_cu, grid);
    }
    if (grid < 0) return;
    hipMemsetAsync((char*)d_ws + WS_CTL, 0, CTL_BYTES, stream);
    Args a{};
    for (int i = 0; i < 17; ++i) a.in[i] = (const float*)d_in[i];
    a.out = (float*)d_out; a.ws = (unsigned char*)d_ws;
    void* args[] = {&a};
    hipError_t e = hipLaunchCooperativeKernel((const void*)fwd_megakernel, dim3(grid), dim3(NWAVES * 64), args, LDS_BYTES, stream);
    if (e != hipSuccess) fprintf(stderr, "cooperative launch failed: %s (grid %d)\n", hipGetErrorString(e), grid);
}
```

```cpp
#include <hip/hip_runtime.h>
#include <hip/hip_cooperative_groups.h>
#include <cstdio>
#include <cstdint>
namespace cg = cooperative_groups;
namespace pg8 {
#define PG8_LAS __attribute__((address_space(3)))
typedef unsigned short bf16_t;
typedef short bf16x8 __attribute__((ext_vector_type(8)));
typedef float f32x4 __attribute__((ext_vector_type(4)));
typedef unsigned u32x4 __attribute__((ext_vector_type(4)));
constexpr int BM = 256, BK = 64, HALF = 128, HTB = HALF * BK * 2  , STAGE_BYTES = 8 * HTB, NXCD = 8, WGM = 8;

__host__ __device__ __forceinline__ int lds_byte(int r, int c) { const int st = (r >> 4) * 2 + (c >> 5), rr = r & 15, cc = c & 31, ob = rr * 64 + cc * 2; return st * 1024 + (ob ^ (((ob >> 9) & 1) << 5)); }
__host__ __device__ __forceinline__ void stage_rc(int b, int& R, int& C) { const int st = b / 1024, sb = b % 1024, swz = sb ^ (((sb >> 9) & 1) << 5); R = (st >> 1) * 16 + swz / 64; C = (st & 1) * 32 + (swz % 64) / 2; }
__host__ __device__ __forceinline__ int perm32(int rho) { const int n = rho >> 4, i = rho & 15; return 8 * (i >> 2) + 4 * n + (i & 3); }

struct Unit { int pm, pn; };
struct Gemm { const bf16_t* A; const bf16_t* Bt; int M, N, K; };

struct StaticOrder {
    int nM, nN, nwg, G, c;
    __host__ __device__ void init(int M, int N, int G_, int c_) { nM = M / BM; nN = N / BM; nwg = nM * nN; G = G_; c = c_; }
    __host__ __device__ bool next(int i, Unit& u) const {
        const long L = (long)i * G + c; if (L >= nwg) return false;
        int wgid = (int)L; { const int q = nwg / NXCD, r = nwg % NXCD, xcd = wgid % NXCD, off = wgid / NXCD; wgid = (xcd < r ? xcd * (q + 1) : r * (q + 1) + (xcd - r) * q) + off; }
        const int nig = WGM * nN, gid = wgid / nig, fm = gid * WGM, gsz = (nM - fm) < WGM ? (nM - fm) : WGM;
        u.pm = fm + ((wgid % nig) % gsz); u.pn = (wgid % nig) / gsz; return true;
    }
    __device__ __forceinline__ void a_ready(const Unit&) const {}
    __device__ __forceinline__ void done(const Unit&) const {}
};

__device__ __forceinline__ unsigned cvt_pk_bf16(float lo, float hi) { unsigned r; asm volatile("v_cvt_pk_bf16_f32 %0, %1, %2" : "=v"(r) : "v"(lo), "v"(hi)); return r; }
__device__ __forceinline__ float silu_f(float g) { return g * __builtin_amdgcn_rcpf(1.0f + __expf(-g)); }
struct EpiSwiGLU {
    static constexpr bool PERM = true, AFTER_DRAIN = false;
    bf16_t* O; int ldc;
    __device__ __forceinline__ void operator()(const f32x4 (&acc)[2][2][4][2], const Unit& u, int wr, int wc, int fr, int fq) const {
        const int row0 = u.pm * BM + wr * 64 + fr; const int col0 = u.pn * 128 + wc * 32 + 8 * fq;
#pragma unroll
        for (int ai = 0; ai < 2; ++ai)
#pragma unroll
            for (int m = 0; m < 4; ++m) { bf16_t* rowp = O + (size_t)(row0 + ai * HALF + m * 16) * ldc + col0;
                const f32x4 g0 = acc[ai][0][m][0], g1 = acc[ai][0][m][1], u0 = acc[ai][1][m][0], u1 = acc[ai][1][m][1];
                u32x4 w;
                w.x = cvt_pk_bf16(silu_f(g0[0]) * u0[0], silu_f(g0[1]) * u0[1]); w.y = cvt_pk_bf16(silu_f(g0[2]) * u0[2], silu_f(g0[3]) * u0[3]);
                w.z = cvt_pk_bf16(silu_f(g1[0]) * u1[0], silu_f(g1[1]) * u1[1]); w.w = cvt_pk_bf16(silu_f(g1[2]) * u1[2], silu_f(g1[3]) * u1[3]);
                *(u32x4*)rowp = w; }
    }
};
struct EpiRes {
    static constexpr bool PERM = false, AFTER_DRAIN = false;
    const float* base; float* out; int ldc; float scale;
    __device__ __forceinline__ void operator()(const f32x4 (&acc)[2][2][4][2], const Unit& u, int wr, int wc, int fr, int fq) const {
        const int row0 = u.pm * BM + wr * 64 + fr; const int col0 = u.pn * BM + wc * 32 + 4 * fq;
#pragma unroll
        for (int ai = 0; ai < 2; ++ai)
#pragma unroll
            for (int m = 0; m < 4; ++m) { const size_t off = (size_t)(row0 + ai * HALF + m * 16) * ldc + col0;
#pragma unroll
                for (int bj = 0; bj < 2; ++bj)
#pragma unroll
                    for (int n = 0; n < 2; ++n) { const f32x4 b = *(const f32x4*)(base + off + bj * HALF + n * 16); *(f32x4*)(out + off + bj * HALF + n * 16) = b + acc[ai][bj][m][n] * scale; }
                asm volatile("" ::: "memory"); }
    }
};
struct EpiStoreBf16 {
    static constexpr bool PERM = true, AFTER_DRAIN = false;
    bf16_t* O; int ldc;
    __device__ __forceinline__ void operator()(const f32x4 (&acc)[2][2][4][2], const Unit& u, int wr, int wc, int fr, int fq) const {
        const int row0 = u.pm * BM + wr * 64 + fr; const int col0 = u.pn * BM + wc * 32 + 8 * fq;
#pragma unroll
        for (int ai = 0; ai < 2; ++ai)
#pragma unroll
            for (int m = 0; m < 4; ++m) { bf16_t* rowp = O + (size_t)(row0 + ai * HALF + m * 16) * ldc + col0;
#pragma unroll
                for (int bj = 0; bj < 2; ++bj) { const f32x4 v0 = acc[ai][bj][m][0], v1 = acc[ai][bj][m][1]; u32x4 w;
                    w.x = cvt_pk_bf16(v0[0], v0[1]); w.y = cvt_pk_bf16(v0[2], v0[3]); w.z = cvt_pk_bf16(v1[0], v1[1]); w.w = cvt_pk_bf16(v1[2], v1[3]);
                    *(u32x4*)(rowp + bj * HALF) = w; } }
    }
};
template <class Epi, class Sched, bool ALIGN_EPI = false, bool SP2 = false>
__device__ __forceinline__ void gemm_phase(PG8_LAS unsigned char* lds, const Gemm g, const Sched& S, const Epi& E) {
    const int tid = threadIdx.x, wid = __builtin_amdgcn_readfirstlane(tid >> 6), lane = tid & 63, wr = wid >> 2, wc = wid & 3, fr = lane & 15, fq = lane >> 4;
    const int K = g.K, nt = K / BK;
    unsigned voffA[2], voffB[2];
#pragma unroll
    for (int i = 0; i < 2; ++i) { int R, C; stage_rc(tid * 16 + i * 8192, R, C); const int Rb = Epi::PERM ? ((R & ~31) + perm32(R & 31)) : R;
        voffA[i] = (unsigned)(R * K + C) * 2u; voffB[i] = (unsigned)(Rb * K + C) * 2u; }
    const size_t kstep = (size_t)(BK * 2);
    const size_t hstep = (size_t)HALF * K * 2;
    const size_t tstep = 2 * hstep;
    const unsigned ldsw = (unsigned)wid * 1024u;
    const int aoff = lds_byte(wr * 64 + fr, fq * 8), boff = lds_byte(wc * 32 + fr, fq * 8);
#define PG8_SA(b, h) (((b) * 2 + (h)) * HTB)
#define PG8_SB(b, h) ((4 + (b) * 2 + (h)) * HTB)
#define PG8_STAGE(bufoff, gbase, voff) do { _Pragma("unroll") for (int _i = 0; _i < 2; ++_i) \
        __builtin_amdgcn_global_load_lds((const unsigned*)((const char*)(gbase) + (voff)[_i]), (PG8_LAS unsigned*)(lds + (bufoff) + ldsw + _i * 8192), 16, 0, 0); } while (0)
#define PG8_LDA(dst, b, h) do { _Pragma("unroll") for (int m = 0; m < 4; ++m) _Pragma("unroll") for (int k = 0; k < 2; ++k) dst[m][k] = *(const PG8_LAS bf16x8*)(lds + PG8_SA(b, h) + aoff + m * 2048 + k * 1024); } while (0)
#define PG8_LDB(dst, b, h) do { _Pragma("unroll") for (int n = 0; n < 2; ++n) _Pragma("unroll") for (int k = 0; k < 2; ++k) dst[n][k] = *(const PG8_LAS bf16x8*)(lds + PG8_SB(b, h) + boff + n * 2048 + k * 1024); } while (0)
#define PG8_MMA(ai, bj, At, Bt) do { __builtin_amdgcn_s_setprio(1); _Pragma("unroll") for (int m = 0; m < 4; ++m) _Pragma("unroll") for (int n = 0; n < 2; ++n) _Pragma("unroll") for (int k = 0; k < 2; ++k) \
        acc[ai][bj][m][n] = __builtin_amdgcn_mfma_f32_16x16x32_bf16(Bt[n][k], At[m][k], acc[ai][bj][m][n], 0, 0, 0); __builtin_amdgcn_s_setprio(0); } while (0)
#define PG8_WAIT_V(n) asm volatile("s_waitcnt vmcnt(" #n ")" ::: "memory")
#define PG8_WAIT_L(n) asm volatile("s_waitcnt lgkmcnt(" #n ")" ::: "memory")
#define PG8_BAR __builtin_amdgcn_s_barrier()
#define PG8_SCHED __builtin_amdgcn_sched_barrier(0)
    Unit cur, nxt; int ui = 0;
    if (!S.next(0, cur)) return;
    f32x4 acc[2][2][4][2];
#pragma unroll
    for (int a = 0; a < 2; ++a)
#pragma unroll
        for (int b = 0; b < 2; ++b)
#pragma unroll
            for (int m = 0; m < 4; ++m)
#pragma unroll
                for (int n = 0; n < 2; ++n) acc[a][b][m][n] = (f32x4){0.f, 0.f, 0.f, 0.f};
    bf16x8 At[4][2], B0[2][2], B1[2][2];
    const char* cA = (const char*)g.A + (size_t)cur.pm * tstep; const char* cB = (const char*)g.Bt + (size_t)cur.pn * tstep;
    S.a_ready(cur);
    if constexpr (SP2) {
        PG8_STAGE(PG8_SB(0, 0), cB, voffB); PG8_STAGE(PG8_SB(0, 1), cB + hstep, voffB); PG8_STAGE(PG8_SA(0, 0), cA, voffA); PG8_STAGE(PG8_SA(0, 1), cA + hstep, voffA);
        if (wr == 1) PG8_BAR;
        PG8_WAIT_V(2); PG8_BAR;
        PG8_STAGE(PG8_SB(1, 0), cB + kstep, voffB); PG8_STAGE(PG8_SA(1, 0), cA + kstep, voffA); PG8_STAGE(PG8_SB(1, 1), cB + hstep + kstep, voffB);
        PG8_WAIT_V(6); PG8_BAR;
    } else {
        PG8_STAGE(PG8_SB(0, 0), cB, voffB); PG8_STAGE(PG8_SA(0, 0), cA, voffA); PG8_STAGE(PG8_SB(0, 1), cB + hstep, voffB); PG8_STAGE(PG8_SA(0, 1), cA + hstep, voffA);
        if (wr == 1) PG8_BAR;
        PG8_WAIT_V(4); PG8_BAR;
        PG8_STAGE(PG8_SB(1, 0), cB + kstep, voffB); PG8_STAGE(PG8_SA(1, 0), cA + kstep, voffA); PG8_STAGE(PG8_SB(1, 1), cB + hstep + kstep, voffB);
        PG8_WAIT_V(6); PG8_BAR;
    }
    for (;;) {
        const bool has_next = S.next(ui + 1, nxt);
        const char* nA = has_next ? (const char*)g.A + (size_t)nxt.pm * tstep : cA; const char* nB = has_next ? (const char*)g.Bt + (size_t)nxt.pn * tstep : cB;
        for (int t = 0; t < nt; t += 2) {
            const bool last = (t == nt - 2);
            const char* a1 = cA + (size_t)(t + 1) * kstep;
            const char* a2 = last ? nA : cA + (size_t)(t + 2) * kstep; const char* b2 = last ? nB : cB + (size_t)(t + 2) * kstep;
            const char* a3 = a2 + kstep; const char* b3 = b2 + kstep;
            if (last && has_next) S.a_ready(nxt);
            if constexpr (SP2) {
            PG8_LDB(B0, 0, 0); PG8_LDB(B1, 0, 1); PG8_SCHED; PG8_LDA(At, 0, 0); PG8_STAGE(PG8_SA(1, 1), a1 + hstep, voffA);
            PG8_WAIT_V(8); PG8_WAIT_L(0); PG8_BAR; PG8_MMA(0, 0, At, B0); PG8_MMA(0, 1, At, B1); PG8_BAR; PG8_SCHED;
            PG8_LDA(At, 0, 1); PG8_STAGE(PG8_SB(0, 0), b2, voffB); PG8_STAGE(PG8_SB(0, 1), b2 + hstep, voffB); PG8_STAGE(PG8_SA(0, 0), a2, voffA);
            PG8_WAIT_V(8); PG8_WAIT_L(0); PG8_BAR; PG8_MMA(1, 0, At, B0); PG8_MMA(1, 1, At, B1); PG8_BAR; PG8_SCHED;
            PG8_LDB(B0, 1, 0); PG8_LDB(B1, 1, 1); PG8_SCHED; PG8_LDA(At, 1, 0); PG8_STAGE(PG8_SA(0, 1), a2 + hstep, voffA);
            PG8_WAIT_V(8); PG8_WAIT_L(0); PG8_BAR; PG8_MMA(0, 0, At, B0); PG8_MMA(0, 1, At, B1); PG8_BAR; PG8_SCHED;
            PG8_LDA(At, 1, 1); PG8_STAGE(PG8_SB(1, 0), b3, voffB); PG8_STAGE(PG8_SB(1, 1), b3 + hstep, voffB); PG8_STAGE(PG8_SA(1, 0), a3, voffA);
            PG8_WAIT_V(8); PG8_WAIT_L(0); PG8_BAR; PG8_MMA(1, 0, At, B0); PG8_MMA(1, 1, At, B1); PG8_BAR; PG8_SCHED;
            } else {
            PG8_LDB(B0, 0, 0); PG8_SCHED; PG8_LDA(At, 0, 0); PG8_STAGE(PG8_SA(1, 1), a1 + hstep, voffA);
            PG8_WAIT_L(8); PG8_BAR; PG8_WAIT_L(0); PG8_MMA(0, 0, At, B0); PG8_BAR; PG8_SCHED;
            PG8_LDB(B1, 0, 1); PG8_STAGE(PG8_SB(0, 0), b2, voffB);
            PG8_BAR; PG8_WAIT_L(0); PG8_MMA(0, 1, At, B1); PG8_BAR;
            PG8_LDA(At, 0, 1); PG8_STAGE(PG8_SA(0, 0), a2, voffA);
            PG8_BAR; PG8_WAIT_L(0); PG8_MMA(1, 0, At, B0); PG8_BAR; PG8_SCHED;
            PG8_STAGE(PG8_SB(0, 1), b2 + hstep, voffB);
            PG8_WAIT_V(6); PG8_BAR; PG8_MMA(1, 1, At, B1); PG8_BAR;
            PG8_LDB(B0, 1, 0); PG8_SCHED; PG8_LDA(At, 1, 0); PG8_STAGE(PG8_SA(0, 1), a2 + hstep, voffA);
            PG8_WAIT_L(8); PG8_BAR; PG8_WAIT_L(0); PG8_MMA(0, 0, At, B0); PG8_BAR; PG8_SCHED;
            PG8_LDB(B1, 1, 1); PG8_STAGE(PG8_SB(1, 0), b3, voffB);
            PG8_BAR; PG8_WAIT_L(0); PG8_MMA(0, 1, At, B1); PG8_BAR;
            PG8_LDA(At, 1, 1); PG8_STAGE(PG8_SA(1, 0), a3, voffA);
            PG8_BAR; PG8_WAIT_L(0); PG8_MMA(1, 0, At, B0); PG8_BAR; PG8_SCHED;
            PG8_STAGE(PG8_SB(1, 1), b3 + hstep, voffB);
            PG8_WAIT_V(6); PG8_BAR; PG8_MMA(1, 1, At, B1); PG8_BAR;
            }
        }
        if constexpr (ALIGN_EPI) { if (wr == 0) PG8_BAR; }
        if constexpr (!Epi::AFTER_DRAIN) { E(acc, cur, wr, wc, fr, fq); S.done(cur); }
        if (!has_next) break;
#pragma unroll
        for (int a = 0; a < 2; ++a)
#pragma unroll
            for (int b = 0; b < 2; ++b)
#pragma unroll
                for (int m = 0; m < 4; ++m)
#pragma unroll
                    for (int n = 0; n < 2; ++n) acc[a][b][m][n] = (f32x4){0.f, 0.f, 0.f, 0.f};
        cur = nxt; cA = nA; cB = nB; ++ui;
        if constexpr (ALIGN_EPI) { if (wr == 1) PG8_BAR; }
    }
    PG8_WAIT_V(0);
    if constexpr (!ALIGN_EPI) { if (wr == 0) PG8_BAR; }
    PG8_BAR;
    if constexpr (Epi::AFTER_DRAIN) { E.fused(acc, cur, wr, wc, fr, fq, lds, wid, lane); S.done(cur); }
#undef PG8_SA
#undef PG8_SB
#undef PG8_STAGE
#undef PG8_LDA
#undef PG8_LDB
#undef PG8_MMA
#undef PG8_WAIT_V
#undef PG8_WAIT_L
#undef PG8_BAR
#undef PG8_SCHED
}
}
constexpr int M = 16384, D = 1024, FF = 2816, NGU = 5632, NIN = 3584, SEQ = 4096;
constexpr int WIN_COLS = 3592;
constexpr size_t MiB = 1u << 20;
constexpr size_t WS_CTL = 0, CTL_BYTES = 4096;
constexpr size_t WS_WIN = 1 * MiB, WS_WOUT = 8 * MiB, WS_WGU2 = 10 * MiB, WS_WD2 = 21 * MiB;
constexpr size_t WS_XN = 27 * MiB;
constexpr size_t WS_ACT = 59 * MiB;
constexpr size_t WS_BD = 171 * MiB;
constexpr size_t WS_EG = 172 * MiB;
constexpr size_t WS_DN = 184 * MiB;
constexpr size_t WS_WGU1 = 184 * MiB, WS_WD1 = 195 * MiB;
constexpr size_t WS_QG = WS_DN, WS_KD = WS_DN + 16 * MiB, WS_U = WS_DN + 32 * MiB, WS_W = WS_DN + 48 * MiB, WS_A = WS_DN + 64 * MiB;
constexpr size_t WS_END = 256 * MiB;
constexpr int LDS_BYTES = 147456;
constexpr int NWAVES = 8;

#define GAS __attribute__((address_space(1)))
#define LAS __attribute__((address_space(3)))
typedef unsigned short bf16;
typedef unsigned v4u __attribute__((ext_vector_type(4)));
typedef unsigned v2u __attribute__((ext_vector_type(2)));
typedef float f32x4 __attribute__((ext_vector_type(4)));
typedef float f32x2 __attribute__((ext_vector_type(2)));
#define LDS_WAIT() asm volatile("s_waitcnt lgkmcnt(0)" ::: "memory")
__device__ __forceinline__ unsigned f2bf(float f) { unsigned u = __builtin_bit_cast(unsigned, f); return (u + 0x7fffu + ((u >> 16) & 1u)) >> 16; }
__device__ __forceinline__ unsigned pk2(float lo, float hi) { return f2bf(lo) | (f2bf(hi) << 16); }
__device__ __forceinline__ float bflo(unsigned u) { return __uint_as_float(u << 16); }
__device__ __forceinline__ float bfhi(unsigned u) { return __uint_as_float(u & 0xffff0000u); }
__device__ __forceinline__ float bf2f(bf16 v) { return __uint_as_float(((unsigned)v) << 16); }
__device__ __forceinline__ float wave_sum(float v) {
#pragma unroll
    for (int o = 1; o < 64; o <<= 1) v += __shfl_xor(v, o);
    return v;
}
__device__ __forceinline__ float wave_max(float v) {
#pragma unroll
    for (int o = 1; o < 64; o <<= 1) v = fmaxf(v, __shfl_xor(v, o));
    return v;
}

__device__ __forceinline__ int opq(int v) { asm volatile("" : "+v"(v)); return v; }
struct Args { const float* in[17]; float* out; unsigned char* ws; };

__device__ __forceinline__ void transpose_item(const float* src, int srcN, int srccol0, bf16* dst, int dstK, int dstrow0, int k0, LAS float* scr, int lane) {
#pragma unroll 8
    for (int i = 0; i < 32; ++i) { const int kk = 2 * i + (lane >> 5); scr[kk * 33 + (lane & 31)] = src[(size_t)(k0 + kk) * srcN + srccol0 + (lane & 31)]; }
    LDS_WAIT(); asm volatile("" ::: "memory");
    const int c = lane & 7;
#pragma unroll
    for (int j = 0; j < 4; ++j) { const int n = (lane >> 3) + 8 * j; const LAS float* s = scr + (8 * c) * 33 + n;
        v4u o; o.x = pk2(s[0 * 33], s[1 * 33]); o.y = pk2(s[2 * 33], s[3 * 33]); o.z = pk2(s[4 * 33], s[5 * 33]); o.w = pk2(s[6 * 33], s[7 * 33]);
        *(v4u*)(dst + (size_t)(dstrow0 + n) * dstK + k0 + 8 * c) = o; }
    LDS_WAIT(); asm volatile("" ::: "memory");
}
__device__ __forceinline__ void tr_gu(const float* gate, const float* up, bf16* dst, int r, LAS float* scr, int lane) {
    const int nblk = NGU / 32, kb = r / nblk, nb = r % nblk, dstrow0 = nb * 32, pn = dstrow0 >> 8, within = dstrow0 & 255;
    transpose_item(within < 128 ? gate : up, FF, pn * 128 + (within & 127), dst, D, dstrow0, kb * 64, scr, lane);
}
__device__ __forceinline__ void tr_plain(const float* src, int K, int N, bf16* dst, int r, LAS float* scr, int lane) {
    const int nblk = N / 32, kb = r / nblk, nb = r % nblk;
    transpose_item(src, N, nb * 32, dst, K, nb * 32, kb * 64, scr, lane);
}
__device__ __forceinline__ void tr_win(const float* src, bf16* dst, int r, LAS float* scr, int lane) {
    const int nblk = NIN / 32, kb = r / nblk, nb = r % nblk, dstrow0 = nb * 32;
    transpose_item(src, WIN_COLS, dstrow0 + (dstrow0 >= 3072 ? 8 : 0), dst, D, dstrow0, kb * 64, scr, lane);
}

__device__ __forceinline__ void rms_row(const float* xrow, const float* gain, int lane, f32x4 (&v)[4]) {
    const f32x4* xr = (const f32x4*)xrow + lane; const f32x4* gr = (const f32x4*)gain + lane;
    float s = 0.f;
#pragma unroll
    for (int j = 0; j < 4; ++j) { v[j] = xr[64 * j]; s += (v[j].x * v[j].x + v[j].y * v[j].y) + (v[j].z * v[j].z + v[j].w * v[j].w); }
    const float rs = 1.0f / sqrtf(wave_sum(s) * (1.f / D) + 1e-6f);
#pragma unroll
    for (int j = 0; j < 4; ++j) { const f32x4 g = gr[64 * j]; v[j] = v[j] * rs * g; }
}
__device__ __forceinline__ void store_row_bf16(bf16* orow, int lane, const f32x4 (&v)[4]) {
    v2u* o8 = (v2u*)orow + lane;
#pragma unroll
    for (int j = 0; j < 4; ++j) { v2u w; w.x = pk2(v[j].x, v[j].y); w.y = pk2(v[j].z, v[j].w); o8[64 * j] = w; }
}

__device__ __forceinline__ int kperm(int x) { return 8 * ((x & 15) >> 2) + 4 * (x >> 4) + (x & 3); }
constexpr int LP = 132;
__device__ __forceinline__ void dn_prep_item(const Args& a, LAS float* L, int ch, int tid, int lane, int wave) {
    unsigned char* ws = a.ws;
    const bf16* PROJ = (const bf16*)(ws + WS_ACT);
    const float* BD = (const float*)(ws + WS_BD);
    const float* conv_w = a.in[7]; const float* a_log = a.in[8]; const float* dt_bias = a.in[9];
    const int bh = ch >> 6, n = ch & 63, b = bh >> 2, h = bh & 3;
    const int tok0 = b * SEQ + n * 64;
    LAS float* qs = L; LAS float* ks = L + 64 * LP; LAS float* vs = L + 2 * 64 * LP; LAS float* As = L + 3 * 64 * LP; LAS float* gcs = As + 64 * 65; LAS float* bts = gcs + 64;
    {
        float cw[3][4][2];
#pragma unroll
        for (int sec = 0; sec < 3; ++sec)
#pragma unroll
            for (int j = 0; j < 4; ++j) { const f32x2 w = *(const f32x2*)(conv_w + j * 1536 + sec * 512 + h * 128 + 2 * lane); cw[sec][j][0] = w.x; cw[sec][j][1] = w.y; }
        for (int rr = 0; rr < 8; ++rr) {
            const int r = wave * 8 + rr, tok = tok0 + r, s = n * 64 + r;
            float val[3][2] = {{0.f, 0.f}, {0.f, 0.f}, {0.f, 0.f}};
#pragma unroll
            for (int j = 0; j < 4; ++j) {
                if (s - 3 + j >= 0) {
#pragma unroll
                    for (int sec = 0; sec < 3; ++sec) { const unsigned w = *(const unsigned*)(PROJ + (size_t)(tok - 3 + j) * NIN + 1536 + sec * 512 + h * 128 + 2 * lane);
                        val[sec][0] += bflo(w) * cw[sec][j][0]; val[sec][1] += bfhi(w) * cw[sec][j][1]; }
                }
            }
#pragma unroll
            for (int sec = 0; sec < 3; ++sec) { val[sec][0] = val[sec][0] / (1.f + __expf(-val[sec][0])); val[sec][1] = val[sec][1] / (1.f + __expf(-val[sec][1])); }
            const float ssq = wave_sum(val[0][0] * val[0][0] + val[0][1] * val[0][1]);
            const float ssk = wave_sum(val[1][0] * val[1][0] + val[1][1] * val[1][1]);
            const float rq = (1.0f / sqrtf(ssq + 1e-6f)) * 0.08838834764831845f, rk = 1.0f / sqrtf(ssk + 1e-6f);
            *(LAS f32x2*)(qs + r * LP + 2 * lane) = (f32x2){val[0][0] * rq, val[0][1] * rq};
            *(LAS f32x2*)(ks + r * LP + 2 * lane) = (f32x2){val[1][0] * rk, val[1][1] * rk};
            *(LAS f32x2*)(vs + r * LP + 2 * lane) = (f32x2){val[2][0], val[2][1]};
        }
    }
    if (wave == 0) {
        const int tok = tok0 + lane;
        const float braw = BD[(size_t)tok * 8 + h], draw = BD[(size_t)tok * 8 + 4 + h] + dt_bias[h];
        const float sp = fmaxf(draw, 0.f) + log1pf(__expf(-fabsf(draw)));
        float g = -expf(a_log[h]) * sp;
#pragma unroll
        for (int o = 1; o < 64; o <<= 1) { const float t = __shfl_up(g, o); if (lane >= o) g += t; }
        gcs[lane] = g; bts[lane] = 1.0f / (1.0f + __expf(-braw));
        if (lane == 63) ((float*)(ws + WS_EG))[ch] = expf(g);
    }
    __syncthreads();
    {
        const int c = tid >> 3, jg = tid & 7;
        float accA[8], accP[8];
#pragma unroll
        for (int jj = 0; jj < 8; ++jj) { accA[jj] = 0.f; accP[jj] = 0.f; }
        for (int d4 = 0; d4 < 32; ++d4) {
            const f32x4 kc = *(const LAS f32x4*)(ks + c * LP + 4 * d4), qc = *(const LAS f32x4*)(qs + c * LP + 4 * d4);
#pragma unroll
            for (int jj = 0; jj < 8; ++jj) { const f32x4 kj = *(const LAS f32x4*)(ks + (jg + 8 * jj) * LP + 4 * d4);
                accA[jj] += (kc.x * kj.x + kc.y * kj.y) + (kc.z * kj.z + kc.w * kj.w);
                accP[jj] += (qc.x * kj.x + qc.y * kj.y) + (qc.z * kj.z + qc.w * kj.w); }
        }
        const float gcc = gcs[c], bc = bts[c];
        bf16* Aout = (bf16*)(ws + WS_A) + (size_t)ch * 4096;
#pragma unroll
        for (int jj = 0; jj < 8; ++jj) { const int j = jg + 8 * jj; const float dec = (j <= c) ? __expf(gcc - gcs[j]) : 0.f;
            As[c * 65 + j] = (j < c) ? bc * accA[jj] * dec : 0.f;
            Aout[c * 64 + (j & 32) + kperm(j & 31)] = (bf16)f2bf((j <= c) ? accP[jj] * dec : 0.f); }
        const float glast = gcs[63];
        bf16* QG = (bf16*)(ws + WS_QG) + (size_t)ch * 8192; bf16* KD = (bf16*)(ws + WS_KD) + (size_t)ch * 8192;
#pragma unroll
        for (int i = 0; i < 8; ++i) { const int idx2 = tid + 512 * i, cc = idx2 >> 6, d = (idx2 & 63) * 2;
            const float eq = __expf(gcs[cc]), ek = __expf(glast - gcs[cc]);
            const f32x2 qv = *(const LAS f32x2*)(qs + cc * LP + d), kv = *(const LAS f32x2*)(ks + cc * LP + d);
            *(unsigned*)(QG + cc * 128 + (d & 96) + kperm(d & 31)) = pk2(qv.x * eq, qv.y * eq);
            const int tp = (cc & 32) + kperm(cc & 31);
            KD[d * 64 + tp] = (bf16)f2bf(kv.x * ek); KD[(d + 1) * 64 + tp] = (bf16)f2bf(kv.y * ek); }
    }
    __syncthreads();
#pragma unroll
    for (int i = 0; i < 8; ++i) { const int idx2 = tid + 512 * i, cc = idx2 >> 6, d = (idx2 & 63) * 2;
        const float be = bts[cc], bek = be * __expf(gcs[cc]);
        const f32x2 vv = *(const LAS f32x2*)(vs + cc * LP + d), kv = *(const LAS f32x2*)(ks + cc * LP + d);
        *(LAS f32x2*)(vs + cc * LP + d) = (f32x2){vv.x * be, vv.y * be}; *(LAS f32x2*)(qs + cc * LP + d) = (f32x2){kv.x * bek, kv.y * bek}; }
    __syncthreads();
    if (tid < 256) {
        LAS float* buf = (tid < 128 ? vs : qs) + (tid & 127);
        for (int c = 1; c < 64; ++c) {
            float acc = buf[c * LP];
            for (int j = 0; j < c; ++j) acc -= As[c * 65 + j] * buf[j * LP];
            buf[c * LP] = acc;
        }
    }
    __syncthreads();
    {
        bf16* U = (bf16*)(ws + WS_U) + (size_t)ch * 8192; bf16* W = (bf16*)(ws + WS_W) + (size_t)ch * 8192;
#pragma unroll
        for (int i = 0; i < 8; ++i) { const int idx2 = tid + 512 * i, cc = idx2 >> 6, d = (idx2 & 63) * 2;
            const f32x2 uv = *(const LAS f32x2*)(vs + cc * LP + d), wv = *(const LAS f32x2*)(qs + cc * LP + d);
            U[d * 64 + cc] = (bf16)f2bf(uv.x); U[(d + 1) * 64 + cc] = (bf16)f2bf(uv.y);
            *(unsigned*)(W + cc * 128 + (d & 96) + kperm(d & 31)) = pk2(-wv.x, -wv.y); }
    }
    __syncthreads();
}

typedef short bf16x8 __attribute__((ext_vector_type(8)));
typedef __bf16 bf16x2_t __attribute__((ext_vector_type(2)));
__device__ __forceinline__ unsigned cvtpk(float lo, float hi) { f32x2 v = {lo, hi}; bf16x2_t b = __builtin_convertvector(v, bf16x2_t); return __builtin_bit_cast(unsigned, b); }
__device__ __forceinline__ bf16x8 pack8(const f32x4& a, const f32x4& b) { v4u w; w.x = cvtpk(a[0], a[1]); w.y = cvtpk(a[2], a[3]); w.z = cvtpk(b[0], b[1]); w.w = cvtpk(b[2], b[3]); return __builtin_bit_cast(bf16x8, w); }
constexpr int SC_W = 0, SC_QG = 17408, SC_KDT = 34816, SC_A = 53248, SC_BUF = 62464;
__device__ __forceinline__ void dn_scan_mfma(const Args& a, LAS unsigned char* L8, int bh, int tid, int lane, int wave) {
    unsigned char* ws = a.ws;
    const int b = bh >> 2, h = bh & 3;
    const int jl = lane & 15, kq = lane >> 4, cs = wave * 16;
    bf16* MIX = (bf16*)(ws + WS_XN);
    const float* EG = (const float*)(ws + WS_EG);
    f32x4 Sacc[8];
#pragma unroll
    for (int T = 0; T < 8; ++T) Sacc[T] = (f32x4){0.f, 0.f, 0.f, 0.f};
    v4u st[7]; v2u ut[4], utn[4];
    const int r16 = tid >> 4, c16 = tid & 15, r8 = tid >> 3, c8 = tid & 7;
#define SC_LOAD(chx) do { const size_t o8 = (size_t)(chx) * 8192; \
        const bf16* Wg = (const bf16*)(ws + WS_W) + o8; const bf16* Qg = (const bf16*)(ws + WS_QG) + o8; const bf16* Kg = (const bf16*)(ws + WS_KD) + o8; const bf16* Ag = (const bf16*)(ws + WS_A) + (size_t)(chx) * 4096; \
        st[0] = *(const v4u*)(Wg + tid * 8); st[1] = *(const v4u*)(Wg + 4096 + tid * 8); st[2] = *(const v4u*)(Qg + tid * 8); st[3] = *(const v4u*)(Qg + 4096 + tid * 8); \
        st[4] = *(const v4u*)(Kg + tid * 8); st[5] = *(const v4u*)(Kg + 4096 + tid * 8); st[6] = *(const v4u*)(Ag + tid * 8); \
        const bf16* Ug = (const bf16*)(ws + WS_U) + o8 + (cs + jl) * 64 + 4 * kq; \
        utn[0] = *(const v2u*)(Ug); utn[1] = *(const v2u*)(Ug + 16); utn[2] = *(const v2u*)(Ug + 32); utn[3] = *(const v2u*)(Ug + 48); } while (0)
#define SC_WRITE(bufp) do { LAS unsigned char* B_ = (bufp); \
        *(LAS v4u*)(B_ + SC_W + r16 * 272 + c16 * 16) = st[0]; *(LAS v4u*)(B_ + SC_W + (r16 + 32) * 272 + c16 * 16) = st[1]; \
        *(LAS v4u*)(B_ + SC_QG + r16 * 272 + c16 * 16) = st[2]; *(LAS v4u*)(B_ + SC_QG + (r16 + 32) * 272 + c16 * 16) = st[3]; \
        *(LAS v4u*)(B_ + SC_KDT + r8 * 144 + c8 * 16) = st[4]; *(LAS v4u*)(B_ + SC_KDT + (r8 + 64) * 144 + c8 * 16) = st[5]; \
        *(LAS v4u*)(B_ + SC_A + r8 * 144 + c8 * 16) = st[6]; } while (0)
    SC_LOAD(bh * 64);
    SC_WRITE(L8);
#pragma unroll
    for (int i = 0; i < 4; ++i) ut[i] = utn[i];
    __syncthreads();
    for (int n = 0; n < 64; ++n) {
        const int ch = bh * 64 + n;
        if (n + 1 < 64) SC_LOAD(ch + 1);
        const float eg = EG[ch];
        const LAS unsigned char* B = L8 + (n & 1) * SC_BUF;
        bf16x8 sb[4];
#pragma unroll
        for (int ks = 0; ks < 4; ++ks) sb[ks] = pack8(Sacc[2 * ks], Sacc[2 * ks + 1]);
        f32x4 vn[4], oa[4];
#pragma unroll
        for (int mt = 0; mt < 4; ++mt) { vn[mt] = (f32x4){bflo(ut[mt].x), bfhi(ut[mt].x), bflo(ut[mt].y), bfhi(ut[mt].y)}; oa[mt] = (f32x4){0.f, 0.f, 0.f, 0.f}; }
#pragma unroll
        for (int mt = 0; mt < 4; ++mt)
#pragma unroll
            for (int ks = 0; ks < 4; ++ks) {
                const bf16x8 wa = *(const LAS bf16x8*)(B + SC_W + (16 * mt + jl) * 272 + (32 * ks + 8 * kq) * 2);
                const bf16x8 qa = *(const LAS bf16x8*)(B + SC_QG + (16 * mt + jl) * 272 + (32 * ks + 8 * kq) * 2);
                vn[mt] = __builtin_amdgcn_mfma_f32_16x16x32_bf16(wa, sb[ks], vn[mt], 0, 0, 0);
                oa[mt] = __builtin_amdgcn_mfma_f32_16x16x32_bf16(qa, sb[ks], oa[mt], 0, 0, 0);
            }
        bf16x8 vb[2];
        vb[0] = pack8(vn[0], vn[1]); vb[1] = pack8(vn[2], vn[3]);
#pragma unroll
        for (int T = 0; T < 8; ++T) { Sacc[T] = Sacc[T] * eg;
#pragma unroll
            for (int k2 = 0; k2 < 2; ++k2) { const bf16x8 ka = *(const LAS bf16x8*)(B + SC_KDT + (16 * T + jl) * 144 + (32 * k2 + 8 * kq) * 2);
                Sacc[T] = __builtin_amdgcn_mfma_f32_16x16x32_bf16(ka, vb[k2], Sacc[T], 0, 0, 0); } }
#pragma unroll
        for (int mt = 0; mt < 4; ++mt)
#pragma unroll
            for (int k2 = 0; k2 < 2; ++k2) { const bf16x8 aa = *(const LAS bf16x8*)(B + SC_A + (16 * mt + jl) * 144 + (32 * k2 + 8 * kq) * 2);
                oa[mt] = __builtin_amdgcn_mfma_f32_16x16x32_bf16(aa, vb[k2], oa[mt], 0, 0, 0); }
        bf16* op = MIX + (size_t)(b * SEQ + n * 64 + 4 * kq) * 1024 + 512 + h * 128 + cs + jl;
#pragma unroll
        for (int mt = 0; mt < 4; ++mt)
#pragma unroll
            for (int e = 0; e < 4; ++e) op[(size_t)(16 * mt + e) * 1024] = (bf16)f2bf(oa[mt][e]);
        if (n + 1 < 64) { SC_WRITE(L8 + ((n + 1) & 1) * SC_BUF);
#pragma unroll
            for (int i = 0; i < 4; ++i) ut[i] = utn[i]; }
        __syncthreads();
    }
#undef SC_LOAD
#undef SC_WRITE
}

typedef float f32x16 __attribute__((ext_vector_type(16)));
typedef short s16x4 __attribute__((ext_vector_type(4)));
__device__ __forceinline__ s16x4 vtr(const LAS unsigned char* p) { return __builtin_bit_cast(s16x4, __builtin_amdgcn_ds_read_tr16_b64_v4i16((LAS s16x4*)p)); }
constexpr int KVP = 144;
constexpr int KV_BYTES = 384 * KVP;
constexpr size_t WS_ML = 173 * MiB;
__device__ __forceinline__ void attn_item(bf16* PROJ, float* ML, LAS unsigned char* L8, int item, int tid, int lane, int wave) {
    asm volatile("" : "+v"(lane));
    const int bh = item / 48, rem = item - bh * 48, p = rem >> 4, sub = rem & 15;
    const int b = bh >> 3, h = bh & 7;
    const int dsh = 2 * p, dil = 1 << dsh, nsh = 4 - dsh;
    const int r = sub >> nsh, qb = sub & ((1 << nsh) - 1);
    const int base = 256 * qb;
    const size_t tokb = (size_t)b * SEQ + r;
#pragma unroll
    for (int i = 0; i < 6; ++i) { const int id = tid + 512 * i, row = id >> 3, ch = id & 7, idx = base - 128 + row;
        v4u kv = (v4u){0u, 0u, 0u, 0u}, vv = (v4u){0u, 0u, 0u, 0u};
        if (idx >= 0) { const bf16* src = PROJ + (tokb + (size_t)dil * idx) * NIN + h * 64 + ch * 8; kv = *(const v4u*)(src + 512); vv = *(const v4u*)(src + 1024); }
        *(LAS v4u*)(L8 + row * KVP + ch * 16) = kv; *(LAS v4u*)(L8 + KV_BYTES + row * KVP + ch * 16) = vv; }
    const int ql = lane & 31, kh = lane >> 5;
    const size_t tokq = tokb + (size_t)dil * (base + 32 * wave + ql);
    bf16x8 qf[4];
#pragma unroll
    for (int s = 0; s < 4; ++s) qf[s] = *(const bf16x8*)(PROJ + tokq * NIN + h * 64 + 16 * s + 8 * kh);
    __syncthreads();
    f32x16 sc[5];
#pragma unroll
    for (int kt = 0; kt < 5; ++kt) { f32x16 acc = {};
#pragma unroll
        for (int s = 0; s < 4; ++s) { const bf16x8 kf = *(const LAS bf16x8*)(L8 + (32 * (wave + kt) + ql) * KVP + (16 * s + 8 * kh) * 2); acc = __builtin_amdgcn_mfma_f32_32x32x16_bf16(kf, qf[s], acc, 0, 0, 0); }
        sc[kt] = acc; }
    const float LOG2E = 1.4426950408889634f;
    const float c1 = 0.125f * LOG2E, c2 = exp2f(-(float)(h + 1)) * (float)dil * LOG2E;
    float mx = -INFINITY;
#pragma unroll
    for (int kt = 0; kt < 5; ++kt)
#pragma unroll
        for (int rr = 0; rr < 16; ++rr) { const int kk = (rr & 3) + 8 * (rr >> 2) + 4 * kh; const int dist = 128 + ql - 32 * kt - kk; const int kidx = base - 128 + 32 * (wave + kt) + kk;
            const bool valid = (dist >= 0) && (dist <= 128) && (kidx >= 0);
            const float v = valid ? sc[kt][rr] * c1 - c2 * (float)dist : -INFINITY; sc[kt][rr] = v; mx = fmaxf(mx, v); }
    mx = fmaxf(mx, __shfl_xor(mx, 32));
    float lsum = 0.f;
#pragma unroll
    for (int kt = 0; kt < 5; ++kt)
#pragma unroll
        for (int rr = 0; rr < 16; ++rr) { const float pv = __builtin_amdgcn_exp2f(sc[kt][rr] - mx); sc[kt][rr] = pv; lsum += pv; }
    lsum += __shfl_xor(lsum, 32);
    f32x16 o[2]; o[0] = (f32x16){}; o[1] = (f32x16){};
    const int q4 = (lane & 15) >> 2, pp = lane & 3, blk = (lane >> 4) & 1;
    const LAS unsigned char* Vb = L8 + KV_BYTES + (4 * kh + q4) * KVP + (16 * blk + 4 * pp) * 2;
#pragma unroll
    for (int kt = 0; kt < 5; ++kt)
#pragma unroll
        for (int s2 = 0; s2 < 2; ++s2) {
            v4u pw; pw.x = cvtpk(sc[kt][8 * s2 + 0], sc[kt][8 * s2 + 1]); pw.y = cvtpk(sc[kt][8 * s2 + 2], sc[kt][8 * s2 + 3]); pw.z = cvtpk(sc[kt][8 * s2 + 4], sc[kt][8 * s2 + 5]); pw.w = cvtpk(sc[kt][8 * s2 + 6], sc[kt][8 * s2 + 7]);
            const bf16x8 pb = __builtin_bit_cast(bf16x8, pw);
            const LAS unsigned char* vr = Vb + (32 * (wave + kt) + 16 * s2) * KVP;
#pragma unroll
            for (int c = 0; c < 2; ++c) { const s16x4 lo = vtr(vr + c * 64), hi = vtr(vr + 8 * KVP + c * 64);
                const bf16x8 va = (bf16x8){lo[0], lo[1], lo[2], lo[3], hi[0], hi[1], hi[2], hi[3]};
                o[c] = __builtin_amdgcn_mfma_f32_32x32x16_bf16(va, pb, o[c], 0, 0, 0); }
        }
    const float inv = 1.0f / lsum;
    bf16* dst = PROJ + tokq * NIN + 1536 + p * 512 + h * 64 + 4 * kh;
#pragma unroll
    for (int c = 0; c < 2; ++c)
#pragma unroll
        for (int g = 0; g < 4; ++g) { v2u w; w.x = cvtpk(o[c][4 * g + 0] * inv, o[c][4 * g + 1] * inv); w.y = cvtpk(o[c][4 * g + 2] * inv, o[c][4 * g + 3] * inv);
            *(v2u*)(dst + 32 * c + 8 * g) = w; }
    if (kh == 0) { float* ml = ML + ((tokq * 8 + h) * 3 + p) * 2; *(f32x2*)ml = (f32x2){mx, lsum}; }
    __syncthreads();
}

__global__ void __launch_bounds__(NWAVES * 64, 2) fwd_megakernel(Args a) {
    extern __shared__ __attribute__((aligned(16))) unsigned char lds[];
    cg::grid_group grid = cg::this_grid();
    LAS unsigned char* L8 = (LAS unsigned char*)lds;
    LAS float* L = (LAS float*)lds;
    const int tid = threadIdx.x, lane = tid & 63, wave = __builtin_amdgcn_readfirstlane(tid >> 6);
    const int G = gridDim.x, gw = blockIdx.x * NWAVES + wave, NGW = G * NWAVES;
    unsigned char* ws = a.ws;
    unsigned* ctl = (unsigned*)(ws + WS_CTL);
    const float* x = a.in[0];
    bf16* XN = (bf16*)(ws + WS_XN); bf16* ACT = (bf16*)(ws + WS_ACT); bf16* PROJ = ACT; bf16* MIX = XN;
    bf16* Wgu1 = (bf16*)(ws + WS_WGU1); bf16* Wd1 = (bf16*)(ws + WS_WD1); bf16* Win = (bf16*)(ws + WS_WIN); bf16* Wout = (bf16*)(ws + WS_WOUT);
    bf16* Wgu2 = (bf16*)(ws + WS_WGU2); bf16* Wd2 = (bf16*)(ws + WS_WD2);
    float* out = a.out;

    {
        const int lane = opq(tid) & 63;
        LAS float* scr = L + wave * 4096;
        constexpr int I_GU = (D / 64) * (NGU / 32), I_D = (FF / 64) * (D / 32), I_IN = (D / 64) * (NIN / 32), I_O = (D / 64) * (D / 32);
        constexpr int NITEMS = 2 * I_GU + 2 * I_D + I_IN + I_O;
        for (int it = gw; it < NITEMS; it += NGW) {
            int r = it;
            if (r < I_GU) { tr_gu(a.in[2], a.in[3], Wgu1, r, scr, lane); continue; } r -= I_GU;
            if (r < I_D) { tr_plain(a.in[4], FF, D, Wd1, r, scr, lane); continue; } r -= I_D;
            if (r < I_IN) { tr_win(a.in[6], Win, r, scr, lane); continue; } r -= I_IN;
            if (r < I_O) { tr_plain(a.in[11], D, D, Wout, r, scr, lane); continue; } r -= I_O;
            if (r < I_GU) { tr_gu(a.in[13], a.in[14], Wgu2, r, scr, lane); continue; } r -= I_GU;
            tr_plain(a.in[15], FF, D, Wd2, r, scr, lane);
        }
        for (int m = gw; m < M; m += NGW) { f32x4 v[4]; rms_row(x + (size_t)m * D, a.in[1], lane, v); store_row_bf16(XN + (size_t)m * D, lane, v); }
    }
    grid.sync();
    {
        pg8::Gemm g{XN, Wgu1, M, NGU, D}; pg8::StaticOrder S; S.init(M, NGU, G, (int)blockIdx.x);
        pg8::EpiSwiGLU E{ACT, FF};
        pg8::gemm_phase<pg8::EpiSwiGLU, pg8::StaticOrder, true, true>(L8, g, S, E);
    }
    grid.sync();
    {
        pg8::Gemm g{ACT, Wd1, M, D, FF}; pg8::StaticOrder S; S.init(M, D, G, (int)blockIdx.x);
        pg8::EpiRes E{x, out, D, 0.5f};
        pg8::gemm_phase<pg8::EpiRes, pg8::StaticOrder, true, true>(L8, g, S, E);
    }
    grid.sync();
    {
        const int lane = opq(tid) & 63;
        const float* w_in = a.in[6]; float* BD = (float*)(ws + WS_BD);
        for (int m = gw; m < M; m += NGW) {
            f32x4 v[4]; rms_row(out + (size_t)m * D, a.in[5], lane, v); store_row_bf16(XN + (size_t)m * D, lane, v);
            float acc[8];
#pragma unroll
            for (int o = 0; o < 8; ++o) acc[o] = 0.f;
#pragma unroll
            for (int j = 0; j < 4; ++j)
#pragma unroll
                for (int i = 0; i < 4; ++i) { const int k = 4 * (lane + 64 * j) + i; const f32x4 w0 = *(const f32x4*)(w_in + (size_t)k * WIN_COLS + 3072), w1 = *(const f32x4*)(w_in + (size_t)k * WIN_COLS + 3076);
                    const float hv = v[j][i];
                    acc[0] += hv * w0.x; acc[1] += hv * w0.y; acc[2] += hv * w0.z; acc[3] += hv * w0.w; acc[4] += hv * w1.x; acc[5] += hv * w1.y; acc[6] += hv * w1.z; acc[7] += hv * w1.w; }
#pragma unroll
            for (int o = 0; o < 8; ++o) acc[o] = wave_sum(acc[o]);
            if (lane == 0) { *(f32x4*)(BD + (size_t)m * 8) = (f32x4){acc[0], acc[1], acc[2], acc[3]}; *(f32x4*)(BD + (size_t)m * 8 + 4) = (f32x4){acc[4], acc[5], acc[6], acc[7]}; }
        }
    }
    grid.sync();
    {
        pg8::Gemm g{XN, Win, M, NIN, D}; pg8::StaticOrder S; S.init(M, NIN, G, (int)blockIdx.x);
        pg8::EpiStoreBf16 E{PROJ, NIN};
        pg8::gemm_phase<pg8::EpiStoreBf16, pg8::StaticOrder, true, true>(L8, g, S, E);
    }
    grid.sync();
    { const int tid_ = opq(tid); for (int ch = blockIdx.x; ch < 1024; ch += G) dn_prep_item(a, L, ch, tid_, tid_ & 63, wave); }
    grid.sync();
    {
        const int tid_ = opq(tid), lane = tid_ & 63;
        for (int it = blockIdx.x; it < 16; it += G) dn_scan_mfma(a, L8, it, tid_, lane, wave);
        LAS unsigned* bc = (LAS unsigned*)(L8 + 2 * KV_BYTES);
        float* ML = (float*)(ws + WS_ML);
        for (;;) {
            if (tid == 0) bc[0] = atomicAdd(ctl + 64, 1u);
            __syncthreads();
            const unsigned item = bc[0];
            __syncthreads();
            if (item >= 1536u) break;
            attn_item(PROJ, ML, L8, (int)item, tid, lane, wave);
        }
    }
    grid.sync();
    {
        const int lane = opq(tid) & 63;
        const float* dn_norm = a.in[10];
        for (int m = gw; m < M; m += NGW) {
            bf16* op = MIX + (size_t)m * 1024 + 512 + 8 * lane; const bf16* gp = PROJ + (size_t)m * NIN + 3072 + 8 * lane;
            const v4u ow = *(const v4u*)op, gwv = *(const v4u*)gp;
            float o[8] = {bflo(ow.x), bfhi(ow.x), bflo(ow.y), bfhi(ow.y), bflo(ow.z), bfhi(ow.z), bflo(ow.w), bfhi(ow.w)};
            float gt[8] = {bflo(gwv.x), bfhi(gwv.x), bflo(gwv.y), bfhi(gwv.y), bflo(gwv.z), bfhi(gwv.z), bflo(gwv.w), bfhi(gwv.w)};
            float ss = 0.f;
#pragma unroll
            for (int i = 0; i < 8; ++i) ss += o[i] * o[i];
            ss += __shfl_xor(ss, 1); ss += __shfl_xor(ss, 2); ss += __shfl_xor(ss, 4); ss += __shfl_xor(ss, 8);
            const float rs = 1.0f / sqrtf(ss * (1.f / 128.f) + 1e-6f);
            const int d0 = (8 * lane) & 127;
            float r[8];
#pragma unroll
            for (int i = 0; i < 8; ++i) r[i] = o[i] * rs * dn_norm[d0 + i] * (gt[i] / (1.f + __expf(-gt[i])));
            v4u w; w.x = pk2(r[0], r[1]); w.y = pk2(r[2], r[3]); w.z = pk2(r[4], r[5]); w.w = pk2(r[6], r[7]);
            *(v4u*)op = w;
            {
                const int ha = lane >> 3;
                const float* ml = (const float*)(ws + WS_ML) + ((size_t)m * 8 + ha) * 6;
                const f32x2 a0 = *(const f32x2*)ml, a1 = *(const f32x2*)(ml + 2), a2 = *(const f32x2*)(ml + 4);
                const float mm = fmaxf(a0.x, fmaxf(a1.x, a2.x));
                const float w0 = a0.y * __builtin_amdgcn_exp2f(a0.x - mm), w1 = a1.y * __builtin_amdgcn_exp2f(a1.x - mm), w2 = a2.y * __builtin_amdgcn_exp2f(a2.x - mm);
                const float iw = 1.0f / (w0 + w1 + w2);
                const bf16* pp = PROJ + (size_t)m * NIN + 1536 + 8 * lane;
                const v4u p0 = *(const v4u*)pp, p1 = *(const v4u*)(pp + 512), p2 = *(const v4u*)(pp + 1024);
                float rr[8];
                rr[0] = w0 * bflo(p0.x) + w1 * bflo(p1.x) + w2 * bflo(p2.x); rr[1] = w0 * bfhi(p0.x) + w1 * bfhi(p1.x) + w2 * bfhi(p2.x);
                rr[2] = w0 * bflo(p0.y) + w1 * bflo(p1.y) + w2 * bflo(p2.y); rr[3] = w0 * bfhi(p0.y) + w1 * bfhi(p1.y) + w2 * bfhi(p2.y);
                rr[4] = w0 * bflo(p0.z) + w1 * bflo(p1.z) + w2 * bflo(p2.z); rr[5] = w0 * bfhi(p0.z) + w1 * bfhi(p1.z) + w2 * bfhi(p2.z);
                rr[6] = w0 * bflo(p0.w) + w1 * bflo(p1.w) + w2 * bflo(p2.w); rr[7] = w0 * bfhi(p0.w) + w1 * bfhi(p1.w) + w2 * bfhi(p2.w);
                v4u wa; wa.x = pk2(rr[0] * iw, rr[1] * iw); wa.y = pk2(rr[2] * iw, rr[3] * iw); wa.z = pk2(rr[4] * iw, rr[5] * iw); wa.w = pk2(rr[6] * iw, rr[7] * iw);
                *(v4u*)(MIX + (size_t)m * 1024 + 8 * lane) = wa;
            }
        }
    }
    grid.sync();
    {
        pg8::Gemm g{MIX, Wout, M, D, D}; pg8::StaticOrder S; S.init(M, D, G, (int)blockIdx.x);
        pg8::EpiRes E{out, out, D, 1.0f};
        pg8::gemm_phase<pg8::EpiRes, pg8::StaticOrder, true, true>(L8, g, S, E);
    }
    grid.sync();
    { const int ln = opq(tid) & 63; for (int m = gw; m < M; m += NGW) { f32x4 v[4]; rms_row(out + (size_t)m * D, a.in[12], ln, v); store_row_bf16(XN + (size_t)m * D, ln, v); } }
    grid.sync();
    {
        pg8::Gemm g{XN, Wgu2, M, NGU, D}; pg8::StaticOrder S; S.init(M, NGU, G, (int)blockIdx.x);
        pg8::EpiSwiGLU E{ACT, FF};
        pg8::gemm_phase<pg8::EpiSwiGLU, pg8::StaticOrder, true, true>(L8, g, S, E);
    }
    grid.sync();
    {
        pg8::Gemm g{ACT, Wd2, M, D, FF}; pg8::StaticOrder S; S.init(M, D, G, (int)blockIdx.x);
        pg8::EpiRes E{out, out, D, 0.5f};
        pg8::gemm_phase<pg8::EpiRes, pg8::StaticOrder, true, true>(L8, g, S, E);
    }
    grid.sync();
    const int lnf = opq(tid) & 63;
    for (int m = gw; m < M; m += NGW) {
        f32x4 v[4]; rms_row(out + (size_t)m * D, a.in[16], lnf, v);
        f32x4* o = (f32x4*)(out + (size_t)m * D) + lnf;
#pragma unroll
        for (int j = 0; j < 4; ++j) o[64 * j] = v[j];
    }
}

extern "C" void kernel_launch(void* const* d_in, const int* in_sizes, int n_in, void* d_out, int out_size, void* d_ws, size_t ws_size, hipStream_t stream) {
    static int grid = 0;
    if (grid == 0) {
        if (n_in != 17 || in_sizes[0] != M * D || out_size != M * D || ws_size < WS_END) { fprintf(stderr, "kernel_launch: unexpected shapes (n_in %d in0 %d out %d ws %zu)\n", n_in, n_in > 0 ? in_sizes[0] : -1, out_size, ws_size); grid = -1; return; }
        int dev = 0, cus = 0, per_cu = 0;
        hipGetDevice(&dev); hipDeviceGetAttribute(&cus, hipDeviceAttributeMultiprocessorCount, dev);
        if (hipFuncSetAttribute((const void*)fwd_megakernel, hipFuncAttributeMaxDynamicSharedMemorySize, LDS_BYTES) != hipSuccess) { fprintf(stderr, "kernel_launch: hipFuncSetAttribute failed\n"); grid = -1; return; }
        if (hipOccupancyMaxActiveBlocksPerMultiprocessor(&per_cu, (const void*)fwd_megakernel, NWAVES * 64, LDS_BYTES) != hipSuccess || per_cu < 1) { fprintf(stderr, "kernel_launch: occupancy query says %d blocks/CU\n", per_cu); (void)hipGetLastError(); per_cu = 1; }
        grid = cus * 1;
        fprintf(stderr, "kernel_launch: cus %d per_cu %d grid %d\n", cus, per_cu, grid);
    }
    if (grid < 0) return;
    hipMemsetAsync((char*)d_ws + WS_CTL, 0, CTL_BYTES, stream);
    Args a{};
    for (int i = 0; i < 17; ++i) a.in[i] = (const float*)d_in[i];
    a.out = (float*)d_out; a.ws = (unsigned char*)d_ws;
    void* args[] = {&a};
    hipError_t e = hipLaunchCooperativeKernel((const void*)fwd_megakernel, dim3(grid), dim3(NWAVES * 64), args, LDS_BYTES, stream);
    if (e != hipSuccess) fprintf(stderr, "cooperative launch failed: %s (grid %d)\n", hipGetErrorString(e), grid);
}
```

```cpp
#include <hip/hip_runtime.h>
#include <hip/hip_cooperative_groups.h>
#include <cstdio>
#include <cstdint>
namespace cg = cooperative_groups;
namespace pg8 {
#define PG8_LAS __attribute__((address_space(3)))
typedef unsigned short bf16_t;
typedef short bf16x8 __attribute__((ext_vector_type(8)));
typedef float f32x4 __attribute__((ext_vector_type(4)));
typedef unsigned u32x4 __attribute__((ext_vector_type(4)));
constexpr int BM = 256, BK = 64, HALF = 128, HTB = HALF * BK * 2  , STAGE_BYTES = 8 * HTB, NXCD = 8, WGM = 8;

__host__ __device__ __forceinline__ int lds_byte(int r, int c) { const int st = (r >> 4) * 2 + (c >> 5), rr = r & 15, cc = c & 31, ob = rr * 64 + cc * 2; return st * 1024 + (ob ^ (((ob >> 9) & 1) << 5)); }
__host__ __device__ __forceinline__ void stage_rc(int b, int& R, int& C) { const int st = b / 1024, sb = b % 1024, swz = sb ^ (((sb >> 9) & 1) << 5); R = (st >> 1) * 16 + swz / 64; C = (st & 1) * 32 + (swz % 64) / 2; }
__host__ __device__ __forceinline__ int perm32(int rho) { const int n = rho >> 4, i = rho & 15; return 8 * (i >> 2) + 4 * n + (i & 3); }

struct Unit { int pm, pn; };
struct Gemm { const bf16_t* A; const bf16_t* Bt; int M, N, K; };

struct StaticOrder {
    int nM, nN, nwg, G, c;
    __host__ __device__ void init(int M, int N, int G_, int c_) { nM = M / BM; nN = N / BM; nwg = nM * nN; G = G_; c = c_; }
    __host__ __device__ bool next(int i, Unit& u) const {
        const long L = (long)i * G + c; if (L >= nwg) return false;
        int wgid = (int)L; { const int q = nwg / NXCD, r = nwg % NXCD, xcd = wgid % NXCD, off = wgid / NXCD; wgid = (xcd < r ? xcd * (q + 1) : r * (q + 1) + (xcd - r) * q) + off; }
        const int nig = WGM * nN, gid = wgid / nig, fm = gid * WGM, gsz = (nM - fm) < WGM ? (nM - fm) : WGM;
        u.pm = fm + ((wgid % nig) % gsz); u.pn = (wgid % nig) / gsz; return true;
    }
    __device__ __forceinline__ void a_ready(const Unit&) const {}
    __device__ __forceinline__ void done(const Unit&) const {}
};

__device__ __forceinline__ unsigned cvt_pk_bf16(float lo, float hi) { unsigned r; asm volatile("v_cvt_pk_bf16_f32 %0, %1, %2" : "=v"(r) : "v"(lo), "v"(hi)); return r; }
__device__ __forceinline__ float silu_f(float g) { return g * __builtin_amdgcn_rcpf(1.0f + __expf(-g)); }
struct EpiSwiGLU {
    static constexpr bool PERM = true, AFTER_DRAIN = false;
    bf16_t* O; int ldc;
    __device__ __forceinline__ void operator()(const f32x4 (&acc)[2][2][4][2], const Unit& u, int wr, int wc, int fr, int fq) const {
        const int row0 = u.pm * BM + wr * 64 + fr; const int col0 = u.pn * 128 + wc * 32 + 8 * fq;
#pragma unroll
        for (int ai = 0; ai < 2; ++ai)
#pragma unroll
            for (int m = 0; m < 4; ++m) { bf16_t* rowp = O + (size_t)(row0 + ai * HALF + m * 16) * ldc + col0;
                const f32x4 g0 = acc[ai][0][m][0], g1 = acc[ai][0][m][1], u0 = acc[ai][1][m][0], u1 = acc[ai][1][m][1];
                u32x4 w;
                w.x = cvt_pk_bf16(silu_f(g0[0]) * u0[0], silu_f(g0[1]) * u0[1]); w.y = cvt_pk_bf16(silu_f(g0[2]) * u0[2], silu_f(g0[3]) * u0[3]);
                w.z = cvt_pk_bf16(silu_f(g1[0]) * u1[0], silu_f(g1[1]) * u1[1]); w.w = cvt_pk_bf16(silu_f(g1[2]) * u1[2], silu_f(g1[3]) * u1[3]);
                *(u32x4*)rowp = w; }
    }
};
struct EpiRes {
    static constexpr bool PERM = false, AFTER_DRAIN = false;
    const float* base; float* out; int ldc; float scale;
    __device__ __forceinline__ void operator()(const f32x4 (&acc)[2][2][4][2], const Unit& u, int wr, int wc, int fr, int fq) const {
        const int row0 = u.pm * BM + wr * 64 + fr; const int col0 = u.pn * BM + wc * 32 + 4 * fq;
#pragma unroll
        for (int ai = 0; ai < 2; ++ai)
#pragma unroll
            for (int m = 0; m < 4; ++m) { const size_t off = (size_t)(row0 + ai * HALF + m * 16) * ldc + col0;
#pragma unroll
                for (int bj = 0; bj < 2; ++bj)
#pragma unroll
                    for (int n = 0; n < 2; ++n) { const f32x4 b = *(const f32x4*)(base + off + bj * HALF + n * 16); *(f32x4*)(out + off + bj * HALF + n * 16) = b + acc[ai][bj][m][n] * scale; }
                asm volatile("" ::: "memory"); }
    }
};
struct EpiStoreBf16 {
    static constexpr bool PERM = true, AFTER_DRAIN = false;
    bf16_t* O; int ldc;
    __device__ __forceinline__ void operator()(const f32x4 (&acc)[2][2][4][2], const Unit& u, int wr, int wc, int fr, int fq) const {
        const int row0 = u.pm * BM + wr * 64 + fr; const int col0 = u.pn * BM + wc * 32 + 8 * fq;
#pragma unroll
        for (int ai = 0; ai < 2; ++ai)
#pragma unroll
            for (int m = 0; m < 4; ++m) { bf16_t* rowp = O + (size_t)(row0 + ai * HALF + m * 16) * ldc + col0;
#pragma unroll
                for (int bj = 0; bj < 2; ++bj) { const f32x4 v0 = acc[ai][bj][m][0], v1 = acc[ai][bj][m][1]; u32x4 w;
                    w.x = cvt_pk_bf16(v0[0], v0[1]); w.y = cvt_pk_bf16(v0[2], v0[3]); w.z = cvt_pk_bf16(v1[0], v1[1]); w.w = cvt_pk_bf16(v1[2], v1[3]);
                    *(u32x4*)(rowp + bj * HALF) = w; } }
    }
};
template <class Epi, class Sched, bool ALIGN_EPI = false, bool SP2 = false>
__device__ __forceinline__ void gemm_phase(PG8_LAS unsigned char* lds, const Gemm g, const Sched& S, const Epi& E) {
    const int tid = threadIdx.x, wid = __builtin_amdgcn_readfirstlane(tid >> 6), lane = tid & 63, wr = wid >> 2, wc = wid & 3, fr = lane & 15, fq = lane >> 4;
    const int K = g.K, nt = K / BK;
    unsigned voffA[2], voffB[2];
#pragma unroll
    for (int i = 0; i < 2; ++i) { int R, C; stage_rc(tid * 16 + i * 8192, R, C); const int Rb = Epi::PERM ? ((R & ~31) + perm32(R & 31)) : R;
        voffA[i] = (unsigned)(R * K + C) * 2u; voffB[i] = (unsigned)(Rb * K + C) * 2u; }
    const size_t kstep = (size_t)(BK * 2);
    const size_t hstep = (size_t)HALF * K * 2;
    const size_t tstep = 2 * hstep;
    const unsigned ldsw = (unsigned)wid * 1024u;
    const int aoff = lds_byte(wr * 64 + fr, fq * 8), boff = lds_byte(wc * 32 + fr, fq * 8);
#define PG8_SA(b, h) (((b) * 2 + (h)) * HTB)
#define PG8_SB(b, h) ((4 + (b) * 2 + (h)) * HTB)
#define PG8_STAGE(bufoff, gbase, voff) do { _Pragma("unroll") for (int _i = 0; _i < 2; ++_i) \
        __builtin_amdgcn_global_load_lds((const unsigned*)((const char*)(gbase) + (voff)[_i]), (PG8_LAS unsigned*)(lds + (bufoff) + ldsw + _i * 8192), 16, 0, 0); } while (0)
#define PG8_LDA(dst, b, h) do { _Pragma("unroll") for (int m = 0; m < 4; ++m) _Pragma("unroll") for (int k = 0; k < 2; ++k) dst[m][k] = *(const PG8_LAS bf16x8*)(lds + PG8_SA(b, h) + aoff + m * 2048 + k * 1024); } while (0)
#define PG8_LDB(dst, b, h) do { _Pragma("unroll") for (int n = 0; n < 2; ++n) _Pragma("unroll") for (int k = 0; k < 2; ++k) dst[n][k] = *(const PG8_LAS bf16x8*)(lds + PG8_SB(b, h) + boff + n * 2048 + k * 1024); } while (0)
#define PG8_MMA(ai, bj, At, Bt) do { __builtin_amdgcn_s_setprio(1); _Pragma("unroll") for (int m = 0; m < 4; ++m) _Pragma("unroll") for (int n = 0; n < 2; ++n) _Pragma("unroll") for (int k = 0; k < 2; ++k) \
        acc[ai][bj][m][n] = __builtin_amdgcn_mfma_f32_16x16x32_bf16(Bt[n][k], At[m][k], acc[ai][bj][m][n], 0, 0, 0); __builtin_amdgcn_s_setprio(0); } while (0)
#define PG8_WAIT_V(n) asm volatile("s_waitcnt vmcnt(" #n ")" ::: "memory")
#define PG8_WAIT_L(n) asm volatile("s_waitcnt lgkmcnt(" #n ")" ::: "memory")
#define PG8_BAR __builtin_amdgcn_s_barrier()
#define PG8_SCHED __builtin_amdgcn_sched_barrier(0)
    Unit cur, nxt; int ui = 0;
    if (!S.next(0, cur)) return;
    f32x4 acc[2][2][4][2];
#pragma unroll
    for (int a = 0; a < 2; ++a)
#pragma unroll
        for (int b = 0; b < 2; ++b)
#pragma unroll
            for (int m = 0; m < 4; ++m)
#pragma unroll
                for (int n = 0; n < 2; ++n) acc[a][b][m][n] = (f32x4){0.f, 0.f, 0.f, 0.f};
    bf16x8 At[4][2], B0[2][2], B1[2][2];
    const char* cA = (const char*)g.A + (size_t)cur.pm * tstep; const char* cB = (const char*)g.Bt + (size_t)cur.pn * tstep;
    S.a_ready(cur);
    if constexpr (SP2) {
        PG8_STAGE(PG8_SB(0, 0), cB, voffB); PG8_STAGE(PG8_SB(0, 1), cB + hstep, voffB); PG8_STAGE(PG8_SA(0, 0), cA, voffA); PG8_STAGE(PG8_SA(0, 1), cA + hstep, voffA);
        if (wr == 1) PG8_BAR;
        PG8_WAIT_V(2); PG8_BAR;
        PG8_STAGE(PG8_SB(1, 0), cB + kstep, voffB); PG8_STAGE(PG8_SA(1, 0), cA + kstep, voffA); PG8_STAGE(PG8_SB(1, 1), cB + hstep + kstep, voffB);
        PG8_WAIT_V(6); PG8_BAR;
    } else {
        PG8_STAGE(PG8_SB(0, 0), cB, voffB); PG8_STAGE(PG8_SA(0, 0), cA, voffA); PG8_STAGE(PG8_SB(0, 1), cB + hstep, voffB); PG8_STAGE(PG8_SA(0, 1), cA + hstep, voffA);
        if (wr == 1) PG8_BAR;
        PG8_WAIT_V(4); PG8_BAR;
        PG8_STAGE(PG8_SB(1, 0), cB + kstep, voffB); PG8_STAGE(PG8_SA(1, 0), cA + kstep, voffA); PG8_STAGE(PG8_SB(1, 1), cB + hstep + kstep, voffB);
        PG8_WAIT_V(6); PG8_BAR;
    }
    for (;;) {
        const bool has_next = S.next(ui + 1, nxt);
        const char* nA = has_next ? (const char*)g.A + (size_t)nxt.pm * tstep : cA; const char* nB = has_next ? (const char*)g.Bt + (size_t)nxt.pn * tstep : cB;
        for (int t = 0; t < nt; t += 2) {
            const bool last = (t == nt - 2);
            const char* a1 = cA + (size_t)(t + 1) * kstep;
            const char* a2 = last ? nA : cA + (size_t)(t + 2) * kstep; const char* b2 = last ? nB : cB + (size_t)(t + 2) * kstep;
            const char* a3 = a2 + kstep; const char* b3 = b2 + kstep;
            if (last && has_next) S.a_ready(nxt);
            if constexpr (SP2) {
            PG8_LDB(B0, 0, 0); PG8_LDB(B1, 0, 1); PG8_SCHED; PG8_LDA(At, 0, 0); PG8_STAGE(PG8_SA(1, 1), a1 + hstep, voffA);
            PG8_WAIT_V(8); PG8_WAIT_L(0); PG8_BAR; PG8_MMA(0, 0, At, B0); PG8_MMA(0, 1, At, B1); PG8_BAR; PG8_SCHED;
            PG8_LDA(At, 0, 1); PG8_STAGE(PG8_SB(0, 0), b2, voffB); PG8_STAGE(PG8_SB(0, 1), b2 + hstep, voffB); PG8_STAGE(PG8_SA(0, 0), a2, voffA);
            PG8_WAIT_V(8); PG8_WAIT_L(0); PG8_BAR; PG8_MMA(1, 0, At, B0); PG8_MMA(1, 1, At, B1); PG8_BAR; PG8_SCHED;
            PG8_LDB(B0, 1, 0); PG8_LDB(B1, 1, 1); PG8_SCHED; PG8_LDA(At, 1, 0); PG8_STAGE(PG8_SA(0, 1), a2 + hstep, voffA);
            PG8_WAIT_V(8); PG8_WAIT_L(0); PG8_BAR; PG8_MMA(0, 0, At, B0); PG8_MMA(0, 1, At, B1); PG8_BAR; PG8_SCHED;
            PG8_LDA(At, 1, 1); PG8_STAGE(PG8_SB(1, 0), b3, voffB); PG8_STAGE(PG8_SB(1, 1), b3 + hstep, voffB); PG8_STAGE(PG8_SA(1, 0), a3, voffA);
            PG8_WAIT_V(8); PG8_WAIT_L(0); PG8_BAR; PG8_MMA(1, 0, At, B0); PG8_MMA(1, 1, At, B1); PG8_BAR; PG8_SCHED;
            } else {
            PG8_LDB(B0, 0, 0); PG8_SCHED; PG8_LDA(At, 0, 0); PG8_STAGE(PG8_SA(1, 1), a1 + hstep, voffA);
            PG8_WAIT_L(8); PG8_BAR; PG8_WAIT_L(0); PG8_MMA(0, 0, At, B0); PG8_BAR; PG8_SCHED;
            PG8_LDB(B1, 0, 1); PG8_STAGE(PG8_SB(0, 0), b2, voffB);
            PG8_BAR; PG8_WAIT_L(0); PG8_MMA(0, 1, At, B1); PG8_BAR;
            PG8_LDA(At, 0, 1); PG8_STAGE(PG8_SA(0, 0), a2, voffA);
            PG8_BAR; PG8_WAIT_L(0); PG8_MMA(1, 0, At, B0); PG8_BAR; PG8_SCHED;
            PG8_STAGE(PG8_SB(0, 1), b2 + hstep, voffB);
            PG8_WAIT_V(6); PG8_BAR; PG8_MMA(1, 1, At, B1); PG8_BAR;
            PG8_LDB(B0, 1, 0); PG8_SCHED; PG8_LDA(At, 1, 0); PG8_STAGE(PG8_SA(0, 1), a2 + hstep, voffA);
            PG8_WAIT_L(8); PG8_BAR; PG8_WAIT_L(0); PG8_MMA(0, 0, At, B0); PG8_BAR; PG8_SCHED;
            PG8_LDB(B1, 1, 1); PG8_STAGE(PG8_SB(1, 0), b3, voffB);
            PG8_BAR; PG8_WAIT_L(0); PG8_MMA(0, 1, At, B1); PG8_BAR;
            PG8_LDA(At, 1, 1); PG8_STAGE(PG8_SA(1, 0), a3, voffA);
            PG8_BAR; PG8_WAIT_L(0); PG8_MMA(1, 0, At, B0); PG8_BAR; PG8_SCHED;
            PG8_STAGE(PG8_SB(1, 1), b3 + hstep, voffB);
            PG8_WAIT_V(6); PG8_BAR; PG8_MMA(1, 1, At, B1); PG8_BAR;
            }
        }
        if constexpr (ALIGN_EPI) { if (wr == 0) PG8_BAR; }
        if constexpr (!Epi::AFTER_DRAIN) { E(acc, cur, wr, wc, fr, fq); S.done(cur); }
        if (!has_next) break;
#pragma unroll
        for (int a = 0; a < 2; ++a)
#pragma unroll
            for (int b = 0; b < 2; ++b)
#pragma unroll
                for (int m = 0; m < 4; ++m)
#pragma unroll
                    for (int n = 0; n < 2; ++n) acc[a][b][m][n] = (f32x4){0.f, 0.f, 0.f, 0.f};
        cur = nxt; cA = nA; cB = nB; ++ui;
        if constexpr (ALIGN_EPI) { if (wr == 1) PG8_BAR; }
    }
    PG8_WAIT_V(0);
    if constexpr (!ALIGN_EPI) { if (wr == 0) PG8_BAR; }
    PG8_BAR;
    if constexpr (Epi::AFTER_DRAIN) { E.fused(acc, cur, wr, wc, fr, fq, lds, wid, lane); S.done(cur); }
#undef PG8_SA
#undef PG8_SB
#undef PG8_STAGE
#undef PG8_LDA
#undef PG8_LDB
#undef PG8_MMA
#undef PG8_WAIT_V
#undef PG8_WAIT_L
#undef PG8_BAR
#undef PG8_SCHED
}
}
constexpr int M = 16384, D = 1024, FF = 2816, NGU = 5632, NIN = 3584, SEQ = 4096;
constexpr int WIN_COLS = 3592;
constexpr size_t MiB = 1u << 20;
constexpr size_t WS_CTL = 0, CTL_BYTES = 65536;
constexpr size_t WS_WIN = 1 * MiB, WS_WOUT = 8 * MiB, WS_WGU2 = 10 * MiB, WS_WD2 = 21 * MiB;
constexpr size_t WS_XN = 27 * MiB;
constexpr size_t WS_ACT = 59 * MiB;
constexpr size_t WS_BD = 171 * MiB;
constexpr size_t WS_EG = 172 * MiB;
constexpr size_t WS_DN = 184 * MiB;
constexpr size_t WS_WGU1 = 184 * MiB, WS_WD1 = 195 * MiB;
constexpr size_t WS_QG = WS_DN, WS_KD = WS_DN + 16 * MiB, WS_U = WS_DN + 32 * MiB, WS_W = WS_DN + 48 * MiB, WS_A = WS_DN + 64 * MiB;
constexpr size_t WS_END = 256 * MiB;
constexpr int LDS_BYTES = 147456;
constexpr int NWAVES = 8;

#define GAS __attribute__((address_space(1)))
#define LAS __attribute__((address_space(3)))
typedef unsigned short bf16;
typedef unsigned v4u __attribute__((ext_vector_type(4)));
typedef unsigned v2u __attribute__((ext_vector_type(2)));
typedef float f32x4 __attribute__((ext_vector_type(4)));
typedef float f32x2 __attribute__((ext_vector_type(2)));
#define LDS_WAIT() asm volatile("s_waitcnt lgkmcnt(0)" ::: "memory")
__device__ __forceinline__ unsigned f2bf(float f) { unsigned u = __builtin_bit_cast(unsigned, f); return (u + 0x7fffu + ((u >> 16) & 1u)) >> 16; }
__device__ __forceinline__ unsigned pk2(float lo, float hi) { return f2bf(lo) | (f2bf(hi) << 16); }
__device__ __forceinline__ float bflo(unsigned u) { return __uint_as_float(u << 16); }
__device__ __forceinline__ float bfhi(unsigned u) { return __uint_as_float(u & 0xffff0000u); }
__device__ __forceinline__ float bf2f(bf16 v) { return __uint_as_float(((unsigned)v) << 16); }
__device__ __forceinline__ float wave_sum(float v) {
#pragma unroll
    for (int o = 1; o < 64; o <<= 1) v += __shfl_xor(v, o);
    return v;
}
__device__ __forceinline__ float wave_max(float v) {
#pragma unroll
    for (int o = 1; o < 64; o <<= 1) v = fmaxf(v, __shfl_xor(v, o));
    return v;
}

__device__ __forceinline__ int opq(int v) { asm volatile("" : "+v"(v)); return v; }
struct Args { const float* in[17]; float* out; unsigned char* ws; };

__device__ __forceinline__ void transpose_item(const float* src, int srcN, int srccol0, bf16* dst, int dstK, int dstrow0, int k0, LAS float* scr, int lane) {
#pragma unroll 8
    for (int i = 0; i < 32; ++i) { const int kk = 2 * i + (lane >> 5); scr[kk * 33 + (lane & 31)] = src[(size_t)(k0 + kk) * srcN + srccol0 + (lane & 31)]; }
    LDS_WAIT(); asm volatile("" ::: "memory");
    const int c = lane & 7;
#pragma unroll
    for (int j = 0; j < 4; ++j) { const int n = (lane >> 3) + 8 * j; const LAS float* s = scr + (8 * c) * 33 + n;
        v4u o; o.x = pk2(s[0 * 33], s[1 * 33]); o.y = pk2(s[2 * 33], s[3 * 33]); o.z = pk2(s[4 * 33], s[5 * 33]); o.w = pk2(s[6 * 33], s[7 * 33]);
        *(v4u*)(dst + (size_t)(dstrow0 + n) * dstK + k0 + 8 * c) = o; }
    LDS_WAIT(); asm volatile("" ::: "memory");
}
__device__ __forceinline__ void tr_gu(const float* gate, const float* up, bf16* dst, int r, LAS float* scr, int lane) {
    const int nblk = NGU / 32, kb = r / nblk, nb = r % nblk, dstrow0 = nb * 32, pn = dstrow0 >> 8, within = dstrow0 & 255;
    transpose_item(within < 128 ? gate : up, FF, pn * 128 + (within & 127), dst, D, dstrow0, kb * 64, scr, lane);
}
__device__ __forceinline__ void tr_plain(const float* src, int K, int N, bf16* dst, int r, LAS float* scr, int lane) {
    const int nblk = N / 32, kb = r / nblk, nb = r % nblk;
    transpose_item(src, N, nb * 32, dst, K, nb * 32, kb * 64, scr, lane);
}
__device__ __forceinline__ void tr_win(const float* src, bf16* dst, int r, LAS float* scr, int lane) {
    const int nblk = NIN / 32, kb = r / nblk, nb = r % nblk, dstrow0 = nb * 32;
    transpose_item(src, WIN_COLS, dstrow0 + (dstrow0 >= 3072 ? 8 : 0), dst, D, dstrow0, kb * 64, scr, lane);
}

__device__ __forceinline__ void rms_row(const float* xrow, const float* gain, int lane, f32x4 (&v)[4]) {
    const f32x4* xr = (const f32x4*)xrow + lane; const f32x4* gr = (const f32x4*)gain + lane;
    float s = 0.f;
#pragma unroll
    for (int j = 0; j < 4; ++j) { v[j] = xr[64 * j]; s += (v[j].x * v[j].x + v[j].y * v[j].y) + (v[j].z * v[j].z + v[j].w * v[j].w); }
    const float rs = 1.0f / sqrtf(wave_sum(s) * (1.f / D) + 1e-6f);
#pragma unroll
    for (int j = 0; j < 4; ++j) { const f32x4 g = gr[64 * j]; v[j] = v[j] * rs * g; }
}
__device__ __forceinline__ void store_row_bf16(bf16* orow, int lane, const f32x4 (&v)[4]) {
    v2u* o8 = (v2u*)orow + lane;
#pragma unroll
    for (int j = 0; j < 4; ++j) { v2u w; w.x = pk2(v[j].x, v[j].y); w.y = pk2(v[j].z, v[j].w); o8[64 * j] = w; }
}

__device__ __forceinline__ int kperm(int x) { return 8 * ((x & 15) >> 2) + 4 * (x >> 4) + (x & 3); }
constexpr int LP = 132;
__device__ __forceinline__ void dn_prep_item(const Args& a, LAS float* L, int ch, int tid, int lane, int wave) {
    unsigned char* ws = a.ws;
    const bf16* PROJ = (const bf16*)(ws + WS_ACT);
    const float* BD = (const float*)(ws + WS_BD);
    const float* conv_w = a.in[7]; const float* a_log = a.in[8]; const float* dt_bias = a.in[9];
    const int bh = ch >> 6, n = ch & 63, b = bh >> 2, h = bh & 3;
    const int tok0 = b * SEQ + n * 64;
    LAS float* qs = L; LAS float* ks = L + 64 * LP; LAS float* vs = L + 2 * 64 * LP; LAS float* As = L + 3 * 64 * LP; LAS float* gcs = As + 64 * 65; LAS float* bts = gcs + 64;
    {
        float cw[3][4][2];
#pragma unroll
        for (int sec = 0; sec < 3; ++sec)
#pragma unroll
            for (int j = 0; j < 4; ++j) { const f32x2 w = *(const f32x2*)(conv_w + j * 1536 + sec * 512 + h * 128 + 2 * lane); cw[sec][j][0] = w.x; cw[sec][j][1] = w.y; }
        for (int rr = 0; rr < 8; ++rr) {
            const int r = wave * 8 + rr, tok = tok0 + r, s = n * 64 + r;
            float val[3][2] = {{0.f, 0.f}, {0.f, 0.f}, {0.f, 0.f}};
#pragma unroll
            for (int j = 0; j < 4; ++j) {
                if (s - 3 + j >= 0) {
#pragma unroll
                    for (int sec = 0; sec < 3; ++sec) { const unsigned w = *(const unsigned*)(PROJ + (size_t)(tok - 3 + j) * NIN + 1536 + sec * 512 + h * 128 + 2 * lane);
                        val[sec][0] += bflo(w) * cw[sec][j][0]; val[sec][1] += bfhi(w) * cw[sec][j][1]; }
                }
            }
#pragma unroll
            for (int sec = 0; sec < 3; ++sec) { val[sec][0] = val[sec][0] / (1.f + __expf(-val[sec][0])); val[sec][1] = val[sec][1] / (1.f + __expf(-val[sec][1])); }
            const float ssq = wave_sum(val[0][0] * val[0][0] + val[0][1] * val[0][1]);
            const float ssk = wave_sum(val[1][0] * val[1][0] + val[1][1] * val[1][1]);
            const float rq = (1.0f / sqrtf(ssq + 1e-6f)) * 0.08838834764831845f, rk = 1.0f / sqrtf(ssk + 1e-6f);
            *(LAS f32x2*)(qs + r * LP + 2 * lane) = (f32x2){val[0][0] * rq, val[0][1] * rq};
            *(LAS f32x2*)(ks + r * LP + 2 * lane) = (f32x2){val[1][0] * rk, val[1][1] * rk};
            *(LAS f32x2*)(vs + r * LP + 2 * lane) = (f32x2){val[2][0], val[2][1]};
        }
    }
    if (wave == 0) {
        const int tok = tok0 + lane;
        const float braw = BD[(size_t)tok * 8 + h], draw = BD[(size_t)tok * 8 + 4 + h] + dt_bias[h];
        const float sp = fmaxf(draw, 0.f) + log1pf(__expf(-fabsf(draw)));
        float g = -expf(a_log[h]) * sp;
#pragma unroll
        for (int o = 1; o < 64; o <<= 1) { const float t = __shfl_up(g, o); if (lane >= o) g += t; }
        gcs[lane] = g; bts[lane] = 1.0f / (1.0f + __expf(-braw));
        if (lane == 63) ((float*)(ws + WS_EG))[ch] = expf(g);
    }
    __syncthreads();
    {
        const int c = tid >> 3, jg = tid & 7;
        float accA[8], accP[8];
#pragma unroll
        for (int jj = 0; jj < 8; ++jj) { accA[jj] = 0.f; accP[jj] = 0.f; }
        for (int d4 = 0; d4 < 32; ++d4) {
            const f32x4 kc = *(const LAS f32x4*)(ks + c * LP + 4 * d4), qc = *(const LAS f32x4*)(qs + c * LP + 4 * d4);
#pragma unroll
            for (int jj = 0; jj < 8; ++jj) { const f32x4 kj = *(const LAS f32x4*)(ks + (jg + 8 * jj) * LP + 4 * d4);
                accA[jj] += (kc.x * kj.x + kc.y * kj.y) + (kc.z * kj.z + kc.w * kj.w);
                accP[jj] += (qc.x * kj.x + qc.y * kj.y) + (qc.z * kj.z + qc.w * kj.w); }
        }
        const float gcc = gcs[c], bc = bts[c];
        bf16* Aout = (bf16*)(ws + WS_A) + (size_t)ch * 4096;
#pragma unroll
        for (int jj = 0; jj < 8; ++jj) { const int j = jg + 8 * jj; const float dec = (j <= c) ? __expf(gcc - gcs[j]) : 0.f;
            As[c * 65 + j] = (j < c) ? bc * accA[jj] * dec : 0.f;
            Aout[c * 64 + (j & 32) + kperm(j & 31)] = (bf16)f2bf((j <= c) ? accP[jj] * dec : 0.f); }
        const float glast = gcs[63];
        bf16* QG = (bf16*)(ws + WS_QG) + (size_t)ch * 8192; bf16* KD = (bf16*)(ws + WS_KD) + (size_t)ch * 8192;
#pragma unroll
        for (int i = 0; i < 8; ++i) { const int idx2 = tid + 512 * i, cc = idx2 >> 6, d = (idx2 & 63) * 2;
            const float eq = __expf(gcs[cc]), ek = __expf(glast - gcs[cc]);
            const f32x2 qv = *(const LAS f32x2*)(qs + cc * LP + d), kv = *(const LAS f32x2*)(ks + cc * LP + d);
            *(unsigned*)(QG + cc * 128 + (d & 96) + kperm(d & 31)) = pk2(qv.x * eq, qv.y * eq);
            const int tp = (cc & 32) + kperm(cc & 31);
            KD[d * 64 + tp] = (bf16)f2bf(kv.x * ek); KD[(d + 1) * 64 + tp] = (bf16)f2bf(kv.y * ek); }
    }
    __syncthreads();
#pragma unroll
    for (int i = 0; i < 8; ++i) { const int idx2 = tid + 512 * i, cc = idx2 >> 6, d = (idx2 & 63) * 2;
        const float be = bts[cc], bek = be * __expf(gcs[cc]);
        const f32x2 vv = *(const LAS f32x2*)(vs + cc * LP + d), kv = *(const LAS f32x2*)(ks + cc * LP + d);
        *(LAS f32x2*)(vs + cc * LP + d) = (f32x2){vv.x * be, vv.y * be}; *(LAS f32x2*)(qs + cc * LP + d) = (f32x2){kv.x * bek, kv.y * bek}; }
    __syncthreads();
    if (tid < 256) {
        LAS float* buf = (tid < 128 ? vs : qs) + (tid & 127);
        for (int c = 1; c < 64; ++c) {
            float acc = buf[c * LP];
            for (int j = 0; j < c; ++j) acc -= As[c * 65 + j] * buf[j * LP];
            buf[c * LP] = acc;
        }
    }
    __syncthreads();
    {
        bf16* U = (bf16*)(ws + WS_U) + (size_t)ch * 8192; bf16* W = (bf16*)(ws + WS_W) + (size_t)ch * 8192;
#pragma unroll
        for (int i = 0; i < 8; ++i) { const int idx2 = tid + 512 * i, cc = idx2 >> 6, d = (idx2 & 63) * 2;
            const f32x2 uv = *(const LAS f32x2*)(vs + cc * LP + d), wv = *(const LAS f32x2*)(qs + cc * LP + d);
            U[d * 64 + cc] = (bf16)f2bf(uv.x); U[(d + 1) * 64 + cc] = (bf16)f2bf(uv.y);
            *(unsigned*)(W + cc * 128 + (d & 96) + kperm(d & 31)) = pk2(-wv.x, -wv.y); }
    }
    __syncthreads();
}

typedef short bf16x8 __attribute__((ext_vector_type(8)));
typedef __bf16 bf16x2_t __attribute__((ext_vector_type(2)));
__device__ __forceinline__ unsigned cvtpk(float lo, float hi) { f32x2 v = {lo, hi}; bf16x2_t b = __builtin_convertvector(v, bf16x2_t); return __builtin_bit_cast(unsigned, b); }
__device__ __forceinline__ bf16x8 pack8(const f32x4& a, const f32x4& b) { v4u w; w.x = cvtpk(a[0], a[1]); w.y = cvtpk(a[2], a[3]); w.z = cvtpk(b[0], b[1]); w.w = cvtpk(b[2], b[3]); return __builtin_bit_cast(bf16x8, w); }
constexpr int SC_W = 0, SC_QG = 17408, SC_KDT = 34816, SC_A = 53248, SC_BUF = 62464;
__device__ __forceinline__ void dn_scan_mfma(const Args& a, LAS unsigned char* L8, int bh, int tid, int lane, int wave) {
    unsigned char* ws = a.ws;
    const int b = bh >> 2, h = bh & 3;
    const int jl = lane & 15, kq = lane >> 4, cs = wave * 16;
    bf16* MIX = (bf16*)(ws + WS_XN);
    const float* EG = (const float*)(ws + WS_EG);
    f32x4 Sacc[8];
#pragma unroll
    for (int T = 0; T < 8; ++T) Sacc[T] = (f32x4){0.f, 0.f, 0.f, 0.f};
    v4u st[7]; v2u ut[4], utn[4];
    const int r16 = tid >> 4, c16 = tid & 15, r8 = tid >> 3, c8 = tid & 7;
#define SC_LOAD(chx) do { const size_t o8 = (size_t)(chx) * 8192; \
        const bf16* Wg = (const bf16*)(ws + WS_W) + o8; const bf16* Qg = (const bf16*)(ws + WS_QG) + o8; const bf16* Kg = (const bf16*)(ws + WS_KD) + o8; const bf16* Ag = (const bf16*)(ws + WS_A) + (size_t)(chx) * 4096; \
        st[0] = *(const v4u*)(Wg + tid * 8); st[1] = *(const v4u*)(Wg + 4096 + tid * 8); st[2] = *(const v4u*)(Qg + tid * 8); st[3] = *(const v4u*)(Qg + 4096 + tid * 8); \
        st[4] = *(const v4u*)(Kg + tid * 8); st[5] = *(const v4u*)(Kg + 4096 + tid * 8); st[6] = *(const v4u*)(Ag + tid * 8); \
        const bf16* Ug = (const bf16*)(ws + WS_U) + o8 + (cs + jl) * 64 + 4 * kq; \
        utn[0] = *(const v2u*)(Ug); utn[1] = *(const v2u*)(Ug + 16); utn[2] = *(const v2u*)(Ug + 32); utn[3] = *(const v2u*)(Ug + 48); } while (0)
#define SC_WRITE(bufp) do { LAS unsigned char* B_ = (bufp); \
        *(LAS v4u*)(B_ + SC_W + r16 * 272 + c16 * 16) = st[0]; *(LAS v4u*)(B_ + SC_W + (r16 + 32) * 272 + c16 * 16) = st[1]; \
        *(LAS v4u*)(B_ + SC_QG + r16 * 272 + c16 * 16) = st[2]; *(LAS v4u*)(B_ + SC_QG + (r16 + 32) * 272 + c16 * 16) = st[3]; \
        *(LAS v4u*)(B_ + SC_KDT + r8 * 144 + c8 * 16) = st[4]; *(LAS v4u*)(B_ + SC_KDT + (r8 + 64) * 144 + c8 * 16) = st[5]; \
        *(LAS v4u*)(B_ + SC_A + r8 * 144 + c8 * 16) = st[6]; } while (0)
    SC_LOAD(bh * 64);
    SC_WRITE(L8);
#pragma unroll
    for (int i = 0; i < 4; ++i) ut[i] = utn[i];
    __syncthreads();
    for (int n = 0; n < 64; ++n) {
        const int ch = bh * 64 + n;
        if (n + 1 < 64) SC_LOAD(ch + 1);
        const float eg = EG[ch];
        const LAS unsigned char* B = L8 + (n & 1) * SC_BUF;
        bf16x8 sb[4];
#pragma unroll
        for (int ks = 0; ks < 4; ++ks) sb[ks] = pack8(Sacc[2 * ks], Sacc[2 * ks + 1]);
        f32x4 vn[4], oa[4];
#pragma unroll
        for (int mt = 0; mt < 4; ++mt) { vn[mt] = (f32x4){bflo(ut[mt].x), bfhi(ut[mt].x), bflo(ut[mt].y), bfhi(ut[mt].y)}; oa[mt] = (f32x4){0.f, 0.f, 0.f, 0.f}; }
#pragma unroll
        for (int mt = 0; mt < 4; ++mt)
#pragma unroll
            for (int ks = 0; ks < 4; ++ks) {
                const bf16x8 wa = *(const LAS bf16x8*)(B + SC_W + (16 * mt + jl) * 272 + (32 * ks + 8 * kq) * 2);
                const bf16x8 qa = *(const LAS bf16x8*)(B + SC_QG + (16 * mt + jl) * 272 + (32 * ks + 8 * kq) * 2);
                vn[mt] = __builtin_amdgcn_mfma_f32_16x16x32_bf16(wa, sb[ks], vn[mt], 0, 0, 0);
                oa[mt] = __builtin_amdgcn_mfma_f32_16x16x32_bf16(qa, sb[ks], oa[mt], 0, 0, 0);
            }
        bf16x8 vb[2];
        vb[0] = pack8(vn[0], vn[1]); vb[1] = pack8(vn[2], vn[3]);
#pragma unroll
        for (int T = 0; T < 8; ++T) { Sacc[T] = Sacc[T] * eg;
#pragma unroll
            for (int k2 = 0; k2 < 2; ++k2) { const bf16x8 ka = *(const LAS bf16x8*)(B + SC_KDT + (16 * T + jl) * 144 + (32 * k2 + 8 * kq) * 2);
                Sacc[T] = __builtin_amdgcn_mfma_f32_16x16x32_bf16(ka, vb[k2], Sacc[T], 0, 0, 0); } }
#pragma unroll
        for (int mt = 0; mt < 4; ++mt)
#pragma unroll
            for (int k2 = 0; k2 < 2; ++k2) { const bf16x8 aa = *(const LAS bf16x8*)(B + SC_A + (16 * mt + jl) * 144 + (32 * k2 + 8 * kq) * 2);
                oa[mt] = __builtin_amdgcn_mfma_f32_16x16x32_bf16(aa, vb[k2], oa[mt], 0, 0, 0); }
        bf16* op = MIX + (size_t)(b * SEQ + n * 64 + 4 * kq) * 1024 + 512 + h * 128 + cs + jl;
#pragma unroll
        for (int mt = 0; mt < 4; ++mt)
#pragma unroll
            for (int e = 0; e < 4; ++e) op[(size_t)(16 * mt + e) * 1024] = (bf16)f2bf(oa[mt][e]);
        if (n + 1 < 64) { SC_WRITE(L8 + ((n + 1) & 1) * SC_BUF);
#pragma unroll
            for (int i = 0; i < 4; ++i) ut[i] = utn[i]; }
        __syncthreads();
    }
#undef SC_LOAD
#undef SC_WRITE
}

typedef float f32x16 __attribute__((ext_vector_type(16)));
typedef short s16x4 __attribute__((ext_vector_type(4)));
__device__ __forceinline__ s16x4 vtr(const LAS unsigned char* p) { return __builtin_bit_cast(s16x4, __builtin_amdgcn_ds_read_tr16_b64_v4i16((LAS s16x4*)p)); }
constexpr int KVP = 144;
constexpr int KV_BYTES = 384 * KVP;
constexpr size_t WS_ML = 173 * MiB;
__device__ __forceinline__ void attn_item(bf16* PROJ, float* ML, LAS unsigned char* L8, int item, int tid, int lane, int wave) {
    asm volatile("" : "+v"(lane));
    const int bh = item / 48, rem = item - bh * 48, p = rem >> 4, sub = rem & 15;
    const int b = bh >> 3, h = bh & 7;
    const int dsh = 2 * p, dil = 1 << dsh, nsh = 4 - dsh;
    const int r = sub >> nsh, qb = sub & ((1 << nsh) - 1);
    const int base = 256 * qb;
    const size_t tokb = (size_t)b * SEQ + r;
#pragma unroll
    for (int i = 0; i < 6; ++i) { const int id = tid + 512 * i, row = id >> 3, ch = id & 7, idx = base - 128 + row;
        v4u kv = (v4u){0u, 0u, 0u, 0u}, vv = (v4u){0u, 0u, 0u, 0u};
        if (idx >= 0) { const bf16* src = PROJ + (tokb + (size_t)dil * idx) * NIN + h * 64 + ch * 8; kv = *(const v4u*)(src + 512); vv = *(const v4u*)(src + 1024); }
        *(LAS v4u*)(L8 + row * KVP + ch * 16) = kv; *(LAS v4u*)(L8 + KV_BYTES + row * KVP + ch * 16) = vv; }
    const int ql = lane & 31, kh = lane >> 5;
    const size_t tokq = tokb + (size_t)dil * (base + 32 * wave + ql);
    bf16x8 qf[4];
#pragma unroll
    for (int s = 0; s < 4; ++s) qf[s] = *(const bf16x8*)(PROJ + tokq * NIN + h * 64 + 16 * s + 8 * kh);
    __syncthreads();
    f32x16 sc[5];
#pragma unroll
    for (int kt = 0; kt < 5; ++kt) { f32x16 acc = {};
#pragma unroll
        for (int s = 0; s < 4; ++s) { const bf16x8 kf = *(const LAS bf16x8*)(L8 + (32 * (wave + kt) + ql) * KVP + (16 * s + 8 * kh) * 2); acc = __builtin_amdgcn_mfma_f32_32x32x16_bf16(kf, qf[s], acc, 0, 0, 0); }
        sc[kt] = acc; }
    const float LOG2E = 1.4426950408889634f;
    const float c1 = 0.125f * LOG2E, c2 = exp2f(-(float)(h + 1)) * (float)dil * LOG2E;
    float mx = -INFINITY;
#pragma unroll
    for (int kt = 0; kt < 5; ++kt)
#pragma unroll
        for (int rr = 0; rr < 16; ++rr) { const int kk = (rr & 3) + 8 * (rr >> 2) + 4 * kh; const int dist = 128 + ql - 32 * kt - kk; const int kidx = base - 128 + 32 * (wave + kt) + kk;
            const bool valid = (dist >= 0) && (dist <= 128) && (kidx >= 0);
            const float v = valid ? sc[kt][rr] * c1 - c2 * (float)dist : -INFINITY; sc[kt][rr] = v; mx = fmaxf(mx, v); }
    mx = fmaxf(mx, __shfl_xor(mx, 32));
    float lsum = 0.f;
#pragma unroll
    for (int kt = 0; kt < 5; ++kt)
#pragma unroll
        for (int rr = 0; rr < 16; ++rr) { const float pv = __builtin_amdgcn_exp2f(sc[kt][rr] - mx); sc[kt][rr] = pv; lsum += pv; }
    lsum += __shfl_xor(lsum, 32);
    f32x16 o[2]; o[0] = (f32x16){}; o[1] = (f32x16){};
    const int q4 = (lane & 15) >> 2, pp = lane & 3, blk = (lane >> 4) & 1;
    const LAS unsigned char* Vb = L8 + KV_BYTES + (4 * kh + q4) * KVP + (16 * blk + 4 * pp) * 2;
#pragma unroll
    for (int kt = 0; kt < 5; ++kt)
#pragma unroll
        for (int s2 = 0; s2 < 2; ++s2) {
            v4u pw; pw.x = cvtpk(sc[kt][8 * s2 + 0], sc[kt][8 * s2 + 1]); pw.y = cvtpk(sc[kt][8 * s2 + 2], sc[kt][8 * s2 + 3]); pw.z = cvtpk(sc[kt][8 * s2 + 4], sc[kt][8 * s2 + 5]); pw.w = cvtpk(sc[kt][8 * s2 + 6], sc[kt][8 * s2 + 7]);
            const bf16x8 pb = __builtin_bit_cast(bf16x8, pw);
            const LAS unsigned char* vr = Vb + (32 * (wave + kt) + 16 * s2) * KVP;
#pragma unroll
            for (int c = 0; c < 2; ++c) { const s16x4 lo = vtr(vr + c * 64), hi = vtr(vr + 8 * KVP + c * 64);
                const bf16x8 va = (bf16x8){lo[0], lo[1], lo[2], lo[3], hi[0], hi[1], hi[2], hi[3]};
                o[c] = __builtin_amdgcn_mfma_f32_32x32x16_bf16(va, pb, o[c], 0, 0, 0); }
        }
    const float inv = 1.0f / lsum;
    bf16* dst = PROJ + tokq * NIN + 1536 + p * 512 + h * 64 + 4 * kh;
#pragma unroll
    for (int c = 0; c < 2; ++c)
#pragma unroll
        for (int g = 0; g < 4; ++g) { v2u w; w.x = cvtpk(o[c][4 * g + 0] * inv, o[c][4 * g + 1] * inv); w.y = cvtpk(o[c][4 * g + 2] * inv, o[c][4 * g + 3] * inv);
            *(v2u*)(dst + 32 * c + 8 * g) = w; }
    if (kh == 0) { float* ml = ML + ((tokq * 8 + h) * 3 + p) * 2; *(f32x2*)ml = (f32x2){mx, lsum}; }
    __syncthreads();
}

#define XB_TMO      128
#define XB_XCNT(j)  (256  + 64 * (j))
#define XB_XSUB(j)  (1280 + 64 * (j))
#define XB_XGEN(j)  (2304 + 64 * (j))
#define XB_TOP      3328
#define XB_TOPGEN   3392
#define XCD_BAR_WORDS 3456
#define XB_SPIN_CAP (1u << 18)

__device__ __forceinline__ unsigned xb_ld(unsigned* p)              { return __hip_atomic_load(p, __ATOMIC_RELAXED, __HIP_MEMORY_SCOPE_AGENT); }
__device__ __forceinline__ unsigned xb_add(unsigned* p, unsigned v) { return __hip_atomic_fetch_add(p, v, __ATOMIC_RELAXED, __HIP_MEMORY_SCOPE_AGENT); }
__device__ __forceinline__ unsigned xb_xcc_id() { return (unsigned)__builtin_amdgcn_s_getreg((3 << 11) | 20) & 0xFu; }
#define XB_SPIN(cond, bar) do { unsigned _sp = 0; while (cond) { __builtin_amdgcn_s_sleep(1); \
    if ((++_sp & 255u) == 0u) { if (xb_ld(&(bar)[XB_TMO])) break; if (_sp > XB_SPIN_CAP) { atomicAdd(&(bar)[XB_TMO], 1u); break; } } } } while (0)

struct XcdBarrier {
    unsigned* bar; unsigned x;
    volatile LAS unsigned* st;
};

__device__ __forceinline__ XcdBarrier xcd_barrier_post(unsigned* bar, volatile LAS unsigned* st) {
    XcdBarrier b; b.bar = bar; b.x = xb_xcc_id(); b.st = st;
    if (threadIdx.x == 0) (void)xb_add(&bar[XB_XCNT(b.x)], 1u);
    return b;
}
__device__ __forceinline__ void xcd_barrier_complete(unsigned* bar, unsigned x, unsigned& nloc, unsigned& nx) {
    const unsigned G = gridDim.x * gridDim.y * gridDim.z;
    unsigned sum, cnt, mine, sp = 0u;
    for (;;) {
        sum = 0u; cnt = 0u; mine = 0u;
#pragma unroll
        for (unsigned j = 0; j < 16; ++j) { const unsigned c = xb_ld(&bar[XB_XCNT(j)]); sum += c; cnt += (c > 0u) ? 1u : 0u; mine = (j == x) ? c : mine; }
        if (sum == G) break;
        __builtin_amdgcn_s_sleep(1);
        if ((++sp & 255u) == 0u) { if (xb_ld(&bar[XB_TMO])) break; if (sp > XB_SPIN_CAP) { atomicAdd(&bar[XB_TMO], 1u); break; } }
    }
    nloc = mine > 0u ? mine : 1u; nx = cnt > 0u ? cnt : 1u;
}

__device__ __forceinline__ void xcd_barrier(const XcdBarrier& b) {
    asm volatile("s_waitcnt vmcnt(0)" ::: "memory");
    __syncthreads();
    if (threadIdx.x == 0) {
        unsigned* bar = b.bar;
        __builtin_amdgcn_s_waitcnt(0);
        unsigned nloc = b.st[0], nx = b.st[1];
        if (nloc == 0u) { xcd_barrier_complete(bar, b.x, nloc, nx); b.st[0] = nloc; b.st[1] = nx; }
        const unsigned old = xb_add(&bar[XB_XSUB(b.x)], 1u);
        const unsigned gen = old / nloc;
        if (old + 1u == (gen + 1u) * nloc) {
            __builtin_amdgcn_fence(__ATOMIC_RELEASE, "agent");
            asm volatile("s_waitcnt vmcnt(0)" ::: "memory");
            const unsigned og = xb_add(&bar[XB_TOP], 1u);
            const unsigned tg = og / nx;
            if (og + 1u == (tg + 1u) * nx) xb_add(&bar[XB_TOPGEN], 1u);
            else XB_SPIN(xb_ld(&bar[XB_TOPGEN]) == tg, bar);
            __builtin_amdgcn_fence(__ATOMIC_ACQUIRE, "agent");
            xb_add(&bar[XB_XGEN(b.x)], 1u);
            asm volatile("s_waitcnt vmcnt(0)" ::: "memory");
        } else {
            XB_SPIN(xb_ld(&bar[XB_XGEN(b.x)]) == gen, bar);
            __builtin_amdgcn_fence(__ATOMIC_ACQUIRE, "agent");
            asm volatile("s_waitcnt vmcnt(0)" ::: "memory");
        }
    }
    __syncthreads();
}

__global__ void __launch_bounds__(NWAVES * 64, 2) fwd_megakernel(Args a) {
    extern __shared__ __attribute__((aligned(16))) unsigned char lds[];
    cg::grid_group grid = cg::this_grid();
    LAS unsigned char* L8 = (LAS unsigned char*)lds;
    LAS float* L = (LAS float*)lds;
    const int tid = threadIdx.x, lane = tid & 63, wave = __builtin_amdgcn_readfirstlane(tid >> 6);
    const int G = gridDim.x, gw = blockIdx.x * NWAVES + wave, NGW = G * NWAVES;
    unsigned char* ws = a.ws;
    unsigned* ctl = (unsigned*)(ws + WS_CTL);
    const float* x = a.in[0];
    bf16* XN = (bf16*)(ws + WS_XN); bf16* ACT = (bf16*)(ws + WS_ACT); bf16* PROJ = ACT; bf16* MIX = XN;
    bf16* Wgu1 = (bf16*)(ws + WS_WGU1); bf16* Wd1 = (bf16*)(ws + WS_WD1); bf16* Win = (bf16*)(ws + WS_WIN); bf16* Wout = (bf16*)(ws + WS_WOUT);
    bf16* Wgu2 = (bf16*)(ws + WS_WGU2); bf16* Wd2 = (bf16*)(ws + WS_WD2);
    float* out = a.out;
    volatile LAS unsigned* xbst = (volatile LAS unsigned*)(L8 + LDS_BYTES - 64);
    if (tid < 2) xbst[tid] = 0u;
    __syncthreads();
    XcdBarrier bar = xcd_barrier_post(ctl + 1024, xbst);
#define GSYNC() xcd_barrier(bar)

    {
        const int lane = opq(tid) & 63;
        LAS float* scr = L + wave * 4096;
        constexpr int I_GU = (D / 64) * (NGU / 32), I_D = (FF / 64) * (D / 32), I_IN = (D / 64) * (NIN / 32), I_O = (D / 64) * (D / 32);
        constexpr int NITEMS = 2 * I_GU + 2 * I_D + I_IN + I_O;
        for (int it = gw; it < NITEMS; it += NGW) {
            int r = it;
            if (r < I_GU) { tr_gu(a.in[2], a.in[3], Wgu1, r, scr, lane); continue; } r -= I_GU;
            if (r < I_D) { tr_plain(a.in[4], FF, D, Wd1, r, scr, lane); continue; } r -= I_D;
            if (r < I_IN) { tr_win(a.in[6], Win, r, scr, lane); continue; } r -= I_IN;
            if (r < I_O) { tr_plain(a.in[11], D, D, Wout, r, scr, lane); continue; } r -= I_O;
            if (r < I_GU) { tr_gu(a.in[13], a.in[14], Wgu2, r, scr, lane); continue; } r -= I_GU;
            tr_plain(a.in[15], FF, D, Wd2, r, scr, lane);
        }
        for (int m = gw; m < M; m += NGW) { f32x4 v[4]; rms_row(x + (size_t)m * D, a.in[1], lane, v); store_row_bf16(XN + (size_t)m * D, lane, v); }
    }
    grid.sync();
    {
        pg8::Gemm g{XN, Wgu1, M, NGU, D}; pg8::StaticOrder S; S.init(M, NGU, G, (int)blockIdx.x);
        pg8::EpiSwiGLU E{ACT, FF};
        pg8::gemm_phase<pg8::EpiSwiGLU, pg8::StaticOrder, true, true>(L8, g, S, E);
    }
    GSYNC();
    {
        pg8::Gemm g{ACT, Wd1, M, D, FF}; pg8::StaticOrder S; S.init(M, D, G, (int)blockIdx.x);
        pg8::EpiRes E{x, out, D, 0.5f};
        pg8::gemm_phase<pg8::EpiRes, pg8::StaticOrder, true, true>(L8, g, S, E);
    }
    GSYNC();
    {
        const int lane = opq(tid) & 63;
        const float* w_in = a.in[6]; float* BD = (float*)(ws + WS_BD);
        for (int m = gw; m < M; m += NGW) {
            f32x4 v[4]; rms_row(out + (size_t)m * D, a.in[5], lane, v); store_row_bf16(XN + (size_t)m * D, lane, v);
            float acc[8];
#pragma unroll
            for (int o = 0; o < 8; ++o) acc[o] = 0.f;
#pragma unroll
            for (int j = 0; j < 4; ++j)
#pragma unroll
                for (int i = 0; i < 4; ++i) { const int k = 4 * (lane + 64 * j) + i; const f32x4 w0 = *(const f32x4*)(w_in + (size_t)k * WIN_COLS + 3072), w1 = *(const f32x4*)(w_in + (size_t)k * WIN_COLS + 3076);
                    const float hv = v[j][i];
                    acc[0] += hv * w0.x; acc[1] += hv * w0.y; acc[2] += hv * w0.z; acc[3] += hv * w0.w; acc[4] += hv * w1.x; acc[5] += hv * w1.y; acc[6] += hv * w1.z; acc[7] += hv * w1.w; }
#pragma unroll
            for (int o = 0; o < 8; ++o) acc[o] = wave_sum(acc[o]);
            if (lane == 0) { *(f32x4*)(BD + (size_t)m * 8) = (f32x4){acc[0], acc[1], acc[2], acc[3]}; *(f32x4*)(BD + (size_t)m * 8 + 4) = (f32x4){acc[4], acc[5], acc[6], acc[7]}; }
        }
    }
    GSYNC();
    {
        pg8::Gemm g{XN, Win, M, NIN, D}; pg8::StaticOrder S; S.init(M, NIN, G, (int)blockIdx.x);
        pg8::EpiStoreBf16 E{PROJ, NIN};
        pg8::gemm_phase<pg8::EpiStoreBf16, pg8::StaticOrder, true, true>(L8, g, S, E);
    }
    GSYNC();
    { const int tid_ = opq(tid); for (int ch = blockIdx.x; ch < 1024; ch += G) dn_prep_item(a, L, ch, tid_, tid_ & 63, wave); }
    GSYNC();
    {
        const int tid_ = opq(tid), lane = tid_ & 63;
        for (int it = blockIdx.x; it < 16; it += G) dn_scan_mfma(a, L8, it, tid_, lane, wave);
        LAS unsigned* bc = (LAS unsigned*)(L8 + 2 * KV_BYTES);
        float* ML = (float*)(ws + WS_ML);
        for (;;) {
            if (tid == 0) bc[0] = atomicAdd(ctl + 64, 1u);
            __syncthreads();
            const unsigned item = bc[0];
            __syncthreads();
            if (item >= 1536u) break;
            attn_item(PROJ, ML, L8, (int)item, tid, lane, wave);
        }
    }
    GSYNC();
    {
        const int lane = opq(tid) & 63;
        const float* dn_norm = a.in[10];
        for (int m = gw; m < M; m += NGW) {
            bf16* op = MIX + (size_t)m * 1024 + 512 + 8 * lane; const bf16* gp = PROJ + (size_t)m * NIN + 3072 + 8 * lane;
            const v4u ow = *(const v4u*)op, gwv = *(const v4u*)gp;
            float o[8] = {bflo(ow.x), bfhi(ow.x), bflo(ow.y), bfhi(ow.y), bflo(ow.z), bfhi(ow.z), bflo(ow.w), bfhi(ow.w)};
            float gt[8] = {bflo(gwv.x), bfhi(gwv.x), bflo(gwv.y), bfhi(gwv.y), bflo(gwv.z), bfhi(gwv.z), bflo(gwv.w), bfhi(gwv.w)};
            float ss = 0.f;
#pragma unroll
            for (int i = 0; i < 8; ++i) ss += o[i] * o[i];
            ss += __shfl_xor(ss, 1); ss += __shfl_xor(ss, 2); ss += __shfl_xor(ss, 4); ss += __shfl_xor(ss, 8);
            const float rs = 1.0f / sqrtf(ss * (1.f / 128.f) + 1e-6f);
            const int d0 = (8 * lane) & 127;
            float r[8];
#pragma unroll
            for (int i = 0; i < 8; ++i) r[i] = o[i] * rs * dn_norm[d0 + i] * (gt[i] / (1.f + __expf(-gt[i])));
            v4u w; w.x = pk2(r[0], r[1]); w.y = pk2(r[2], r[3]); w.z = pk2(r[4], r[5]); w.w = pk2(r[6], r[7]);
            *(v4u*)op = w;
            {
                const int ha = lane >> 3;
                const float* ml = (const float*)(ws + WS_ML) + ((size_t)m * 8 + ha) * 6;
                const f32x2 a0 = *(const f32x2*)ml, a1 = *(const f32x2*)(ml + 2), a2 = *(const f32x2*)(ml + 4);
                const float mm = fmaxf(a0.x, fmaxf(a1.x, a2.x));
                const float w0 = a0.y * __builtin_amdgcn_exp2f(a0.x - mm), w1 = a1.y * __builtin_amdgcn_exp2f(a1.x - mm), w2 = a2.y * __builtin_amdgcn_exp2f(a2.x - mm);
                const float iw = 1.0f / (w0 + w1 + w2);
                const bf16* pp = PROJ + (size_t)m * NIN + 1536 + 8 * lane;
                const v4u p0 = *(const v4u*)pp, p1 = *(const v4u*)(pp + 512), p2 = *(const v4u*)(pp + 1024);
                float rr[8];
                rr[0] = w0 * bflo(p0.x) + w1 * bflo(p1.x) + w2 * bflo(p2.x); rr[1] = w0 * bfhi(p0.x) + w1 * bfhi(p1.x) + w2 * bfhi(p2.x);
                rr[2] = w0 * bflo(p0.y) + w1 * bflo(p1.y) + w2 * bflo(p2.y); rr[3] = w0 * bfhi(p0.y) + w1 * bfhi(p1.y) + w2 * bfhi(p2.y);
                rr[4] = w0 * bflo(p0.z) + w1 * bflo(p1.z) + w2 * bflo(p2.z); rr[5] = w0 * bfhi(p0.z) + w1 * bfhi(p1.z) + w2 * bfhi(p2.z);
                rr[6] = w0 * bflo(p0.w) + w1 * bflo(p1.w) + w2 * bflo(p2.w); rr[7] = w0 * bfhi(p0.w) + w1 * bfhi(p1.w) + w2 * bfhi(p2.w);
                v4u wa; wa.x = pk2(rr[0] * iw, rr[1] * iw); wa.y = pk2(rr[2] * iw, rr[3] * iw); wa.z = pk2(rr[4] * iw, rr[5] * iw); wa.w = pk2(rr[6] * iw, rr[7] * iw);
                *(v4u*)(MIX + (size_t)m * 1024 + 8 * lane) = wa;
            }
        }
    }
    GSYNC();
    {
        pg8::Gemm g{MIX, Wout, M, D, D}; pg8::StaticOrder S; S.init(M, D, G, (int)blockIdx.x);
        pg8::EpiRes E{out, out, D, 1.0f};
        pg8::gemm_phase<pg8::EpiRes, pg8::StaticOrder, true, true>(L8, g, S, E);
    }
    GSYNC();
    { const int ln = opq(tid) & 63; for (int m = gw; m < M; m += NGW) { f32x4 v[4]; rms_row(out + (size_t)m * D, a.in[12], ln, v); store_row_bf16(XN + (size_t)m * D, ln, v); } }
    GSYNC();
    {
        pg8::Gemm g{XN, Wgu2, M, NGU, D}; pg8::StaticOrder S; S.init(M, NGU, G, (int)blockIdx.x);
        pg8::EpiSwiGLU E{ACT, FF};
        pg8::gemm_phase<pg8::EpiSwiGLU, pg8::StaticOrder, true, true>(L8, g, S, E);
    }
    GSYNC();
    {
        pg8::Gemm g{ACT, Wd2, M, D, FF}; pg8::StaticOrder S; S.init(M, D, G, (int)blockIdx.x);
        pg8::EpiRes E{out, out, D, 0.5f};
        pg8::gemm_phase<pg8::EpiRes, pg8::StaticOrder, true, true>(L8, g, S, E);
    }
    GSYNC();
    const int lnf = opq(tid) & 63;
    for (int m = gw; m < M; m += NGW) {
        f32x4 v[4]; rms_row(out + (size_t)m * D, a.in[16], lnf, v);
        f32x4* o = (f32x4*)(out + (size_t)m * D) + lnf;
#pragma unroll
        for (int j = 0; j < 4; ++j) o[64 * j] = v[j];
    }
}

extern "C" void kernel_launch(void* const* d_in, const int* in_sizes, int n_in, void* d_out, int out_size, void* d_ws, size_t ws_size, hipStream_t stream) {
    static int grid = 0;
    if (grid == 0) {
        if (n_in != 17 || in_sizes[0] != M * D || out_size != M * D || ws_size < WS_END) { fprintf(stderr, "kernel_launch: unexpected shapes (n_in %d in0 %d out %d ws %zu)\n", n_in, n_in > 0 ? in_sizes[0] : -1, out_size, ws_size); grid = -1; return; }
        int dev = 0, cus = 0, per_cu = 0;
        hipGetDevice(&dev); hipDeviceGetAttribute(&cus, hipDeviceAttributeMultiprocessorCount, dev);
        if (hipFuncSetAttribute((const void*)fwd_megakernel, hipFuncAttributeMaxDynamicSharedMemorySize, LDS_BYTES) != hipSuccess) { fprintf(stderr, "kernel_launch: hipFuncSetAttribute failed\n"); grid = -1; return; }
        if (hipOccupancyMaxActiveBlocksPerMultiprocessor(&per_cu, (const void*)fwd_megakernel, NWAVES * 64, LDS_BYTES) != hipSuccess || per_cu < 1) { fprintf(stderr, "kernel_launch: occupancy query says %d blocks/CU\n", per_cu); (void)hipGetLastError(); per_cu = 1; }
        grid = cus * 1;
        fprintf(stderr, "kernel_launch: cus %d per_cu %d grid %d\n", cus, per_cu, grid);
    }
    if (grid < 0) return;
    hipMemsetAsync((char*)d_ws + WS_CTL, 0, CTL_BYTES, stream);
    Args a{};
    for (int i = 0; i < 17; ++i) a.in[i] = (const float*)d_in[i];
    a.out = (float*)d_out; a.ws = (unsigned char*)d_ws;
    void* args[] = {&a};
    hipError_t e = hipLaunchCooperativeKernel((const void*)fwd_megakernel, dim3(grid), dim3(NWAVES * 64), args, LDS_BYTES, stream);
    if (e != hipSuccess) fprintf(stderr, "cooperative launch failed: %s (grid %d)\n", hipGetErrorString(e), grid);
}
```

```cpp
#include <hip/hip_runtime.h>
#include <hip/hip_cooperative_groups.h>
#include <cstdio>
#include <cstdint>
namespace cg = cooperative_groups;
namespace pg8 {
#define PG8_LAS __attribute__((address_space(3)))
typedef unsigned short bf16_t;
typedef short bf16x8 __attribute__((ext_vector_type(8)));
typedef float f32x4 __attribute__((ext_vector_type(4)));
typedef unsigned u32x4 __attribute__((ext_vector_type(4)));
constexpr int BM = 256, BK = 64, HALF = 128, HTB = HALF * BK * 2  , STAGE_BYTES = 8 * HTB, NXCD = 8, WGM = 8;

__host__ __device__ __forceinline__ int lds_byte(int r, int c) { const int st = (r >> 4) * 2 + (c >> 5), rr = r & 15, cc = c & 31, ob = rr * 64 + cc * 2; return st * 1024 + (ob ^ (((ob >> 9) & 1) << 5)); }
__host__ __device__ __forceinline__ void stage_rc(int b, int& R, int& C) { const int st = b / 1024, sb = b % 1024, swz = sb ^ (((sb >> 9) & 1) << 5); R = (st >> 1) * 16 + swz / 64; C = (st & 1) * 32 + (swz % 64) / 2; }
__host__ __device__ __forceinline__ int perm32(int rho) { const int n = rho >> 4, i = rho & 15; return 8 * (i >> 2) + 4 * n + (i & 3); }

struct Unit { int pm, pn; };
struct Gemm { const bf16_t* A; const bf16_t* Bt; int M, N, K; };

struct StaticOrder {
    int nM, nN, nwg, G, c;
    __host__ __device__ void init(int M, int N, int G_, int c_) { nM = M / BM; nN = N / BM; nwg = nM * nN; G = G_; c = c_; }
    __host__ __device__ bool next(int i, Unit& u) const {
        const long L = (long)i * G + c; if (L >= nwg) return false;
        int wgid = (int)L; { const int q = nwg / NXCD, r = nwg % NXCD, xcd = wgid % NXCD, off = wgid / NXCD; wgid = (xcd < r ? xcd * (q + 1) : r * (q + 1) + (xcd - r) * q) + off; }
        const int nig = WGM * nN, gid = wgid / nig, fm = gid * WGM, gsz = (nM - fm) < WGM ? (nM - fm) : WGM;
        u.pm = fm + ((wgid % nig) % gsz); u.pn = (wgid % nig) / gsz; return true;
    }
    __device__ __forceinline__ void a_ready(const Unit&) const {}
    __device__ __forceinline__ void done(const Unit&) const {}
};

__device__ __forceinline__ unsigned cvt_pk_bf16(float lo, float hi) { unsigned r; asm volatile("v_cvt_pk_bf16_f32 %0, %1, %2" : "=v"(r) : "v"(lo), "v"(hi)); return r; }
__device__ __forceinline__ float silu_f(float g) { return g * __builtin_amdgcn_rcpf(1.0f + __expf(-g)); }
struct EpiSwiGLU {
    static constexpr bool PERM = true, AFTER_DRAIN = false;
    bf16_t* O; int ldc;
    __device__ __forceinline__ void operator()(const f32x4 (&acc)[2][2][4][2], const Unit& u, int wr, int wc, int fr, int fq) const {
        const int row0 = u.pm * BM + wr * 64 + fr; const int col0 = u.pn * 128 + wc * 32 + 8 * fq;
#pragma unroll
        for (int ai = 0; ai < 2; ++ai)
#pragma unroll
            for (int m = 0; m < 4; ++m) { bf16_t* rowp = O + (size_t)(row0 + ai * HALF + m * 16) * ldc + col0;
                const f32x4 g0 = acc[ai][0][m][0], g1 = acc[ai][0][m][1], u0 = acc[ai][1][m][0], u1 = acc[ai][1][m][1];
                u32x4 w;
                w.x = cvt_pk_bf16(silu_f(g0[0]) * u0[0], silu_f(g0[1]) * u0[1]); w.y = cvt_pk_bf16(silu_f(g0[2]) * u0[2], silu_f(g0[3]) * u0[3]);
                w.z = cvt_pk_bf16(silu_f(g1[0]) * u1[0], silu_f(g1[1]) * u1[1]); w.w = cvt_pk_bf16(silu_f(g1[2]) * u1[2], silu_f(g1[3]) * u1[3]);
                *(u32x4*)rowp = w; }
    }
};
struct EpiRes {
    static constexpr bool PERM = false, AFTER_DRAIN = false;
    const float* base; float* out; int ldc; float scale;
    __device__ __forceinline__ void operator()(const f32x4 (&acc)[2][2][4][2], const Unit& u, int wr, int wc, int fr, int fq) const {
        const int row0 = u.pm * BM + wr * 64 + fr; const int col0 = u.pn * BM + wc * 32 + 4 * fq;
#pragma unroll
        for (int ai = 0; ai < 2; ++ai)
#pragma unroll
            for (int m = 0; m < 4; ++m) { const size_t off = (size_t)(row0 + ai * HALF + m * 16) * ldc + col0;
#pragma unroll
                for (int bj = 0; bj < 2; ++bj)
#pragma unroll
                    for (int n = 0; n < 2; ++n) { const f32x4 b = *(const f32x4*)(base + off + bj * HALF + n * 16); *(f32x4*)(out + off + bj * HALF + n * 16) = b + acc[ai][bj][m][n] * scale; }
                asm volatile("" ::: "memory"); }
    }
};
struct EpiStoreBf16 {
    static constexpr bool PERM = true, AFTER_DRAIN = false;
    bf16_t* O; int ldc;
    __device__ __forceinline__ void operator()(const f32x4 (&acc)[2][2][4][2], const Unit& u, int wr, int wc, int fr, int fq) const {
        const int row0 = u.pm * BM + wr * 64 + fr; const int col0 = u.pn * BM + wc * 32 + 8 * fq;
#pragma unroll
        for (int ai = 0; ai < 2; ++ai)
#pragma unroll
            for (int m = 0; m < 4; ++m) { bf16_t* rowp = O + (size_t)(row0 + ai * HALF + m * 16) * ldc + col0;
#pragma unroll
                for (int bj = 0; bj < 2; ++bj) { const f32x4 v0 = acc[ai][bj][m][0], v1 = acc[ai][bj][m][1]; u32x4 w;
                    w.x = cvt_pk_bf16(v0[0], v0[1]); w.y = cvt_pk_bf16(v0[2], v0[3]); w.z = cvt_pk_bf16(v1[0], v1[1]); w.w = cvt_pk_bf16(v1[2], v1[3]);
                    *(u32x4*)(rowp + bj * HALF) = w; } }
    }
};
template <class Epi, class Sched, bool ALIGN_EPI = false, bool SP2 = false>
__device__ __forceinline__ void gemm_phase(PG8_LAS unsigned char* lds, const Gemm g, const Sched& S, const Epi& E) {
    const int tid = threadIdx.x, wid = __builtin_amdgcn_readfirstlane(tid >> 6), lane = tid & 63, wr = wid >> 2, wc = wid & 3, fr = lane & 15, fq = lane >> 4;
    const int K = g.K, nt = K / BK;
    unsigned voffA[2], voffB[2];
#pragma unroll
    for (int i = 0; i < 2; ++i) { int R, C; stage_rc(tid * 16 + i * 8192, R, C); const int Rb = Epi::PERM ? ((R & ~31) + perm32(R & 31)) : R;
        voffA[i] = (unsigned)(R * K + C) * 2u; voffB[i] = (unsigned)(Rb * K + C) * 2u; }
    const size_t kstep = (size_t)(BK * 2);
    const size_t hstep = (size_t)HALF * K * 2;
    const size_t tstep = 2 * hstep;
    const unsigned ldsw = (unsigned)wid * 1024u;
    const int aoff = lds_byte(wr * 64 + fr, fq * 8), boff = lds_byte(wc * 32 + fr, fq * 8);
#define PG8_SA(b, h) (((b) * 2 + (h)) * HTB)
#define PG8_SB(b, h) ((4 + (b) * 2 + (h)) * HTB)
#define PG8_STAGE(bufoff, gbase, voff) do { _Pragma("unroll") for (int _i = 0; _i < 2; ++_i) \
        __builtin_amdgcn_global_load_lds((const unsigned*)((const char*)(gbase) + (voff)[_i]), (PG8_LAS unsigned*)(lds + (bufoff) + ldsw + _i * 8192), 16, 0, 0); } while (0)
#define PG8_LDA(dst, b, h) do { _Pragma("unroll") for (int m = 0; m < 4; ++m) _Pragma("unroll") for (int k = 0; k < 2; ++k) dst[m][k] = *(const PG8_LAS bf16x8*)(lds + PG8_SA(b, h) + aoff + m * 2048 + k * 1024); } while (0)
#define PG8_LDB(dst, b, h) do { _Pragma("unroll") for (int n = 0; n < 2; ++n) _Pragma("unroll") for (int k = 0; k < 2; ++k) dst[n][k] = *(const PG8_LAS bf16x8*)(lds + PG8_SB(b, h) + boff + n * 2048 + k * 1024); } while (0)
#define PG8_MMA(ai, bj, At, Bt) do { __builtin_amdgcn_s_setprio(1); _Pragma("unroll") for (int m = 0; m < 4; ++m) _Pragma("unroll") for (int n = 0; n < 2; ++n) _Pragma("unroll") for (int k = 0; k < 2; ++k) \
        acc[ai][bj][m][n] = __builtin_amdgcn_mfma_f32_16x16x32_bf16(Bt[n][k], At[m][k], acc[ai][bj][m][n], 0, 0, 0); __builtin_amdgcn_s_setprio(0); } while (0)
#define PG8_WAIT_V(n) asm volatile("s_waitcnt vmcnt(" #n ")" ::: "memory")
#define PG8_WAIT_L(n) asm volatile("s_waitcnt lgkmcnt(" #n ")" ::: "memory")
#define PG8_BAR __builtin_amdgcn_s_barrier()
#define PG8_SCHED __builtin_amdgcn_sched_barrier(0)
    Unit cur, nxt; int ui = 0;
    if (!S.next(0, cur)) return;
    f32x4 acc[2][2][4][2];
#pragma unroll
    for (int a = 0; a < 2; ++a)
#pragma unroll
        for (int b = 0; b < 2; ++b)
#pragma unroll
            for (int m = 0; m < 4; ++m)
#pragma unroll
                for (int n = 0; n < 2; ++n) acc[a][b][m][n] = (f32x4){0.f, 0.f, 0.f, 0.f};
    bf16x8 At[4][2], B0[2][2], B1[2][2];
    const char* cA = (const char*)g.A + (size_t)cur.pm * tstep; const char* cB = (const char*)g.Bt + (size_t)cur.pn * tstep;
    S.a_ready(cur);
    if constexpr (SP2) {
        PG8_STAGE(PG8_SB(0, 0), cB, voffB); PG8_STAGE(PG8_SB(0, 1), cB + hstep, voffB); PG8_STAGE(PG8_SA(0, 0), cA, voffA); PG8_STAGE(PG8_SA(0, 1), cA + hstep, voffA);
        if (wr == 1) PG8_BAR;
        PG8_WAIT_V(2); PG8_BAR;
        PG8_STAGE(PG8_SB(1, 0), cB + kstep, voffB); PG8_STAGE(PG8_SA(1, 0), cA + kstep, voffA); PG8_STAGE(PG8_SB(1, 1), cB + hstep + kstep, voffB);
        PG8_WAIT_V(6); PG8_BAR;
    } else {
        PG8_STAGE(PG8_SB(0, 0), cB, voffB); PG8_STAGE(PG8_SA(0, 0), cA, voffA); PG8_STAGE(PG8_SB(0, 1), cB + hstep, voffB); PG8_STAGE(PG8_SA(0, 1), cA + hstep, voffA);
        if (wr == 1) PG8_BAR;
        PG8_WAIT_V(4); PG8_BAR;
        PG8_STAGE(PG8_SB(1, 0), cB + kstep, voffB); PG8_STAGE(PG8_SA(1, 0), cA + kstep, voffA); PG8_STAGE(PG8_SB(1, 1), cB + hstep + kstep, voffB);
        PG8_WAIT_V(6); PG8_BAR;
    }
    for (;;) {
        const bool has_next = S.next(ui + 1, nxt);
        const char* nA = has_next ? (const char*)g.A + (size_t)nxt.pm * tstep : cA; const char* nB = has_next ? (const char*)g.Bt + (size_t)nxt.pn * tstep : cB;
        for (int t = 0; t < nt; t += 2) {
            const bool last = (t == nt - 2);
            const char* a1 = cA + (size_t)(t + 1) * kstep;
            const char* a2 = last ? nA : cA + (size_t)(t + 2) * kstep; const char* b2 = last ? nB : cB + (size_t)(t + 2) * kstep;
            const char* a3 = a2 + kstep; const char* b3 = b2 + kstep;
            if (last && has_next) S.a_ready(nxt);
            if constexpr (SP2) {
            PG8_LDB(B0, 0, 0); PG8_LDB(B1, 0, 1); PG8_SCHED; PG8_LDA(At, 0, 0); PG8_STAGE(PG8_SA(1, 1), a1 + hstep, voffA);
            PG8_WAIT_V(8); PG8_WAIT_L(0); PG8_BAR; PG8_MMA(0, 0, At, B0); PG8_MMA(0, 1, At, B1); PG8_BAR; PG8_SCHED;
            PG8_LDA(At, 0, 1); PG8_STAGE(PG8_SB(0, 0), b2, voffB); PG8_STAGE(PG8_SB(0, 1), b2 + hstep, voffB); PG8_STAGE(PG8_SA(0, 0), a2, voffA);
            PG8_WAIT_V(8); PG8_WAIT_L(0); PG8_BAR; PG8_MMA(1, 0, At, B0); PG8_MMA(1, 1, At, B1); PG8_BAR; PG8_SCHED;
            PG8_LDB(B0, 1, 0); PG8_LDB(B1, 1, 1); PG8_SCHED; PG8_LDA(At, 1, 0); PG8_STAGE(PG8_SA(0, 1), a2 + hstep, voffA);
            PG8_WAIT_V(8); PG8_WAIT_L(0); PG8_BAR; PG8_MMA(0, 0, At, B0); PG8_MMA(0, 1, At, B1); PG8_BAR; PG8_SCHED;
            PG8_LDA(At, 1, 1); PG8_STAGE(PG8_SB(1, 0), b3, voffB); PG8_STAGE(PG8_SB(1, 1), b3 + hstep, voffB); PG8_STAGE(PG8_SA(1, 0), a3, voffA);
            PG8_WAIT_V(8); PG8_WAIT_L(0); PG8_BAR; PG8_MMA(1, 0, At, B0); PG8_MMA(1, 1, At, B1); PG8_BAR; PG8_SCHED;
            } else {
            PG8_LDB(B0, 0, 0); PG8_SCHED; PG8_LDA(At, 0, 0); PG8_STAGE(PG8_SA(1, 1), a1 + hstep, voffA);
            PG8_WAIT_L(8); PG8_BAR; PG8_WAIT_L(0); PG8_MMA(0, 0, At, B0); PG8_BAR; PG8_SCHED;
            PG8_LDB(B1, 0, 1); PG8_STAGE(PG8_SB(0, 0), b2, voffB);
            PG8_BAR; PG8_WAIT_L(0); PG8_MMA(0, 1, At, B1); PG8_BAR;
            PG8_LDA(At, 0, 1); PG8_STAGE(PG8_SA(0, 0), a2, voffA);
            PG8_BAR; PG8_WAIT_L(0); PG8_MMA(1, 0, At, B0); PG8_BAR; PG8_SCHED;
            PG8_STAGE(PG8_SB(0, 1), b2 + hstep, voffB);
            PG8_WAIT_V(6); PG8_BAR; PG8_MMA(1, 1, At, B1); PG8_BAR;
            PG8_LDB(B0, 1, 0); PG8_SCHED; PG8_LDA(At, 1, 0); PG8_STAGE(PG8_SA(0, 1), a2 + hstep, voffA);
            PG8_WAIT_L(8); PG8_BAR; PG8_WAIT_L(0); PG8_MMA(0, 0, At, B0); PG8_BAR; PG8_SCHED;
            PG8_LDB(B1, 1, 1); PG8_STAGE(PG8_SB(1, 0), b3, voffB);
            PG8_BAR; PG8_WAIT_L(0); PG8_MMA(0, 1, At, B1); PG8_BAR;
            PG8_LDA(At, 1, 1); PG8_STAGE(PG8_SA(1, 0), a3, voffA);
            PG8_BAR; PG8_WAIT_L(0); PG8_MMA(1, 0, At, B0); PG8_BAR; PG8_SCHED;
            PG8_STAGE(PG8_SB(1, 1), b3 + hstep, voffB);
            PG8_WAIT_V(6); PG8_BAR; PG8_MMA(1, 1, At, B1); PG8_BAR;
            }
        }
        if constexpr (ALIGN_EPI) { if (wr == 0) PG8_BAR; }
        if constexpr (!Epi::AFTER_DRAIN) { E(acc, cur, wr, wc, fr, fq); S.done(cur); }
        if (!has_next) break;
#pragma unroll
        for (int a = 0; a < 2; ++a)
#pragma unroll
            for (int b = 0; b < 2; ++b)
#pragma unroll
                for (int m = 0; m < 4; ++m)
#pragma unroll
                    for (int n = 0; n < 2; ++n) acc[a][b][m][n] = (f32x4){0.f, 0.f, 0.f, 0.f};
        cur = nxt; cA = nA; cB = nB; ++ui;
        if constexpr (ALIGN_EPI) { if (wr == 1) PG8_BAR; }
    }
    PG8_WAIT_V(0);
    if constexpr (!ALIGN_EPI) { if (wr == 0) PG8_BAR; }
    PG8_BAR;
    if constexpr (Epi::AFTER_DRAIN) { E.fused(acc, cur, wr, wc, fr, fq, lds, wid, lane); S.done(cur); }
#undef PG8_SA
#undef PG8_SB
#undef PG8_STAGE
#undef PG8_LDA
#undef PG8_LDB
#undef PG8_MMA
#undef PG8_WAIT_V
#undef PG8_WAIT_L
#undef PG8_BAR
#undef PG8_SCHED
}
}
constexpr int M = 16384, D = 1024, FF = 2816, NGU = 5632, NIN = 3584, SEQ = 4096;
constexpr int WIN_COLS = 3592;
constexpr size_t MiB = 1u << 20;
constexpr size_t WS_CTL = 0, CTL_BYTES = 65536;
constexpr size_t WS_WIN = 1 * MiB, WS_WOUT = 8 * MiB, WS_WGU2 = 10 * MiB, WS_WD2 = 21 * MiB;
constexpr size_t WS_XN = 27 * MiB;
constexpr size_t WS_ACT = 59 * MiB;
constexpr size_t WS_BD = 171 * MiB;
constexpr size_t WS_EG = 172 * MiB;
constexpr size_t WS_DN = 184 * MiB;
constexpr size_t WS_WGU1 = 184 * MiB, WS_WD1 = 195 * MiB;
constexpr size_t WS_QG = WS_DN, WS_KD = WS_DN + 16 * MiB, WS_U = WS_DN + 32 * MiB, WS_W = WS_DN + 48 * MiB, WS_A = WS_DN + 64 * MiB;
constexpr size_t WS_END = 256 * MiB;
constexpr int LDS_BYTES = 147456;
constexpr int NWAVES = 8;

#define GAS __attribute__((address_space(1)))
#define LAS __attribute__((address_space(3)))
typedef unsigned short bf16;
typedef unsigned v4u __attribute__((ext_vector_type(4)));
typedef unsigned v2u __attribute__((ext_vector_type(2)));
typedef float f32x4 __attribute__((ext_vector_type(4)));
typedef float f32x2 __attribute__((ext_vector_type(2)));
#define LDS_WAIT() asm volatile("s_waitcnt lgkmcnt(0)" ::: "memory")
__device__ __forceinline__ unsigned f2bf(float f) { unsigned u = __builtin_bit_cast(unsigned, f); return (u + 0x7fffu + ((u >> 16) & 1u)) >> 16; }
__device__ __forceinline__ unsigned pk2(float lo, float hi) { return f2bf(lo) | (f2bf(hi) << 16); }
__device__ __forceinline__ float bflo(unsigned u) { return __uint_as_float(u << 16); }
__device__ __forceinline__ float bfhi(unsigned u) { return __uint_as_float(u & 0xffff0000u); }
__device__ __forceinline__ float bf2f(bf16 v) { return __uint_as_float(((unsigned)v) << 16); }
__device__ __forceinline__ float wave_sum(float v) {
#pragma unroll
    for (int o = 1; o < 64; o <<= 1) v += __shfl_xor(v, o);
    return v;
}
__device__ __forceinline__ float wave_max(float v) {
#pragma unroll
    for (int o = 1; o < 64; o <<= 1) v = fmaxf(v, __shfl_xor(v, o));
    return v;
}

__device__ __forceinline__ int opq(int v) { asm volatile("" : "+v"(v)); return v; }
struct Args { const float* in[17]; float* out; unsigned char* ws; };

__device__ __forceinline__ void transpose_item(const float* src, int srcN, int srccol0, bf16* dst, int dstK, int dstrow0, int k0, LAS float* scr, int lane) {
#pragma unroll 8
    for (int i = 0; i < 32; ++i) { const int kk = 2 * i + (lane >> 5); scr[kk * 33 + (lane & 31)] = src[(size_t)(k0 + kk) * srcN + srccol0 + (lane & 31)]; }
    LDS_WAIT(); asm volatile("" ::: "memory");
    const int c = lane & 7;
#pragma unroll
    for (int j = 0; j < 4; ++j) { const int n = (lane >> 3) + 8 * j; const LAS float* s = scr + (8 * c) * 33 + n;
        v4u o; o.x = pk2(s[0 * 33], s[1 * 33]); o.y = pk2(s[2 * 33], s[3 * 33]); o.z = pk2(s[4 * 33], s[5 * 33]); o.w = pk2(s[6 * 33], s[7 * 33]);
        *(v4u*)(dst + (size_t)(dstrow0 + n) * dstK + k0 + 8 * c) = o; }
    LDS_WAIT(); asm volatile("" ::: "memory");
}
__device__ __forceinline__ void tr_gu(const float* gate, const float* up, bf16* dst, int r, LAS float* scr, int lane) {
    const int nblk = NGU / 32, kb = r / nblk, nb = r % nblk, dstrow0 = nb * 32, pn = dstrow0 >> 8, within = dstrow0 & 255;
    transpose_item(within < 128 ? gate : up, FF, pn * 128 + (within & 127), dst, D, dstrow0, kb * 64, scr, lane);
}
__device__ __forceinline__ void tr_plain(const float* src, int K, int N, bf16* dst, int r, LAS float* scr, int lane) {
    const int nblk = N / 32, kb = r / nblk, nb = r % nblk;
    transpose_item(src, N, nb * 32, dst, K, nb * 32, kb * 64, scr, lane);
}
__device__ __forceinline__ void tr_win(const float* src, bf16* dst, int r, LAS float* scr, int lane) {
    const int nblk = NIN / 32, kb = r / nblk, nb = r % nblk, dstrow0 = nb * 32;
    transpose_item(src, WIN_COLS, dstrow0 + (dstrow0 >= 3072 ? 8 : 0), dst, D, dstrow0, kb * 64, scr, lane);
}

__device__ __forceinline__ void rms_row(const float* xrow, const float* gain, int lane, f32x4 (&v)[4]) {
    const f32x4* xr = (const f32x4*)xrow + lane; const f32x4* gr = (const f32x4*)gain + lane;
    float s = 0.f;
#pragma unroll
    for (int j = 0; j < 4; ++j) { v[j] = xr[64 * j]; s += (v[j].x * v[j].x + v[j].y * v[j].y) + (v[j].z * v[j].z + v[j].w * v[j].w); }
    const float rs = 1.0f / sqrtf(wave_sum(s) * (1.f / D) + 1e-6f);
#pragma unroll
    for (int j = 0; j < 4; ++j) { const f32x4 g = gr[64 * j]; v[j] = v[j] * rs * g; }
}
__device__ __forceinline__ void store_row_bf16(bf16* orow, int lane, const f32x4 (&v)[4]) {
    v2u* o8 = (v2u*)orow + lane;
#pragma unroll
    for (int j = 0; j < 4; ++j) { v2u w; w.x = pk2(v[j].x, v[j].y); w.y = pk2(v[j].z, v[j].w); o8[64 * j] = w; }
}

__device__ __forceinline__ int kperm(int x) { return 8 * ((x & 15) >> 2) + 4 * (x >> 4) + (x & 3); }
typedef short bf16x8 __attribute__((ext_vector_type(8)));
typedef __bf16 bf16x2_t __attribute__((ext_vector_type(2)));
__device__ __forceinline__ unsigned cvtpk(float lo, float hi) { f32x2 v = {lo, hi}; bf16x2_t b = __builtin_convertvector(v, bf16x2_t); return __builtin_bit_cast(unsigned, b); }
constexpr int PQ = 0, PK = 17408, PVB = 34816, PKB = 53248, PAS = 71680, PTS = 88320, PMS = 104960, PTB = 121600, PGC = 130816;
__device__ __forceinline__ void dn_prep_item(const Args& a, LAS unsigned char* L8, int ch, int tid, int lane, int wave) {
    unsigned char* ws = a.ws;
    const bf16* PROJ = (const bf16*)(ws + WS_ACT);
    const float* BD = (const float*)(ws + WS_BD);
    const float* conv_w = a.in[7]; const float* a_log = a.in[8]; const float* dt_bias = a.in[9];
    const int bh = ch >> 6, n = ch & 63, b = bh >> 2, h = bh & 3;
    const int tok0 = b * SEQ + n * 64;
    LAS float* As = (LAS float*)(L8 + PAS); LAS float* Ts = (LAS float*)(L8 + PTS); LAS float* Ms = (LAS float*)(L8 + PMS);
    LAS float* gcs = (LAS float*)(L8 + PGC); LAS float* bts = gcs + 64;
    const int jl = lane & 15, kq = lane >> 4;
    unsigned raw[11][3];
#pragma unroll
    for (int i = 0; i < 11; ++i) { const int s = n * 64 + wave * 8 - 3 + i;
#pragma unroll
        for (int sec = 0; sec < 3; ++sec) raw[i][sec] = (s >= 0) ? *(const unsigned*)(PROJ + (size_t)(tok0 + wave * 8 - 3 + i) * NIN + 1536 + sec * 512 + h * 128 + 2 * lane) : 0u; }
    if (wave == 0) {
        const int tok = tok0 + lane;
        const float braw = BD[(size_t)tok * 8 + h], draw = BD[(size_t)tok * 8 + 4 + h] + dt_bias[h];
        const float sp = fmaxf(draw, 0.f) + log1pf(__expf(-fabsf(draw)));
        float g = -expf(a_log[h]) * sp;
#pragma unroll
        for (int o = 1; o < 64; o <<= 1) { const float t = __shfl_up(g, o); if (lane >= o) g += t; }
        gcs[lane] = g; bts[lane] = 1.0f / (1.0f + __expf(-braw));
        if (lane == 63) ((float*)(ws + WS_EG))[ch] = expf(g);
    }
    for (int i = tid; i < 64 * 65; i += 512) Ts[i] = 0.f;
    __syncthreads();
    {
        float cw[3][4][2];
#pragma unroll
        for (int sec = 0; sec < 3; ++sec)
#pragma unroll
            for (int j = 0; j < 4; ++j) { const f32x2 w = *(const f32x2*)(conv_w + j * 1536 + sec * 512 + h * 128 + 2 * lane); cw[sec][j][0] = w.x; cw[sec][j][1] = w.y; }
        const float glast = gcs[63];
        bf16* QG = (bf16*)(ws + WS_QG) + (size_t)ch * 8192; bf16* KD = (bf16*)(ws + WS_KD) + (size_t)ch * 8192;
#pragma unroll
        for (int rr = 0; rr < 8; ++rr) {
            const int r = wave * 8 + rr;
            float val[3][2];
#pragma unroll
            for (int sec = 0; sec < 3; ++sec) { float v0 = 0.f, v1 = 0.f;
#pragma unroll
                for (int j = 0; j < 4; ++j) { v0 += bflo(raw[rr + j][sec]) * cw[sec][j][0]; v1 += bfhi(raw[rr + j][sec]) * cw[sec][j][1]; }
                val[sec][0] = v0 / (1.f + __expf(-v0)); val[sec][1] = v1 / (1.f + __expf(-v1)); }
            const float ssq = wave_sum(val[0][0] * val[0][0] + val[0][1] * val[0][1]);
            const float ssk = wave_sum(val[1][0] * val[1][0] + val[1][1] * val[1][1]);
            const float rq = (1.0f / sqrtf(ssq + 1e-6f)) * 0.08838834764831845f, rk = 1.0f / sqrtf(ssk + 1e-6f);
            const float q0 = val[0][0] * rq, q1 = val[0][1] * rq, k0 = val[1][0] * rk, k1 = val[1][1] * rk;
            const float gr = gcs[r], be = bts[r], eq = __expf(gr), ek = __expf(glast - gr), bek = be * eq;
            *(LAS unsigned*)(L8 + PQ + r * 272 + 4 * lane) = cvtpk(q0, q1);
            *(LAS unsigned*)(L8 + PK + r * 272 + 4 * lane) = cvtpk(k0, k1);
            const unsigned vb = cvtpk(val[2][0] * be, val[2][1] * be), kb = cvtpk(k0 * bek, k1 * bek);
            *(LAS bf16*)(L8 + PVB + (2 * lane) * 144 + 2 * r) = (bf16)(vb & 0xffffu); *(LAS bf16*)(L8 + PVB + (2 * lane + 1) * 144 + 2 * r) = (bf16)(vb >> 16);
            *(LAS bf16*)(L8 + PKB + (2 * lane) * 144 + 2 * r) = (bf16)(kb & 0xffffu); *(LAS bf16*)(L8 + PKB + (2 * lane + 1) * 144 + 2 * r) = (bf16)(kb >> 16);
            const int d = 2 * lane;
            *(unsigned*)(QG + r * 128 + (d & 96) + kperm(d & 31)) = cvtpk(q0 * eq, q1 * eq);
            const int tp = (r & 32) + kperm(r & 31); const unsigned kd = cvtpk(k0 * ek, k1 * ek);
            KD[d * 64 + tp] = (bf16)(kd & 0xffffu); KD[(d + 1) * 64 + tp] = (bf16)(kd >> 16);
        }
    }
    __syncthreads();
    {
        bf16* Aout = (bf16*)(ws + WS_A) + (size_t)ch * 4096;
#pragma unroll
        for (int t2 = 0; t2 < 2; ++t2) {
            const int idx = 2 * wave + t2, ct = idx >> 2, jt = idx & 3;
            f32x4 acc1 = {0.f, 0.f, 0.f, 0.f}, acc2 = {0.f, 0.f, 0.f, 0.f};
#pragma unroll
            for (int ks = 0; ks < 4; ++ks) {
                const bf16x8 kc = *(const LAS bf16x8*)(L8 + PK + (16 * ct + jl) * 272 + (32 * ks + 8 * kq) * 2);
                const bf16x8 kj = *(const LAS bf16x8*)(L8 + PK + (16 * jt + jl) * 272 + (32 * ks + 8 * kq) * 2);
                const bf16x8 qc = *(const LAS bf16x8*)(L8 + PQ + (16 * ct + jl) * 272 + (32 * ks + 8 * kq) * 2);
                acc1 = __builtin_amdgcn_mfma_f32_16x16x32_bf16(kc, kj, acc1, 0, 0, 0);
                acc2 = __builtin_amdgcn_mfma_f32_16x16x32_bf16(kj, qc, acc2, 0, 0, 0);
            }
            { const int j = 16 * jt + jl; const float gj = gcs[j];
#pragma unroll
              for (int e = 0; e < 4; ++e) { const int c = 16 * ct + 4 * kq + e; As[c * 65 + j] = (j < c) ? bts[c] * acc1[e] * __expf(gcs[c] - gj) : 0.f; } }
            { const int c = 16 * ct + jl; const float gc_ = gcs[c]; float pv[4];
#pragma unroll
              for (int e = 0; e < 4; ++e) { const int j = 16 * jt + 4 * kq + e; pv[e] = (j <= c) ? acc2[e] * __expf(gc_ - gcs[j]) : 0.f; }
              v2u w; w.x = cvtpk(pv[0], pv[1]); w.y = cvtpk(pv[2], pv[3]);
              *(v2u*)(Aout + c * 64 + 32 * (jt >> 1) + 8 * kq + 4 * (jt & 1)) = w; }
        }
    }
    __syncthreads();
    if (wave == 0) {
        const int bb = lane >> 4, col = lane & 15;
        float xv[16];
#pragma unroll
        for (int c = 0; c < 16; ++c) { float s = (c == col) ? 1.f : 0.f;
#pragma unroll
            for (int j = 0; j < c; ++j) s -= As[(16 * bb + c) * 65 + 16 * bb + j] * xv[j];
            xv[c] = s; }
#pragma unroll
        for (int c = 0; c < 16; ++c) Ts[(16 * bb + c) * 65 + 16 * bb + col] = xv[c];
    }
    __syncthreads();
    {
        const int pr = tid >> 8, i = (tid >> 4) & 15, jj = tid & 15, hb = 32 * pr + 16, lb = 32 * pr;
        float s = 0.f;
#pragma unroll
        for (int k = 0; k < 16; ++k) s += As[(hb + i) * 65 + lb + k] * Ts[(lb + k) * 65 + lb + jj];
        Ms[(hb + i) * 65 + lb + jj] = s;
        __syncthreads();
        float t = 0.f;
#pragma unroll
        for (int k = 0; k < 16; ++k) t += Ts[(hb + i) * 65 + hb + k] * Ms[(hb + k) * 65 + lb + jj];
        Ts[(hb + i) * 65 + lb + jj] = -t;
    }
    __syncthreads();
    {
        const int i = tid >> 4, j0 = (tid & 15) * 2;
        float s0 = 0.f, s1 = 0.f;
#pragma unroll 8
        for (int k = 0; k < 32; ++k) { const float av = As[(32 + i) * 65 + k]; s0 += av * Ts[k * 65 + j0]; s1 += av * Ts[k * 65 + j0 + 1]; }
        Ms[(32 + i) * 65 + j0] = s0; Ms[(32 + i) * 65 + j0 + 1] = s1;
        __syncthreads();
        float t0 = 0.f, t1 = 0.f;
#pragma unroll 8
        for (int k = 0; k < 32; ++k) { const float tv = Ts[(32 + i) * 65 + 32 + k]; t0 += tv * Ms[(32 + k) * 65 + j0]; t1 += tv * Ms[(32 + k) * 65 + j0 + 1]; }
        __syncthreads();
        Ts[(32 + i) * 65 + j0] = -t0; Ts[(32 + i) * 65 + j0 + 1] = -t1;
    }
    __syncthreads();
#pragma unroll
    for (int i = 0; i < 4; ++i) { const int idx2 = tid + 512 * i, r = idx2 >> 5, c = (idx2 & 31) * 2;
        *(LAS unsigned*)(L8 + PTB + r * 144 + 2 * c) = cvtpk(Ts[r * 65 + c], Ts[r * 65 + c + 1]); }
    __syncthreads();
    {
        bf16* U = (bf16*)(ws + WS_U) + (size_t)ch * 8192; bf16* W = (bf16*)(ws + WS_W) + (size_t)ch * 8192;
        const int mt = wave & 3, ntb = 4 * (wave >> 2);
        bf16x8 ta[2];
#pragma unroll
        for (int ks = 0; ks < 2; ++ks) ta[ks] = *(const LAS bf16x8*)(L8 + PTB + (16 * mt + jl) * 144 + (32 * ks + 8 * kq) * 2);
#pragma unroll
        for (int q = 0; q < 4; ++q) { const int nt = ntb + q; f32x4 acc = {0.f, 0.f, 0.f, 0.f};
#pragma unroll
            for (int ks = 0; ks < 2; ++ks) { const bf16x8 vb = *(const LAS bf16x8*)(L8 + PVB + (16 * nt + jl) * 144 + (32 * ks + 8 * kq) * 2);
                acc = __builtin_amdgcn_mfma_f32_16x16x32_bf16(ta[ks], vb, acc, 0, 0, 0); }
            v2u w; w.x = cvtpk(acc[0], acc[1]); w.y = cvtpk(acc[2], acc[3]);
            *(v2u*)(U + (16 * nt + jl) * 64 + 16 * mt + 4 * kq) = w; }
        bf16x8 ka[2];
#pragma unroll
        for (int ks = 0; ks < 2; ++ks) ka[ks] = *(const LAS bf16x8*)(L8 + PKB + (16 * wave + jl) * 144 + (32 * ks + 8 * kq) * 2);
#pragma unroll
        for (int ctile = 0; ctile < 4; ++ctile) { f32x4 acc = {0.f, 0.f, 0.f, 0.f};
#pragma unroll
            for (int ks = 0; ks < 2; ++ks) { const bf16x8 tb = *(const LAS bf16x8*)(L8 + PTB + (16 * ctile + jl) * 144 + (32 * ks + 8 * kq) * 2);
                acc = __builtin_amdgcn_mfma_f32_16x16x32_bf16(ka[ks], tb, acc, 0, 0, 0); }
            v2u w; w.x = cvtpk(-acc[0], -acc[1]); w.y = cvtpk(-acc[2], -acc[3]);
            *(v2u*)(W + (16 * ctile + jl) * 128 + 32 * (wave >> 1) + 8 * kq + 4 * (wave & 1)) = w; }
    }
    __syncthreads();
}

__device__ __forceinline__ bf16x8 pack8(const f32x4& a, const f32x4& b) { v4u w; w.x = cvtpk(a[0], a[1]); w.y = cvtpk(a[2], a[3]); w.z = cvtpk(b[0], b[1]); w.w = cvtpk(b[2], b[3]); return __builtin_bit_cast(bf16x8, w); }
constexpr int SC_W = 0, SC_QG = 17408, SC_KDT = 34816, SC_A = 53248, SC_BUF = 62464;
__device__ __forceinline__ void dn_scan_mfma(const Args& a, LAS unsigned char* L8, int bh, int tid, int lane, int wave) {
    unsigned char* ws = a.ws;
    const int b = bh >> 2, h = bh & 3;
    const int jl = lane & 15, kq = lane >> 4, cs = wave * 16;
    bf16* MIX = (bf16*)(ws + WS_XN);
    const float* EG = (const float*)(ws + WS_EG);
    f32x4 Sacc[8];
#pragma unroll
    for (int T = 0; T < 8; ++T) Sacc[T] = (f32x4){0.f, 0.f, 0.f, 0.f};
    v4u st[7]; v2u ut[4], utn[4];
    const int r16 = tid >> 4, c16 = tid & 15, r8 = tid >> 3, c8 = tid & 7;
#define SC_LOAD(chx) do { const size_t o8 = (size_t)(chx) * 8192; \
        const bf16* Wg = (const bf16*)(ws + WS_W) + o8; const bf16* Qg = (const bf16*)(ws + WS_QG) + o8; const bf16* Kg = (const bf16*)(ws + WS_KD) + o8; const bf16* Ag = (const bf16*)(ws + WS_A) + (size_t)(chx) * 4096; \
        st[0] = *(const v4u*)(Wg + tid * 8); st[1] = *(const v4u*)(Wg + 4096 + tid * 8); st[2] = *(const v4u*)(Qg + tid * 8); st[3] = *(const v4u*)(Qg + 4096 + tid * 8); \
        st[4] = *(const v4u*)(Kg + tid * 8); st[5] = *(const v4u*)(Kg + 4096 + tid * 8); st[6] = *(const v4u*)(Ag + tid * 8); \
        const bf16* Ug = (const bf16*)(ws + WS_U) + o8 + (cs + jl) * 64 + 4 * kq; \
        utn[0] = *(const v2u*)(Ug); utn[1] = *(const v2u*)(Ug + 16); utn[2] = *(const v2u*)(Ug + 32); utn[3] = *(const v2u*)(Ug + 48); } while (0)
#define SC_WRITE(bufp) do { LAS unsigned char* B_ = (bufp); \
        *(LAS v4u*)(B_ + SC_W + r16 * 272 + c16 * 16) = st[0]; *(LAS v4u*)(B_ + SC_W + (r16 + 32) * 272 + c16 * 16) = st[1]; \
        *(LAS v4u*)(B_ + SC_QG + r16 * 272 + c16 * 16) = st[2]; *(LAS v4u*)(B_ + SC_QG + (r16 + 32) * 272 + c16 * 16) = st[3]; \
        *(LAS v4u*)(B_ + SC_KDT + r8 * 144 + c8 * 16) = st[4]; *(LAS v4u*)(B_ + SC_KDT + (r8 + 64) * 144 + c8 * 16) = st[5]; \
        *(LAS v4u*)(B_ + SC_A + r8 * 144 + c8 * 16) = st[6]; } while (0)
    SC_LOAD(bh * 64);
    SC_WRITE(L8);
#pragma unroll
    for (int i = 0; i < 4; ++i) ut[i] = utn[i];
    __syncthreads();
    for (int n = 0; n < 64; ++n) {
        const int ch = bh * 64 + n;
        if (n + 1 < 64) SC_LOAD(ch + 1);
        const float eg = EG[ch];
        const LAS unsigned char* B = L8 + (n & 1) * SC_BUF;
        bf16x8 sb[4];
#pragma unroll
        for (int ks = 0; ks < 4; ++ks) sb[ks] = pack8(Sacc[2 * ks], Sacc[2 * ks + 1]);
        f32x4 vn[4], oa[4];
#pragma unroll
        for (int mt = 0; mt < 4; ++mt) { vn[mt] = (f32x4){bflo(ut[mt].x), bfhi(ut[mt].x), bflo(ut[mt].y), bfhi(ut[mt].y)}; oa[mt] = (f32x4){0.f, 0.f, 0.f, 0.f}; }
#pragma unroll
        for (int mt = 0; mt < 4; ++mt)
#pragma unroll
            for (int ks = 0; ks < 4; ++ks) {
                const bf16x8 wa = *(const LAS bf16x8*)(B + SC_W + (16 * mt + jl) * 272 + (32 * ks + 8 * kq) * 2);
                const bf16x8 qa = *(const LAS bf16x8*)(B + SC_QG + (16 * mt + jl) * 272 + (32 * ks + 8 * kq) * 2);
                vn[mt] = __builtin_amdgcn_mfma_f32_16x16x32_bf16(wa, sb[ks], vn[mt], 0, 0, 0);
                oa[mt] = __builtin_amdgcn_mfma_f32_16x16x32_bf16(qa, sb[ks], oa[mt], 0, 0, 0);
            }
        bf16x8 vb[2];
        vb[0] = pack8(vn[0], vn[1]); vb[1] = pack8(vn[2], vn[3]);
#pragma unroll
        for (int T = 0; T < 8; ++T) { Sacc[T] = Sacc[T] * eg;
#pragma unroll
            for (int k2 = 0; k2 < 2; ++k2) { const bf16x8 ka = *(const LAS bf16x8*)(B + SC_KDT + (16 * T + jl) * 144 + (32 * k2 + 8 * kq) * 2);
                Sacc[T] = __builtin_amdgcn_mfma_f32_16x16x32_bf16(ka, vb[k2], Sacc[T], 0, 0, 0); } }
#pragma unroll
        for (int mt = 0; mt < 4; ++mt)
#pragma unroll
            for (int k2 = 0; k2 < 2; ++k2) { const bf16x8 aa = *(const LAS bf16x8*)(B + SC_A + (16 * mt + jl) * 144 + (32 * k2 + 8 * kq) * 2);
                oa[mt] = __builtin_amdgcn_mfma_f32_16x16x32_bf16(aa, vb[k2], oa[mt], 0, 0, 0); }
        bf16* op = MIX + (size_t)(b * SEQ + n * 64 + 4 * kq) * 1024 + 512 + h * 128 + cs + jl;
#pragma unroll
        for (int mt = 0; mt < 4; ++mt)
#pragma unroll
            for (int e = 0; e < 4; ++e) op[(size_t)(16 * mt + e) * 1024] = (bf16)f2bf(oa[mt][e]);
        if (n + 1 < 64) { SC_WRITE(L8 + ((n + 1) & 1) * SC_BUF);
#pragma unroll
            for (int i = 0; i < 4; ++i) ut[i] = utn[i]; }
        __syncthreads();
    }
#undef SC_LOAD
#undef SC_WRITE
}

typedef float f32x16 __attribute__((ext_vector_type(16)));
typedef short s16x4 __attribute__((ext_vector_type(4)));
__device__ __forceinline__ s16x4 vtr(const LAS unsigned char* p) { return __builtin_bit_cast(s16x4, __builtin_amdgcn_ds_read_tr16_b64_v4i16((LAS s16x4*)p)); }
constexpr int KVP = 144;
constexpr int KV_BYTES = 384 * KVP;
constexpr size_t WS_ML = 173 * MiB;
__device__ __forceinline__ void attn_item(bf16* PROJ, float* ML, LAS unsigned char* L8, int item, int tid, int lane, int wave) {
    asm volatile("" : "+v"(lane));
    const int bh = item / 48, rem = item - bh * 48, p = rem >> 4, sub = rem & 15;
    const int b = bh >> 3, h = bh & 7;
    const int dsh = 2 * p, dil = 1 << dsh, nsh = 4 - dsh;
    const int r = sub >> nsh, qb = sub & ((1 << nsh) - 1);
    const int base = 256 * qb;
    const size_t tokb = (size_t)b * SEQ + r;
#pragma unroll
    for (int i = 0; i < 6; ++i) { const int id = tid + 512 * i, row = id >> 3, ch = id & 7, idx = base - 128 + row;
        v4u kv = (v4u){0u, 0u, 0u, 0u}, vv = (v4u){0u, 0u, 0u, 0u};
        if (idx >= 0) { const bf16* src = PROJ + (tokb + (size_t)dil * idx) * NIN + h * 64 + ch * 8; kv = *(const v4u*)(src + 512); vv = *(const v4u*)(src + 1024); }
        *(LAS v4u*)(L8 + row * KVP + ch * 16) = kv; *(LAS v4u*)(L8 + KV_BYTES + row * KVP + ch * 16) = vv; }
    const int ql = lane & 31, kh = lane >> 5;
    const size_t tokq = tokb + (size_t)dil * (base + 32 * wave + ql);
    bf16x8 qf[4];
#pragma unroll
    for (int s = 0; s < 4; ++s) qf[s] = *(const bf16x8*)(PROJ + tokq * NIN + h * 64 + 16 * s + 8 * kh);
    __syncthreads();
    f32x16 sc[5];
#pragma unroll
    for (int kt = 0; kt < 5; ++kt) { f32x16 acc = {};
#pragma unroll
        for (int s = 0; s < 4; ++s) { const bf16x8 kf = *(const LAS bf16x8*)(L8 + (32 * (wave + kt) + ql) * KVP + (16 * s + 8 * kh) * 2); acc = __builtin_amdgcn_mfma_f32_32x32x16_bf16(kf, qf[s], acc, 0, 0, 0); }
        sc[kt] = acc; }
    const float LOG2E = 1.4426950408889634f;
    const float c1 = 0.125f * LOG2E, c2 = exp2f(-(float)(h + 1)) * (float)dil * LOG2E;
    float mx = -INFINITY;
#pragma unroll
    for (int kt = 0; kt < 5; ++kt)
#pragma unroll
        for (int rr = 0; rr < 16; ++rr) { const int kk = (rr & 3) + 8 * (rr >> 2) + 4 * kh; const int dist = 128 + ql - 32 * kt - kk; const int kidx = base - 128 + 32 * (wave + kt) + kk;
            const bool valid = (dist >= 0) && (dist <= 128) && (kidx >= 0);
            const float v = valid ? sc[kt][rr] * c1 - c2 * (float)dist : -INFINITY; sc[kt][rr] = v; mx = fmaxf(mx, v); }
    mx = fmaxf(mx, __shfl_xor(mx, 32));
    float lsum = 0.f;
#pragma unroll
    for (int kt = 0; kt < 5; ++kt)
#pragma unroll
        for (int rr = 0; rr < 16; ++rr) { const float pv = __builtin_amdgcn_exp2f(sc[kt][rr] - mx); sc[kt][rr] = pv; lsum += pv; }
    lsum += __shfl_xor(lsum, 32);
    f32x16 o[2]; o[0] = (f32x16){}; o[1] = (f32x16){};
    const int q4 = (lane & 15) >> 2, pp = lane & 3, blk = (lane >> 4) & 1;
    const LAS unsigned char* Vb = L8 + KV_BYTES + (4 * kh + q4) * KVP + (16 * blk + 4 * pp) * 2;
#pragma unroll
    for (int kt = 0; kt < 5; ++kt)
#pragma unroll
        for (int s2 = 0; s2 < 2; ++s2) {
            v4u pw; pw.x = cvtpk(sc[kt][8 * s2 + 0], sc[kt][8 * s2 + 1]); pw.y = cvtpk(sc[kt][8 * s2 + 2], sc[kt][8 * s2 + 3]); pw.z = cvtpk(sc[kt][8 * s2 + 4], sc[kt][8 * s2 + 5]); pw.w = cvtpk(sc[kt][8 * s2 + 6], sc[kt][8 * s2 + 7]);
            const bf16x8 pb = __builtin_bit_cast(bf16x8, pw);
            const LAS unsigned char* vr = Vb + (32 * (wave + kt) + 16 * s2) * KVP;
#pragma unroll
            for (int c = 0; c < 2; ++c) { const s16x4 lo = vtr(vr + c * 64), hi = vtr(vr + 8 * KVP + c * 64);
                const bf16x8 va = (bf16x8){lo[0], lo[1], lo[2], lo[3], hi[0], hi[1], hi[2], hi[3]};
                o[c] = __builtin_amdgcn_mfma_f32_32x32x16_bf16(va, pb, o[c], 0, 0, 0); }
        }
    const float inv = 1.0f / lsum;
    bf16* dst = PROJ + tokq * NIN + 1536 + p * 512 + h * 64 + 4 * kh;
#pragma unroll
    for (int c = 0; c < 2; ++c)
#pragma unroll
        for (int g = 0; g < 4; ++g) { v2u w; w.x = cvtpk(o[c][4 * g + 0] * inv, o[c][4 * g + 1] * inv); w.y = cvtpk(o[c][4 * g + 2] * inv, o[c][4 * g + 3] * inv);
            *(v2u*)(dst + 32 * c + 8 * g) = w; }
    if (kh == 0) { float* ml = ML + ((tokq * 8 + h) * 3 + p) * 2; *(f32x2*)ml = (f32x2){mx, lsum}; }
    __syncthreads();
}

#define XB_TMO      128
#define XB_XCNT(j)  (256  + 64 * (j))
#define XB_XSUB(j)  (1280 + 64 * (j))
#define XB_XGEN(j)  (2304 + 64 * (j))
#define XB_TOP      3328
#define XB_TOPGEN   3392
#define XCD_BAR_WORDS 3456
#define XB_SPIN_CAP (1u << 18)

__device__ __forceinline__ unsigned xb_ld(unsigned* p)              { return __hip_atomic_load(p, __ATOMIC_RELAXED, __HIP_MEMORY_SCOPE_AGENT); }
__device__ __forceinline__ unsigned xb_add(unsigned* p, unsigned v) { return __hip_atomic_fetch_add(p, v, __ATOMIC_RELAXED, __HIP_MEMORY_SCOPE_AGENT); }
__device__ __forceinline__ unsigned xb_xcc_id() { return (unsigned)__builtin_amdgcn_s_getreg((3 << 11) | 20) & 0xFu; }
#define XB_SPIN(cond, bar) do { unsigned _sp = 0; while (cond) { __builtin_amdgcn_s_sleep(1); \
    if ((++_sp & 255u) == 0u) { if (xb_ld(&(bar)[XB_TMO])) break; if (_sp > XB_SPIN_CAP) { atomicAdd(&(bar)[XB_TMO], 1u); break; } } } } while (0)

struct XcdBarrier {
    unsigned* bar; unsigned x;
    volatile LAS unsigned* st;
};

__device__ __forceinline__ XcdBarrier xcd_barrier_post(unsigned* bar, volatile LAS unsigned* st) {
    XcdBarrier b; b.bar = bar; b.x = xb_xcc_id(); b.st = st;
    if (threadIdx.x == 0) (void)xb_add(&bar[XB_XCNT(b.x)], 1u);
    return b;
}
__device__ __forceinline__ void xcd_barrier_complete(unsigned* bar, unsigned x, unsigned& nloc, unsigned& nx) {
    const unsigned G = gridDim.x * gridDim.y * gridDim.z;
    unsigned sum, cnt, mine, sp = 0u;
    for (;;) {
        sum = 0u; cnt = 0u; mine = 0u;
#pragma unroll
        for (unsigned j = 0; j < 16; ++j) { const unsigned c = xb_ld(&bar[XB_XCNT(j)]); sum += c; cnt += (c > 0u) ? 1u : 0u; mine = (j == x) ? c : mine; }
        if (sum == G) break;
        __builtin_amdgcn_s_sleep(1);
        if ((++sp & 255u) == 0u) { if (xb_ld(&bar[XB_TMO])) break; if (sp > XB_SPIN_CAP) { atomicAdd(&bar[XB_TMO], 1u); break; } }
    }
    nloc = mine > 0u ? mine : 1u; nx = cnt > 0u ? cnt : 1u;
}

__device__ __forceinline__ void xcd_barrier(const XcdBarrier& b) {
    asm volatile("s_waitcnt vmcnt(0)" ::: "memory");
    __syncthreads();
    if (threadIdx.x == 0) {
        unsigned* bar = b.bar;
        __builtin_amdgcn_s_waitcnt(0);
        unsigned nloc = b.st[0], nx = b.st[1];
        if (nloc == 0u) { xcd_barrier_complete(bar, b.x, nloc, nx); b.st[0] = nloc; b.st[1] = nx; }
        const unsigned old = xb_add(&bar[XB_XSUB(b.x)], 1u);
        const unsigned gen = old / nloc;
        if (old + 1u == (gen + 1u) * nloc) {
            __builtin_amdgcn_fence(__ATOMIC_RELEASE, "agent");
            asm volatile("s_waitcnt vmcnt(0)" ::: "memory");
            const unsigned og = xb_add(&bar[XB_TOP], 1u);
            const unsigned tg = og / nx;
            if (og + 1u == (tg + 1u) * nx) xb_add(&bar[XB_TOPGEN], 1u);
            else XB_SPIN(xb_ld(&bar[XB_TOPGEN]) == tg, bar);
            __builtin_amdgcn_fence(__ATOMIC_ACQUIRE, "agent");
            xb_add(&bar[XB_XGEN(b.x)], 1u);
            asm volatile("s_waitcnt vmcnt(0)" ::: "memory");
        } else {
            XB_SPIN(xb_ld(&bar[XB_XGEN(b.x)]) == gen, bar);
            __builtin_amdgcn_fence(__ATOMIC_ACQUIRE, "agent");
            asm volatile("s_waitcnt vmcnt(0)" ::: "memory");
        }
    }
    __syncthreads();
}

__global__ void __launch_bounds__(NWAVES * 64, 2) fwd_megakernel(Args a) {
    extern __shared__ __attribute__((aligned(16))) unsigned char lds[];
    cg::grid_group grid = cg::this_grid();
    LAS unsigned char* L8 = (LAS unsigned char*)lds;
    LAS float* L = (LAS float*)lds;
    const int tid = threadIdx.x, lane = tid & 63, wave = __builtin_amdgcn_readfirstlane(tid >> 6);
    const int G = gridDim.x, gw = blockIdx.x * NWAVES + wave, NGW = G * NWAVES;
    unsigned char* ws = a.ws;
    unsigned* ctl = (unsigned*)(ws + WS_CTL);
    const float* x = a.in[0];
    bf16* XN = (bf16*)(ws + WS_XN); bf16* ACT = (bf16*)(ws + WS_ACT); bf16* PROJ = ACT; bf16* MIX = XN;
    bf16* Wgu1 = (bf16*)(ws + WS_WGU1); bf16* Wd1 = (bf16*)(ws + WS_WD1); bf16* Win = (bf16*)(ws + WS_WIN); bf16* Wout = (bf16*)(ws + WS_WOUT);
    bf16* Wgu2 = (bf16*)(ws + WS_WGU2); bf16* Wd2 = (bf16*)(ws + WS_WD2);
    float* out = a.out;
    volatile LAS unsigned* xbst = (volatile LAS unsigned*)(L8 + LDS_BYTES - 64);
    if (tid < 2) xbst[tid] = 0u;
    __syncthreads();
    XcdBarrier bar = xcd_barrier_post(ctl + 1024, xbst);
#define GSYNC() xcd_barrier(bar)

    {
        const int lane = opq(tid) & 63;
        LAS float* scr = L + wave * 4096;
        constexpr int I_GU = (D / 64) * (NGU / 32), I_D = (FF / 64) * (D / 32), I_IN = (D / 64) * (NIN / 32), I_O = (D / 64) * (D / 32);
        constexpr int NITEMS = 2 * I_GU + 2 * I_D + I_IN + I_O;
        for (int it = gw; it < NITEMS; it += NGW) {
            int r = it;
            if (r < I_GU) { tr_gu(a.in[2], a.in[3], Wgu1, r, scr, lane); continue; } r -= I_GU;
            if (r < I_D) { tr_plain(a.in[4], FF, D, Wd1, r, scr, lane); continue; } r -= I_D;
            if (r < I_IN) { tr_win(a.in[6], Win, r, scr, lane); continue; } r -= I_IN;
            if (r < I_O) { tr_plain(a.in[11], D, D, Wout, r, scr, lane); continue; } r -= I_O;
            if (r < I_GU) { tr_gu(a.in[13], a.in[14], Wgu2, r, scr, lane); continue; } r -= I_GU;
            tr_plain(a.in[15], FF, D, Wd2, r, scr, lane);
        }
        for (int m = gw; m < M; m += NGW) { f32x4 v[4]; rms_row(x + (size_t)m * D, a.in[1], lane, v); store_row_bf16(XN + (size_t)m * D, lane, v); }
    }
    grid.sync();
    {
        pg8::Gemm g{XN, Wgu1, M, NGU, D}; pg8::StaticOrder S; S.init(M, NGU, G, (int)blockIdx.x);
        pg8::EpiSwiGLU E{ACT, FF};
        pg8::gemm_phase<pg8::EpiSwiGLU, pg8::StaticOrder, true, true>(L8, g, S, E);
    }
    GSYNC();
    {
        pg8::Gemm g{ACT, Wd1, M, D, FF}; pg8::StaticOrder S; S.init(M, D, G, (int)blockIdx.x);
        pg8::EpiRes E{x, out, D, 0.5f};
        pg8::gemm_phase<pg8::EpiRes, pg8::StaticOrder, true, true>(L8, g, S, E);
    }
    GSYNC();
    {
        const int lane = opq(tid) & 63;
        const float* w_in = a.in[6]; float* BD = (float*)(ws + WS_BD);
        for (int m = gw; m < M; m += NGW) {
            f32x4 v[4]; rms_row(out + (size_t)m * D, a.in[5], lane, v); store_row_bf16(XN + (size_t)m * D, lane, v);
            float acc[8];
#pragma unroll
            for (int o = 0; o < 8; ++o) acc[o] = 0.f;
#pragma unroll
            for (int j = 0; j < 4; ++j)
#pragma unroll
                for (int i = 0; i < 4; ++i) { const int k = 4 * (lane + 64 * j) + i; const f32x4 w0 = *(const f32x4*)(w_in + (size_t)k * WIN_COLS + 3072), w1 = *(const f32x4*)(w_in + (size_t)k * WIN_COLS + 3076);
                    const float hv = v[j][i];
                    acc[0] += hv * w0.x; acc[1] += hv * w0.y; acc[2] += hv * w0.z; acc[3] += hv * w0.w; acc[4] += hv * w1.x; acc[5] += hv * w1.y; acc[6] += hv * w1.z; acc[7] += hv * w1.w; }
#pragma unroll
            for (int o = 0; o < 8; ++o) acc[o] = wave_sum(acc[o]);
            if (lane == 0) { *(f32x4*)(BD + (size_t)m * 8) = (f32x4){acc[0], acc[1], acc[2], acc[3]}; *(f32x4*)(BD + (size_t)m * 8 + 4) = (f32x4){acc[4], acc[5], acc[6], acc[7]}; }
        }
    }
    GSYNC();
    {
        pg8::Gemm g{XN, Win, M, NIN, D}; pg8::StaticOrder S; S.init(M, NIN, G, (int)blockIdx.x);
        pg8::EpiStoreBf16 E{PROJ, NIN};
        pg8::gemm_phase<pg8::EpiStoreBf16, pg8::StaticOrder, true, true>(L8, g, S, E);
    }
    GSYNC();
    { const int tid_ = opq(tid); for (int ch = blockIdx.x; ch < 1024; ch += G) dn_prep_item(a, L8, ch, tid_, tid_ & 63, wave); }
    GSYNC();
    {
        const int tid_ = opq(tid), lane = tid_ & 63;
        for (int it = blockIdx.x; it < 16; it += G) dn_scan_mfma(a, L8, it, tid_, lane, wave);
        LAS unsigned* bc = (LAS unsigned*)(L8 + 2 * KV_BYTES);
        float* ML = (float*)(ws + WS_ML);
        for (;;) {
            if (tid == 0) bc[0] = atomicAdd(ctl + 64, 1u);
            __syncthreads();
            const unsigned item = bc[0];
            __syncthreads();
            if (item >= 1536u) break;
            attn_item(PROJ, ML, L8, (int)item, tid, lane, wave);
        }
    }
    GSYNC();
    {
        const int lane = opq(tid) & 63;
        const float* dn_norm = a.in[10];
        for (int m = gw; m < M; m += NGW) {
            bf16* op = MIX + (size_t)m * 1024 + 512 + 8 * lane; const bf16* gp = PROJ + (size_t)m * NIN + 3072 + 8 * lane;
            const v4u ow = *(const v4u*)op, gwv = *(const v4u*)gp;
            float o[8] = {bflo(ow.x), bfhi(ow.x), bflo(ow.y), bfhi(ow.y), bflo(ow.z), bfhi(ow.z), bflo(ow.w), bfhi(ow.w)};
            float gt[8] = {bflo(gwv.x), bfhi(gwv.x), bflo(gwv.y), bfhi(gwv.y), bflo(gwv.z), bfhi(gwv.z), bflo(gwv.w), bfhi(gwv.w)};
            float ss = 0.f;
#pragma unroll
            for (int i = 0; i < 8; ++i) ss += o[i] * o[i];
            ss += __shfl_xor(ss, 1); ss += __shfl_xor(ss, 2); ss += __shfl_xor(ss, 4); ss += __shfl_xor(ss, 8);
            const float rs = 1.0f / sqrtf(ss * (1.f / 128.f) + 1e-6f);
            const int d0 = (8 * lane) & 127;
            float r[8];
#pragma unroll
            for (int i = 0; i < 8; ++i) r[i] = o[i] * rs * dn_norm[d0 + i] * (gt[i] / (1.f + __expf(-gt[i])));
            v4u w; w.x = pk2(r[0], r[1]); w.y = pk2(r[2], r[3]); w.z = pk2(r[4], r[5]); w.w = pk2(r[6], r[7]);
            *(v4u*)op = w;
            {
                const int ha = lane >> 3;
                const float* ml = (const float*)(ws + WS_ML) + ((size_t)m * 8 + ha) * 6;
                const f32x2 a0 = *(const f32x2*)ml, a1 = *(const f32x2*)(ml + 2), a2 = *(const f32x2*)(ml + 4);
                const float mm = fmaxf(a0.x, fmaxf(a1.x, a2.x));
                const float w0 = a0.y * __builtin_amdgcn_exp2f(a0.x - mm), w1 = a1.y * __builtin_amdgcn_exp2f(a1.x - mm), w2 = a2.y * __builtin_amdgcn_exp2f(a2.x - mm);
                const float iw = 1.0f / (w0 + w1 + w2);
                const bf16* pp = PROJ + (size_t)m * NIN + 1536 + 8 * lane;
                const v4u p0 = *(const v4u*)pp, p1 = *(const v4u*)(pp + 512), p2 = *(const v4u*)(pp + 1024);
                float rr[8];
                rr[0] = w0 * bflo(p0.x) + w1 * bflo(p1.x) + w2 * bflo(p2.x); rr[1] = w0 * bfhi(p0.x) + w1 * bfhi(p1.x) + w2 * bfhi(p2.x);
                rr[2] = w0 * bflo(p0.y) + w1 * bflo(p1.y) + w2 * bflo(p2.y); rr[3] = w0 * bfhi(p0.y) + w1 * bfhi(p1.y) + w2 * bfhi(p2.y);
                rr[4] = w0 * bflo(p0.z) + w1 * bflo(p1.z) + w2 * bflo(p2.z); rr[5] = w0 * bfhi(p0.z) + w1 * bfhi(p1.z) + w2 * bfhi(p2.z);
                rr[6] = w0 * bflo(p0.w) + w1 * bflo(p1.w) + w2 * bflo(p2.w); rr[7] = w0 * bfhi(p0.w) + w1 * bfhi(p1.w) + w2 * bfhi(p2.w);
                v4u wa; wa.x = pk2(rr[0] * iw, rr[1] * iw); wa.y = pk2(rr[2] * iw, rr[3] * iw); wa.z = pk2(rr[4] * iw, rr[5] * iw); wa.w = pk2(rr[6] * iw, rr[7] * iw);
                *(v4u*)(MIX + (size_t)m * 1024 + 8 * lane) = wa;
            }
        }
    }
    GSYNC();
    {
        pg8::Gemm g{MIX, Wout, M, D, D}; pg8::StaticOrder S; S.init(M, D, G, (int)blockIdx.x);
        pg8::EpiRes E{out, out, D, 1.0f};
        pg8::gemm_phase<pg8::EpiRes, pg8::StaticOrder, true, true>(L8, g, S, E);
    }
    GSYNC();
    { const int ln = opq(tid) & 63; for (int m = gw; m < M; m += NGW) { f32x4 v[4]; rms_row(out + (size_t)m * D, a.in[12], ln, v); store_row_bf16(XN + (size_t)m * D, ln, v); } }
    GSYNC();
    {
        pg8::Gemm g{XN, Wgu2, M, NGU, D}; pg8::StaticOrder S; S.init(M, NGU, G, (int)blockIdx.x);
        pg8::EpiSwiGLU E{ACT, FF};
        pg8::gemm_phase<pg8::EpiSwiGLU, pg8::StaticOrder, true, true>(L8, g, S, E);
    }
    GSYNC();
    {
        pg8::Gemm g{ACT, Wd2, M, D, FF}; pg8::StaticOrder S; S.init(M, D, G, (int)blockIdx.x);
        pg8::EpiRes E{out, out, D, 0.5f};
        pg8::gemm_phase<pg8::EpiRes, pg8::StaticOrder, true, true>(L8, g, S, E);
    }
    GSYNC();
    const int lnf = opq(tid) & 63;
    for (int m = gw; m < M; m += NGW) {
        f32x4 v[4]; rms_row(out + (size_t)m * D, a.in[16], lnf, v);
        f32x4* o = (f32x4*)(out + (size_t)m * D) + lnf;
#pragma unroll
        for (int j = 0; j < 4; ++j) o[64 * j] = v[j];
    }
}

extern "C" void kernel_launch(void* const* d_in, const int* in_sizes, int n_in, void* d_out, int out_size, void* d_ws, size_t ws_size, hipStream_t stream) {
    static int grid = 0;
    if (grid == 0) {
        if (n_in != 17 || in_sizes[0] != M * D || out_size != M * D || ws_size < WS_END) { fprintf(stderr, "kernel_launch: unexpected shapes (n_in %d in0 %d out %d ws %zu)\n", n_in, n_in > 0 ? in_sizes[0] : -1, out_size, ws_size); grid = -1; return; }
        int dev = 0, cus = 0, per_cu = 0;
        hipGetDevice(&dev); hipDeviceGetAttribute(&cus, hipDeviceAttributeMultiprocessorCount, dev);
        if (hipFuncSetAttribute((const void*)fwd_megakernel, hipFuncAttributeMaxDynamicSharedMemorySize, LDS_BYTES) != hipSuccess) { fprintf(stderr, "kernel_launch: hipFuncSetAttribute failed\n"); grid = -1; return; }
        if (hipOccupancyMaxActiveBlocksPerMultiprocessor(&per_cu, (const void*)fwd_megakernel, NWAVES * 64, LDS_BYTES) != hipSuccess || per_cu < 1) { fprintf(stderr, "kernel_launch: occupancy query says %d blocks/CU\n", per_cu); (void)hipGetLastError(); per_cu = 1; }
        grid = cus * 1;
        fprintf(stderr, "kernel_launch: cus %d per_cu %d grid %d\n", cus, per_cu, grid);
    }
    if (grid < 0) return;
    hipMemsetAsync((char*)d_ws + WS_CTL, 0, CTL_BYTES, stream);
    Args a{};
    for (int i = 0; i < 17; ++i) a.in[i] = (const float*)d_in[i];
    a.out = (float*)d_out; a.ws = (unsigned char*)d_ws;
    void* args[] = {&a};
    hipError_t e = hipLaunchCooperativeKernel((const void*)fwd_megakernel, dim3(grid), dim3(NWAVES * 64), args, LDS_BYTES, stream);
    if (e != hipSuccess) fprintf(stderr, "cooperative launch failed: %s (grid %d)\n", hipGetErrorString(e), grid);
}
```

```cpp
#include <hip/hip_runtime.h>
#include <hip/hip_cooperative_groups.h>
#include <cstdio>
#include <cstdint>
namespace cg = cooperative_groups;
namespace pg8 {
#define PG8_LAS __attribute__((address_space(3)))
typedef unsigned short bf16_t;
typedef short bf16x8 __attribute__((ext_vector_type(8)));
typedef float f32x4 __attribute__((ext_vector_type(4)));
typedef unsigned u32x4 __attribute__((ext_vector_type(4)));
constexpr int BM = 256, BK = 64, HALF = 128, HTB = HALF * BK * 2  , STAGE_BYTES = 8 * HTB, NXCD = 8, WGM = 8;

__host__ __device__ __forceinline__ int lds_byte(int r, int c) { const int st = (r >> 4) * 2 + (c >> 5), rr = r & 15, cc = c & 31, ob = rr * 64 + cc * 2; return st * 1024 + (ob ^ (((ob >> 9) & 1) << 5)); }
__host__ __device__ __forceinline__ void stage_rc(int b, int& R, int& C) { const int st = b / 1024, sb = b % 1024, swz = sb ^ (((sb >> 9) & 1) << 5); R = (st >> 1) * 16 + swz / 64; C = (st & 1) * 32 + (swz % 64) / 2; }
__host__ __device__ __forceinline__ int perm32(int rho) { const int n = rho >> 4, i = rho & 15; return 8 * (i >> 2) + 4 * n + (i & 3); }

struct Unit { int pm, pn; };
struct Gemm { const bf16_t* A; const bf16_t* Bt; int M, N, K; };

struct StaticOrder {
    int nM, nN, nwg, G, c;
    __host__ __device__ void init(int M, int N, int G_, int c_) { nM = M / BM; nN = N / BM; nwg = nM * nN; G = G_; c = c_; }
    __host__ __device__ bool next(int i, Unit& u) const {
        const long L = (long)i * G + c; if (L >= nwg) return false;
        int wgid = (int)L; { const int q = nwg / NXCD, r = nwg % NXCD, xcd = wgid % NXCD, off = wgid / NXCD; wgid = (xcd < r ? xcd * (q + 1) : r * (q + 1) + (xcd - r) * q) + off; }
        const int nig = WGM * nN, gid = wgid / nig, fm = gid * WGM, gsz = (nM - fm) < WGM ? (nM - fm) : WGM;
        u.pm = fm + ((wgid % nig) % gsz); u.pn = (wgid % nig) / gsz; return true;
    }
    __device__ __forceinline__ void a_ready(const Unit&) const {}
    __device__ __forceinline__ void done(const Unit&) const {}
};

__device__ __forceinline__ unsigned cvt_pk_bf16(float lo, float hi) { unsigned r; asm volatile("v_cvt_pk_bf16_f32 %0, %1, %2" : "=v"(r) : "v"(lo), "v"(hi)); return r; }
__device__ __forceinline__ float silu_f(float g) { return g * __builtin_amdgcn_rcpf(1.0f + __expf(-g)); }
struct EpiSwiGLU {
    static constexpr bool PERM = true, AFTER_DRAIN = false;
    bf16_t* O; int ldc;
    __device__ __forceinline__ void operator()(const f32x4 (&acc)[2][2][4][2], const Unit& u, int wr, int wc, int fr, int fq) const {
        const int row0 = u.pm * BM + wr * 64 + fr; const int col0 = u.pn * 128 + wc * 32 + 8 * fq;
#pragma unroll
        for (int ai = 0; ai < 2; ++ai)
#pragma unroll
            for (int m = 0; m < 4; ++m) { bf16_t* rowp = O + (size_t)(row0 + ai * HALF + m * 16) * ldc + col0;
                const f32x4 g0 = acc[ai][0][m][0], g1 = acc[ai][0][m][1], u0 = acc[ai][1][m][0], u1 = acc[ai][1][m][1];
                u32x4 w;
                w.x = cvt_pk_bf16(silu_f(g0[0]) * u0[0], silu_f(g0[1]) * u0[1]); w.y = cvt_pk_bf16(silu_f(g0[2]) * u0[2], silu_f(g0[3]) * u0[3]);
                w.z = cvt_pk_bf16(silu_f(g1[0]) * u1[0], silu_f(g1[1]) * u1[1]); w.w = cvt_pk_bf16(silu_f(g1[2]) * u1[2], silu_f(g1[3]) * u1[3]);
                *(u32x4*)rowp = w; }
    }
};
struct EpiRes {
    static constexpr bool PERM = false, AFTER_DRAIN = false;
    const float* base; float* out; int ldc; float scale;
    __device__ __forceinline__ void operator()(const f32x4 (&acc)[2][2][4][2], const Unit& u, int wr, int wc, int fr, int fq) const {
        const int row0 = u.pm * BM + wr * 64 + fr; const int col0 = u.pn * BM + wc * 32 + 4 * fq;
#pragma unroll
        for (int ai = 0; ai < 2; ++ai)
#pragma unroll
            for (int m = 0; m < 4; ++m) { const size_t off = (size_t)(row0 + ai * HALF + m * 16) * ldc + col0;
#pragma unroll
                for (int bj = 0; bj < 2; ++bj)
#pragma unroll
                    for (int n = 0; n < 2; ++n) { const f32x4 b = *(const f32x4*)(base + off + bj * HALF + n * 16); *(f32x4*)(out + off + bj * HALF + n * 16) = b + acc[ai][bj][m][n] * scale; }
                asm volatile("" ::: "memory"); }
    }
};
struct EpiProj {
    static constexpr bool PERM = true, AFTER_DRAIN = false;
    bf16_t* Qh; bf16_t* KVh; bf16_t* P2;
    __device__ __forceinline__ void operator()(const f32x4 (&acc)[2][2][4][2], const Unit& u, int wr, int wc, int fr, int fq) const {
        const int row0 = u.pm * BM + wr * 64 + fr;
#pragma unroll
        for (int ai = 0; ai < 2; ++ai)
#pragma unroll
            for (int m = 0; m < 4; ++m) { const int row = row0 + ai * HALF + m * 16, bb = row >> 12, t = row & 4095;
#pragma unroll
                for (int bj = 0; bj < 2; ++bj) { const int col = u.pn * BM + bj * HALF + wc * 32 + 8 * fq;
                    bf16_t* dst;
                    if (u.pn < 6) { const int sec = col >> 9, hc = col & 511, hh = hc >> 6, d = hc & 63; const size_t rt = (size_t)(bb * 8 + hh) * 4096 + t;
                        dst = (sec == 0) ? Qh + rt * 64 + d : KVh + rt * 128 + (sec - 1) * 64 + d; }
                    else dst = P2 + (size_t)row * 2048 + (col - 1536);
                    const f32x4 v0 = acc[ai][bj][m][0], v1 = acc[ai][bj][m][1]; u32x4 w;
                    w.x = cvt_pk_bf16(v0[0], v0[1]); w.y = cvt_pk_bf16(v0[2], v0[3]); w.z = cvt_pk_bf16(v1[0], v1[1]); w.w = cvt_pk_bf16(v1[2], v1[3]);
                    *(u32x4*)dst = w; } }
    }
};
struct EpiStoreBf16 {
    static constexpr bool PERM = true, AFTER_DRAIN = false;
    bf16_t* O; int ldc;
    __device__ __forceinline__ void operator()(const f32x4 (&acc)[2][2][4][2], const Unit& u, int wr, int wc, int fr, int fq) const {
        const int row0 = u.pm * BM + wr * 64 + fr; const int col0 = u.pn * BM + wc * 32 + 8 * fq;
#pragma unroll
        for (int ai = 0; ai < 2; ++ai)
#pragma unroll
            for (int m = 0; m < 4; ++m) { bf16_t* rowp = O + (size_t)(row0 + ai * HALF + m * 16) * ldc + col0;
#pragma unroll
                for (int bj = 0; bj < 2; ++bj) { const f32x4 v0 = acc[ai][bj][m][0], v1 = acc[ai][bj][m][1]; u32x4 w;
                    w.x = cvt_pk_bf16(v0[0], v0[1]); w.y = cvt_pk_bf16(v0[2], v0[3]); w.z = cvt_pk_bf16(v1[0], v1[1]); w.w = cvt_pk_bf16(v1[2], v1[3]);
                    *(u32x4*)(rowp + bj * HALF) = w; } }
    }
};
template <class Epi, class Sched, bool ALIGN_EPI = false, bool SP2 = false>
__device__ __forceinline__ void gemm_phase(PG8_LAS unsigned char* lds, const Gemm g, const Sched& S, const Epi& E) {
    const int tid = threadIdx.x, wid = __builtin_amdgcn_readfirstlane(tid >> 6), lane = tid & 63, wr = wid >> 2, wc = wid & 3, fr = lane & 15, fq = lane >> 4;
    const int K = g.K, nt = K / BK;
    unsigned voffA[2], voffB[2];
#pragma unroll
    for (int i = 0; i < 2; ++i) { int R, C; stage_rc(tid * 16 + i * 8192, R, C); const int Rb = Epi::PERM ? ((R & ~31) + perm32(R & 31)) : R;
        voffA[i] = (unsigned)(R * K + C) * 2u; voffB[i] = (unsigned)(Rb * K + C) * 2u; }
    const size_t kstep = (size_t)(BK * 2);
    const size_t hstep = (size_t)HALF * K * 2;
    const size_t tstep = 2 * hstep;
    const unsigned ldsw = (unsigned)wid * 1024u;
    const int aoff = lds_byte(wr * 64 + fr, fq * 8), boff = lds_byte(wc * 32 + fr, fq * 8);
#define PG8_SA(b, h) (((b) * 2 + (h)) * HTB)
#define PG8_SB(b, h) ((4 + (b) * 2 + (h)) * HTB)
#define PG8_STAGE(bufoff, gbase, voff) do { _Pragma("unroll") for (int _i = 0; _i < 2; ++_i) \
        __builtin_amdgcn_global_load_lds((const unsigned*)((const char*)(gbase) + (voff)[_i]), (PG8_LAS unsigned*)(lds + (bufoff) + ldsw + _i * 8192), 16, 0, 0); } while (0)
#define PG8_LDA(dst, b, h) do { _Pragma("unroll") for (int m = 0; m < 4; ++m) _Pragma("unroll") for (int k = 0; k < 2; ++k) dst[m][k] = *(const PG8_LAS bf16x8*)(lds + PG8_SA(b, h) + aoff + m * 2048 + k * 1024); } while (0)
#define PG8_LDB(dst, b, h) do { _Pragma("unroll") for (int n = 0; n < 2; ++n) _Pragma("unroll") for (int k = 0; k < 2; ++k) dst[n][k] = *(const PG8_LAS bf16x8*)(lds + PG8_SB(b, h) + boff + n * 2048 + k * 1024); } while (0)
#define PG8_MMA(ai, bj, At, Bt) do { __builtin_amdgcn_s_setprio(1); _Pragma("unroll") for (int m = 0; m < 4; ++m) _Pragma("unroll") for (int n = 0; n < 2; ++n) _Pragma("unroll") for (int k = 0; k < 2; ++k) \
        acc[ai][bj][m][n] = __builtin_amdgcn_mfma_f32_16x16x32_bf16(Bt[n][k], At[m][k], acc[ai][bj][m][n], 0, 0, 0); __builtin_amdgcn_s_setprio(0); } while (0)
#define PG8_WAIT_V(n) asm volatile("s_waitcnt vmcnt(" #n ")" ::: "memory")
#define PG8_WAIT_L(n) asm volatile("s_waitcnt lgkmcnt(" #n ")" ::: "memory")
#define PG8_BAR __builtin_amdgcn_s_barrier()
#define PG8_SCHED __builtin_amdgcn_sched_barrier(0)
    Unit cur, nxt; int ui = 0;
    if (!S.next(0, cur)) return;
    f32x4 acc[2][2][4][2];
#pragma unroll
    for (int a = 0; a < 2; ++a)
#pragma unroll
        for (int b = 0; b < 2; ++b)
#pragma unroll
            for (int m = 0; m < 4; ++m)
#pragma unroll
                for (int n = 0; n < 2; ++n) acc[a][b][m][n] = (f32x4){0.f, 0.f, 0.f, 0.f};
    bf16x8 At[4][2], B0[2][2], B1[2][2];
    const char* cA = (const char*)g.A + (size_t)cur.pm * tstep; const char* cB = (const char*)g.Bt + (size_t)cur.pn * tstep;
    S.a_ready(cur);
    if constexpr (SP2) {
        PG8_STAGE(PG8_SB(0, 0), cB, voffB); PG8_STAGE(PG8_SB(0, 1), cB + hstep, voffB); PG8_STAGE(PG8_SA(0, 0), cA, voffA); PG8_STAGE(PG8_SA(0, 1), cA + hstep, voffA);
        if (wr == 1) PG8_BAR;
        PG8_WAIT_V(2); PG8_BAR;
        PG8_STAGE(PG8_SB(1, 0), cB + kstep, voffB); PG8_STAGE(PG8_SA(1, 0), cA + kstep, voffA); PG8_STAGE(PG8_SB(1, 1), cB + hstep + kstep, voffB);
        PG8_WAIT_V(6); PG8_BAR;
    } else {
        PG8_STAGE(PG8_SB(0, 0), cB, voffB); PG8_STAGE(PG8_SA(0, 0), cA, voffA); PG8_STAGE(PG8_SB(0, 1), cB + hstep, voffB); PG8_STAGE(PG8_SA(0, 1), cA + hstep, voffA);
        if (wr == 1) PG8_BAR;
        PG8_WAIT_V(4); PG8_BAR;
        PG8_STAGE(PG8_SB(1, 0), cB + kstep, voffB); PG8_STAGE(PG8_SA(1, 0), cA + kstep, voffA); PG8_STAGE(PG8_SB(1, 1), cB + hstep + kstep, voffB);
        PG8_WAIT_V(6); PG8_BAR;
    }
    for (;;) {
        const bool has_next = S.next(ui + 1, nxt);
        const char* nA = has_next ? (const char*)g.A + (size_t)nxt.pm * tstep : cA; const char* nB = has_next ? (const char*)g.Bt + (size_t)nxt.pn * tstep : cB;
        for (int t = 0; t < nt; t += 2) {
            const bool last = (t == nt - 2);
            const char* a1 = cA + (size_t)(t + 1) * kstep;
            const char* a2 = last ? nA : cA + (size_t)(t + 2) * kstep; const char* b2 = last ? nB : cB + (size_t)(t + 2) * kstep;
            const char* a3 = a2 + kstep; const char* b3 = b2 + kstep;
            if (last && has_next) S.a_ready(nxt);
            if constexpr (SP2) {
            PG8_LDB(B0, 0, 0); PG8_LDB(B1, 0, 1); PG8_SCHED; PG8_LDA(At, 0, 0); PG8_STAGE(PG8_SA(1, 1), a1 + hstep, voffA);
            PG8_WAIT_V(8); PG8_WAIT_L(0); PG8_BAR; PG8_MMA(0, 0, At, B0); PG8_MMA(0, 1, At, B1); PG8_BAR; PG8_SCHED;
            PG8_LDA(At, 0, 1); PG8_STAGE(PG8_SB(0, 0), b2, voffB); PG8_STAGE(PG8_SB(0, 1), b2 + hstep, voffB); PG8_STAGE(PG8_SA(0, 0), a2, voffA);
            PG8_WAIT_V(8); PG8_WAIT_L(0); PG8_BAR; PG8_MMA(1, 0, At, B0); PG8_MMA(1, 1, At, B1); PG8_BAR; PG8_SCHED;
            PG8_LDB(B0, 1, 0); PG8_LDB(B1, 1, 1); PG8_SCHED; PG8_LDA(At, 1, 0); PG8_STAGE(PG8_SA(0, 1), a2 + hstep, voffA);
            PG8_WAIT_V(8); PG8_WAIT_L(0); PG8_BAR; PG8_MMA(0, 0, At, B0); PG8_MMA(0, 1, At, B1); PG8_BAR; PG8_SCHED;
            PG8_LDA(At, 1, 1); PG8_STAGE(PG8_SB(1, 0), b3, voffB); PG8_STAGE(PG8_SB(1, 1), b3 + hstep, voffB); PG8_STAGE(PG8_SA(1, 0), a3, voffA);
            PG8_WAIT_V(8); PG8_WAIT_L(0); PG8_BAR; PG8_MMA(1, 0, At, B0); PG8_MMA(1, 1, At, B1); PG8_BAR; PG8_SCHED;
            } else {
            PG8_LDB(B0, 0, 0); PG8_SCHED; PG8_LDA(At, 0, 0); PG8_STAGE(PG8_SA(1, 1), a1 + hstep, voffA);
            PG8_WAIT_L(8); PG8_BAR; PG8_WAIT_L(0); PG8_MMA(0, 0, At, B0); PG8_BAR; PG8_SCHED;
            PG8_LDB(B1, 0, 1); PG8_STAGE(PG8_SB(0, 0), b2, voffB);
            PG8_BAR; PG8_WAIT_L(0); PG8_MMA(0, 1, At, B1); PG8_BAR;
            PG8_LDA(At, 0, 1); PG8_STAGE(PG8_SA(0, 0), a2, voffA);
            PG8_BAR; PG8_WAIT_L(0); PG8_MMA(1, 0, At, B0); PG8_BAR; PG8_SCHED;
            PG8_STAGE(PG8_SB(0, 1), b2 + hstep, voffB);
            PG8_WAIT_V(6); PG8_BAR; PG8_MMA(1, 1, At, B1); PG8_BAR;
            PG8_LDB(B0, 1, 0); PG8_SCHED; PG8_LDA(At, 1, 0); PG8_STAGE(PG8_SA(0, 1), a2 + hstep, voffA);
            PG8_WAIT_L(8); PG8_BAR; PG8_WAIT_L(0); PG8_MMA(0, 0, At, B0); PG8_BAR; PG8_SCHED;
            PG8_LDB(B1, 1, 1); PG8_STAGE(PG8_SB(1, 0), b3, voffB);
            PG8_BAR; PG8_WAIT_L(0); PG8_MMA(0, 1, At, B1); PG8_BAR;
            PG8_LDA(At, 1, 1); PG8_STAGE(PG8_SA(1, 0), a3, voffA);
            PG8_BAR; PG8_WAIT_L(0); PG8_MMA(1, 0, At, B0); PG8_BAR; PG8_SCHED;
            PG8_STAGE(PG8_SB(1, 1), b3 + hstep, voffB);
            PG8_WAIT_V(6); PG8_BAR; PG8_MMA(1, 1, At, B1); PG8_BAR;
            }
        }
        if constexpr (ALIGN_EPI) { if (wr == 0) PG8_BAR; }
        if constexpr (!Epi::AFTER_DRAIN) { E(acc, cur, wr, wc, fr, fq); S.done(cur); }
        if (!has_next) break;
#pragma unroll
        for (int a = 0; a < 2; ++a)
#pragma unroll
            for (int b = 0; b < 2; ++b)
#pragma unroll
                for (int m = 0; m < 4; ++m)
#pragma unroll
                    for (int n = 0; n < 2; ++n) acc[a][b][m][n] = (f32x4){0.f, 0.f, 0.f, 0.f};
        cur = nxt; cA = nA; cB = nB; ++ui;
        if constexpr (ALIGN_EPI) { if (wr == 1) PG8_BAR; }
    }
    PG8_WAIT_V(0);
    if constexpr (!ALIGN_EPI) { if (wr == 0) PG8_BAR; }
    PG8_BAR;
    if constexpr (Epi::AFTER_DRAIN) { E.fused(acc, cur, wr, wc, fr, fq, lds, wid, lane); S.done(cur); }
#undef PG8_SA
#undef PG8_SB
#undef PG8_STAGE
#undef PG8_LDA
#undef PG8_LDB
#undef PG8_MMA
#undef PG8_WAIT_V
#undef PG8_WAIT_L
#undef PG8_BAR
#undef PG8_SCHED
}
}
constexpr int M = 16384, D = 1024, FF = 2816, NGU = 5632, NIN = 3584, SEQ = 4096;
constexpr int WIN_COLS = 3592;
constexpr size_t MiB = 1u << 20;
constexpr size_t WS_CTL = 0, CTL_BYTES = 65536;
constexpr size_t WS_WIN = 1 * MiB, WS_WOUT = 8 * MiB, WS_WGU2 = 10 * MiB, WS_WD2 = 21 * MiB;
constexpr size_t WS_XN = 27 * MiB;
constexpr size_t WS_ACT = 59 * MiB;
constexpr size_t WS_QH = 123 * MiB, WS_KVH = 139 * MiB;
constexpr int P2LD = 2048;
constexpr size_t WS_BD = 171 * MiB;
constexpr size_t WS_EG = 172 * MiB;
constexpr size_t WS_DN = 184 * MiB;
constexpr size_t WS_WGU1 = 184 * MiB, WS_WD1 = 195 * MiB;
constexpr size_t WS_QG = WS_DN, WS_KD = WS_DN + 16 * MiB, WS_U = WS_DN + 32 * MiB, WS_W = WS_DN + 48 * MiB, WS_A = WS_DN + 64 * MiB;
constexpr size_t WS_END = 256 * MiB;
constexpr int LDS_BYTES = 147456;
constexpr int NWAVES = 8;

#define GAS __attribute__((address_space(1)))
#define LAS __attribute__((address_space(3)))
typedef unsigned short bf16;
typedef unsigned v4u __attribute__((ext_vector_type(4)));
typedef unsigned v2u __attribute__((ext_vector_type(2)));
typedef float f32x4 __attribute__((ext_vector_type(4)));
typedef float f32x2 __attribute__((ext_vector_type(2)));
#define LDS_WAIT() asm volatile("s_waitcnt lgkmcnt(0)" ::: "memory")
__device__ __forceinline__ unsigned f2bf(float f) { unsigned u = __builtin_bit_cast(unsigned, f); return (u + 0x7fffu + ((u >> 16) & 1u)) >> 16; }
__device__ __forceinline__ unsigned pk2(float lo, float hi) { return f2bf(lo) | (f2bf(hi) << 16); }
__device__ __forceinline__ float bflo(unsigned u) { return __uint_as_float(u << 16); }
__device__ __forceinline__ float bfhi(unsigned u) { return __uint_as_float(u & 0xffff0000u); }
__device__ __forceinline__ float bf2f(bf16 v) { return __uint_as_float(((unsigned)v) << 16); }
__device__ __forceinline__ float wave_sum(float v) {
#pragma unroll
    for (int o = 1; o < 64; o <<= 1) v += __shfl_xor(v, o);
    return v;
}
__device__ __forceinline__ float wave_max(float v) {
#pragma unroll
    for (int o = 1; o < 64; o <<= 1) v = fmaxf(v, __shfl_xor(v, o));
    return v;
}

__device__ __forceinline__ int opq(int v) { asm volatile("" : "+v"(v)); return v; }
struct Args { const float* in[17]; float* out; unsigned char* ws; };

__device__ __forceinline__ void transpose_item(const float* src, int srcN, int srccol0, bf16* dst, int dstK, int dstrow0, int k0, LAS float* scr, int lane) {
#pragma unroll 8
    for (int i = 0; i < 32; ++i) { const int kk = 2 * i + (lane >> 5); scr[kk * 33 + (lane & 31)] = src[(size_t)(k0 + kk) * srcN + srccol0 + (lane & 31)]; }
    LDS_WAIT(); asm volatile("" ::: "memory");
    const int c = lane & 7;
#pragma unroll
    for (int j = 0; j < 4; ++j) { const int n = (lane >> 3) + 8 * j; const LAS float* s = scr + (8 * c) * 33 + n;
        v4u o; o.x = pk2(s[0 * 33], s[1 * 33]); o.y = pk2(s[2 * 33], s[3 * 33]); o.z = pk2(s[4 * 33], s[5 * 33]); o.w = pk2(s[6 * 33], s[7 * 33]);
        *(v4u*)(dst + (size_t)(dstrow0 + n) * dstK + k0 + 8 * c) = o; }
    LDS_WAIT(); asm volatile("" ::: "memory");
}
__device__ __forceinline__ void tr_gu(const float* gate, const float* up, bf16* dst, int r, LAS float* scr, int lane) {
    const int nblk = NGU / 32, kb = r / nblk, nb = r % nblk, dstrow0 = nb * 32, pn = dstrow0 >> 8, within = dstrow0 & 255;
    transpose_item(within < 128 ? gate : up, FF, pn * 128 + (within & 127), dst, D, dstrow0, kb * 64, scr, lane);
}
__device__ __forceinline__ void tr_plain(const float* src, int K, int N, bf16* dst, int r, LAS float* scr, int lane) {
    const int nblk = N / 32, kb = r / nblk, nb = r % nblk;
    transpose_item(src, N, nb * 32, dst, K, nb * 32, kb * 64, scr, lane);
}
__device__ __forceinline__ void tr_win(const float* src, bf16* dst, int r, LAS float* scr, int lane) {
    const int nblk = NIN / 32, kb = r / nblk, nb = r % nblk, dstrow0 = nb * 32;
    transpose_item(src, WIN_COLS, dstrow0 + (dstrow0 >= 3072 ? 8 : 0), dst, D, dstrow0, kb * 64, scr, lane);
}

__device__ __forceinline__ void rms_row(const float* xrow, const float* gain, int lane, f32x4 (&v)[4]) {
    const f32x4* xr = (const f32x4*)xrow + lane; const f32x4* gr = (const f32x4*)gain + lane;
    float s = 0.f;
#pragma unroll
    for (int j = 0; j < 4; ++j) { v[j] = xr[64 * j]; s += (v[j].x * v[j].x + v[j].y * v[j].y) + (v[j].z * v[j].z + v[j].w * v[j].w); }
    const float rs = 1.0f / sqrtf(wave_sum(s) * (1.f / D) + 1e-6f);
#pragma unroll
    for (int j = 0; j < 4; ++j) { const f32x4 g = gr[64 * j]; v[j] = v[j] * rs * g; }
}
__device__ __forceinline__ void store_row_bf16(bf16* orow, int lane, const f32x4 (&v)[4]) {
    v2u* o8 = (v2u*)orow + lane;
#pragma unroll
    for (int j = 0; j < 4; ++j) { v2u w; w.x = pk2(v[j].x, v[j].y); w.y = pk2(v[j].z, v[j].w); o8[64 * j] = w; }
}

__device__ __forceinline__ int kperm(int x) { return 8 * ((x & 15) >> 2) + 4 * (x >> 4) + (x & 3); }
typedef short bf16x8 __attribute__((ext_vector_type(8)));
typedef __bf16 bf16x2_t __attribute__((ext_vector_type(2)));
__device__ __forceinline__ unsigned cvtpk(float lo, float hi) { f32x2 v = {lo, hi}; bf16x2_t b = __builtin_convertvector(v, bf16x2_t); return __builtin_bit_cast(unsigned, b); }
constexpr int PQ = 0, PK = 17408, PVB = 34816, PKB = 53248, PAS = 71680, PTS = 88320, PMS = 104960, PTB = 121600, PGC = 130816;
__device__ __forceinline__ void dn_prep_item(const Args& a, LAS unsigned char* L8, int ch, int tid, int lane, int wave) {
    unsigned char* ws = a.ws;
    const bf16* PROJ = (const bf16*)(ws + WS_ACT);
    const float* BD = (const float*)(ws + WS_BD);
    const float* conv_w = a.in[7]; const float* a_log = a.in[8]; const float* dt_bias = a.in[9];
    const int bh = ch >> 6, n = ch & 63, b = bh >> 2, h = bh & 3;
    const int tok0 = b * SEQ + n * 64;
    LAS float* As = (LAS float*)(L8 + PAS); LAS float* Ts = (LAS float*)(L8 + PTS); LAS float* Ms = (LAS float*)(L8 + PMS);
    LAS float* gcs = (LAS float*)(L8 + PGC); LAS float* bts = gcs + 64;
    const int jl = lane & 15, kq = lane >> 4;
    unsigned raw[11][3];
#pragma unroll
    for (int i = 0; i < 11; ++i) { const int s = n * 64 + wave * 8 - 3 + i;
#pragma unroll
        for (int sec = 0; sec < 3; ++sec) raw[i][sec] = (s >= 0) ? *(const unsigned*)(PROJ + (size_t)(tok0 + wave * 8 - 3 + i) * P2LD + sec * 512 + h * 128 + 2 * lane) : 0u; }
    if (wave == 0) {
        const int tok = tok0 + lane;
        const float braw = BD[(size_t)tok * 8 + h], draw = BD[(size_t)tok * 8 + 4 + h] + dt_bias[h];
        const float sp = fmaxf(draw, 0.f) + log1pf(__expf(-fabsf(draw)));
        float g = -expf(a_log[h]) * sp;
#pragma unroll
        for (int o = 1; o < 64; o <<= 1) { const float t = __shfl_up(g, o); if (lane >= o) g += t; }
        gcs[lane] = g; bts[lane] = 1.0f / (1.0f + __expf(-braw));
        if (lane == 63) ((float*)(ws + WS_EG))[ch] = expf(g);
    }
    for (int i = tid; i < 64 * 65; i += 512) Ts[i] = 0.f;
    __syncthreads();
    {
        float cw[3][4][2];
#pragma unroll
        for (int sec = 0; sec < 3; ++sec)
#pragma unroll
            for (int j = 0; j < 4; ++j) { const f32x2 w = *(const f32x2*)(conv_w + j * 1536 + sec * 512 + h * 128 + 2 * lane); cw[sec][j][0] = w.x; cw[sec][j][1] = w.y; }
        const float glast = gcs[63];
        bf16* QG = (bf16*)(ws + WS_QG) + (size_t)ch * 8192; bf16* KD = (bf16*)(ws + WS_KD) + (size_t)ch * 8192;
#pragma unroll
        for (int rr = 0; rr < 8; ++rr) {
            const int r = wave * 8 + rr;
            float val[3][2];
#pragma unroll
            for (int sec = 0; sec < 3; ++sec) { float v0 = 0.f, v1 = 0.f;
#pragma unroll
                for (int j = 0; j < 4; ++j) { v0 += bflo(raw[rr + j][sec]) * cw[sec][j][0]; v1 += bfhi(raw[rr + j][sec]) * cw[sec][j][1]; }
                val[sec][0] = v0 / (1.f + __expf(-v0)); val[sec][1] = v1 / (1.f + __expf(-v1)); }
            const float ssq = wave_sum(val[0][0] * val[0][0] + val[0][1] * val[0][1]);
            const float ssk = wave_sum(val[1][0] * val[1][0] + val[1][1] * val[1][1]);
            const float rq = (1.0f / sqrtf(ssq + 1e-6f)) * 0.08838834764831845f, rk = 1.0f / sqrtf(ssk + 1e-6f);
            const float q0 = val[0][0] * rq, q1 = val[0][1] * rq, k0 = val[1][0] * rk, k1 = val[1][1] * rk;
            const float gr = gcs[r], be = bts[r], eq = __expf(gr), ek = __expf(glast - gr), bek = be * eq;
            *(LAS unsigned*)(L8 + PQ + r * 272 + 4 * lane) = cvtpk(q0, q1);
            *(LAS unsigned*)(L8 + PK + r * 272 + 4 * lane) = cvtpk(k0, k1);
            const unsigned vb = cvtpk(val[2][0] * be, val[2][1] * be), kb = cvtpk(k0 * bek, k1 * bek);
            *(LAS bf16*)(L8 + PVB + (2 * lane) * 144 + 2 * r) = (bf16)(vb & 0xffffu); *(LAS bf16*)(L8 + PVB + (2 * lane + 1) * 144 + 2 * r) = (bf16)(vb >> 16);
            *(LAS bf16*)(L8 + PKB + (2 * lane) * 144 + 2 * r) = (bf16)(kb & 0xffffu); *(LAS bf16*)(L8 + PKB + (2 * lane + 1) * 144 + 2 * r) = (bf16)(kb >> 16);
            const int d = 2 * lane;
            *(unsigned*)(QG + r * 128 + (d & 96) + kperm(d & 31)) = cvtpk(q0 * eq, q1 * eq);
            const int tp = (r & 32) + kperm(r & 31); const unsigned kd = cvtpk(k0 * ek, k1 * ek);
            KD[d * 64 + tp] = (bf16)(kd & 0xffffu); KD[(d + 1) * 64 + tp] = (bf16)(kd >> 16);
        }
    }
    __syncthreads();
    {
        bf16* Aout = (bf16*)(ws + WS_A) + (size_t)ch * 4096;
#pragma unroll
        for (int t2 = 0; t2 < 2; ++t2) {
            const int idx = 2 * wave + t2, ct = idx >> 2, jt = idx & 3;
            f32x4 acc1 = {0.f, 0.f, 0.f, 0.f}, acc2 = {0.f, 0.f, 0.f, 0.f};
#pragma unroll
            for (int ks = 0; ks < 4; ++ks) {
                const bf16x8 kc = *(const LAS bf16x8*)(L8 + PK + (16 * ct + jl) * 272 + (32 * ks + 8 * kq) * 2);
                const bf16x8 kj = *(const LAS bf16x8*)(L8 + PK + (16 * jt + jl) * 272 + (32 * ks + 8 * kq) * 2);
                const bf16x8 qc = *(const LAS bf16x8*)(L8 + PQ + (16 * ct + jl) * 272 + (32 * ks + 8 * kq) * 2);
                acc1 = __builtin_amdgcn_mfma_f32_16x16x32_bf16(kc, kj, acc1, 0, 0, 0);
                acc2 = __builtin_amdgcn_mfma_f32_16x16x32_bf16(kj, qc, acc2, 0, 0, 0);
            }
            { const int j = 16 * jt + jl; const float gj = gcs[j];
#pragma unroll
              for (int e = 0; e < 4; ++e) { const int c = 16 * ct + 4 * kq + e; As[c * 65 + j] = (j < c) ? bts[c] * acc1[e] * __expf(gcs[c] - gj) : 0.f; } }
            { const int c = 16 * ct + jl; const float gc_ = gcs[c]; float pv[4];
#pragma unroll
              for (int e = 0; e < 4; ++e) { const int j = 16 * jt + 4 * kq + e; pv[e] = (j <= c) ? acc2[e] * __expf(gc_ - gcs[j]) : 0.f; }
              v2u w; w.x = cvtpk(pv[0], pv[1]); w.y = cvtpk(pv[2], pv[3]);
              *(v2u*)(Aout + c * 64 + 32 * (jt >> 1) + 8 * kq + 4 * (jt & 1)) = w; }
        }
    }
    __syncthreads();
    if (wave == 0) {
        const int bb = lane >> 4, col = lane & 15;
        float xv[16];
#pragma unroll
        for (int c = 0; c < 16; ++c) { float s = (c == col) ? 1.f : 0.f;
#pragma unroll
            for (int j = 0; j < c; ++j) s -= As[(16 * bb + c) * 65 + 16 * bb + j] * xv[j];
            xv[c] = s; }
#pragma unroll
        for (int c = 0; c < 16; ++c) Ts[(16 * bb + c) * 65 + 16 * bb + col] = xv[c];
    }
    __syncthreads();
    {
        const int pr = tid >> 8, i = (tid >> 4) & 15, jj = tid & 15, hb = 32 * pr + 16, lb = 32 * pr;
        float s = 0.f;
#pragma unroll
        for (int k = 0; k < 16; ++k) s += As[(hb + i) * 65 + lb + k] * Ts[(lb + k) * 65 + lb + jj];
        Ms[(hb + i) * 65 + lb + jj] = s;
        __syncthreads();
        float t = 0.f;
#pragma unroll
        for (int k = 0; k < 16; ++k) t += Ts[(hb + i) * 65 + hb + k] * Ms[(hb + k) * 65 + lb + jj];
        Ts[(hb + i) * 65 + lb + jj] = -t;
    }
    __syncthreads();
    {
        const int i = tid >> 4, j0 = (tid & 15) * 2;
        float s0 = 0.f, s1 = 0.f;
#pragma unroll 8
        for (int k = 0; k < 32; ++k) { const float av = As[(32 + i) * 65 + k]; s0 += av * Ts[k * 65 + j0]; s1 += av * Ts[k * 65 + j0 + 1]; }
        Ms[(32 + i) * 65 + j0] = s0; Ms[(32 + i) * 65 + j0 + 1] = s1;
        __syncthreads();
        float t0 = 0.f, t1 = 0.f;
#pragma unroll 8
        for (int k = 0; k < 32; ++k) { const float tv = Ts[(32 + i) * 65 + 32 + k]; t0 += tv * Ms[(32 + k) * 65 + j0]; t1 += tv * Ms[(32 + k) * 65 + j0 + 1]; }
        __syncthreads();
        Ts[(32 + i) * 65 + j0] = -t0; Ts[(32 + i) * 65 + j0 + 1] = -t1;
    }
    __syncthreads();
#pragma unroll
    for (int i = 0; i < 4; ++i) { const int idx2 = tid + 512 * i, r = idx2 >> 5, c = (idx2 & 31) * 2;
        *(LAS unsigned*)(L8 + PTB + r * 144 + 2 * c) = cvtpk(Ts[r * 65 + c], Ts[r * 65 + c + 1]); }
    __syncthreads();
    {
        bf16* U = (bf16*)(ws + WS_U) + (size_t)ch * 8192; bf16* W = (bf16*)(ws + WS_W) + (size_t)ch * 8192;
        const int mt = wave & 3, ntb = 4 * (wave >> 2);
        bf16x8 ta[2];
#pragma unroll
        for (int ks = 0; ks < 2; ++ks) ta[ks] = *(const LAS bf16x8*)(L8 + PTB + (16 * mt + jl) * 144 + (32 * ks + 8 * kq) * 2);
#pragma unroll
        for (int q = 0; q < 4; ++q) { const int nt = ntb + q; f32x4 acc = {0.f, 0.f, 0.f, 0.f};
#pragma unroll
            for (int ks = 0; ks < 2; ++ks) { const bf16x8 vb = *(const LAS bf16x8*)(L8 + PVB + (16 * nt + jl) * 144 + (32 * ks + 8 * kq) * 2);
                acc = __builtin_amdgcn_mfma_f32_16x16x32_bf16(ta[ks], vb, acc, 0, 0, 0); }
            v2u w; w.x = cvtpk(acc[0], acc[1]); w.y = cvtpk(acc[2], acc[3]);
            *(v2u*)(U + (16 * nt + jl) * 64 + 16 * mt + 4 * kq) = w; }
        bf16x8 ka[2];
#pragma unroll
        for (int ks = 0; ks < 2; ++ks) ka[ks] = *(const LAS bf16x8*)(L8 + PKB + (16 * wave + jl) * 144 + (32 * ks + 8 * kq) * 2);
#pragma unroll
        for (int ctile = 0; ctile < 4; ++ctile) { f32x4 acc = {0.f, 0.f, 0.f, 0.f};
#pragma unroll
            for (int ks = 0; ks < 2; ++ks) { const bf16x8 tb = *(const LAS bf16x8*)(L8 + PTB + (16 * ctile + jl) * 144 + (32 * ks + 8 * kq) * 2);
                acc = __builtin_amdgcn_mfma_f32_16x16x32_bf16(ka[ks], tb, acc, 0, 0, 0); }
            v2u w; w.x = cvtpk(-acc[0], -acc[1]); w.y = cvtpk(-acc[2], -acc[3]);
            *(v2u*)(W + (16 * ctile + jl) * 128 + 32 * (wave >> 1) + 8 * kq + 4 * (wave & 1)) = w; }
    }
    __syncthreads();
}

__device__ __forceinline__ bf16x8 pack8(const f32x4& a, const f32x4& b) { v4u w; w.x = cvtpk(a[0], a[1]); w.y = cvtpk(a[2], a[3]); w.z = cvtpk(b[0], b[1]); w.w = cvtpk(b[2], b[3]); return __builtin_bit_cast(bf16x8, w); }
constexpr int SC_W = 0, SC_QG = 17408, SC_KDT = 34816, SC_A = 53248, SC_BUF = 62464;
struct ScanRegs { v4u st[7]; v2u ut[4]; };
__device__ __forceinline__ void sc_load(ScanRegs& R, const unsigned char* ws, int chx, int tid, int ucol, int kq) {
    const size_t o8 = (size_t)chx * 8192;
    const bf16* Wg = (const bf16*)(ws + WS_W) + o8; const bf16* Qg = (const bf16*)(ws + WS_QG) + o8; const bf16* Kg = (const bf16*)(ws + WS_KD) + o8; const bf16* Ag = (const bf16*)(ws + WS_A) + (size_t)chx * 4096;
    R.st[0] = *(const v4u*)(Wg + tid * 8); R.st[1] = *(const v4u*)(Wg + 4096 + tid * 8); R.st[2] = *(const v4u*)(Qg + tid * 8); R.st[3] = *(const v4u*)(Qg + 4096 + tid * 8);
    R.st[4] = *(const v4u*)(Kg + tid * 8); R.st[5] = *(const v4u*)(Kg + 4096 + tid * 8); R.st[6] = *(const v4u*)(Ag + tid * 8);
    const bf16* Ug = (const bf16*)(ws + WS_U) + o8 + ucol * 64 + 4 * kq;
    R.ut[0] = *(const v2u*)(Ug); R.ut[1] = *(const v2u*)(Ug + 16); R.ut[2] = *(const v2u*)(Ug + 32); R.ut[3] = *(const v2u*)(Ug + 48);
}
__device__ __forceinline__ void sc_write(const ScanRegs& R, LAS unsigned char* B_, int tid) {
    const int r16 = tid >> 4, c16 = tid & 15, r8 = tid >> 3, c8 = tid & 7;
    *(LAS v4u*)(B_ + SC_W + r16 * 272 + c16 * 16) = R.st[0]; *(LAS v4u*)(B_ + SC_W + (r16 + 32) * 272 + c16 * 16) = R.st[1];
    *(LAS v4u*)(B_ + SC_QG + r16 * 272 + c16 * 16) = R.st[2]; *(LAS v4u*)(B_ + SC_QG + (r16 + 32) * 272 + c16 * 16) = R.st[3];
    *(LAS v4u*)(B_ + SC_KDT + r8 * 144 + c8 * 16) = R.st[4]; *(LAS v4u*)(B_ + SC_KDT + (r8 + 64) * 144 + c8 * 16) = R.st[5];
    *(LAS v4u*)(B_ + SC_A + r8 * 144 + c8 * 16) = R.st[6];
}
__device__ __forceinline__ void sc_step(const unsigned char* ws, LAS unsigned char* L8, bf16* MIX, int bh, int b, int h, int n, bool cw_, int tid, int jl, int kq, int cs, float egv,
                                        f32x4 (&Sacc)[8], v2u (&ut)[4], ScanRegs& RL, ScanRegs& RW) {
    if (n + 2 < 64) sc_load(RL, ws, bh * 64 + n + 2, tid, cs + jl, kq);
    const float eg = __builtin_bit_cast(float, __builtin_amdgcn_readlane(__builtin_bit_cast(int, egv), n));
    const LAS unsigned char* B = L8 + (n & 1) * SC_BUF;
    if (cw_) {
        bf16x8 sb[4];
#pragma unroll
        for (int ks = 0; ks < 4; ++ks) sb[ks] = pack8(Sacc[2 * ks], Sacc[2 * ks + 1]);
        f32x4 vn[4], oa[4];
#pragma unroll
        for (int mt = 0; mt < 4; ++mt) { vn[mt] = (f32x4){bflo(ut[mt].x), bfhi(ut[mt].x), bflo(ut[mt].y), bfhi(ut[mt].y)}; oa[mt] = (f32x4){0.f, 0.f, 0.f, 0.f}; }
#pragma unroll
        for (int mt = 0; mt < 4; ++mt)
#pragma unroll
            for (int ks = 0; ks < 4; ++ks) {
                const bf16x8 wa = *(const LAS bf16x8*)(B + SC_W + (16 * mt + jl) * 272 + (32 * ks + 8 * kq) * 2);
                const bf16x8 qa = *(const LAS bf16x8*)(B + SC_QG + (16 * mt + jl) * 272 + (32 * ks + 8 * kq) * 2);
                vn[mt] = __builtin_amdgcn_mfma_f32_16x16x32_bf16(wa, sb[ks], vn[mt], 0, 0, 0);
                oa[mt] = __builtin_amdgcn_mfma_f32_16x16x32_bf16(qa, sb[ks], oa[mt], 0, 0, 0);
            }
        bf16x8 vb[2];
        vb[0] = pack8(vn[0], vn[1]); vb[1] = pack8(vn[2], vn[3]);
#pragma unroll
        for (int T = 0; T < 8; ++T) { Sacc[T] = Sacc[T] * eg;
#pragma unroll
            for (int k2 = 0; k2 < 2; ++k2) { const bf16x8 ka = *(const LAS bf16x8*)(B + SC_KDT + (16 * T + jl) * 144 + (32 * k2 + 8 * kq) * 2);
                Sacc[T] = __builtin_amdgcn_mfma_f32_16x16x32_bf16(ka, vb[k2], Sacc[T], 0, 0, 0); } }
#pragma unroll
        for (int mt = 0; mt < 4; ++mt)
#pragma unroll
            for (int k2 = 0; k2 < 2; ++k2) { const bf16x8 aa = *(const LAS bf16x8*)(B + SC_A + (16 * mt + jl) * 144 + (32 * k2 + 8 * kq) * 2);
                oa[mt] = __builtin_amdgcn_mfma_f32_16x16x32_bf16(aa, vb[k2], oa[mt], 0, 0, 0); }
        bf16* op = MIX + (size_t)(b * SEQ + n * 64 + 4 * kq) * 1024 + 512 + h * 128 + cs + jl;
#pragma unroll
        for (int mt = 0; mt < 4; ++mt)
#pragma unroll
            for (int e = 0; e < 4; ++e) op[(size_t)(16 * mt + e) * 1024] = (bf16)f2bf(oa[mt][e]);
    }
    if (n + 1 < 64) { sc_write(RW, L8 + ((n + 1) & 1) * SC_BUF, tid);
#pragma unroll
        for (int i = 0; i < 4; ++i) ut[i] = RW.ut[i]; }
    __syncthreads();
}
__device__ __forceinline__ void dn_scan_mfma(const Args& a, LAS unsigned char* L8, int item, int tid, int lane, int wave) {
    unsigned char* ws = a.ws;
    const int bh = item >> 2, qtr = item & 3, b = bh >> 2, h = bh & 3;
    const bool cw_ = wave < 2;
    const int jl = lane & 15, kq = lane >> 4, cs = qtr * 32 + (wave & 1) * 16;
    bf16* MIX = (bf16*)(ws + WS_XN);
    const float* EG = (const float*)(ws + WS_EG);
    f32x4 Sacc[8];
#pragma unroll
    for (int T = 0; T < 8; ++T) Sacc[T] = (f32x4){0.f, 0.f, 0.f, 0.f};
    const float egv = EG[bh * 64 + lane];
    ScanRegs R0, R1; v2u ut[4];
    sc_load(R0, ws, bh * 64, tid, cs + jl, kq);
    sc_load(R1, ws, bh * 64 + 1, tid, cs + jl, kq);
    sc_write(R0, L8, tid);
#pragma unroll
    for (int i = 0; i < 4; ++i) ut[i] = R0.ut[i];
    __syncthreads();
    for (int n = 0; n < 64; n += 2) {
        sc_step(ws, L8, MIX, bh, b, h, n, cw_, tid, jl, kq, cs, egv, Sacc, ut, R0, R1);
        sc_step(ws, L8, MIX, bh, b, h, n + 1, cw_, tid, jl, kq, cs, egv, Sacc, ut, R1, R0);
    }
}

typedef float f32x16 __attribute__((ext_vector_type(16)));
typedef short s16x4 __attribute__((ext_vector_type(4)));
__device__ __forceinline__ s16x4 vtr(const LAS unsigned char* p) { return __builtin_bit_cast(s16x4, __builtin_amdgcn_ds_read_tr16_b64_v4i16((LAS s16x4*)p)); }
constexpr int KVP = 144;
constexpr int KV_BYTES = 384 * KVP;
constexpr size_t WS_ML = 173 * MiB;
__device__ __forceinline__ void attn_item(const bf16* Qh, const bf16* KVh, bf16* PROJ, float* ML, LAS unsigned char* L8, int item, int tid, int lane, int wave) {
    asm volatile("" : "+v"(lane));
    const int bh = item / 48, rem = item - bh * 48, p = rem >> 4, sub = rem & 15;
    const int b = bh >> 3, h = bh & 7;
    const int dsh = 2 * p, dil = 1 << dsh, nsh = 4 - dsh;
    const int r = sub >> nsh, qb = sub & ((1 << nsh) - 1);
    const int base = 256 * qb;
    const bf16* KVb = KVh + (size_t)(bh * 4096 + r) * 128;
#pragma unroll
    for (int i = 0; i < 12; ++i) { const int id = tid + 512 * i, row = id >> 4, ch = id & 15, idx = base - 128 + row;
        v4u kv = (v4u){0u, 0u, 0u, 0u};
        if (idx >= 0) kv = *(const v4u*)(KVb + (size_t)(dil * idx) * 128 + ch * 8);
        *(LAS v4u*)(L8 + ((ch & 8) ? KV_BYTES : 0) + row * KVP + (ch & 7) * 16) = kv; }
    const int ql = lane & 31, kh = lane >> 5;
    const int tq = r + dil * (base + 32 * wave + ql);
    const size_t tokq = (size_t)b * SEQ + tq;
    bf16x8 qf[4];
#pragma unroll
    for (int s = 0; s < 4; ++s) qf[s] = *(const bf16x8*)(Qh + ((size_t)bh * 4096 + tq) * 64 + 16 * s + 8 * kh);
    __syncthreads();
    f32x16 sc[5];
#pragma unroll
    for (int kt = 0; kt < 5; ++kt) { f32x16 acc = {};
#pragma unroll
        for (int s = 0; s < 4; ++s) { const bf16x8 kf = *(const LAS bf16x8*)(L8 + (32 * (wave + kt) + ql) * KVP + (16 * s + 8 * kh) * 2); acc = __builtin_amdgcn_mfma_f32_32x32x16_bf16(kf, qf[s], acc, 0, 0, 0); }
        sc[kt] = acc; }
    const float LOG2E = 1.4426950408889634f;
    const float c1 = 0.125f * LOG2E, c2 = exp2f(-(float)(h + 1)) * (float)dil * LOG2E;
    float mx = -INFINITY;
#pragma unroll
    for (int kt = 0; kt < 5; ++kt)
#pragma unroll
        for (int rr = 0; rr < 16; ++rr) { const int kk = (rr & 3) + 8 * (rr >> 2) + 4 * kh; const int dist = 128 + ql - 32 * kt - kk; const int kidx = base - 128 + 32 * (wave + kt) + kk;
            const bool valid = (dist >= 0) && (dist <= 128) && (kidx >= 0);
            const float v = valid ? sc[kt][rr] * c1 - c2 * (float)dist : -INFINITY; sc[kt][rr] = v; mx = fmaxf(mx, v); }
    mx = fmaxf(mx, __shfl_xor(mx, 32));
    float lsum = 0.f;
#pragma unroll
    for (int kt = 0; kt < 5; ++kt)
#pragma unroll
        for (int rr = 0; rr < 16; ++rr) { const float pv = __builtin_amdgcn_exp2f(sc[kt][rr] - mx); sc[kt][rr] = pv; lsum += pv; }
    lsum += __shfl_xor(lsum, 32);
    f32x16 o[2]; o[0] = (f32x16){}; o[1] = (f32x16){};
    const int q4 = (lane & 15) >> 2, pp = lane & 3, blk = (lane >> 4) & 1;
    const LAS unsigned char* Vb = L8 + KV_BYTES + (4 * kh + q4) * KVP + (16 * blk + 4 * pp) * 2;
#pragma unroll
    for (int kt = 0; kt < 5; ++kt)
#pragma unroll
        for (int s2 = 0; s2 < 2; ++s2) {
            v4u pw; pw.x = cvtpk(sc[kt][8 * s2 + 0], sc[kt][8 * s2 + 1]); pw.y = cvtpk(sc[kt][8 * s2 + 2], sc[kt][8 * s2 + 3]); pw.z = cvtpk(sc[kt][8 * s2 + 4], sc[kt][8 * s2 + 5]); pw.w = cvtpk(sc[kt][8 * s2 + 6], sc[kt][8 * s2 + 7]);
            const bf16x8 pb = __builtin_bit_cast(bf16x8, pw);
            const LAS unsigned char* vr = Vb + (32 * (wave + kt) + 16 * s2) * KVP;
#pragma unroll
            for (int c = 0; c < 2; ++c) { const s16x4 lo = vtr(vr + c * 64), hi = vtr(vr + 8 * KVP + c * 64);
                const bf16x8 va = (bf16x8){lo[0], lo[1], lo[2], lo[3], hi[0], hi[1], hi[2], hi[3]};
                o[c] = __builtin_amdgcn_mfma_f32_32x32x16_bf16(va, pb, o[c], 0, 0, 0); }
        }
    const float inv = 1.0f / lsum;
    bf16* dst = PROJ + tokq * P2LD + p * 512 + h * 64 + 4 * kh;
#pragma unroll
    for (int c = 0; c < 2; ++c)
#pragma unroll
        for (int g = 0; g < 4; ++g) { v2u w; w.x = cvtpk(o[c][4 * g + 0] * inv, o[c][4 * g + 1] * inv); w.y = cvtpk(o[c][4 * g + 2] * inv, o[c][4 * g + 3] * inv);
            *(v2u*)(dst + 32 * c + 8 * g) = w; }
    if (kh == 0) { float* ml = ML + ((tokq * 8 + h) * 3 + p) * 2; *(f32x2*)ml = (f32x2){mx, lsum}; }
    __syncthreads();
}

#define XB_TMO      128
#define XB_XCNT(j)  (256  + 64 * (j))
#define XB_XSUB(j)  (1280 + 64 * (j))
#define XB_XGEN(j)  (2304 + 64 * (j))
#define XB_TOP      3328
#define XB_TOPGEN   3392
#define XCD_BAR_WORDS 3456
#define XB_SPIN_CAP (1u << 18)

__device__ __forceinline__ unsigned xb_ld(unsigned* p)              { return __hip_atomic_load(p, __ATOMIC_RELAXED, __HIP_MEMORY_SCOPE_AGENT); }
__device__ __forceinline__ unsigned xb_add(unsigned* p, unsigned v) { return __hip_atomic_fetch_add(p, v, __ATOMIC_RELAXED, __HIP_MEMORY_SCOPE_AGENT); }
__device__ __forceinline__ unsigned xb_xcc_id() { return (unsigned)__builtin_amdgcn_s_getreg((3 << 11) | 20) & 0xFu; }
#define XB_SPIN(cond, bar) do { unsigned _sp = 0; while (cond) { __builtin_amdgcn_s_sleep(1); \
    if ((++_sp & 255u) == 0u) { if (xb_ld(&(bar)[XB_TMO])) break; if (_sp > XB_SPIN_CAP) { atomicAdd(&(bar)[XB_TMO], 1u); break; } } } } while (0)

struct XcdBarrier {
    unsigned* bar; unsigned x;
    volatile LAS unsigned* st;
};

__device__ __forceinline__ XcdBarrier xcd_barrier_post(unsigned* bar, volatile LAS unsigned* st) {
    XcdBarrier b; b.bar = bar; b.x = xb_xcc_id(); b.st = st;
    if (threadIdx.x == 0) (void)xb_add(&bar[XB_XCNT(b.x)], 1u);
    return b;
}
__device__ __forceinline__ void xcd_barrier_complete(unsigned* bar, unsigned x, unsigned& nloc, unsigned& nx) {
    const unsigned G = gridDim.x * gridDim.y * gridDim.z;
    unsigned sum, cnt, mine, sp = 0u;
    for (;;) {
        sum = 0u; cnt = 0u; mine = 0u;
#pragma unroll
        for (unsigned j = 0; j < 16; ++j) { const unsigned c = xb_ld(&bar[XB_XCNT(j)]); sum += c; cnt += (c > 0u) ? 1u : 0u; mine = (j == x) ? c : mine; }
        if (sum == G) break;
        __builtin_amdgcn_s_sleep(1);
        if ((++sp & 255u) == 0u) { if (xb_ld(&bar[XB_TMO])) break; if (sp > XB_SPIN_CAP) { atomicAdd(&bar[XB_TMO], 1u); break; } }
    }
    nloc = mine > 0u ? mine : 1u; nx = cnt > 0u ? cnt : 1u;
}

__device__ __forceinline__ void xcd_barrier(const XcdBarrier& b) {
    asm volatile("s_waitcnt vmcnt(0)" ::: "memory");
    __syncthreads();
    if (threadIdx.x == 0) {
        unsigned* bar = b.bar;
        __builtin_amdgcn_s_waitcnt(0);
        unsigned nloc = b.st[0], nx = b.st[1];
        if (nloc == 0u) { xcd_barrier_complete(bar, b.x, nloc, nx); b.st[0] = nloc; b.st[1] = nx; }
        const unsigned old = xb_add(&bar[XB_XSUB(b.x)], 1u);
        const unsigned gen = old / nloc;
        if (old + 1u == (gen + 1u) * nloc) {
            __builtin_amdgcn_fence(__ATOMIC_RELEASE, "agent");
            asm volatile("s_waitcnt vmcnt(0)" ::: "memory");
            const unsigned og = xb_add(&bar[XB_TOP], 1u);
            const unsigned tg = og / nx;
            if (og + 1u == (tg + 1u) * nx) xb_add(&bar[XB_TOPGEN], 1u);
            else XB_SPIN(xb_ld(&bar[XB_TOPGEN]) == tg, bar);
            __builtin_amdgcn_fence(__ATOMIC_ACQUIRE, "agent");
            xb_add(&bar[XB_XGEN(b.x)], 1u);
            asm volatile("s_waitcnt vmcnt(0)" ::: "memory");
        } else {
            XB_SPIN(xb_ld(&bar[XB_XGEN(b.x)]) == gen, bar);
            __builtin_amdgcn_fence(__ATOMIC_ACQUIRE, "agent");
            asm volatile("s_waitcnt vmcnt(0)" ::: "memory");
        }
    }
    __syncthreads();
}

__global__ void __launch_bounds__(NWAVES * 64, 2) fwd_megakernel(Args a) {
    extern __shared__ __attribute__((aligned(16))) unsigned char lds[];
    cg::grid_group grid = cg::this_grid();
    LAS unsigned char* L8 = (LAS unsigned char*)lds;
    LAS float* L = (LAS float*)lds;
    const int tid = threadIdx.x, lane = tid & 63, wave = __builtin_amdgcn_readfirstlane(tid >> 6);
    const int G = gridDim.x, gw = blockIdx.x * NWAVES + wave, NGW = G * NWAVES;
    unsigned char* ws = a.ws;
    unsigned* ctl = (unsigned*)(ws + WS_CTL);
    const float* x = a.in[0];
    bf16* XN = (bf16*)(ws + WS_XN); bf16* ACT = (bf16*)(ws + WS_ACT); bf16* PROJ = ACT; bf16* MIX = XN;
    bf16* Wgu1 = (bf16*)(ws + WS_WGU1); bf16* Wd1 = (bf16*)(ws + WS_WD1); bf16* Win = (bf16*)(ws + WS_WIN); bf16* Wout = (bf16*)(ws + WS_WOUT);
    bf16* Wgu2 = (bf16*)(ws + WS_WGU2); bf16* Wd2 = (bf16*)(ws + WS_WD2);
    float* out = a.out;
    volatile LAS unsigned* xbst = (volatile LAS unsigned*)(L8 + LDS_BYTES - 64);
    if (tid < 2) xbst[tid] = 0u;
    __syncthreads();
    XcdBarrier bar = xcd_barrier_post(ctl + 1024, xbst);
#define GSYNC() xcd_barrier(bar)

    {
        const int lane = opq(tid) & 63;
        LAS float* scr = L + wave * 4096;
        constexpr int I_GU = (D / 64) * (NGU / 32), I_D = (FF / 64) * (D / 32), I_IN = (D / 64) * (NIN / 32), I_O = (D / 64) * (D / 32);
        constexpr int NITEMS = 2 * I_GU + 2 * I_D + I_IN + I_O;
        for (int it = gw; it < NITEMS; it += NGW) {
            int r = it;
            if (r < I_GU) { tr_gu(a.in[2], a.in[3], Wgu1, r, scr, lane); continue; } r -= I_GU;
            if (r < I_D) { tr_plain(a.in[4], FF, D, Wd1, r, scr, lane); continue; } r -= I_D;
            if (r < I_IN) { tr_win(a.in[6], Win, r, scr, lane); continue; } r -= I_IN;
            if (r < I_O) { tr_plain(a.in[11], D, D, Wout, r, scr, lane); continue; } r -= I_O;
            if (r < I_GU) { tr_gu(a.in[13], a.in[14], Wgu2, r, scr, lane); continue; } r -= I_GU;
            tr_plain(a.in[15], FF, D, Wd2, r, scr, lane);
        }
        for (int m = gw; m < M; m += NGW) { f32x4 v[4]; rms_row(x + (size_t)m * D, a.in[1], lane, v); store_row_bf16(XN + (size_t)m * D, lane, v); }
    }
    grid.sync();
    {
        pg8::Gemm g{XN, Wgu1, M, NGU, D}; pg8::StaticOrder S; S.init(M, NGU, G, (int)blockIdx.x);
        pg8::EpiSwiGLU E{ACT, FF};
        pg8::gemm_phase<pg8::EpiSwiGLU, pg8::StaticOrder, true, true>(L8, g, S, E);
    }
    GSYNC();
    {
        pg8::Gemm g{ACT, Wd1, M, D, FF}; pg8::StaticOrder S; S.init(M, D, G, (int)blockIdx.x);
        pg8::EpiRes E{x, out, D, 0.5f};
        pg8::gemm_phase<pg8::EpiRes, pg8::StaticOrder, true, true>(L8, g, S, E);
    }
    GSYNC();
    {
        const int lane = opq(tid) & 63;
        const float* w_in = a.in[6]; float* BD = (float*)(ws + WS_BD);
        for (int m = gw; m < M; m += NGW) {
            f32x4 v[4]; rms_row(out + (size_t)m * D, a.in[5], lane, v); store_row_bf16(XN + (size_t)m * D, lane, v);
            float acc[8];
#pragma unroll
            for (int o = 0; o < 8; ++o) acc[o] = 0.f;
#pragma unroll
            for (int j = 0; j < 4; ++j)
#pragma unroll
                for (int i = 0; i < 4; ++i) { const int k = 4 * (lane + 64 * j) + i; const f32x4 w0 = *(const f32x4*)(w_in + (size_t)k * WIN_COLS + 3072), w1 = *(const f32x4*)(w_in + (size_t)k * WIN_COLS + 3076);
                    const float hv = v[j][i];
                    acc[0] += hv * w0.x; acc[1] += hv * w0.y; acc[2] += hv * w0.z; acc[3] += hv * w0.w; acc[4] += hv * w1.x; acc[5] += hv * w1.y; acc[6] += hv * w1.z; acc[7] += hv * w1.w; }
#pragma unroll
            for (int o = 0; o < 8; ++o) acc[o] = wave_sum(acc[o]);
            if (lane == 0) { *(f32x4*)(BD + (size_t)m * 8) = (f32x4){acc[0], acc[1], acc[2], acc[3]}; *(f32x4*)(BD + (size_t)m * 8 + 4) = (f32x4){acc[4], acc[5], acc[6], acc[7]}; }
        }
    }
    GSYNC();
    {
        pg8::Gemm g{XN, Win, M, NIN, D}; pg8::StaticOrder S; S.init(M, NIN, G, (int)blockIdx.x);
        pg8::EpiProj E{(bf16*)(ws + WS_QH), (bf16*)(ws + WS_KVH), PROJ};
        pg8::gemm_phase<pg8::EpiProj, pg8::StaticOrder, true, true>(L8, g, S, E);
    }
    GSYNC();
    { const int tid_ = opq(tid); for (int ch = blockIdx.x; ch < 1024; ch += G) dn_prep_item(a, L8, ch, tid_, tid_ & 63, wave); }
    GSYNC();
    {
        const int tid_ = opq(tid), lane = tid_ & 63;
        for (int it = blockIdx.x; it < 64; it += G) dn_scan_mfma(a, L8, it, tid_, lane, wave);
        float* ML = (float*)(ws + WS_ML);
        if ((int)blockIdx.x >= 64 || G <= 64) {
            const int nb = (G > 64) ? G - 64 : G, j0 = (G > 64) ? (int)blockIdx.x - 64 : (int)blockIdx.x;
            for (int item = j0; item < 1536; item += nb) attn_item((const bf16*)(ws + WS_QH), (const bf16*)(ws + WS_KVH), PROJ, ML, L8, item, tid, lane, wave);
        }
    }
    GSYNC();
    {
        const int lane = opq(tid) & 63;
        const float* dn_norm = a.in[10];
        for (int m = gw; m < M; m += NGW) {
            bf16* op = MIX + (size_t)m * 1024 + 512 + 8 * lane; const bf16* gp = PROJ + (size_t)m * P2LD + 1536 + 8 * lane;
            const v4u ow = *(const v4u*)op, gwv = *(const v4u*)gp;
            float o[8] = {bflo(ow.x), bfhi(ow.x), bflo(ow.y), bfhi(ow.y), bflo(ow.z), bfhi(ow.z), bflo(ow.w), bfhi(ow.w)};
            float gt[8] = {bflo(gwv.x), bfhi(gwv.x), bflo(gwv.y), bfhi(gwv.y), bflo(gwv.z), bfhi(gwv.z), bflo(gwv.w), bfhi(gwv.w)};
            float ss = 0.f;
#pragma unroll
            for (int i = 0; i < 8; ++i) ss += o[i] * o[i];
            ss += __shfl_xor(ss, 1); ss += __shfl_xor(ss, 2); ss += __shfl_xor(ss, 4); ss += __shfl_xor(ss, 8);
            const float rs = 1.0f / sqrtf(ss * (1.f / 128.f) + 1e-6f);
            const int d0 = (8 * lane) & 127;
            float r[8];
#pragma unroll
            for (int i = 0; i < 8; ++i) r[i] = o[i] * rs * dn_norm[d0 + i] * (gt[i] / (1.f + __expf(-gt[i])));
            v4u w; w.x = pk2(r[0], r[1]); w.y = pk2(r[2], r[3]); w.z = pk2(r[4], r[5]); w.w = pk2(r[6], r[7]);
            *(v4u*)op = w;
            {
                const int ha = lane >> 3;
                const float* ml = (const float*)(ws + WS_ML) + ((size_t)m * 8 + ha) * 6;
                const f32x2 a0 = *(const f32x2*)ml, a1 = *(const f32x2*)(ml + 2), a2 = *(const f32x2*)(ml + 4);
                const float mm = fmaxf(a0.x, fmaxf(a1.x, a2.x));
                const float w0 = a0.y * __builtin_amdgcn_exp2f(a0.x - mm), w1 = a1.y * __builtin_amdgcn_exp2f(a1.x - mm), w2 = a2.y * __builtin_amdgcn_exp2f(a2.x - mm);
                const float iw = 1.0f / (w0 + w1 + w2);
                const bf16* pp = PROJ + (size_t)m * P2LD + 8 * lane;
                const v4u p0 = *(const v4u*)pp, p1 = *(const v4u*)(pp + 512), p2 = *(const v4u*)(pp + 1024);
                float rr[8];
                rr[0] = w0 * bflo(p0.x) + w1 * bflo(p1.x) + w2 * bflo(p2.x); rr[1] = w0 * bfhi(p0.x) + w1 * bfhi(p1.x) + w2 * bfhi(p2.x);
                rr[2] = w0 * bflo(p0.y) + w1 * bflo(p1.y) + w2 * bflo(p2.y); rr[3] = w0 * bfhi(p0.y) + w1 * bfhi(p1.y) + w2 * bfhi(p2.y);
                rr[4] = w0 * bflo(p0.z) + w1 * bflo(p1.z) + w2 * bflo(p2.z); rr[5] = w0 * bfhi(p0.z) + w1 * bfhi(p1.z) + w2 * bfhi(p2.z);
                rr[6] = w0 * bflo(p0.w) + w1 * bflo(p1.w) + w2 * bflo(p2.w); rr[7] = w0 * bfhi(p0.w) + w1 * bfhi(p1.w) + w2 * bfhi(p2.w);
                v4u wa; wa.x = pk2(rr[0] * iw, rr[1] * iw); wa.y = pk2(rr[2] * iw, rr[3] * iw); wa.z = pk2(rr[4] * iw, rr[5] * iw); wa.w = pk2(rr[6] * iw, rr[7] * iw);
                *(v4u*)(MIX + (size_t)m * 1024 + 8 * lane) = wa;
            }
        }
    }
    GSYNC();
    {
        pg8::Gemm g{MIX, Wout, M, D, D}; pg8::StaticOrder S; S.init(M, D, G, (int)blockIdx.x);
        pg8::EpiRes E{out, out, D, 1.0f};
        pg8::gemm_phase<pg8::EpiRes, pg8::StaticOrder, true, true>(L8, g, S, E);
    }
    GSYNC();
    { const int ln = opq(tid) & 63; for (int m = gw; m < M; m += NGW) { f32x4 v[4]; rms_row(out + (size_t)m * D, a.in[12], ln, v); store_row_bf16(XN + (size_t)m * D, ln, v); } }
    GSYNC();
    {
        pg8::Gemm g{XN, Wgu2, M, NGU, D}; pg8::StaticOrder S; S.init(M, NGU, G, (int)blockIdx.x);
        pg8::EpiSwiGLU E{ACT, FF};
        pg8::gemm_phase<pg8::EpiSwiGLU, pg8::StaticOrder, true, true>(L8, g, S, E);
    }
    GSYNC();
    {
        pg8::Gemm g{ACT, Wd2, M, D, FF}; pg8::StaticOrder S; S.init(M, D, G, (int)blockIdx.x);
        pg8::EpiRes E{out, out, D, 0.5f};
        pg8::gemm_phase<pg8::EpiRes, pg8::StaticOrder, true, true>(L8, g, S, E);
    }
    GSYNC();
    const int lnf = opq(tid) & 63;
    for (int m = gw; m < M; m += NGW) {
        f32x4 v[4]; rms_row(out + (size_t)m * D, a.in[16], lnf, v);
        f32x4* o = (f32x4*)(out + (size_t)m * D) + lnf;
#pragma unroll
        for (int j = 0; j < 4; ++j) o[64 * j] = v[j];
    }
}

extern "C" void kernel_launch(void* const* d_in, const int* in_sizes, int n_in, void* d_out, int out_size, void* d_ws, size_t ws_size, hipStream_t stream) {
    static int grid = 0;
    if (grid == 0) {
        if (n_in != 17 || in_sizes[0] != M * D || out_size != M * D || ws_size < WS_END) { fprintf(stderr, "kernel_launch: unexpected shapes (n_in %d in0 %d out %d ws %zu)\n", n_in, n_in > 0 ? in_sizes[0] : -1, out_size, ws_size); grid = -1; return; }
        int dev = 0, cus = 0, per_cu = 0;
        hipGetDevice(&dev); hipDeviceGetAttribute(&cus, hipDeviceAttributeMultiprocessorCount, dev);
        if (hipFuncSetAttribute((const void*)fwd_megakernel, hipFuncAttributeMaxDynamicSharedMemorySize, LDS_BYTES) != hipSuccess) { fprintf(stderr, "kernel_launch: hipFuncSetAttribute failed\n"); grid = -1; return; }
        if (hipOccupancyMaxActiveBlocksPerMultiprocessor(&per_cu, (const void*)fwd_megakernel, NWAVES * 64, LDS_BYTES) != hipSuccess || per_cu < 1) { fprintf(stderr, "kernel_launch: occupancy query says %d blocks/CU\n", per_cu); (void)hipGetLastError(); per_cu = 1; }
        grid = cus * 1;
        fprintf(stderr, "kernel_launch: cus %d per_cu %d grid %d\n", cus, per_cu, grid);
    }
    if (grid < 0) return;
    hipMemsetAsync((char*)d_ws + WS_CTL, 0, CTL_BYTES, stream);
    Args a{};
    for (int i = 0; i < 17; ++i) a.in[i] = (const float*)d_in[i];
    a.out = (float*)d_out; a.ws = (unsigned char*)d_ws;
    void* args[] = {&a};
    hipError_t e = hipLaunchCooperativeKernel((const void*)fwd_megakernel, dim3(grid), dim3(NWAVES * 64), args, LDS_BYTES, stream);
    if (e != hipSuccess) fprintf(stderr, "cooperative launch failed: %s (grid %d)\n", hipGetErrorString(e), grid);
}
```

```cpp
#include <hip/hip_runtime.h>
#include <hip/hip_cooperative_groups.h>
#include <cstdio>
#include <cstdint>
namespace cg = cooperative_groups;
namespace pg8 {
#define PG8_LAS __attribute__((address_space(3)))
typedef unsigned short bf16_t;
typedef short bf16x8 __attribute__((ext_vector_type(8)));
typedef float f32x4 __attribute__((ext_vector_type(4)));
typedef unsigned u32x4 __attribute__((ext_vector_type(4)));
constexpr int BM = 256, BK = 64, HALF = 128, HTB = HALF * BK * 2  , STAGE_BYTES = 8 * HTB, NXCD = 8, WGM = 8;

__host__ __device__ __forceinline__ int lds_byte(int r, int c) { const int st = (r >> 4) * 2 + (c >> 5), rr = r & 15, cc = c & 31, ob = rr * 64 + cc * 2; return st * 1024 + (ob ^ (((ob >> 9) & 1) << 5)); }
__host__ __device__ __forceinline__ void stage_rc(int b, int& R, int& C) { const int st = b / 1024, sb = b % 1024, swz = sb ^ (((sb >> 9) & 1) << 5); R = (st >> 1) * 16 + swz / 64; C = (st & 1) * 32 + (swz % 64) / 2; }
__host__ __device__ __forceinline__ int perm32(int rho) { const int n = rho >> 4, i = rho & 15; return 8 * (i >> 2) + 4 * n + (i & 3); }

struct Unit { int pm, pn; };
struct Gemm { const bf16_t* A; const bf16_t* Bt; int M, N, K; };

struct StaticOrder {
    int nM, nN, nwg, G, c;
    __host__ __device__ void init(int M, int N, int G_, int c_) { nM = M / BM; nN = N / BM; nwg = nM * nN; G = G_; c = c_; }
    __host__ __device__ bool next(int i, Unit& u) const {
        const long L = (long)i * G + c; if (L >= nwg) return false;
        int wgid = (int)L; { const int q = nwg / NXCD, r = nwg % NXCD, xcd = wgid % NXCD, off = wgid / NXCD; wgid = (xcd < r ? xcd * (q + 1) : r * (q + 1) + (xcd - r) * q) + off; }
        const int nig = WGM * nN, gid = wgid / nig, fm = gid * WGM, gsz = (nM - fm) < WGM ? (nM - fm) : WGM;
        u.pm = fm + ((wgid % nig) % gsz); u.pn = (wgid % nig) / gsz; return true;
    }
    __device__ __forceinline__ void a_ready(const Unit&) const {}
    __device__ __forceinline__ void done(const Unit&) const {}
};

__device__ __forceinline__ unsigned cvt_pk_bf16(float lo, float hi) { unsigned r; asm volatile("v_cvt_pk_bf16_f32 %0, %1, %2" : "=v"(r) : "v"(lo), "v"(hi)); return r; }
__device__ __forceinline__ float silu_f(float g) { return g * __builtin_amdgcn_rcpf(1.0f + __expf(-g)); }
struct EpiSwiGLU {
    static constexpr bool PERM = true, AFTER_DRAIN = false;
    bf16_t* O; int ldc;
    __device__ __forceinline__ void operator()(const f32x4 (&acc)[2][2][4][2], const Unit& u, int wr, int wc, int fr, int fq) const {
        const int row0 = u.pm * BM + wr * 64 + fr; const int col0 = u.pn * 128 + wc * 32 + 8 * fq;
#pragma unroll
        for (int ai = 0; ai < 2; ++ai)
#pragma unroll
            for (int m = 0; m < 4; ++m) { bf16_t* rowp = O + (size_t)(row0 + ai * HALF + m * 16) * ldc + col0;
                const f32x4 g0 = acc[ai][0][m][0], g1 = acc[ai][0][m][1], u0 = acc[ai][1][m][0], u1 = acc[ai][1][m][1];
                u32x4 w;
                w.x = cvt_pk_bf16(silu_f(g0[0]) * u0[0], silu_f(g0[1]) * u0[1]); w.y = cvt_pk_bf16(silu_f(g0[2]) * u0[2], silu_f(g0[3]) * u0[3]);
                w.z = cvt_pk_bf16(silu_f(g1[0]) * u1[0], silu_f(g1[1]) * u1[1]); w.w = cvt_pk_bf16(silu_f(g1[2]) * u1[2], silu_f(g1[3]) * u1[3]);
                *(u32x4*)rowp = w; }
    }
};
struct EpiRes {
    static constexpr bool PERM = false, AFTER_DRAIN = false;
    const float* base; float* out; int ldc; float scale;
    __device__ __forceinline__ void operator()(const f32x4 (&acc)[2][2][4][2], const Unit& u, int wr, int wc, int fr, int fq) const {
        const int row0 = u.pm * BM + wr * 64 + fr; const int col0 = u.pn * BM + wc * 32 + 4 * fq;
#pragma unroll
        for (int ai = 0; ai < 2; ++ai)
#pragma unroll
            for (int m = 0; m < 4; ++m) { const size_t off = (size_t)(row0 + ai * HALF + m * 16) * ldc + col0;
#pragma unroll
                for (int bj = 0; bj < 2; ++bj)
#pragma unroll
                    for (int n = 0; n < 2; ++n) { const f32x4 b = *(const f32x4*)(base + off + bj * HALF + n * 16); *(f32x4*)(out + off + bj * HALF + n * 16) = b + acc[ai][bj][m][n] * scale; }
                asm volatile("" ::: "memory"); }
    }
};
struct EpiProj {
    static constexpr bool PERM = true, AFTER_DRAIN = false;
    bf16_t* Qh; bf16_t* KVh; bf16_t* P2;
    __device__ __forceinline__ void operator()(const f32x4 (&acc)[2][2][4][2], const Unit& u, int wr, int wc, int fr, int fq) const {
        const int row0 = u.pm * BM + wr * 64 + fr;
#pragma unroll
        for (int ai = 0; ai < 2; ++ai)
#pragma unroll
            for (int m = 0; m < 4; ++m) { const int row = row0 + ai * HALF + m * 16, bb = row >> 12, t = row & 4095;
#pragma unroll
                for (int bj = 0; bj < 2; ++bj) { const int col = u.pn * BM + bj * HALF + wc * 32 + 8 * fq;
                    bf16_t* dst;
                    if (u.pn < 6) { const int sec = col >> 9, hc = col & 511, hh = hc >> 6, d = hc & 63; const size_t rt = (size_t)(bb * 8 + hh) * 4096 + t;
                        dst = (sec == 0) ? Qh + rt * 64 + d : KVh + rt * 128 + (sec - 1) * 64 + d; }
                    else dst = P2 + (size_t)row * 2048 + (col - 1536);
                    const f32x4 v0 = acc[ai][bj][m][0], v1 = acc[ai][bj][m][1]; u32x4 w;
                    w.x = cvt_pk_bf16(v0[0], v0[1]); w.y = cvt_pk_bf16(v0[2], v0[3]); w.z = cvt_pk_bf16(v1[0], v1[1]); w.w = cvt_pk_bf16(v1[2], v1[3]);
                    *(u32x4*)dst = w; } }
    }
};
struct EpiStoreBf16 {
    static constexpr bool PERM = true, AFTER_DRAIN = false;
    bf16_t* O; int ldc;
    __device__ __forceinline__ void operator()(const f32x4 (&acc)[2][2][4][2], const Unit& u, int wr, int wc, int fr, int fq) const {
        const int row0 = u.pm * BM + wr * 64 + fr; const int col0 = u.pn * BM + wc * 32 + 8 * fq;
#pragma unroll
        for (int ai = 0; ai < 2; ++ai)
#pragma unroll
            for (int m = 0; m < 4; ++m) { bf16_t* rowp = O + (size_t)(row0 + ai * HALF + m * 16) * ldc + col0;
#pragma unroll
                for (int bj = 0; bj < 2; ++bj) { const f32x4 v0 = acc[ai][bj][m][0], v1 = acc[ai][bj][m][1]; u32x4 w;
                    w.x = cvt_pk_bf16(v0[0], v0[1]); w.y = cvt_pk_bf16(v0[2], v0[3]); w.z = cvt_pk_bf16(v1[0], v1[1]); w.w = cvt_pk_bf16(v1[2], v1[3]);
                    *(u32x4*)(rowp + bj * HALF) = w; } }
    }
};
template <class Epi, class Sched, bool ALIGN_EPI = false, bool SP2 = false>
__device__ __forceinline__ void gemm_phase(PG8_LAS unsigned char* lds, const Gemm g, const Sched& S, const Epi& E) {
    const int tid = threadIdx.x, wid = __builtin_amdgcn_readfirstlane(tid >> 6), lane = tid & 63, wr = wid >> 2, wc = wid & 3, fr = lane & 15, fq = lane >> 4;
    const int K = g.K, nt = K / BK;
    unsigned voffA[2], voffB[2];
#pragma unroll
    for (int i = 0; i < 2; ++i) { int R, C; stage_rc(tid * 16 + i * 8192, R, C); const int Rb = Epi::PERM ? ((R & ~31) + perm32(R & 31)) : R;
        voffA[i] = (unsigned)(R * K + C) * 2u; voffB[i] = (unsigned)(Rb * K + C) * 2u; }
    const size_t kstep = (size_t)(BK * 2);
    const size_t hstep = (size_t)HALF * K * 2;
    const size_t tstep = 2 * hstep;
    const unsigned ldsw = (unsigned)wid * 1024u;
    const int aoff = lds_byte(wr * 64 + fr, fq * 8), boff = lds_byte(wc * 32 + fr, fq * 8);
#define PG8_SA(b, h) (((b) * 2 + (h)) * HTB)
#define PG8_SB(b, h) ((4 + (b) * 2 + (h)) * HTB)
#define PG8_STAGE(bufoff, gbase, voff) do { _Pragma("unroll") for (int _i = 0; _i < 2; ++_i) \
        __builtin_amdgcn_global_load_lds((const unsigned*)((const char*)(gbase) + (voff)[_i]), (PG8_LAS unsigned*)(lds + (bufoff) + ldsw + _i * 8192), 16, 0, 0); } while (0)
#define PG8_LDA(dst, b, h) do { _Pragma("unroll") for (int m = 0; m < 4; ++m) _Pragma("unroll") for (int k = 0; k < 2; ++k) dst[m][k] = *(const PG8_LAS bf16x8*)(lds + PG8_SA(b, h) + aoff + m * 2048 + k * 1024); } while (0)
#define PG8_LDB(dst, b, h) do { _Pragma("unroll") for (int n = 0; n < 2; ++n) _Pragma("unroll") for (int k = 0; k < 2; ++k) dst[n][k] = *(const PG8_LAS bf16x8*)(lds + PG8_SB(b, h) + boff + n * 2048 + k * 1024); } while (0)
#define PG8_MMA(ai, bj, At, Bt) do { __builtin_amdgcn_s_setprio(1); _Pragma("unroll") for (int m = 0; m < 4; ++m) _Pragma("unroll") for (int n = 0; n < 2; ++n) _Pragma("unroll") for (int k = 0; k < 2; ++k) \
        acc[ai][bj][m][n] = __builtin_amdgcn_mfma_f32_16x16x32_bf16(Bt[n][k], At[m][k], acc[ai][bj][m][n], 0, 0, 0); __builtin_amdgcn_s_setprio(0); } while (0)
#define PG8_WAIT_V(n) asm volatile("s_waitcnt vmcnt(" #n ")" ::: "memory")
#define PG8_WAIT_L(n) asm volatile("s_waitcnt lgkmcnt(" #n ")" ::: "memory")
#define PG8_BAR __builtin_amdgcn_s_barrier()
#define PG8_SCHED __builtin_amdgcn_sched_barrier(0)
    Unit cur, nxt; int ui = 0;
    if (!S.next(0, cur)) return;
    f32x4 acc[2][2][4][2];
#pragma unroll
    for (int a = 0; a < 2; ++a)
#pragma unroll
        for (int b = 0; b < 2; ++b)
#pragma unroll
            for (int m = 0; m < 4; ++m)
#pragma unroll
                for (int n = 0; n < 2; ++n) acc[a][b][m][n] = (f32x4){0.f, 0.f, 0.f, 0.f};
    bf16x8 At[4][2], B0[2][2], B1[2][2];
    const char* cA = (const char*)g.A + (size_t)cur.pm * tstep; const char* cB = (const char*)g.Bt + (size_t)cur.pn * tstep;
    S.a_ready(cur);
    if constexpr (SP2) {
        PG8_STAGE(PG8_SB(0, 0), cB, voffB); PG8_STAGE(PG8_SB(0, 1), cB + hstep, voffB); PG8_STAGE(PG8_SA(0, 0), cA, voffA); PG8_STAGE(PG8_SA(0, 1), cA + hstep, voffA);
        if (wr == 1) PG8_BAR;
        PG8_WAIT_V(2); PG8_BAR;
        PG8_STAGE(PG8_SB(1, 0), cB + kstep, voffB); PG8_STAGE(PG8_SA(1, 0), cA + kstep, voffA); PG8_STAGE(PG8_SB(1, 1), cB + hstep + kstep, voffB);
        PG8_WAIT_V(6); PG8_BAR;
    } else {
        PG8_STAGE(PG8_SB(0, 0), cB, voffB); PG8_STAGE(PG8_SA(0, 0), cA, voffA); PG8_STAGE(PG8_SB(0, 1), cB + hstep, voffB); PG8_STAGE(PG8_SA(0, 1), cA + hstep, voffA);
        if (wr == 1) PG8_BAR;
        PG8_WAIT_V(4); PG8_BAR;
        PG8_STAGE(PG8_SB(1, 0), cB + kstep, voffB); PG8_STAGE(PG8_SA(1, 0), cA + kstep, voffA); PG8_STAGE(PG8_SB(1, 1), cB + hstep + kstep, voffB);
        PG8_WAIT_V(6); PG8_BAR;
    }
    for (;;) {
        const bool has_next = S.next(ui + 1, nxt);
        const char* nA = has_next ? (const char*)g.A + (size_t)nxt.pm * tstep : cA; const char* nB = has_next ? (const char*)g.Bt + (size_t)nxt.pn * tstep : cB;
        for (int t = 0; t < nt; t += 2) {
            const bool last = (t == nt - 2);
            const char* a1 = cA + (size_t)(t + 1) * kstep;
            const char* a2 = last ? nA : cA + (size_t)(t + 2) * kstep; const char* b2 = last ? nB : cB + (size_t)(t + 2) * kstep;
            const char* a3 = a2 + kstep; const char* b3 = b2 + kstep;
            if (last && has_next) S.a_ready(nxt);
            if constexpr (SP2) {
            PG8_LDB(B0, 0, 0); PG8_LDB(B1, 0, 1); PG8_SCHED; PG8_LDA(At, 0, 0); PG8_STAGE(PG8_SA(1, 1), a1 + hstep, voffA);
            PG8_WAIT_V(8); PG8_WAIT_L(0); PG8_BAR; PG8_MMA(0, 0, At, B0); PG8_MMA(0, 1, At, B1); PG8_BAR; PG8_SCHED;
            PG8_LDA(At, 0, 1); PG8_STAGE(PG8_SB(0, 0), b2, voffB); PG8_STAGE(PG8_SB(0, 1), b2 + hstep, voffB); PG8_STAGE(PG8_SA(0, 0), a2, voffA);
            PG8_WAIT_V(8); PG8_WAIT_L(0); PG8_BAR; PG8_MMA(1, 0, At, B0); PG8_MMA(1, 1, At, B1); PG8_BAR; PG8_SCHED;
            PG8_LDB(B0, 1, 0); PG8_LDB(B1, 1, 1); PG8_SCHED; PG8_LDA(At, 1, 0); PG8_STAGE(PG8_SA(0, 1), a2 + hstep, voffA);
            PG8_WAIT_V(8); PG8_WAIT_L(0); PG8_BAR; PG8_MMA(0, 0, At, B0); PG8_MMA(0, 1, At, B1); PG8_BAR; PG8_SCHED;
            PG8_LDA(At, 1, 1); PG8_STAGE(PG8_SB(1, 0), b3, voffB); PG8_STAGE(PG8_SB(1, 1), b3 + hstep, voffB); PG8_STAGE(PG8_SA(1, 0), a3, voffA);
            PG8_WAIT_V(8); PG8_WAIT_L(0); PG8_BAR; PG8_MMA(1, 0, At, B0); PG8_MMA(1, 1, At, B1); PG8_BAR; PG8_SCHED;
            } else {
            PG8_LDB(B0, 0, 0); PG8_SCHED; PG8_LDA(At, 0, 0); PG8_STAGE(PG8_SA(1, 1), a1 + hstep, voffA);
            PG8_WAIT_L(8); PG8_BAR; PG8_WAIT_L(0); PG8_MMA(0, 0, At, B0); PG8_BAR; PG8_SCHED;
            PG8_LDB(B1, 0, 1); PG8_STAGE(PG8_SB(0, 0), b2, voffB);
            PG8_BAR; PG8_WAIT_L(0); PG8_MMA(0, 1, At, B1); PG8_BAR;
            PG8_LDA(At, 0, 1); PG8_STAGE(PG8_SA(0, 0), a2, voffA);
            PG8_BAR; PG8_WAIT_L(0); PG8_MMA(1, 0, At, B0); PG8_BAR; PG8_SCHED;
            PG8_STAGE(PG8_SB(0, 1), b2 + hstep, voffB);
            PG8_WAIT_V(6); PG8_BAR; PG8_MMA(1, 1, At, B1); PG8_BAR;
            PG8_LDB(B0, 1, 0); PG8_SCHED; PG8_LDA(At, 1, 0); PG8_STAGE(PG8_SA(0, 1), a2 + hstep, voffA);
            PG8_WAIT_L(8); PG8_BAR; PG8_WAIT_L(0); PG8_MMA(0, 0, At, B0); PG8_BAR; PG8_SCHED;
            PG8_LDB(B1, 1, 1); PG8_STAGE(PG8_SB(1, 0), b3, voffB);
            PG8_BAR; PG8_WAIT_L(0); PG8_MMA(0, 1, At, B1); PG8_BAR;
            PG8_LDA(At, 1, 1); PG8_STAGE(PG8_SA(1, 0), a3, voffA);
            PG8_BAR; PG8_WAIT_L(0); PG8_MMA(1, 0, At, B0); PG8_BAR; PG8_SCHED;
            PG8_STAGE(PG8_SB(1, 1), b3 + hstep, voffB);
            PG8_WAIT_V(6); PG8_BAR; PG8_MMA(1, 1, At, B1); PG8_BAR;
            }
        }
        if constexpr (ALIGN_EPI) { if (wr == 0) PG8_BAR; }
        if constexpr (!Epi::AFTER_DRAIN) { E(acc, cur, wr, wc, fr, fq); S.done(cur); }
        if (!has_next) break;
#pragma unroll
        for (int a = 0; a < 2; ++a)
#pragma unroll
            for (int b = 0; b < 2; ++b)
#pragma unroll
                for (int m = 0; m < 4; ++m)
#pragma unroll
                    for (int n = 0; n < 2; ++n) acc[a][b][m][n] = (f32x4){0.f, 0.f, 0.f, 0.f};
        cur = nxt; cA = nA; cB = nB; ++ui;
        if constexpr (ALIGN_EPI) { if (wr == 1) PG8_BAR; }
    }
    PG8_WAIT_V(0);
    if constexpr (!ALIGN_EPI) { if (wr == 0) PG8_BAR; }
    PG8_BAR;
    if constexpr (Epi::AFTER_DRAIN) { E.fused(acc, cur, wr, wc, fr, fq, lds, wid, lane); S.done(cur); }
#undef PG8_SA
#undef PG8_SB
#undef PG8_STAGE
#undef PG8_LDA
#undef PG8_LDB
#undef PG8_MMA
#undef PG8_WAIT_V
#undef PG8_WAIT_L
#undef PG8_BAR
#undef PG8_SCHED
}
}
constexpr int M = 16384, D = 1024, FF = 2816, NGU = 5632, NIN = 3584, SEQ = 4096;
constexpr int WIN_COLS = 3592;
constexpr size_t MiB = 1u << 20;
constexpr size_t WS_CTL = 0, CTL_BYTES = 65536;
constexpr size_t WS_WIN = 1 * MiB, WS_WOUT = 8 * MiB, WS_WGU2 = 10 * MiB, WS_WD2 = 21 * MiB;
constexpr size_t WS_XN = 27 * MiB;
constexpr size_t WS_ACT = 59 * MiB;
constexpr size_t WS_QH = 123 * MiB, WS_KVH = 139 * MiB;
constexpr int P2LD = 2048;
constexpr size_t WS_BD = 171 * MiB;
constexpr size_t WS_EG = 172 * MiB;
constexpr size_t WS_DN = 184 * MiB;
constexpr size_t WS_WGU1 = 184 * MiB, WS_WD1 = 195 * MiB;
constexpr size_t WS_QG = WS_DN, WS_KD = WS_DN + 16 * MiB, WS_U = WS_DN + 32 * MiB, WS_W = WS_DN + 48 * MiB, WS_A = WS_DN + 64 * MiB;
constexpr size_t WS_END = 256 * MiB;
constexpr int LDS_BYTES = 147456;
constexpr int NWAVES = 8;

#define GAS __attribute__((address_space(1)))
#define LAS __attribute__((address_space(3)))
typedef unsigned short bf16;
typedef unsigned v4u __attribute__((ext_vector_type(4)));
typedef unsigned v2u __attribute__((ext_vector_type(2)));
typedef float f32x4 __attribute__((ext_vector_type(4)));
typedef float f32x2 __attribute__((ext_vector_type(2)));
#define LDS_WAIT() asm volatile("s_waitcnt lgkmcnt(0)" ::: "memory")
__device__ __forceinline__ unsigned f2bf(float f) { unsigned u = __builtin_bit_cast(unsigned, f); return (u + 0x7fffu + ((u >> 16) & 1u)) >> 16; }
__device__ __forceinline__ unsigned pk2(float lo, float hi) { return f2bf(lo) | (f2bf(hi) << 16); }
__device__ __forceinline__ float bflo(unsigned u) { return __uint_as_float(u << 16); }
__device__ __forceinline__ float bfhi(unsigned u) { return __uint_as_float(u & 0xffff0000u); }
__device__ __forceinline__ float bf2f(bf16 v) { return __uint_as_float(((unsigned)v) << 16); }
__device__ __forceinline__ float wave_sum(float v) {
#pragma unroll
    for (int o = 1; o < 64; o <<= 1) v += __shfl_xor(v, o);
    return v;
}
__device__ __forceinline__ float wave_max(float v) {
#pragma unroll
    for (int o = 1; o < 64; o <<= 1) v = fmaxf(v, __shfl_xor(v, o));
    return v;
}

__device__ __forceinline__ int opq(int v) { asm volatile("" : "+v"(v)); return v; }
struct Args { const float* in[17]; float* out; unsigned char* ws; };

__device__ __forceinline__ void transpose_item(const float* src, int srcN, int srccol0, bf16* dst, int dstK, int dstrow0, int k0, LAS float* scr, int lane) {
#pragma unroll 8
    for (int i = 0; i < 32; ++i) { const int kk = 2 * i + (lane >> 5); scr[kk * 33 + (lane & 31)] = src[(size_t)(k0 + kk) * srcN + srccol0 + (lane & 31)]; }
    LDS_WAIT(); asm volatile("" ::: "memory");
    const int c = lane & 7;
#pragma unroll
    for (int j = 0; j < 4; ++j) { const int n = (lane >> 3) + 8 * j; const LAS float* s = scr + (8 * c) * 33 + n;
        v4u o; o.x = pk2(s[0 * 33], s[1 * 33]); o.y = pk2(s[2 * 33], s[3 * 33]); o.z = pk2(s[4 * 33], s[5 * 33]); o.w = pk2(s[6 * 33], s[7 * 33]);
        *(v4u*)(dst + (size_t)(dstrow0 + n) * dstK + k0 + 8 * c) = o; }
    LDS_WAIT(); asm volatile("" ::: "memory");
}
__device__ __forceinline__ void tr_gu(const float* gate, const float* up, bf16* dst, int r, LAS float* scr, int lane) {
    const int nblk = NGU / 32, kb = r / nblk, nb = r % nblk, dstrow0 = nb * 32, pn = dstrow0 >> 8, within = dstrow0 & 255;
    transpose_item(within < 128 ? gate : up, FF, pn * 128 + (within & 127), dst, D, dstrow0, kb * 64, scr, lane);
}
__device__ __forceinline__ void tr_plain(const float* src, int K, int N, bf16* dst, int r, LAS float* scr, int lane) {
    const int nblk = N / 32, kb = r / nblk, nb = r % nblk;
    transpose_item(src, N, nb * 32, dst, K, nb * 32, kb * 64, scr, lane);
}
__device__ __forceinline__ void tr_win(const float* src, bf16* dst, int r, LAS float* scr, int lane) {
    const int nblk = NIN / 32, kb = r / nblk, nb = r % nblk, dstrow0 = nb * 32;
    transpose_item(src, WIN_COLS, dstrow0 + (dstrow0 >= 3072 ? 8 : 0), dst, D, dstrow0, kb * 64, scr, lane);
}

__device__ __forceinline__ void rms_row(const float* xrow, const float* gain, int lane, f32x4 (&v)[4]) {
    const f32x4* xr = (const f32x4*)xrow + lane; const f32x4* gr = (const f32x4*)gain + lane;
    float s = 0.f;
#pragma unroll
    for (int j = 0; j < 4; ++j) { v[j] = xr[64 * j]; s += (v[j].x * v[j].x + v[j].y * v[j].y) + (v[j].z * v[j].z + v[j].w * v[j].w); }
    const float rs = 1.0f / sqrtf(wave_sum(s) * (1.f / D) + 1e-6f);
#pragma unroll
    for (int j = 0; j < 4; ++j) { const f32x4 g = gr[64 * j]; v[j] = v[j] * rs * g; }
}
__device__ __forceinline__ void store_row_bf16(bf16* orow, int lane, const f32x4 (&v)[4]) {
    v2u* o8 = (v2u*)orow + lane;
#pragma unroll
    for (int j = 0; j < 4; ++j) { v2u w; w.x = pk2(v[j].x, v[j].y); w.y = pk2(v[j].z, v[j].w); o8[64 * j] = w; }
}

__device__ __forceinline__ int kperm(int x) { return 8 * ((x & 15) >> 2) + 4 * (x >> 4) + (x & 3); }
typedef short bf16x8 __attribute__((ext_vector_type(8)));
typedef __bf16 bf16x2_t __attribute__((ext_vector_type(2)));
__device__ __forceinline__ unsigned cvtpk(float lo, float hi) { f32x2 v = {lo, hi}; bf16x2_t b = __builtin_convertvector(v, bf16x2_t); return __builtin_bit_cast(unsigned, b); }
constexpr int PQ = 0, PK = 17408, PVB = 34816, PKB = 53248, PAS = 71680, PTS = 88320, PMS = 104960, PTB = 121600, PGC = 130816;
__device__ __forceinline__ void dn_prep_item(const Args& a, LAS unsigned char* L8, int ch, int tid, int lane, int wave) {
    unsigned char* ws = a.ws;
    const bf16* PROJ = (const bf16*)(ws + WS_ACT);
    const float* BD = (const float*)(ws + WS_BD);
    const float* conv_w = a.in[7]; const float* a_log = a.in[8]; const float* dt_bias = a.in[9];
    const int bh = ch >> 6, n = ch & 63, b = bh >> 2, h = bh & 3;
    const int tok0 = b * SEQ + n * 64;
    LAS float* As = (LAS float*)(L8 + PAS); LAS float* Ts = (LAS float*)(L8 + PTS); LAS float* Ms = (LAS float*)(L8 + PMS);
    LAS float* gcs = (LAS float*)(L8 + PGC); LAS float* bts = gcs + 64;
    const int jl = lane & 15, kq = lane >> 4;
    unsigned raw[11][3];
#pragma unroll
    for (int i = 0; i < 11; ++i) { const int s = n * 64 + wave * 8 - 3 + i;
#pragma unroll
        for (int sec = 0; sec < 3; ++sec) raw[i][sec] = (s >= 0) ? *(const unsigned*)(PROJ + (size_t)(tok0 + wave * 8 - 3 + i) * P2LD + sec * 512 + h * 128 + 2 * lane) : 0u; }
    if (wave == 0) {
        const int tok = tok0 + lane;
        const float braw = BD[(size_t)tok * 8 + h], draw = BD[(size_t)tok * 8 + 4 + h] + dt_bias[h];
        const float sp = fmaxf(draw, 0.f) + log1pf(__expf(-fabsf(draw)));
        float g = -expf(a_log[h]) * sp;
#pragma unroll
        for (int o = 1; o < 64; o <<= 1) { const float t = __shfl_up(g, o); if (lane >= o) g += t; }
        gcs[lane] = g; bts[lane] = 1.0f / (1.0f + __expf(-braw));
        if (lane == 63) ((float*)(ws + WS_EG))[ch] = expf(g);
    }
    for (int i = tid; i < 64 * 65; i += 512) Ts[i] = 0.f;
    __syncthreads();
    {
        float cw[3][4][2];
#pragma unroll
        for (int sec = 0; sec < 3; ++sec)
#pragma unroll
            for (int j = 0; j < 4; ++j) { const f32x2 w = *(const f32x2*)(conv_w + j * 1536 + sec * 512 + h * 128 + 2 * lane); cw[sec][j][0] = w.x; cw[sec][j][1] = w.y; }
        const float glast = gcs[63];
        bf16* QG = (bf16*)(ws + WS_QG) + (size_t)ch * 8192; bf16* KD = (bf16*)(ws + WS_KD) + (size_t)ch * 8192;
#pragma unroll
        for (int rr = 0; rr < 8; ++rr) {
            const int r = wave * 8 + rr;
            float val[3][2];
#pragma unroll
            for (int sec = 0; sec < 3; ++sec) { float v0 = 0.f, v1 = 0.f;
#pragma unroll
                for (int j = 0; j < 4; ++j) { v0 += bflo(raw[rr + j][sec]) * cw[sec][j][0]; v1 += bfhi(raw[rr + j][sec]) * cw[sec][j][1]; }
                val[sec][0] = v0 / (1.f + __expf(-v0)); val[sec][1] = v1 / (1.f + __expf(-v1)); }
            const float ssq = wave_sum(val[0][0] * val[0][0] + val[0][1] * val[0][1]);
            const float ssk = wave_sum(val[1][0] * val[1][0] + val[1][1] * val[1][1]);
            const float rq = (1.0f / sqrtf(ssq + 1e-6f)) * 0.08838834764831845f, rk = 1.0f / sqrtf(ssk + 1e-6f);
            const float q0 = val[0][0] * rq, q1 = val[0][1] * rq, k0 = val[1][0] * rk, k1 = val[1][1] * rk;
            const float gr = gcs[r], be = bts[r], eq = __expf(gr), ek = __expf(glast - gr), bek = be * eq;
            *(LAS unsigned*)(L8 + PQ + r * 272 + 4 * lane) = cvtpk(q0, q1);
            *(LAS unsigned*)(L8 + PK + r * 272 + 4 * lane) = cvtpk(k0, k1);
            const unsigned vb = cvtpk(val[2][0] * be, val[2][1] * be), kb = cvtpk(k0 * bek, k1 * bek);
            *(LAS bf16*)(L8 + PVB + (2 * lane) * 144 + 2 * r) = (bf16)(vb & 0xffffu); *(LAS bf16*)(L8 + PVB + (2 * lane + 1) * 144 + 2 * r) = (bf16)(vb >> 16);
            *(LAS bf16*)(L8 + PKB + (2 * lane) * 144 + 2 * r) = (bf16)(kb & 0xffffu); *(LAS bf16*)(L8 + PKB + (2 * lane + 1) * 144 + 2 * r) = (bf16)(kb >> 16);
            const int d = 2 * lane;
            *(unsigned*)(QG + r * 128 + (d & 96) + kperm(d & 31)) = cvtpk(q0 * eq, q1 * eq);
            const int tp = (r & 32) + kperm(r & 31); const unsigned kd = cvtpk(k0 * ek, k1 * ek);
            KD[d * 64 + tp] = (bf16)(kd & 0xffffu); KD[(d + 1) * 64 + tp] = (bf16)(kd >> 16);
        }
    }
    __syncthreads();
    {
        bf16* Aout = (bf16*)(ws + WS_A) + (size_t)ch * 4096;
#pragma unroll
        for (int t2 = 0; t2 < 2; ++t2) {
            const int idx = 2 * wave + t2, ct = idx >> 2, jt = idx & 3;
            f32x4 acc1 = {0.f, 0.f, 0.f, 0.f}, acc2 = {0.f, 0.f, 0.f, 0.f};
#pragma unroll
            for (int ks = 0; ks < 4; ++ks) {
                const bf16x8 kc = *(const LAS bf16x8*)(L8 + PK + (16 * ct + jl) * 272 + (32 * ks + 8 * kq) * 2);
                const bf16x8 kj = *(const LAS bf16x8*)(L8 + PK + (16 * jt + jl) * 272 + (32 * ks + 8 * kq) * 2);
                const bf16x8 qc = *(const LAS bf16x8*)(L8 + PQ + (16 * ct + jl) * 272 + (32 * ks + 8 * kq) * 2);
                acc1 = __builtin_amdgcn_mfma_f32_16x16x32_bf16(kc, kj, acc1, 0, 0, 0);
                acc2 = __builtin_amdgcn_mfma_f32_16x16x32_bf16(kj, qc, acc2, 0, 0, 0);
            }
            { const int j = 16 * jt + jl; const float gj = gcs[j];
#pragma unroll
              for (int e = 0; e < 4; ++e) { const int c = 16 * ct + 4 * kq + e; As[c * 65 + j] = (j < c) ? bts[c] * acc1[e] * __expf(gcs[c] - gj) : 0.f; } }
            { const int c = 16 * ct + jl; const float gc_ = gcs[c]; float pv[4];
#pragma unroll
              for (int e = 0; e < 4; ++e) { const int j = 16 * jt + 4 * kq + e; pv[e] = (j <= c) ? acc2[e] * __expf(gc_ - gcs[j]) : 0.f; }
              v2u w; w.x = cvtpk(pv[0], pv[1]); w.y = cvtpk(pv[2], pv[3]);
              *(v2u*)(Aout + c * 64 + 32 * (jt >> 1) + 8 * kq + 4 * (jt & 1)) = w; }
        }
    }
    __syncthreads();
    if (wave == 0) {
        const int bb = lane >> 4, col = lane & 15;
        float xv[16];
#pragma unroll
        for (int c = 0; c < 16; ++c) { float s = (c == col) ? 1.f : 0.f;
#pragma unroll
            for (int j = 0; j < c; ++j) s -= As[(16 * bb + c) * 65 + 16 * bb + j] * xv[j];
            xv[c] = s; }
#pragma unroll
        for (int c = 0; c < 16; ++c) Ts[(16 * bb + c) * 65 + 16 * bb + col] = xv[c];
    }
    __syncthreads();
    {
        const int pr = tid >> 8, i = (tid >> 4) & 15, jj = tid & 15, hb = 32 * pr + 16, lb = 32 * pr;
        float s = 0.f;
#pragma unroll
        for (int k = 0; k < 16; ++k) s += As[(hb + i) * 65 + lb + k] * Ts[(lb + k) * 65 + lb + jj];
        Ms[(hb + i) * 65 + lb + jj] = s;
        __syncthreads();
        float t = 0.f;
#pragma unroll
        for (int k = 0; k < 16; ++k) t += Ts[(hb + i) * 65 + hb + k] * Ms[(hb + k) * 65 + lb + jj];
        Ts[(hb + i) * 65 + lb + jj] = -t;
    }
    __syncthreads();
    {
        const int i = tid >> 4, j0 = (tid & 15) * 2;
        float s0 = 0.f, s1 = 0.f;
#pragma unroll 8
        for (int k = 0; k < 32; ++k) { const float av = As[(32 + i) * 65 + k]; s0 += av * Ts[k * 65 + j0]; s1 += av * Ts[k * 65 + j0 + 1]; }
        Ms[(32 + i) * 65 + j0] = s0; Ms[(32 + i) * 65 + j0 + 1] = s1;
        __syncthreads();
        float t0 = 0.f, t1 = 0.f;
#pragma unroll 8
        for (int k = 0; k < 32; ++k) { const float tv = Ts[(32 + i) * 65 + 32 + k]; t0 += tv * Ms[(32 + k) * 65 + j0]; t1 += tv * Ms[(32 + k) * 65 + j0 + 1]; }
        __syncthreads();
        Ts[(32 + i) * 65 + j0] = -t0; Ts[(32 + i) * 65 + j0 + 1] = -t1;
    }
    __syncthreads();
#pragma unroll
    for (int i = 0; i < 4; ++i) { const int idx2 = tid + 512 * i, r = idx2 >> 5, c = (idx2 & 31) * 2;
        *(LAS unsigned*)(L8 + PTB + r * 144 + 2 * c) = cvtpk(Ts[r * 65 + c], Ts[r * 65 + c + 1]); }
    __syncthreads();
    {
        bf16* U = (bf16*)(ws + WS_U) + (size_t)ch * 8192; bf16* W = (bf16*)(ws + WS_W) + (size_t)ch * 8192;
        const int mt = wave & 3, ntb = 4 * (wave >> 2);
        bf16x8 ta[2];
#pragma unroll
        for (int ks = 0; ks < 2; ++ks) ta[ks] = *(const LAS bf16x8*)(L8 + PTB + (16 * mt + jl) * 144 + (32 * ks + 8 * kq) * 2);
#pragma unroll
        for (int q = 0; q < 4; ++q) { const int nt = ntb + q; f32x4 acc = {0.f, 0.f, 0.f, 0.f};
#pragma unroll
            for (int ks = 0; ks < 2; ++ks) { const bf16x8 vb = *(const LAS bf16x8*)(L8 + PVB + (16 * nt + jl) * 144 + (32 * ks + 8 * kq) * 2);
                acc = __builtin_amdgcn_mfma_f32_16x16x32_bf16(ta[ks], vb, acc, 0, 0, 0); }
            v2u w; w.x = cvtpk(acc[0], acc[1]); w.y = cvtpk(acc[2], acc[3]);
            *(v2u*)(U + (16 * nt + jl) * 64 + 16 * mt + 4 * kq) = w; }
        bf16x8 ka[2];
#pragma unroll
        for (int ks = 0; ks < 2; ++ks) ka[ks] = *(const LAS bf16x8*)(L8 + PKB + (16 * wave + jl) * 144 + (32 * ks + 8 * kq) * 2);
#pragma unroll
        for (int ctile = 0; ctile < 4; ++ctile) { f32x4 acc = {0.f, 0.f, 0.f, 0.f};
#pragma unroll
            for (int ks = 0; ks < 2; ++ks) { const bf16x8 tb = *(const LAS bf16x8*)(L8 + PTB + (16 * ctile + jl) * 144 + (32 * ks + 8 * kq) * 2);
                acc = __builtin_amdgcn_mfma_f32_16x16x32_bf16(ka[ks], tb, acc, 0, 0, 0); }
            v2u w; w.x = cvtpk(-acc[0], -acc[1]); w.y = cvtpk(-acc[2], -acc[3]);
            *(v2u*)(W + (16 * ctile + jl) * 128 + 32 * (wave >> 1) + 8 * kq + 4 * (wave & 1)) = w; }
    }
    __syncthreads();
}

__device__ __forceinline__ bf16x8 pack8(const f32x4& a, const f32x4& b) { v4u w; w.x = cvtpk(a[0], a[1]); w.y = cvtpk(a[2], a[3]); w.z = cvtpk(b[0], b[1]); w.w = cvtpk(b[2], b[3]); return __builtin_bit_cast(bf16x8, w); }
constexpr int SC_W = 0, SC_QG = 17408, SC_KDT = 34816, SC_A = 53248, SC_U = 62464, SC_BUF = 67072;
constexpr int SC_OUT = 2 * SC_BUF;
struct ScanRegs { v4u st[12]; };
__device__ __forceinline__ void sc_load(ScanRegs& R, const unsigned char* ws, int chx, int st_, int qtr) {
    asm volatile("" : "+v"(st_));
#pragma unroll
    for (int j = 0; j < 12; ++j) { const int id = st_ + 320 * j, arr = id >> 10, within = id & 1023;
        const bf16* g;
        if (id < 3584) { const size_t base = (arr == 0) ? WS_W : (arr == 1) ? WS_QG : (arr == 2) ? WS_KD : WS_A; g = (const bf16*)(ws + base) + (size_t)chx * (arr == 3 ? 4096 : 8192) + within * 8; }
        else { const int wi = id - 3584; g = (const bf16*)(ws + WS_U) + (size_t)chx * 8192 + (qtr * 32 + (wi >> 3)) * 64 + (wi & 7) * 8; }
        R.st[j] = *(const v4u*)g; }
}
__device__ __forceinline__ void sc_write(const ScanRegs& R, LAS unsigned char* B_, int st_) {
    asm volatile("" : "+v"(st_));
#pragma unroll
    for (int j = 0; j < 12; ++j) { const int id = st_ + 320 * j, arr = id >> 10, within = id & 1023;
        int off;
        if (id < 3584) off = (arr < 2) ? ((arr == 0 ? SC_W : SC_QG) + (within >> 4) * 272 + (within & 15) * 16) : ((arr == 2 ? SC_KDT : SC_A) + (within >> 3) * 144 + (within & 7) * 16);
        else { const int wi = id - 3584; off = SC_U + (wi >> 3) * 144 + (wi & 7) * 16; }
        *(LAS v4u*)(B_ + off) = R.st[j]; }
}
#define SC_BARRIER() do { asm volatile("s_waitcnt lgkmcnt(0)" ::: "memory"); __builtin_amdgcn_s_barrier(); asm volatile("" ::: "memory"); } while (0)
__device__ __forceinline__ void sc_step_compute(LAS unsigned char* L8, int n, int jl, int kq, int wcol, float egv, f32x4 (&Sacc)[8]) {
    const float eg = __builtin_bit_cast(float, __builtin_amdgcn_readlane(__builtin_bit_cast(int, egv), n));
    const LAS unsigned char* B = L8 + (n & 1) * SC_BUF;
    bf16x8 sb[4];
#pragma unroll
    for (int ks = 0; ks < 4; ++ks) sb[ks] = pack8(Sacc[2 * ks], Sacc[2 * ks + 1]);
    f32x4 vn[4], oa[4];
#pragma unroll
    for (int mt = 0; mt < 4; ++mt) { const v2u u = *(const LAS v2u*)(B + SC_U + (wcol + jl) * 144 + (16 * mt + 4 * kq) * 2);
        vn[mt] = (f32x4){bflo(u.x), bfhi(u.x), bflo(u.y), bfhi(u.y)}; oa[mt] = (f32x4){0.f, 0.f, 0.f, 0.f}; }
    const LAS unsigned char* pW = B + SC_W + jl * 272 + kq * 16; const LAS unsigned char* pQ = B + SC_QG + jl * 272 + kq * 16;
    const LAS unsigned char* pK = B + SC_KDT + jl * 144 + kq * 16; const LAS unsigned char* pA = B + SC_A + jl * 144 + kq * 16;
#define SC_LD_WQ(dst, mt) do { _Pragma("unroll") for (int ks = 0; ks < 4; ++ks) { dst[ks] = *(const LAS bf16x8*)(pW + (mt) * 16 * 272 + ks * 64); dst[4 + ks] = *(const LAS bf16x8*)(pQ + (mt) * 16 * 272 + ks * 64); } } while (0)
#define SC_LD_K(dst, t0) do { _Pragma("unroll") for (int t = 0; t < 4; ++t) _Pragma("unroll") for (int k2 = 0; k2 < 2; ++k2) dst[2 * t + k2] = *(const LAS bf16x8*)(pK + ((t0) + t) * 16 * 144 + k2 * 64); } while (0)
#define SC_LD_A(dst) do { _Pragma("unroll") for (int mt = 0; mt < 4; ++mt) _Pragma("unroll") for (int k2 = 0; k2 < 2; ++k2) dst[2 * mt + k2] = *(const LAS bf16x8*)(pA + mt * 16 * 144 + k2 * 64); } while (0)
#define SC_MM_WQ(src, mt) do { _Pragma("unroll") for (int ks = 0; ks < 4; ++ks) { vn[mt] = __builtin_amdgcn_mfma_f32_16x16x32_bf16(src[ks], sb[ks], vn[mt], 0, 0, 0); oa[mt] = __builtin_amdgcn_mfma_f32_16x16x32_bf16(src[4 + ks], sb[ks], oa[mt], 0, 0, 0); } } while (0)
#define SC_MM_K(src, t0) do { _Pragma("unroll") for (int k2 = 0; k2 < 2; ++k2) _Pragma("unroll") for (int t = 0; t < 4; ++t) Sacc[(t0) + t] = __builtin_amdgcn_mfma_f32_16x16x32_bf16(src[2 * t + k2], vb[k2], Sacc[(t0) + t], 0, 0, 0); } while (0)
#define SC_MM_A(src) do { _Pragma("unroll") for (int k2 = 0; k2 < 2; ++k2) _Pragma("unroll") for (int mt = 0; mt < 4; ++mt) oa[mt] = __builtin_amdgcn_mfma_f32_16x16x32_bf16(src[2 * mt + k2], vb[k2], oa[mt], 0, 0, 0); } while (0)
#define SC_SB() __builtin_amdgcn_sched_barrier(0)
    bf16x8 fa[8], fb[8];
    SC_LD_WQ(fa, 0); SC_LD_WQ(fb, 1); SC_SB();
    SC_MM_WQ(fa, 0); SC_SB(); SC_LD_WQ(fa, 2); SC_SB();
    SC_MM_WQ(fb, 1); SC_SB(); SC_LD_WQ(fb, 3); SC_SB();
    SC_MM_WQ(fa, 2); SC_SB(); SC_LD_K(fa, 0); SC_SB();
    SC_MM_WQ(fb, 3); SC_SB(); SC_LD_K(fb, 4); SC_SB();
    bf16x8 vb[2];
    vb[0] = pack8(vn[0], vn[1]); vb[1] = pack8(vn[2], vn[3]);
#pragma unroll
    for (int T = 0; T < 8; ++T) Sacc[T] = Sacc[T] * eg;
    SC_SB();
    SC_MM_K(fa, 0); SC_SB(); SC_LD_A(fa); SC_SB();
    SC_MM_K(fb, 4); SC_SB();
    SC_MM_A(fa);
#undef SC_LD_WQ
#undef SC_LD_K
#undef SC_LD_A
#undef SC_MM_WQ
#undef SC_MM_K
#undef SC_MM_A
#undef SC_SB
    LAS unsigned char* ob = L8 + SC_OUT + (n & 1) * 4096 + (4 * kq) * 64 + (wcol + jl) * 2;
#pragma unroll
    for (int mt = 0; mt < 4; ++mt)
#pragma unroll
        for (int e = 0; e < 4; ++e) *(LAS bf16*)(ob + (16 * mt + e) * 64) = (bf16)f2bf(oa[mt][e]);
    SC_BARRIER();
}
__device__ __forceinline__ void sc_out_tile(LAS unsigned char* L8, bf16* MIX, int b, int h, int qtr, int n, int l_) {
    const LAS unsigned char* ob = L8 + SC_OUT + (n & 1) * 4096 + l_ * 64;
    const v4u w0 = *(const LAS v4u*)ob, w1 = *(const LAS v4u*)(ob + 16), w2 = *(const LAS v4u*)(ob + 32), w3 = *(const LAS v4u*)(ob + 48);
    bf16* gp = MIX + (size_t)(b * SEQ + n * 64 + l_) * 1024 + 512 + h * 128 + qtr * 32;
    *(v4u*)gp = w0; *(v4u*)(gp + 8) = w1; *(v4u*)(gp + 16) = w2; *(v4u*)(gp + 24) = w3;
}
__device__ __forceinline__ void dn_scan_mfma(const Args& a, LAS unsigned char* L8, int item, int tid, int lane, int wave) {
    unsigned char* ws = a.ws;
    const int bh = item >> 2, qtr = item & 3, b = bh >> 2, h = bh & 3;
    if (wave < 2) {
        const int jl = lane & 15, kq = lane >> 4;
        f32x4 Sacc[8];
#pragma unroll
        for (int T = 0; T < 8; ++T) Sacc[T] = (f32x4){0.f, 0.f, 0.f, 0.f};
        const float egv = ((const float*)(ws + WS_EG))[bh * 64 + lane];
        asm volatile("s_waitcnt vmcnt(0)" ::: "memory");
        SC_BARRIER();
        for (int n = 0; n < 64; ++n) sc_step_compute(L8, n, jl, kq, wave * 16, egv, Sacc);
    } else if (wave < 7) {
        ScanRegs R0, R1; const int st_ = tid - 128;
        sc_load(R0, ws, bh * 64, st_, qtr); sc_write(R0, L8, st_);
        sc_load(R0, ws, bh * 64 + 1, st_, qtr); sc_load(R1, ws, bh * 64 + 2, st_, qtr);
        SC_BARRIER();
        for (int n = 0; n < 64; n += 2) {
            sc_write(R0, L8 + SC_BUF, st_);
            if (n + 3 < 64) sc_load(R0, ws, bh * 64 + n + 3, st_, qtr);
            SC_BARRIER();
            if (n + 2 < 64) sc_write(R1, L8, st_);
            if (n + 4 < 64) sc_load(R1, ws, bh * 64 + n + 4, st_, qtr);
            SC_BARRIER();
        }
    } else {
        bf16* MIX = (bf16*)(ws + WS_XN);
        SC_BARRIER();
        for (int n = 0; n < 64; ++n) { if (n > 0) sc_out_tile(L8, MIX, b, h, qtr, n - 1, lane); SC_BARRIER(); }
        sc_out_tile(L8, MIX, b, h, qtr, 63, lane);
    }
    __syncthreads();
}

typedef float f32x16 __attribute__((ext_vector_type(16)));
typedef short s16x4 __attribute__((ext_vector_type(4)));
__device__ __forceinline__ s16x4 vtr(const LAS unsigned char* p) { return __builtin_bit_cast(s16x4, __builtin_amdgcn_ds_read_tr16_b64_v4i16((LAS s16x4*)p)); }
constexpr int KVP = 144;
constexpr int KV_BYTES = 384 * KVP;
constexpr size_t WS_ML = 173 * MiB;
__device__ __forceinline__ void attn_item(const bf16* Qh, const bf16* KVh, bf16* PROJ, float* ML, LAS unsigned char* L8, int item, int tid, int lane, int wave) {
    asm volatile("" : "+v"(lane));
    const int bh = item / 48, rem = item - bh * 48, p = rem >> 4, sub = rem & 15;
    const int b = bh >> 3, h = bh & 7;
    const int dsh = 2 * p, dil = 1 << dsh, nsh = 4 - dsh;
    const int r = sub >> nsh, qb = sub & ((1 << nsh) - 1);
    const int base = 256 * qb;
    const bf16* KVb = KVh + (size_t)(bh * 4096 + r) * 128;
#pragma unroll
    for (int i = 0; i < 12; ++i) { const int id = tid + 512 * i, row = id >> 4, ch = id & 15, idx = base - 128 + row;
        v4u kv = (v4u){0u, 0u, 0u, 0u};
        if (idx >= 0) kv = *(const v4u*)(KVb + (size_t)(dil * idx) * 128 + ch * 8);
        *(LAS v4u*)(L8 + ((ch & 8) ? KV_BYTES : 0) + row * KVP + (ch & 7) * 16) = kv; }
    const int ql = lane & 31, kh = lane >> 5;
    const int tq = r + dil * (base + 32 * wave + ql);
    const size_t tokq = (size_t)b * SEQ + tq;
    bf16x8 qf[4];
#pragma unroll
    for (int s = 0; s < 4; ++s) qf[s] = *(const bf16x8*)(Qh + ((size_t)bh * 4096 + tq) * 64 + 16 * s + 8 * kh);
    __syncthreads();
    f32x16 sc[5];
    {
        const LAS unsigned char* Kp = L8 + (32 * wave + ql) * KVP + kh * 16;
        bf16x8 kf[2][4];
#pragma unroll
        for (int s = 0; s < 4; ++s) kf[0][s] = *(const LAS bf16x8*)(Kp + s * 32);
#pragma unroll
        for (int kt = 0; kt < 5; ++kt) {
            if (kt + 1 < 5) {
#pragma unroll
                for (int s = 0; s < 4; ++s) kf[(kt + 1) & 1][s] = *(const LAS bf16x8*)(Kp + (kt + 1) * 32 * KVP + s * 32); }
            __builtin_amdgcn_sched_barrier(0);
            f32x16 acc = {};
#pragma unroll
            for (int s = 0; s < 4; ++s) acc = __builtin_amdgcn_mfma_f32_32x32x16_bf16(kf[kt & 1][s], qf[s], acc, 0, 0, 0);
            sc[kt] = acc;
            __builtin_amdgcn_sched_barrier(0);
        }
    }
    const float LOG2E = 1.4426950408889634f;
    const float c1 = 0.125f * LOG2E, c2 = exp2f(-(float)(h + 1)) * (float)dil * LOG2E;
    const float Al = -c2 * (float)(128 + ql - 4 * kh);
    float mx = -INFINITY;
#pragma unroll
    for (int kt = 0; kt < 5; ++kt)
#pragma unroll
        for (int rr = 0; rr < 16; ++rr) { const int kc = (rr & 3) + 8 * (rr >> 2);
            float v = fmaf(sc[kt][rr], c1, fmaf(c2, (float)(32 * kt + kc), Al));
            if (kt == 0) v = (kc + 4 * kh >= ql) ? v : -INFINITY;
            if (kt == 4) v = (kc + 4 * kh <= ql) ? v : -INFINITY;
            sc[kt][rr] = v; }
    if (base == 0) {
#pragma unroll
        for (int kt = 0; kt < 4; ++kt)
#pragma unroll
            for (int rr = 0; rr < 16; ++rr) { const int kidx = -128 + 32 * (wave + kt) + (rr & 3) + 8 * (rr >> 2) + 4 * kh; sc[kt][rr] = (kidx >= 0) ? sc[kt][rr] : -INFINITY; }
    }
#pragma unroll
    for (int kt = 0; kt < 5; ++kt)
#pragma unroll
        for (int rr = 0; rr < 16; ++rr) mx = fmaxf(mx, sc[kt][rr]);
    mx = fmaxf(mx, __shfl_xor(mx, 32));
    float lsum = 0.f;
#pragma unroll
    for (int kt = 0; kt < 5; ++kt)
#pragma unroll
        for (int rr = 0; rr < 16; ++rr) { const float pv = __builtin_amdgcn_exp2f(sc[kt][rr] - mx); sc[kt][rr] = pv; lsum += pv; }
    lsum += __shfl_xor(lsum, 32);
    f32x16 o[2]; o[0] = (f32x16){}; o[1] = (f32x16){};
    {
        const int q4 = (lane & 15) >> 2, pp = lane & 3, blk = (lane >> 4) & 1;
        const LAS unsigned char* Vb = L8 + KV_BYTES + (32 * wave + 4 * kh + q4) * KVP + (16 * blk + 4 * pp) * 2;
        s16x4 vf[3][4];
#define AT_LDV(set, step) do { const LAS unsigned char* vr_ = Vb + (16 * (step)) * KVP; vf[set][0] = vtr(vr_); vf[set][1] = vtr(vr_ + 8 * KVP); vf[set][2] = vtr(vr_ + 64); vf[set][3] = vtr(vr_ + 8 * KVP + 64); } while (0)
        AT_LDV(0, 0); AT_LDV(1, 1);
#pragma unroll
        for (int st = 0; st < 10; ++st) {
            if (st + 2 < 10) AT_LDV((st + 2) % 3, st + 2);
            __builtin_amdgcn_sched_barrier(0);
            const int kt = st >> 1, s2 = st & 1;
            v4u pw; pw.x = cvtpk(sc[kt][8 * s2 + 0], sc[kt][8 * s2 + 1]); pw.y = cvtpk(sc[kt][8 * s2 + 2], sc[kt][8 * s2 + 3]); pw.z = cvtpk(sc[kt][8 * s2 + 4], sc[kt][8 * s2 + 5]); pw.w = cvtpk(sc[kt][8 * s2 + 6], sc[kt][8 * s2 + 7]);
            const bf16x8 pb = __builtin_bit_cast(bf16x8, pw);
            const s16x4 l0 = vf[st % 3][0], h0 = vf[st % 3][1], l1 = vf[st % 3][2], h1 = vf[st % 3][3];
            o[0] = __builtin_amdgcn_mfma_f32_32x32x16_bf16((bf16x8){l0[0], l0[1], l0[2], l0[3], h0[0], h0[1], h0[2], h0[3]}, pb, o[0], 0, 0, 0);
            o[1] = __builtin_amdgcn_mfma_f32_32x32x16_bf16((bf16x8){l1[0], l1[1], l1[2], l1[3], h1[0], h1[1], h1[2], h1[3]}, pb, o[1], 0, 0, 0);
            __builtin_amdgcn_sched_barrier(0);
        }
#undef AT_LDV
    }
    const float inv = 1.0f / lsum;
    bf16* dst = PROJ + tokq * P2LD + p * 512 + h * 64 + 4 * kh;
#pragma unroll
    for (int c = 0; c < 2; ++c)
#pragma unroll
        for (int g = 0; g < 4; ++g) { v2u w; w.x = cvtpk(o[c][4 * g + 0] * inv, o[c][4 * g + 1] * inv); w.y = cvtpk(o[c][4 * g + 2] * inv, o[c][4 * g + 3] * inv);
            *(v2u*)(dst + 32 * c + 8 * g) = w; }
    if (kh == 0) { float* ml = ML + ((tokq * 8 + h) * 3 + p) * 2; *(f32x2*)ml = (f32x2){mx, lsum}; }
    __syncthreads();
}

#define XB_TMO      128
#define XB_XCNT(j)  (256  + 64 * (j))
#define XB_XSUB(j)  (1280 + 64 * (j))
#define XB_XGEN(j)  (2304 + 64 * (j))
#define XB_TOP      3328
#define XB_TOPGEN   3392
#define XCD_BAR_WORDS 3456
#define XB_SPIN_CAP (1u << 18)

__device__ __forceinline__ unsigned xb_ld(unsigned* p)              { return __hip_atomic_load(p, __ATOMIC_RELAXED, __HIP_MEMORY_SCOPE_AGENT); }
__device__ __forceinline__ unsigned xb_add(unsigned* p, unsigned v) { return __hip_atomic_fetch_add(p, v, __ATOMIC_RELAXED, __HIP_MEMORY_SCOPE_AGENT); }
__device__ __forceinline__ unsigned xb_xcc_id() { return (unsigned)__builtin_amdgcn_s_getreg((3 << 11) | 20) & 0xFu; }
#define XB_SPIN(cond, bar) do { unsigned _sp = 0; while (cond) { __builtin_amdgcn_s_sleep(1); \
    if ((++_sp & 255u) == 0u) { if (xb_ld(&(bar)[XB_TMO])) break; if (_sp > XB_SPIN_CAP) { atomicAdd(&(bar)[XB_TMO], 1u); break; } } } } while (0)

struct XcdBarrier {
    unsigned* bar; unsigned x;
    volatile LAS unsigned* st;
};

__device__ __forceinline__ XcdBarrier xcd_barrier_post(unsigned* bar, volatile LAS unsigned* st) {
    XcdBarrier b; b.bar = bar; b.x = xb_xcc_id(); b.st = st;
    if (threadIdx.x == 0) (void)xb_add(&bar[XB_XCNT(b.x)], 1u);
    return b;
}
__device__ __forceinline__ void xcd_barrier_complete(unsigned* bar, unsigned x, unsigned& nloc, unsigned& nx) {
    const unsigned G = gridDim.x * gridDim.y * gridDim.z;
    unsigned sum, cnt, mine, sp = 0u;
    for (;;) {
        sum = 0u; cnt = 0u; mine = 0u;
#pragma unroll
        for (unsigned j = 0; j < 16; ++j) { const unsigned c = xb_ld(&bar[XB_XCNT(j)]); sum += c; cnt += (c > 0u) ? 1u : 0u; mine = (j == x) ? c : mine; }
        if (sum == G) break;
        __builtin_amdgcn_s_sleep(1);
        if ((++sp & 255u) == 0u) { if (xb_ld(&bar[XB_TMO])) break; if (sp > XB_SPIN_CAP) { atomicAdd(&bar[XB_TMO], 1u); break; } }
    }
    nloc = mine > 0u ? mine : 1u; nx = cnt > 0u ? cnt : 1u;
}

__device__ __forceinline__ void xcd_barrier(const XcdBarrier& b) {
    asm volatile("s_waitcnt vmcnt(0)" ::: "memory");
    __syncthreads();
    if (threadIdx.x == 0) {
        unsigned* bar = b.bar;
        __builtin_amdgcn_s_waitcnt(0);
        unsigned nloc = b.st[0], nx = b.st[1];
        if (nloc == 0u) { xcd_barrier_complete(bar, b.x, nloc, nx); b.st[0] = nloc; b.st[1] = nx; }
        const unsigned old = xb_add(&bar[XB_XSUB(b.x)], 1u);
        const unsigned gen = old / nloc;
        if (old + 1u == (gen + 1u) * nloc) {
            __builtin_amdgcn_fence(__ATOMIC_RELEASE, "agent");
            asm volatile("s_waitcnt vmcnt(0)" ::: "memory");
            const unsigned og = xb_add(&bar[XB_TOP], 1u);
            const unsigned tg = og / nx;
            if (og + 1u == (tg + 1u) * nx) xb_add(&bar[XB_TOPGEN], 1u);
            else XB_SPIN(xb_ld(&bar[XB_TOPGEN]) == tg, bar);
            __builtin_amdgcn_fence(__ATOMIC_ACQUIRE, "agent");
            xb_add(&bar[XB_XGEN(b.x)], 1u);
            asm volatile("s_waitcnt vmcnt(0)" ::: "memory");
        } else {
            XB_SPIN(xb_ld(&bar[XB_XGEN(b.x)]) == gen, bar);
            __builtin_amdgcn_fence(__ATOMIC_ACQUIRE, "agent");
            asm volatile("s_waitcnt vmcnt(0)" ::: "memory");
        }
    }
    __syncthreads();
}

__global__ void __launch_bounds__(NWAVES * 64, 2) fwd_megakernel(Args a) {
    extern __shared__ __attribute__((aligned(16))) unsigned char lds[];
    cg::grid_group grid = cg::this_grid();
    LAS unsigned char* L8 = (LAS unsigned char*)lds;
    LAS float* L = (LAS float*)lds;
    const int tid = threadIdx.x, lane = tid & 63, wave = __builtin_amdgcn_readfirstlane(tid >> 6);
    const int G = gridDim.x, gw = blockIdx.x * NWAVES + wave, NGW = G * NWAVES;
    unsigned char* ws = a.ws;
    unsigned* ctl = (unsigned*)(ws + WS_CTL);
    const float* x = a.in[0];
    bf16* XN = (bf16*)(ws + WS_XN); bf16* ACT = (bf16*)(ws + WS_ACT); bf16* PROJ = ACT; bf16* MIX = XN;
    bf16* Wgu1 = (bf16*)(ws + WS_WGU1); bf16* Wd1 = (bf16*)(ws + WS_WD1); bf16* Win = (bf16*)(ws + WS_WIN); bf16* Wout = (bf16*)(ws + WS_WOUT);
    bf16* Wgu2 = (bf16*)(ws + WS_WGU2); bf16* Wd2 = (bf16*)(ws + WS_WD2);
    float* out = a.out;
    volatile LAS unsigned* xbst = (volatile LAS unsigned*)(L8 + LDS_BYTES - 64);
    if (tid < 2) xbst[tid] = 0u;
    __syncthreads();
    XcdBarrier bar = xcd_barrier_post(ctl + 1024, xbst);
#define GSYNC() xcd_barrier(bar)

    {
        const int lane = opq(tid) & 63;
        LAS float* scr = L + wave * 4096;
        constexpr int I_GU = (D / 64) * (NGU / 32), I_D = (FF / 64) * (D / 32), I_IN = (D / 64) * (NIN / 32), I_O = (D / 64) * (D / 32);
        constexpr int NITEMS = 2 * I_GU + 2 * I_D + I_IN + I_O;
        for (int it = gw; it < NITEMS; it += NGW) {
            int r = it;
            if (r < I_GU) { tr_gu(a.in[2], a.in[3], Wgu1, r, scr, lane); continue; } r -= I_GU;
            if (r < I_D) { tr_plain(a.in[4], FF, D, Wd1, r, scr, lane); continue; } r -= I_D;
            if (r < I_IN) { tr_win(a.in[6], Win, r, scr, lane); continue; } r -= I_IN;
            if (r < I_O) { tr_plain(a.in[11], D, D, Wout, r, scr, lane); continue; } r -= I_O;
            if (r < I_GU) { tr_gu(a.in[13], a.in[14], Wgu2, r, scr, lane); continue; } r -= I_GU;
            tr_plain(a.in[15], FF, D, Wd2, r, scr, lane);
        }
        for (int m = gw; m < M; m += NGW) { f32x4 v[4]; rms_row(x + (size_t)m * D, a.in[1], lane, v); store_row_bf16(XN + (size_t)m * D, lane, v); }
    }
    grid.sync();
    {
        pg8::Gemm g{XN, Wgu1, M, NGU, D}; pg8::StaticOrder S; S.init(M, NGU, G, (int)blockIdx.x);
        pg8::EpiSwiGLU E{ACT, FF};
        pg8::gemm_phase<pg8::EpiSwiGLU, pg8::StaticOrder, true, true>(L8, g, S, E);
    }
    GSYNC();
    {
        pg8::Gemm g{ACT, Wd1, M, D, FF}; pg8::StaticOrder S; S.init(M, D, G, (int)blockIdx.x);
        pg8::EpiRes E{x, out, D, 0.5f};
        pg8::gemm_phase<pg8::EpiRes, pg8::StaticOrder, true, true>(L8, g, S, E);
    }
    GSYNC();
    {
        const int lane = opq(tid) & 63;
        const float* w_in = a.in[6]; float* BD = (float*)(ws + WS_BD);
        for (int m = gw; m < M; m += NGW) {
            f32x4 v[4]; rms_row(out + (size_t)m * D, a.in[5], lane, v); store_row_bf16(XN + (size_t)m * D, lane, v);
            float acc[8];
#pragma unroll
            for (int o = 0; o < 8; ++o) acc[o] = 0.f;
#pragma unroll
            for (int j = 0; j < 4; ++j)
#pragma unroll
                for (int i = 0; i < 4; ++i) { const int k = 4 * (lane + 64 * j) + i; const f32x4 w0 = *(const f32x4*)(w_in + (size_t)k * WIN_COLS + 3072), w1 = *(const f32x4*)(w_in + (size_t)k * WIN_COLS + 3076);
                    const float hv = v[j][i];
                    acc[0] += hv * w0.x; acc[1] += hv * w0.y; acc[2] += hv * w0.z; acc[3] += hv * w0.w; acc[4] += hv * w1.x; acc[5] += hv * w1.y; acc[6] += hv * w1.z; acc[7] += hv * w1.w; }
#pragma unroll
            for (int o = 0; o < 8; ++o) acc[o] = wave_sum(acc[o]);
            if (lane == 0) { *(f32x4*)(BD + (size_t)m * 8) = (f32x4){acc[0], acc[1], acc[2], acc[3]}; *(f32x4*)(BD + (size_t)m * 8 + 4) = (f32x4){acc[4], acc[5], acc[6], acc[7]}; }
        }
    }
    GSYNC();
    {
        pg8::Gemm g{XN, Win, M, NIN, D}; pg8::StaticOrder S; S.init(M, NIN, G, (int)blockIdx.x);
        pg8::EpiProj E{(bf16*)(ws + WS_QH), (bf16*)(ws + WS_KVH), PROJ};
        pg8::gemm_phase<pg8::EpiProj, pg8::StaticOrder, true, true>(L8, g, S, E);
    }
    GSYNC();
    { const int tid_ = opq(tid); for (int ch = blockIdx.x; ch < 1024; ch += G) dn_prep_item(a, L8, ch, tid_, tid_ & 63, wave); }
    GSYNC();
    {
        const int tid_ = opq(tid), lane = tid_ & 63;
        for (int it = blockIdx.x; it < 64; it += G) dn_scan_mfma(a, L8, it, tid_, lane, wave);
        float* ML = (float*)(ws + WS_ML);
        if ((int)blockIdx.x >= 64 || G <= 64) {
            const int nb = (G > 64) ? G - 64 : G, j0 = (G > 64) ? (int)blockIdx.x - 64 : (int)blockIdx.x;
            for (int item = j0; item < 1536; item += nb) attn_item((const bf16*)(ws + WS_QH), (const bf16*)(ws + WS_KVH), PROJ, ML, L8, item, tid, lane, wave);
        }
    }
    GSYNC();
    {
        const int lane = opq(tid) & 63;
        const float* dn_norm = a.in[10];
        for (int m = gw; m < M; m += NGW) {
            bf16* op = MIX + (size_t)m * 1024 + 512 + 8 * lane; const bf16* gp = PROJ + (size_t)m * P2LD + 1536 + 8 * lane;
            const v4u ow = *(const v4u*)op, gwv = *(const v4u*)gp;
            float o[8] = {bflo(ow.x), bfhi(ow.x), bflo(ow.y), bfhi(ow.y), bflo(ow.z), bfhi(ow.z), bflo(ow.w), bfhi(ow.w)};
            float gt[8] = {bflo(gwv.x), bfhi(gwv.x), bflo(gwv.y), bfhi(gwv.y), bflo(gwv.z), bfhi(gwv.z), bflo(gwv.w), bfhi(gwv.w)};
            float ss = 0.f;
#pragma unroll
            for (int i = 0; i < 8; ++i) ss += o[i] * o[i];
            ss += __shfl_xor(ss, 1); ss += __shfl_xor(ss, 2); ss += __shfl_xor(ss, 4); ss += __shfl_xor(ss, 8);
            const float rs = 1.0f / sqrtf(ss * (1.f / 128.f) + 1e-6f);
            const int d0 = (8 * lane) & 127;
            float r[8];
#pragma unroll
            for (int i = 0; i < 8; ++i) r[i] = o[i] * rs * dn_norm[d0 + i] * (gt[i] / (1.f + __expf(-gt[i])));
            v4u w; w.x = pk2(r[0], r[1]); w.y = pk2(r[2], r[3]); w.z = pk2(r[4], r[5]); w.w = pk2(r[6], r[7]);
            *(v4u*)op = w;
            {
                const int ha = lane >> 3;
                const float* ml = (const float*)(ws + WS_ML) + ((size_t)m * 8 + ha) * 6;
                const f32x2 a0 = *(const f32x2*)ml, a1 = *(const f32x2*)(ml + 2), a2 = *(const f32x2*)(ml + 4);
                const float mm = fmaxf(a0.x, fmaxf(a1.x, a2.x));
                const float w0 = a0.y * __builtin_amdgcn_exp2f(a0.x - mm), w1 = a1.y * __builtin_amdgcn_exp2f(a1.x - mm), w2 = a2.y * __builtin_amdgcn_exp2f(a2.x - mm);
                const float iw = 1.0f / (w0 + w1 + w2);
                const bf16* pp = PROJ + (size_t)m * P2LD + 8 * lane;
                const v4u p0 = *(const v4u*)pp, p1 = *(const v4u*)(pp + 512), p2 = *(const v4u*)(pp + 1024);
                float rr[8];
                rr[0] = w0 * bflo(p0.x) + w1 * bflo(p1.x) + w2 * bflo(p2.x); rr[1] = w0 * bfhi(p0.x) + w1 * bfhi(p1.x) + w2 * bfhi(p2.x);
                rr[2] = w0 * bflo(p0.y) + w1 * bflo(p1.y) + w2 * bflo(p2.y); rr[3] = w0 * bfhi(p0.y) + w1 * bfhi(p1.y) + w2 * bfhi(p2.y);
                rr[4] = w0 * bflo(p0.z) + w1 * bflo(p1.z) + w2 * bflo(p2.z); rr[5] = w0 * bfhi(p0.z) + w1 * bfhi(p1.z) + w2 * bfhi(p2.z);
                rr[6] = w0 * bflo(p0.w) + w1 * bflo(p1.w) + w2 * bflo(p2.w); rr[7] = w0 * bfhi(p0.w) + w1 * bfhi(p1.w) + w2 * bfhi(p2.w);
                v4u wa; wa.x = pk2(rr[0] * iw, rr[1] * iw); wa.y = pk2(rr[2] * iw, rr[3] * iw); wa.z = pk2(rr[4] * iw, rr[5] * iw); wa.w = pk2(rr[6] * iw, rr[7] * iw);
                *(v4u*)(MIX + (size_t)m * 1024 + 8 * lane) = wa;
            }
        }
    }
    GSYNC();
    {
        pg8::Gemm g{MIX, Wout, M, D, D}; pg8::StaticOrder S; S.init(M, D, G, (int)blockIdx.x);
        pg8::EpiRes E{out, out, D, 1.0f};
        pg8::gemm_phase<pg8::EpiRes, pg8::StaticOrder, true, true>(L8, g, S, E);
    }
    GSYNC();
    { const int ln = opq(tid) & 63; for (int m = gw; m < M; m += NGW) { f32x4 v[4]; rms_row(out + (size_t)m * D, a.in[12], ln, v); store_row_bf16(XN + (size_t)m * D, ln, v); } }
    GSYNC();
    {
        pg8::Gemm g{XN, Wgu2, M, NGU, D}; pg8::StaticOrder S; S.init(M, NGU, G, (int)blockIdx.x);
        pg8::EpiSwiGLU E{ACT, FF};
        pg8::gemm_phase<pg8::EpiSwiGLU, pg8::StaticOrder, true, true>(L8, g, S, E);
    }
    GSYNC();
    {
        pg8::Gemm g{ACT, Wd2, M, D, FF}; pg8::StaticOrder S; S.init(M, D, G, (int)blockIdx.x);
        pg8::EpiRes E{out, out, D, 0.5f};
        pg8::gemm_phase<pg8::EpiRes, pg8::StaticOrder, true, true>(L8, g, S, E);
    }
    GSYNC();
    const int lnf = opq(tid) & 63;
    for (int m = gw; m < M; m += NGW) {
        f32x4 v[4]; rms_row(out + (size_t)m * D, a.in[16], lnf, v);
        f32x4* o = (f32x4*)(out + (size_t)m * D) + lnf;
#pragma unroll
        for (int j = 0; j < 4; ++j) o[64 * j] = v[j];
    }
}

extern "C" void kernel_launch(void* const* d_in, const int* in_sizes, int n_in, void* d_out, int out_size, void* d_ws, size_t ws_size, hipStream_t stream) {
    static int grid = 0;
    if (grid == 0) {
        if (n_in != 17 || in_sizes[0] != M * D || out_size != M * D || ws_size < WS_END) { fprintf(stderr, "kernel_launch: unexpected shapes (n_in %d in0 %d out %d ws %zu)\n", n_in, n_in > 0 ? in_sizes[0] : -1, out_size, ws_size); grid = -1; return; }
        int dev = 0, cus = 0, per_cu = 0;
        hipGetDevice(&dev); hipDeviceGetAttribute(&cus, hipDeviceAttributeMultiprocessorCount, dev);
        if (hipFuncSetAttribute((const void*)fwd_megakernel, hipFuncAttributeMaxDynamicSharedMemorySize, LDS_BYTES) != hipSuccess) { fprintf(stderr, "kernel_launch: hipFuncSetAttribute failed\n"); grid = -1; return; }
        if (hipOccupancyMaxActiveBlocksPerMultiprocessor(&per_cu, (const void*)fwd_megakernel, NWAVES * 64, LDS_BYTES) != hipSuccess || per_cu < 1) { fprintf(stderr, "kernel_launch: occupancy query says %d blocks/CU\n", per_cu); (void)hipGetLastError(); per_cu = 1; }
        grid = cus * 1;
        fprintf(stderr, "kernel_launch: cus %d per_cu %d grid %d\n", cus, per_cu, grid);
    }
    if (grid < 0) return;
    hipMemsetAsync((char*)d_ws + WS_CTL, 0, CTL_BYTES, stream);
    Args a{};
    for (int i = 0; i < 17; ++i) a.in[i] = (const float*)d_in[i];
    a.out = (float*)d_out; a.ws = (unsigned char*)d_ws;
    void* args[] = {&a};
    hipError_t e = hipLaunchCooperativeKernel((const void*)fwd_megakernel, dim3(grid), dim3(NWAVES * 64), args, LDS_BYTES, stream);
    if (e != hipSuccess) fprintf(stderr, "cooperative launch failed: %s (grid %d)\n", hipGetErrorString(e), grid);
}
```

```cpp
#include <hip/hip_runtime.h>
#include <hip/hip_cooperative_groups.h>
#include <cstdio>
#include <cstdint>
namespace cg = cooperative_groups;
namespace pg8 {
#define PG8_LAS __attribute__((address_space(3)))
typedef unsigned short bf16_t;
typedef short bf16x8 __attribute__((ext_vector_type(8)));
typedef float f32x4 __attribute__((ext_vector_type(4)));
typedef unsigned u32x4 __attribute__((ext_vector_type(4)));
constexpr int BM = 256, BK = 64, HALF = 128, HTB = HALF * BK * 2  , STAGE_BYTES = 8 * HTB, NXCD = 8, WGM = 8;

__host__ __device__ __forceinline__ int lds_byte(int r, int c) { const int st = (r >> 4) * 2 + (c >> 5), rr = r & 15, cc = c & 31, ob = rr * 64 + cc * 2; return st * 1024 + (ob ^ (((ob >> 9) & 1) << 5)); }
__host__ __device__ __forceinline__ void stage_rc(int b, int& R, int& C) { const int st = b / 1024, sb = b % 1024, swz = sb ^ (((sb >> 9) & 1) << 5); R = (st >> 1) * 16 + swz / 64; C = (st & 1) * 32 + (swz % 64) / 2; }
__host__ __device__ __forceinline__ int perm32(int rho) { const int n = rho >> 4, i = rho & 15; return 8 * (i >> 2) + 4 * n + (i & 3); }

struct Unit { int pm, pn; };
struct Gemm { const bf16_t* A; const bf16_t* Bt; int M, N, K; };

struct StaticOrder {
    int nM, nN, nwg, G, c;
    __host__ __device__ void init(int M, int N, int G_, int c_) { nM = M / BM; nN = N / BM; nwg = nM * nN; G = G_; c = c_; }
    __host__ __device__ bool next(int i, Unit& u) const {
        const long L = (long)i * G + c; if (L >= nwg) return false;
        int wgid = (int)L; { const int q = nwg / NXCD, r = nwg % NXCD, xcd = wgid % NXCD, off = wgid / NXCD; wgid = (xcd < r ? xcd * (q + 1) : r * (q + 1) + (xcd - r) * q) + off; }
        const int nig = WGM * nN, gid = wgid / nig, fm = gid * WGM, gsz = (nM - fm) < WGM ? (nM - fm) : WGM;
        u.pm = fm + ((wgid % nig) % gsz); u.pn = (wgid % nig) / gsz; return true;
    }
    __device__ __forceinline__ void a_ready(const Unit&) const {}
    __device__ __forceinline__ void done(const Unit&) const {}
};

__device__ __forceinline__ unsigned cvt_pk_bf16(float lo, float hi) { unsigned r; asm volatile("v_cvt_pk_bf16_f32 %0, %1, %2" : "=v"(r) : "v"(lo), "v"(hi)); return r; }
__device__ __forceinline__ float silu_f(float g) { return g * __builtin_amdgcn_rcpf(1.0f + __expf(-g)); }
struct EpiSwiGLU {
    static constexpr bool PERM = true, AFTER_DRAIN = false;
    bf16_t* O; int ldc;
    __device__ __forceinline__ void operator()(const f32x4 (&acc)[2][2][4][2], const Unit& u, int wr, int wc, int fr, int fq) const {
        const int row0 = u.pm * BM + wr * 64 + fr; const int col0 = u.pn * 128 + wc * 32 + 8 * fq;
#pragma unroll
        for (int ai = 0; ai < 2; ++ai)
#pragma unroll
            for (int m = 0; m < 4; ++m) { bf16_t* rowp = O + (size_t)(row0 + ai * HALF + m * 16) * ldc + col0;
                const f32x4 g0 = acc[ai][0][m][0], g1 = acc[ai][0][m][1], u0 = acc[ai][1][m][0], u1 = acc[ai][1][m][1];
                u32x4 w;
                w.x = cvt_pk_bf16(silu_f(g0[0]) * u0[0], silu_f(g0[1]) * u0[1]); w.y = cvt_pk_bf16(silu_f(g0[2]) * u0[2], silu_f(g0[3]) * u0[3]);
                w.z = cvt_pk_bf16(silu_f(g1[0]) * u1[0], silu_f(g1[1]) * u1[1]); w.w = cvt_pk_bf16(silu_f(g1[2]) * u1[2], silu_f(g1[3]) * u1[3]);
                *(u32x4*)rowp = w; }
    }
};
struct EpiRes {
    static constexpr bool PERM = false, AFTER_DRAIN = false;
    const float* base; float* out; int ldc; float scale;
    __device__ __forceinline__ void operator()(const f32x4 (&acc)[2][2][4][2], const Unit& u, int wr, int wc, int fr, int fq) const {
        const int row0 = u.pm * BM + wr * 64 + fr; const int col0 = u.pn * BM + wc * 32 + 4 * fq;
#pragma unroll
        for (int ai = 0; ai < 2; ++ai)
#pragma unroll
            for (int m = 0; m < 4; ++m) { const size_t off = (size_t)(row0 + ai * HALF + m * 16) * ldc + col0;
#pragma unroll
                for (int bj = 0; bj < 2; ++bj)
#pragma unroll
                    for (int n = 0; n < 2; ++n) { const f32x4 b = *(const f32x4*)(base + off + bj * HALF + n * 16); *(f32x4*)(out + off + bj * HALF + n * 16) = b + acc[ai][bj][m][n] * scale; }
                asm volatile("" ::: "memory"); }
    }
};
struct EpiProj {
    static constexpr bool PERM = true, AFTER_DRAIN = false;
    bf16_t* Qh; bf16_t* KVh; bf16_t* P2;
    __device__ __forceinline__ void operator()(const f32x4 (&acc)[2][2][4][2], const Unit& u, int wr, int wc, int fr, int fq) const {
        const int row0 = u.pm * BM + wr * 64 + fr;
#pragma unroll
        for (int ai = 0; ai < 2; ++ai)
#pragma unroll
            for (int m = 0; m < 4; ++m) { const int row = row0 + ai * HALF + m * 16, bb = row >> 12, t = row & 4095;
#pragma unroll
                for (int bj = 0; bj < 2; ++bj) { const int col = u.pn * BM + bj * HALF + wc * 32 + 8 * fq;
                    bf16_t* dst;
                    if (u.pn < 6) { const int sec = col >> 9, hc = col & 511, hh = hc >> 6, d = hc & 63; const size_t rt = (size_t)(bb * 8 + hh) * 4096 + t;
                        dst = (sec == 0) ? Qh + rt * 64 + d : KVh + rt * 128 + (sec - 1) * 64 + d; }
                    else dst = P2 + (size_t)row * 2048 + (col - 1536);
                    const f32x4 v0 = acc[ai][bj][m][0], v1 = acc[ai][bj][m][1]; u32x4 w;
                    w.x = cvt_pk_bf16(v0[0], v0[1]); w.y = cvt_pk_bf16(v0[2], v0[3]); w.z = cvt_pk_bf16(v1[0], v1[1]); w.w = cvt_pk_bf16(v1[2], v1[3]);
                    *(u32x4*)dst = w; } }
    }
};
struct EpiStoreBf16 {
    static constexpr bool PERM = true, AFTER_DRAIN = false;
    bf16_t* O; int ldc;
    __device__ __forceinline__ void operator()(const f32x4 (&acc)[2][2][4][2], const Unit& u, int wr, int wc, int fr, int fq) const {
        const int row0 = u.pm * BM + wr * 64 + fr; const int col0 = u.pn * BM + wc * 32 + 8 * fq;
#pragma unroll
        for (int ai = 0; ai < 2; ++ai)
#pragma unroll
            for (int m = 0; m < 4; ++m) { bf16_t* rowp = O + (size_t)(row0 + ai * HALF + m * 16) * ldc + col0;
#pragma unroll
                for (int bj = 0; bj < 2; ++bj) { const f32x4 v0 = acc[ai][bj][m][0], v1 = acc[ai][bj][m][1]; u32x4 w;
                    w.x = cvt_pk_bf16(v0[0], v0[1]); w.y = cvt_pk_bf16(v0[2], v0[3]); w.z = cvt_pk_bf16(v1[0], v1[1]); w.w = cvt_pk_bf16(v1[2], v1[3]);
                    *(u32x4*)(rowp + bj * HALF) = w; } }
    }
};
template <class Epi, class Sched, bool ALIGN_EPI = false, bool SP2 = false>
__device__ __forceinline__ void gemm_phase(PG8_LAS unsigned char* lds, const Gemm g, const Sched& S, const Epi& E) {
    const int tid = threadIdx.x, wid = __builtin_amdgcn_readfirstlane(tid >> 6), lane = tid & 63, wr = wid >> 2, wc = wid & 3, fr = lane & 15, fq = lane >> 4;
    const int K = g.K, nt = K / BK;
    unsigned voffA[2], voffB[2];
#pragma unroll
    for (int i = 0; i < 2; ++i) { int R, C; stage_rc(tid * 16 + i * 8192, R, C); const int Rb = Epi::PERM ? ((R & ~31) + perm32(R & 31)) : R;
        voffA[i] = (unsigned)(R * K + C) * 2u; voffB[i] = (unsigned)(Rb * K + C) * 2u; }
    const size_t kstep = (size_t)(BK * 2);
    const size_t hstep = (size_t)HALF * K * 2;
    const size_t tstep = 2 * hstep;
    const unsigned ldsw = (unsigned)wid * 1024u;
    const int aoff = lds_byte(wr * 64 + fr, fq * 8), boff = lds_byte(wc * 32 + fr, fq * 8);
#define PG8_SA(b, h) (((b) * 2 + (h)) * HTB)
#define PG8_SB(b, h) ((4 + (b) * 2 + (h)) * HTB)
#define PG8_STAGE(bufoff, gbase, voff) do { _Pragma("unroll") for (int _i = 0; _i < 2; ++_i) \
        __builtin_amdgcn_global_load_lds((const unsigned*)((const char*)(gbase) + (voff)[_i]), (PG8_LAS unsigned*)(lds + (bufoff) + ldsw + _i * 8192), 16, 0, 0); } while (0)
#define PG8_LDA(dst, b, h) do { _Pragma("unroll") for (int m = 0; m < 4; ++m) _Pragma("unroll") for (int k = 0; k < 2; ++k) dst[m][k] = *(const PG8_LAS bf16x8*)(lds + PG8_SA(b, h) + aoff + m * 2048 + k * 1024); } while (0)
#define PG8_LDB(dst, b, h) do { _Pragma("unroll") for (int n = 0; n < 2; ++n) _Pragma("unroll") for (int k = 0; k < 2; ++k) dst[n][k] = *(const PG8_LAS bf16x8*)(lds + PG8_SB(b, h) + boff + n * 2048 + k * 1024); } while (0)
#define PG8_MMA(ai, bj, At, Bt) do { __builtin_amdgcn_s_setprio(1); _Pragma("unroll") for (int m = 0; m < 4; ++m) _Pragma("unroll") for (int n = 0; n < 2; ++n) _Pragma("unroll") for (int k = 0; k < 2; ++k) \
        acc[ai][bj][m][n] = __builtin_amdgcn_mfma_f32_16x16x32_bf16(Bt[n][k], At[m][k], acc[ai][bj][m][n], 0, 0, 0); __builtin_amdgcn_s_setprio(0); } while (0)
#define PG8_WAIT_V(n) asm volatile("s_waitcnt vmcnt(" #n ")" ::: "memory")
#define PG8_WAIT_L(n) asm volatile("s_waitcnt lgkmcnt(" #n ")" ::: "memory")
#define PG8_BAR __builtin_amdgcn_s_barrier()
#define PG8_SCHED __builtin_amdgcn_sched_barrier(0)
    Unit cur, nxt; int ui = 0;
    if (!S.next(0, cur)) return;
    f32x4 acc[2][2][4][2];
#pragma unroll
    for (int a = 0; a < 2; ++a)
#pragma unroll
        for (int b = 0; b < 2; ++b)
#pragma unroll
            for (int m = 0; m < 4; ++m)
#pragma unroll
                for (int n = 0; n < 2; ++n) acc[a][b][m][n] = (f32x4){0.f, 0.f, 0.f, 0.f};
    bf16x8 At[4][2], B0[2][2], B1[2][2];
    const char* cA = (const char*)g.A + (size_t)cur.pm * tstep; const char* cB = (const char*)g.Bt + (size_t)cur.pn * tstep;
    S.a_ready(cur);
    if constexpr (SP2) {
        PG8_STAGE(PG8_SB(0, 0), cB, voffB); PG8_STAGE(PG8_SB(0, 1), cB + hstep, voffB); PG8_STAGE(PG8_SA(0, 0), cA, voffA); PG8_STAGE(PG8_SA(0, 1), cA + hstep, voffA);
        if (wr == 1) PG8_BAR;
        PG8_WAIT_V(2); PG8_BAR;
        PG8_STAGE(PG8_SB(1, 0), cB + kstep, voffB); PG8_STAGE(PG8_SA(1, 0), cA + kstep, voffA); PG8_STAGE(PG8_SB(1, 1), cB + hstep + kstep, voffB);
        PG8_WAIT_V(6); PG8_BAR;
    } else {
        PG8_STAGE(PG8_SB(0, 0), cB, voffB); PG8_STAGE(PG8_SA(0, 0), cA, voffA); PG8_STAGE(PG8_SB(0, 1), cB + hstep, voffB); PG8_STAGE(PG8_SA(0, 1), cA + hstep, voffA);
        if (wr == 1) PG8_BAR;
        PG8_WAIT_V(4); PG8_BAR;
        PG8_STAGE(PG8_SB(1, 0), cB + kstep, voffB); PG8_STAGE(PG8_SA(1, 0), cA + kstep, voffA); PG8_STAGE(PG8_SB(1, 1), cB + hstep + kstep, voffB);
        PG8_WAIT_V(6); PG8_BAR;
    }
    for (;;) {
        const bool has_next = S.next(ui + 1, nxt);
        const char* nA = has_next ? (const char*)g.A + (size_t)nxt.pm * tstep : cA; const char* nB = has_next ? (const char*)g.Bt + (size_t)nxt.pn * tstep : cB;
        for (int t = 0; t < nt; t += 2) {
            const bool last = (t == nt - 2);
            const char* a1 = cA + (size_t)(t + 1) * kstep;
            const char* a2 = last ? nA : cA + (size_t)(t + 2) * kstep; const char* b2 = last ? nB : cB + (size_t)(t + 2) * kstep;
            const char* a3 = a2 + kstep; const char* b3 = b2 + kstep;
            if (last && has_next) S.a_ready(nxt);
            if constexpr (SP2) {
            PG8_LDB(B0, 0, 0); PG8_LDB(B1, 0, 1); PG8_SCHED; PG8_LDA(At, 0, 0); PG8_STAGE(PG8_SA(1, 1), a1 + hstep, voffA);
            PG8_WAIT_V(8); PG8_WAIT_L(0); PG8_BAR; PG8_MMA(0, 0, At, B0); PG8_MMA(0, 1, At, B1); PG8_BAR; PG8_SCHED;
            PG8_LDA(At, 0, 1); PG8_STAGE(PG8_SB(0, 0), b2, voffB); PG8_STAGE(PG8_SB(0, 1), b2 + hstep, voffB); PG8_STAGE(PG8_SA(0, 0), a2, voffA);
            PG8_WAIT_V(8); PG8_WAIT_L(0); PG8_BAR; PG8_MMA(1, 0, At, B0); PG8_MMA(1, 1, At, B1); PG8_BAR; PG8_SCHED;
            PG8_LDB(B0, 1, 0); PG8_LDB(B1, 1, 1); PG8_SCHED; PG8_LDA(At, 1, 0); PG8_STAGE(PG8_SA(0, 1), a2 + hstep, voffA);
            PG8_WAIT_V(8); PG8_WAIT_L(0); PG8_BAR; PG8_MMA(0, 0, At, B0); PG8_MMA(0, 1, At, B1); PG8_BAR; PG8_SCHED;
            PG8_LDA(At, 1, 1); PG8_STAGE(PG8_SB(1, 0), b3, voffB); PG8_STAGE(PG8_SB(1, 1), b3 + hstep, voffB); PG8_STAGE(PG8_SA(1, 0), a3, voffA);
            PG8_WAIT_V(8); PG8_WAIT_L(0); PG8_BAR; PG8_MMA(1, 0, At, B0); PG8_MMA(1, 1, At, B1); PG8_BAR; PG8_SCHED;
            } else {
            PG8_LDB(B0, 0, 0); PG8_SCHED; PG8_LDA(At, 0, 0); PG8_STAGE(PG8_SA(1, 1), a1 + hstep, voffA);
            PG8_WAIT_L(8); PG8_BAR; PG8_WAIT_L(0); PG8_MMA(0, 0, At, B0); PG8_BAR; PG8_SCHED;
            PG8_LDB(B1, 0, 1); PG8_STAGE(PG8_SB(0, 0), b2, voffB);
            PG8_BAR; PG8_WAIT_L(0); PG8_MMA(0, 1, At, B1); PG8_BAR;
            PG8_LDA(At, 0, 1); PG8_STAGE(PG8_SA(0, 0), a2, voffA);
            PG8_BAR; PG8_WAIT_L(0); PG8_MMA(1, 0, At, B0); PG8_BAR; PG8_SCHED;
            PG8_STAGE(PG8_SB(0, 1), b2 + hstep, voffB);
            PG8_WAIT_V(6); PG8_BAR; PG8_MMA(1, 1, At, B1); PG8_BAR;
            PG8_LDB(B0, 1, 0); PG8_SCHED; PG8_LDA(At, 1, 0); PG8_STAGE(PG8_SA(0, 1), a2 + hstep, voffA);
            PG8_WAIT_L(8); PG8_BAR; PG8_WAIT_L(0); PG8_MMA(0, 0, At, B0); PG8_BAR; PG8_SCHED;
            PG8_LDB(B1, 1, 1); PG8_STAGE(PG8_SB(1, 0), b3, voffB);
            PG8_BAR; PG8_WAIT_L(0); PG8_MMA(0, 1, At, B1); PG8_BAR;
            PG8_LDA(At, 1, 1); PG8_STAGE(PG8_SA(1, 0), a3, voffA);
            PG8_BAR; PG8_WAIT_L(0); PG8_MMA(1, 0, At, B0); PG8_BAR; PG8_SCHED;
            PG8_STAGE(PG8_SB(1, 1), b3 + hstep, voffB);
            PG8_WAIT_V(6); PG8_BAR; PG8_MMA(1, 1, At, B1); PG8_BAR;
            }
        }
        if constexpr (ALIGN_EPI) { if (wr == 0) PG8_BAR; }
        if constexpr (!Epi::AFTER_DRAIN) { E(acc, cur, wr, wc, fr, fq); S.done(cur); }
        if (!has_next) break;
#pragma unroll
        for (int a = 0; a < 2; ++a)
#pragma unroll
            for (int b = 0; b < 2; ++b)
#pragma unroll
                for (int m = 0; m < 4; ++m)
#pragma unroll
                    for (int n = 0; n < 2; ++n) acc[a][b][m][n] = (f32x4){0.f, 0.f, 0.f, 0.f};
        cur = nxt; cA = nA; cB = nB; ++ui;
        if constexpr (ALIGN_EPI) { if (wr == 1) PG8_BAR; }
    }
    PG8_WAIT_V(0);
    if constexpr (!ALIGN_EPI) { if (wr == 0) PG8_BAR; }
    PG8_BAR;
    if constexpr (Epi::AFTER_DRAIN) { E.fused(acc, cur, wr, wc, fr, fq, lds, wid, lane); S.done(cur); }
#undef PG8_SA
#undef PG8_SB
#undef PG8_STAGE
#undef PG8_LDA
#undef PG8_LDB
#undef PG8_MMA
#undef PG8_WAIT_V
#undef PG8_WAIT_L
#undef PG8_BAR
#undef PG8_SCHED
}
}
constexpr int M = 16384, D = 1024, FF = 2816, NGU = 5632, NIN = 3584, SEQ = 4096;
constexpr int WIN_COLS = 3592;
constexpr size_t MiB = 1u << 20;
constexpr size_t WS_CTL = 0, CTL_BYTES = 65536;
constexpr size_t WS_WIN = 1 * MiB, WS_WOUT = 8 * MiB, WS_WGU2 = 10 * MiB, WS_WD2 = 21 * MiB;
constexpr size_t WS_XN = 27 * MiB;
constexpr size_t WS_ACT = 59 * MiB;
constexpr size_t WS_QH = 123 * MiB, WS_KVH = 139 * MiB;
constexpr int P2LD = 2048;
constexpr size_t WS_BD = 171 * MiB;
constexpr size_t WS_EG = 172 * MiB;
constexpr size_t WS_DN = 184 * MiB;
constexpr size_t WS_WGU1 = 184 * MiB, WS_WD1 = 195 * MiB;
constexpr size_t WS_QG = WS_DN, WS_KD = WS_DN + 16 * MiB, WS_U = WS_DN + 32 * MiB, WS_W = WS_DN + 48 * MiB, WS_A = WS_DN + 64 * MiB;
constexpr size_t WS_END = 256 * MiB;
constexpr int LDS_BYTES = 147456;
constexpr int NWAVES = 8;

#define GAS __attribute__((address_space(1)))
#define LAS __attribute__((address_space(3)))
typedef unsigned short bf16;
typedef unsigned v4u __attribute__((ext_vector_type(4)));
typedef unsigned v2u __attribute__((ext_vector_type(2)));
typedef float f32x4 __attribute__((ext_vector_type(4)));
typedef float f32x2 __attribute__((ext_vector_type(2)));
#define LDS_WAIT() asm volatile("s_waitcnt lgkmcnt(0)" ::: "memory")
__device__ __forceinline__ unsigned f2bf(float f) { unsigned u = __builtin_bit_cast(unsigned, f); return (u + 0x7fffu + ((u >> 16) & 1u)) >> 16; }
__device__ __forceinline__ unsigned pk2(float lo, float hi) { return f2bf(lo) | (f2bf(hi) << 16); }
__device__ __forceinline__ float bflo(unsigned u) { return __uint_as_float(u << 16); }
__device__ __forceinline__ float bfhi(unsigned u) { return __uint_as_float(u & 0xffff0000u); }
__device__ __forceinline__ float bf2f(bf16 v) { return __uint_as_float(((unsigned)v) << 16); }
__device__ __forceinline__ float wave_sum(float v) {
#pragma unroll
    for (int o = 1; o < 64; o <<= 1) v += __shfl_xor(v, o);
    return v;
}
__device__ __forceinline__ float wave_max(float v) {
#pragma unroll
    for (int o = 1; o < 64; o <<= 1) v = fmaxf(v, __shfl_xor(v, o));
    return v;
}

__device__ __forceinline__ int opq(int v) { asm volatile("" : "+v"(v)); return v; }
struct Args { const float* in[17]; float* out; unsigned char* ws; };

__device__ __forceinline__ void transpose_item(const float* src, int srcN, int srccol0, bf16* dst, int dstK, int dstrow0, int k0, LAS float* scr, int lane) {
#pragma unroll 8
    for (int i = 0; i < 32; ++i) { const int kk = 2 * i + (lane >> 5); scr[kk * 33 + (lane & 31)] = src[(size_t)(k0 + kk) * srcN + srccol0 + (lane & 31)]; }
    LDS_WAIT(); asm volatile("" ::: "memory");
    const int c = lane & 7;
#pragma unroll
    for (int j = 0; j < 4; ++j) { const int n = (lane >> 3) + 8 * j; const LAS float* s = scr + (8 * c) * 33 + n;
        v4u o; o.x = pk2(s[0 * 33], s[1 * 33]); o.y = pk2(s[2 * 33], s[3 * 33]); o.z = pk2(s[4 * 33], s[5 * 33]); o.w = pk2(s[6 * 33], s[7 * 33]);
        *(v4u*)(dst + (size_t)(dstrow0 + n) * dstK + k0 + 8 * c) = o; }
    LDS_WAIT(); asm volatile("" ::: "memory");
}
__device__ __forceinline__ void tr_gu(const float* gate, const float* up, bf16* dst, int r, LAS float* scr, int lane) {
    const int nblk = NGU / 32, kb = r / nblk, nb = r % nblk, dstrow0 = nb * 32, pn = dstrow0 >> 8, within = dstrow0 & 255;
    transpose_item(within < 128 ? gate : up, FF, pn * 128 + (within & 127), dst, D, dstrow0, kb * 64, scr, lane);
}
__device__ __forceinline__ void tr_plain(const float* src, int K, int N, bf16* dst, int r, LAS float* scr, int lane) {
    const int nblk = N / 32, kb = r / nblk, nb = r % nblk;
    transpose_item(src, N, nb * 32, dst, K, nb * 32, kb * 64, scr, lane);
}
__device__ __forceinline__ void tr_win(const float* src, bf16* dst, int r, LAS float* scr, int lane) {
    const int nblk = NIN / 32, kb = r / nblk, nb = r % nblk, dstrow0 = nb * 32;
    transpose_item(src, WIN_COLS, dstrow0 + (dstrow0 >= 3072 ? 8 : 0), dst, D, dstrow0, kb * 64, scr, lane);
}

__device__ __forceinline__ void rms_row(const float* xrow, const float* gain, int lane, f32x4 (&v)[4]) {
    const f32x4* xr = (const f32x4*)xrow + lane; const f32x4* gr = (const f32x4*)gain + lane;
    float s = 0.f;
#pragma unroll
    for (int j = 0; j < 4; ++j) { v[j] = xr[64 * j]; s += (v[j].x * v[j].x + v[j].y * v[j].y) + (v[j].z * v[j].z + v[j].w * v[j].w); }
    const float rs = 1.0f / sqrtf(wave_sum(s) * (1.f / D) + 1e-6f);
#pragma unroll
    for (int j = 0; j < 4; ++j) { const f32x4 g = gr[64 * j]; v[j] = v[j] * rs * g; }
}
__device__ __forceinline__ void store_row_bf16(bf16* orow, int lane, const f32x4 (&v)[4]) {
    v2u* o8 = (v2u*)orow + lane;
#pragma unroll
    for (int j = 0; j < 4; ++j) { v2u w; w.x = pk2(v[j].x, v[j].y); w.y = pk2(v[j].z, v[j].w); o8[64 * j] = w; }
}

__device__ __forceinline__ int kperm(int x) { return 8 * ((x & 15) >> 2) + 4 * (x >> 4) + (x & 3); }
typedef short bf16x8 __attribute__((ext_vector_type(8)));
typedef __bf16 bf16x2_t __attribute__((ext_vector_type(2)));
__device__ __forceinline__ unsigned cvtpk(float lo, float hi) { f32x2 v = {lo, hi}; bf16x2_t b = __builtin_convertvector(v, bf16x2_t); return __builtin_bit_cast(unsigned, b); }
constexpr int PQ = 0, PK = 17408, PVB = 34816, PKB = 53248, PAS = 71680, PTS = 88320, PMS = 104960, PTB = 121600, PGC = 130816;
__device__ __forceinline__ void dn_prep_item(const Args& a, LAS unsigned char* L8, int ch, int tid, int lane, int wave) {
    unsigned char* ws = a.ws;
    const bf16* PROJ = (const bf16*)(ws + WS_ACT);
    const float* BD = (const float*)(ws + WS_BD);
    const float* conv_w = a.in[7]; const float* a_log = a.in[8]; const float* dt_bias = a.in[9];
    const int bh = ch >> 6, n = ch & 63, b = bh >> 2, h = bh & 3;
    const int tok0 = b * SEQ + n * 64;
    LAS float* As = (LAS float*)(L8 + PAS); LAS float* Ts = (LAS float*)(L8 + PTS); LAS float* Ms = (LAS float*)(L8 + PMS);
    LAS float* gcs = (LAS float*)(L8 + PGC); LAS float* bts = gcs + 64;
    const int jl = lane & 15, kq = lane >> 4;
    unsigned raw[11][3];
#pragma unroll
    for (int i = 0; i < 11; ++i) { const int s = n * 64 + wave * 8 - 3 + i;
#pragma unroll
        for (int sec = 0; sec < 3; ++sec) raw[i][sec] = (s >= 0) ? *(const unsigned*)(PROJ + (size_t)(tok0 + wave * 8 - 3 + i) * P2LD + sec * 512 + h * 128 + 2 * lane) : 0u; }
    if (wave == 0) {
        const int tok = tok0 + lane;
        const float braw = BD[(size_t)tok * 8 + h], draw = BD[(size_t)tok * 8 + 4 + h] + dt_bias[h];
        const float sp = fmaxf(draw, 0.f) + log1pf(__expf(-fabsf(draw)));
        float g = -expf(a_log[h]) * sp;
#pragma unroll
        for (int o = 1; o < 64; o <<= 1) { const float t = __shfl_up(g, o); if (lane >= o) g += t; }
        gcs[lane] = g; bts[lane] = 1.0f / (1.0f + __expf(-braw));
        if (lane == 63) ((float*)(ws + WS_EG))[ch] = expf(g);
    }
    for (int i = tid; i < 64 * 65; i += 512) Ts[i] = 0.f;
    __syncthreads();
    {
        float cw[3][4][2];
#pragma unroll
        for (int sec = 0; sec < 3; ++sec)
#pragma unroll
            for (int j = 0; j < 4; ++j) { const f32x2 w = *(const f32x2*)(conv_w + j * 1536 + sec * 512 + h * 128 + 2 * lane); cw[sec][j][0] = w.x; cw[sec][j][1] = w.y; }
        const float glast = gcs[63];
        bf16* QG = (bf16*)(ws + WS_QG) + (size_t)ch * 8192; bf16* KD = (bf16*)(ws + WS_KD) + (size_t)ch * 8192;
#pragma unroll
        for (int rr = 0; rr < 8; ++rr) {
            const int r = wave * 8 + rr;
            float val[3][2];
#pragma unroll
            for (int sec = 0; sec < 3; ++sec) { float v0 = 0.f, v1 = 0.f;
#pragma unroll
                for (int j = 0; j < 4; ++j) { v0 += bflo(raw[rr + j][sec]) * cw[sec][j][0]; v1 += bfhi(raw[rr + j][sec]) * cw[sec][j][1]; }
                val[sec][0] = v0 / (1.f + __expf(-v0)); val[sec][1] = v1 / (1.f + __expf(-v1)); }
            const float ssq = wave_sum(val[0][0] * val[0][0] + val[0][1] * val[0][1]);
            const float ssk = wave_sum(val[1][0] * val[1][0] + val[1][1] * val[1][1]);
            const float rq = (1.0f / sqrtf(ssq + 1e-6f)) * 0.08838834764831845f, rk = 1.0f / sqrtf(ssk + 1e-6f);
            const float q0 = val[0][0] * rq, q1 = val[0][1] * rq, k0 = val[1][0] * rk, k1 = val[1][1] * rk;
            const float gr = gcs[r], be = bts[r], eq = __expf(gr), ek = __expf(glast - gr), bek = be * eq;
            *(LAS unsigned*)(L8 + PQ + r * 272 + 4 * lane) = cvtpk(q0, q1);
            *(LAS unsigned*)(L8 + PK + r * 272 + 4 * lane) = cvtpk(k0, k1);
            const unsigned vb = cvtpk(val[2][0] * be, val[2][1] * be), kb = cvtpk(k0 * bek, k1 * bek);
            *(LAS bf16*)(L8 + PVB + (2 * lane) * 144 + 2 * r) = (bf16)(vb & 0xffffu); *(LAS bf16*)(L8 + PVB + (2 * lane + 1) * 144 + 2 * r) = (bf16)(vb >> 16);
            *(LAS bf16*)(L8 + PKB + (2 * lane) * 144 + 2 * r) = (bf16)(kb & 0xffffu); *(LAS bf16*)(L8 + PKB + (2 * lane + 1) * 144 + 2 * r) = (bf16)(kb >> 16);
            const int d = 2 * lane;
            *(unsigned*)(QG + r * 128 + (d & 96) + kperm(d & 31)) = cvtpk(q0 * eq, q1 * eq);
            const int tp = (r & 32) + kperm(r & 31); const unsigned kd = cvtpk(k0 * ek, k1 * ek);
            KD[d * 64 + tp] = (bf16)(kd & 0xffffu); KD[(d + 1) * 64 + tp] = (bf16)(kd >> 16);
        }
    }
    __syncthreads();
    {
        bf16* Aout = (bf16*)(ws + WS_A) + (size_t)ch * 4096;
#pragma unroll
        for (int t2 = 0; t2 < 2; ++t2) {
            const int idx = 2 * wave + t2, ct = idx >> 2, jt = idx & 3;
            f32x4 acc1 = {0.f, 0.f, 0.f, 0.f}, acc2 = {0.f, 0.f, 0.f, 0.f};
#pragma unroll
            for (int ks = 0; ks < 4; ++ks) {
                const bf16x8 kc = *(const LAS bf16x8*)(L8 + PK + (16 * ct + jl) * 272 + (32 * ks + 8 * kq) * 2);
                const bf16x8 kj = *(const LAS bf16x8*)(L8 + PK + (16 * jt + jl) * 272 + (32 * ks + 8 * kq) * 2);
                const bf16x8 qc = *(const LAS bf16x8*)(L8 + PQ + (16 * ct + jl) * 272 + (32 * ks + 8 * kq) * 2);
                acc1 = __builtin_amdgcn_mfma_f32_16x16x32_bf16(kc, kj, acc1, 0, 0, 0);
                acc2 = __builtin_amdgcn_mfma_f32_16x16x32_bf16(kj, qc, acc2, 0, 0, 0);
            }
            { const int j = 16 * jt + jl; const float gj = gcs[j];
#pragma unroll
              for (int e = 0; e < 4; ++e) { const int c = 16 * ct + 4 * kq + e; As[c * 65 + j] = (j < c) ? bts[c] * acc1[e] * __expf(gcs[c] - gj) : 0.f; } }
            { const int c = 16 * ct + jl; const float gc_ = gcs[c]; float pv[4];
#pragma unroll
              for (int e = 0; e < 4; ++e) { const int j = 16 * jt + 4 * kq + e; pv[e] = (j <= c) ? acc2[e] * __expf(gc_ - gcs[j]) : 0.f; }
              v2u w; w.x = cvtpk(pv[0], pv[1]); w.y = cvtpk(pv[2], pv[3]);
              *(v2u*)(Aout + c * 64 + 32 * (jt >> 1) + 8 * kq + 4 * (jt & 1)) = w; }
        }
    }
    __syncthreads();
    if (wave == 0) {
        const int bb = lane >> 4, col = lane & 15;
        float xv[16];
#pragma unroll
        for (int c = 0; c < 16; ++c) { float s = (c == col) ? 1.f : 0.f;
#pragma unroll
            for (int j = 0; j < c; ++j) s -= As[(16 * bb + c) * 65 + 16 * bb + j] * xv[j];
            xv[c] = s; }
#pragma unroll
        for (int c = 0; c < 16; ++c) Ts[(16 * bb + c) * 65 + 16 * bb + col] = xv[c];
    }
    __syncthreads();
    {
        const int pr = tid >> 8, i = (tid >> 4) & 15, jj = tid & 15, hb = 32 * pr + 16, lb = 32 * pr;
        float s = 0.f;
#pragma unroll
        for (int k = 0; k < 16; ++k) s += As[(hb + i) * 65 + lb + k] * Ts[(lb + k) * 65 + lb + jj];
        Ms[(hb + i) * 65 + lb + jj] = s;
        __syncthreads();
        float t = 0.f;
#pragma unroll
        for (int k = 0; k < 16; ++k) t += Ts[(hb + i) * 65 + hb + k] * Ms[(hb + k) * 65 + lb + jj];
        Ts[(hb + i) * 65 + lb + jj] = -t;
    }
    __syncthreads();
    {
        const int i = tid >> 4, j0 = (tid & 15) * 2;
        float s0 = 0.f, s1 = 0.f;
#pragma unroll 8
        for (int k = 0; k < 32; ++k) { const float av = As[(32 + i) * 65 + k]; s0 += av * Ts[k * 65 + j0]; s1 += av * Ts[k * 65 + j0 + 1]; }
        Ms[(32 + i) * 65 + j0] = s0; Ms[(32 + i) * 65 + j0 + 1] = s1;
        __syncthreads();
        float t0 = 0.f, t1 = 0.f;
#pragma unroll 8
        for (int k = 0; k < 32; ++k) { const float tv = Ts[(32 + i) * 65 + 32 + k]; t0 += tv * Ms[(32 + k) * 65 + j0]; t1 += tv * Ms[(32 + k) * 65 + j0 + 1]; }
        __syncthreads();
        Ts[(32 + i) * 65 + j0] = -t0; Ts[(32 + i) * 65 + j0 + 1] = -t1;
    }
    __syncthreads();
#pragma unroll
    for (int i = 0; i < 4; ++i) { const int idx2 = tid + 512 * i, r = idx2 >> 5, c = (idx2 & 31) * 2;
        *(LAS unsigned*)(L8 + PTB + r * 144 + 2 * c) = cvtpk(Ts[r * 65 + c], Ts[r * 65 + c + 1]); }
    __syncthreads();
    {
        bf16* U = (bf16*)(ws + WS_U) + (size_t)ch * 8192; bf16* W = (bf16*)(ws + WS_W) + (size_t)ch * 8192;
        const int mt = wave & 3, ntb = 4 * (wave >> 2);
        bf16x8 ta[2];
#pragma unroll
        for (int ks = 0; ks < 2; ++ks) ta[ks] = *(const LAS bf16x8*)(L8 + PTB + (16 * mt + jl) * 144 + (32 * ks + 8 * kq) * 2);
#pragma unroll
        for (int q = 0; q < 4; ++q) { const int nt = ntb + q; f32x4 acc = {0.f, 0.f, 0.f, 0.f};
#pragma unroll
            for (int ks = 0; ks < 2; ++ks) { const bf16x8 vb = *(const LAS bf16x8*)(L8 + PVB + (16 * nt + jl) * 144 + (32 * ks + 8 * kq) * 2);
                acc = __builtin_amdgcn_mfma_f32_16x16x32_bf16(ta[ks], vb, acc, 0, 0, 0); }
            v2u w; w.x = cvtpk(acc[0], acc[1]); w.y = cvtpk(acc[2], acc[3]);
            *(v2u*)(U + (16 * nt + jl) * 64 + 16 * mt + 4 * kq) = w; }
        bf16x8 ka[2];
#pragma unroll
        for (int ks = 0; ks < 2; ++ks) ka[ks] = *(const LAS bf16x8*)(L8 + PKB + (16 * wave + jl) * 144 + (32 * ks + 8 * kq) * 2);
#pragma unroll
        for (int ctile = 0; ctile < 4; ++ctile) { f32x4 acc = {0.f, 0.f, 0.f, 0.f};
#pragma unroll
            for (int ks = 0; ks < 2; ++ks) { const bf16x8 tb = *(const LAS bf16x8*)(L8 + PTB + (16 * ctile + jl) * 144 + (32 * ks + 8 * kq) * 2);
                acc = __builtin_amdgcn_mfma_f32_16x16x32_bf16(ka[ks], tb, acc, 0, 0, 0); }
            v2u w; w.x = cvtpk(-acc[0], -acc[1]); w.y = cvtpk(-acc[2], -acc[3]);
            *(v2u*)(W + (16 * ctile + jl) * 128 + 32 * (wave >> 1) + 8 * kq + 4 * (wave & 1)) = w; }
    }
    __syncthreads();
}

__device__ __forceinline__ bf16x8 pack8(const f32x4& a, const f32x4& b) { v4u w; w.x = cvtpk(a[0], a[1]); w.y = cvtpk(a[2], a[3]); w.z = cvtpk(b[0], b[1]); w.w = cvtpk(b[2], b[3]); return __builtin_bit_cast(bf16x8, w); }
constexpr int SC_W = 0, SC_QG = 17408, SC_KDT = 34816, SC_A = 53248, SC_U = 62464, SC_BUF = 67072;
constexpr int SC_OUT = 2 * SC_BUF;
struct ScanRegs { v4u st[15]; };
__device__ __forceinline__ void sc_load(ScanRegs& R, const unsigned char* ws, int chx, int t, int qtr) {
    const unsigned vo = (unsigned)t * 16u;
    const unsigned char* pw = ws + WS_W + (size_t)chx * 16384; const unsigned char* pq = ws + WS_QG + (size_t)chx * 16384; const unsigned char* pk = ws + WS_KD + (size_t)chx * 16384;
    const unsigned char* pa = ws + WS_A + (size_t)chx * 8192; const unsigned char* pu = ws + WS_U + (size_t)chx * 16384 + qtr * 4096;
#define SC_LDG(k, p) do { R.st[k] = *(const v4u*)(p); __builtin_amdgcn_sched_barrier(0); } while (0)
    __builtin_amdgcn_sched_barrier(0);
    SC_LDG(0, pw + vo); SC_LDG(1, pw + 4096 + vo); SC_LDG(2, pw + 8192 + vo); SC_LDG(3, pw + 12288 + vo);
    SC_LDG(4, pq + vo); SC_LDG(5, pq + 4096 + vo); SC_LDG(6, pq + 8192 + vo); SC_LDG(7, pq + 12288 + vo);
    SC_LDG(8, pk + vo); SC_LDG(9, pk + 4096 + vo); SC_LDG(10, pk + 8192 + vo); SC_LDG(11, pk + 12288 + vo);
    SC_LDG(12, pa + vo); SC_LDG(13, pa + 4096 + vo); SC_LDG(14, pu + vo);
#undef SC_LDG
}
__device__ __forceinline__ void sc_write(const ScanRegs& R, LAS unsigned char* B_, int t) {
    LAS unsigned char* w16 = B_ + (t >> 4) * 272 + (t & 15) * 16;
    LAS unsigned char* k8 = B_ + (t >> 3) * 144 + (t & 7) * 16;
#define SC_STL(k, p) do { *(LAS v4u*)(p) = R.st[k]; __builtin_amdgcn_sched_barrier(0); } while (0)
    __builtin_amdgcn_sched_barrier(0);
    SC_STL(0, w16 + SC_W); SC_STL(1, w16 + SC_W + 16 * 272); SC_STL(2, w16 + SC_W + 32 * 272); SC_STL(3, w16 + SC_W + 48 * 272);
    SC_STL(4, w16 + SC_QG); SC_STL(5, w16 + SC_QG + 16 * 272); SC_STL(6, w16 + SC_QG + 32 * 272); SC_STL(7, w16 + SC_QG + 48 * 272);
    SC_STL(8, k8 + SC_KDT); SC_STL(9, k8 + SC_KDT + 32 * 144); SC_STL(10, k8 + SC_KDT + 64 * 144); SC_STL(11, k8 + SC_KDT + 96 * 144);
    SC_STL(12, k8 + SC_A); SC_STL(13, k8 + SC_A + 32 * 144); SC_STL(14, k8 + SC_U);
#undef SC_STL
}
#define SC_BARRIER() do { asm volatile("s_waitcnt lgkmcnt(0)" ::: "memory"); __builtin_amdgcn_s_barrier(); asm volatile("" ::: "memory"); } while (0)
__device__ __forceinline__ void sc_step_compute(LAS unsigned char* L8, int n, int jl, int kq, int wcol, float egv, f32x4 (&Sacc)[8]) {
    const float eg = __builtin_bit_cast(float, __builtin_amdgcn_readlane(__builtin_bit_cast(int, egv), n));
    const LAS unsigned char* B = L8 + (n & 1) * SC_BUF;
    bf16x8 sb[4];
#pragma unroll
    for (int ks = 0; ks < 4; ++ks) sb[ks] = pack8(Sacc[2 * ks], Sacc[2 * ks + 1]);
    f32x4 vn[4], oa[4];
#pragma unroll
    for (int mt = 0; mt < 4; ++mt) { const v2u u = *(const LAS v2u*)(B + SC_U + (wcol + jl) * 144 + (16 * mt + 4 * kq) * 2);
        vn[mt] = (f32x4){bflo(u.x), bfhi(u.x), bflo(u.y), bfhi(u.y)}; oa[mt] = (f32x4){0.f, 0.f, 0.f, 0.f}; }
    const LAS unsigned char* pW = B + SC_W + jl * 272 + kq * 16; const LAS unsigned char* pQ = B + SC_QG + jl * 272 + kq * 16;
    const LAS unsigned char* pK = B + SC_KDT + jl * 144 + kq * 16; const LAS unsigned char* pA = B + SC_A + jl * 144 + kq * 16;
#define SC_LD_WQ(dst, mt) do { _Pragma("unroll") for (int ks = 0; ks < 4; ++ks) { dst[ks] = *(const LAS bf16x8*)(pW + (mt) * 16 * 272 + ks * 64); dst[4 + ks] = *(const LAS bf16x8*)(pQ + (mt) * 16 * 272 + ks * 64); } } while (0)
#define SC_LD_K(dst, t0) do { _Pragma("unroll") for (int t = 0; t < 4; ++t) _Pragma("unroll") for (int k2 = 0; k2 < 2; ++k2) dst[2 * t + k2] = *(const LAS bf16x8*)(pK + ((t0) + t) * 16 * 144 + k2 * 64); } while (0)
#define SC_LD_A(dst) do { _Pragma("unroll") for (int mt = 0; mt < 4; ++mt) _Pragma("unroll") for (int k2 = 0; k2 < 2; ++k2) dst[2 * mt + k2] = *(const LAS bf16x8*)(pA + mt * 16 * 144 + k2 * 64); } while (0)
#define SC_MM_WQ(src, mt) do { _Pragma("unroll") for (int ks = 0; ks < 4; ++ks) { vn[mt] = __builtin_amdgcn_mfma_f32_16x16x32_bf16(src[ks], sb[ks], vn[mt], 0, 0, 0); oa[mt] = __builtin_amdgcn_mfma_f32_16x16x32_bf16(src[4 + ks], sb[ks], oa[mt], 0, 0, 0); } } while (0)
#define SC_MM_K(src, t0) do { _Pragma("unroll") for (int k2 = 0; k2 < 2; ++k2) _Pragma("unroll") for (int t = 0; t < 4; ++t) Sacc[(t0) + t] = __builtin_amdgcn_mfma_f32_16x16x32_bf16(src[2 * t + k2], vb[k2], Sacc[(t0) + t], 0, 0, 0); } while (0)
#define SC_MM_A(src) do { _Pragma("unroll") for (int k2 = 0; k2 < 2; ++k2) _Pragma("unroll") for (int mt = 0; mt < 4; ++mt) oa[mt] = __builtin_amdgcn_mfma_f32_16x16x32_bf16(src[2 * mt + k2], vb[k2], oa[mt], 0, 0, 0); } while (0)
#define SC_SB() __builtin_amdgcn_sched_barrier(0)
    bf16x8 fa[8], fb[8];
    SC_LD_WQ(fa, 0); SC_LD_WQ(fb, 1); SC_SB();
    SC_MM_WQ(fa, 0); SC_SB(); SC_LD_WQ(fa, 2); SC_SB();
    SC_MM_WQ(fb, 1); SC_SB(); SC_LD_WQ(fb, 3); SC_SB();
    SC_MM_WQ(fa, 2); SC_SB(); SC_LD_K(fa, 0); SC_SB();
    SC_MM_WQ(fb, 3); SC_SB(); SC_LD_K(fb, 4); SC_SB();
    bf16x8 vb[2];
    vb[0] = pack8(vn[0], vn[1]); vb[1] = pack8(vn[2], vn[3]);
#pragma unroll
    for (int T = 0; T < 8; ++T) Sacc[T] = Sacc[T] * eg;
    SC_SB();
    SC_MM_K(fa, 0); SC_SB(); SC_LD_A(fa); SC_SB();
    SC_MM_K(fb, 4); SC_SB();
    SC_MM_A(fa);
#undef SC_LD_WQ
#undef SC_LD_K
#undef SC_LD_A
#undef SC_MM_WQ
#undef SC_MM_K
#undef SC_MM_A
#undef SC_SB
    LAS unsigned char* ob = L8 + SC_OUT + (n & 1) * 4096 + (4 * kq) * 64 + (wcol + jl) * 2;
#pragma unroll
    for (int mt = 0; mt < 4; ++mt)
#pragma unroll
        for (int e = 0; e < 4; ++e) *(LAS bf16*)(ob + (16 * mt + e) * 64) = (bf16)f2bf(oa[mt][e]);
    SC_BARRIER();
}
__device__ __forceinline__ void sc_out_tile(LAS unsigned char* L8, bf16* MIX, int b, int h, int qtr, int n, int l_) {
    const LAS unsigned char* ob = L8 + SC_OUT + (n & 1) * 4096 + l_ * 64;
    const v4u w0 = *(const LAS v4u*)ob, w1 = *(const LAS v4u*)(ob + 16), w2 = *(const LAS v4u*)(ob + 32), w3 = *(const LAS v4u*)(ob + 48);
    bf16* gp = MIX + (size_t)(b * SEQ + n * 64 + l_) * 1024 + 512 + h * 128 + qtr * 32;
    *(v4u*)gp = w0; *(v4u*)(gp + 8) = w1; *(v4u*)(gp + 16) = w2; *(v4u*)(gp + 24) = w3;
}
__device__ __forceinline__ void dn_scan_mfma(const Args& a, LAS unsigned char* L8, int item, int tid, int lane, int wave) {
    unsigned char* ws = a.ws;
    const int bh = item >> 2, qtr = item & 3, b = bh >> 2, h = bh & 3;
    if (wave < 2) {
        const int jl = lane & 15, kq = lane >> 4;
        f32x4 Sacc[8];
#pragma unroll
        for (int T = 0; T < 8; ++T) Sacc[T] = (f32x4){0.f, 0.f, 0.f, 0.f};
        const float egv = ((const float*)(ws + WS_EG))[bh * 64 + lane];
        asm volatile("s_waitcnt vmcnt(0)" ::: "memory");
        SC_BARRIER();
        for (int n = 0; n < 64; ++n) sc_step_compute(L8, n, jl, kq, wave * 16, egv, Sacc);
    } else if (wave < 6) {
        ScanRegs R0, R1; const int t = tid - 128, c0 = bh * 64;
        sc_load(R0, ws, c0, t, qtr); sc_write(R0, L8, t);
        sc_load(R0, ws, c0 + 1, t, qtr); sc_load(R1, ws, c0 + 2, t, qtr);
        SC_BARRIER();
        for (int n = 0; n < 64; n += 2) {
            sc_write(R0, L8 + SC_BUF, t);
            sc_load(R0, ws, c0 + (n + 3 < 63 ? n + 3 : 63), t, qtr);
            SC_BARRIER();
            sc_write(R1, L8, t);
            sc_load(R1, ws, c0 + (n + 4 < 63 ? n + 4 : 63), t, qtr);
            SC_BARRIER();
        }
    } else if (wave == 6) {
        SC_BARRIER();
        for (int n = 0; n < 64; ++n) SC_BARRIER();
    } else {
        bf16* MIX = (bf16*)(ws + WS_XN);
        SC_BARRIER();
        for (int n = 0; n < 64; ++n) { if (n > 0) sc_out_tile(L8, MIX, b, h, qtr, n - 1, lane); SC_BARRIER(); }
        sc_out_tile(L8, MIX, b, h, qtr, 63, lane);
    }
    __syncthreads();
}

typedef float f32x16 __attribute__((ext_vector_type(16)));
typedef short s16x4 __attribute__((ext_vector_type(4)));
__device__ __forceinline__ s16x4 vtr(const LAS unsigned char* p) { return __builtin_bit_cast(s16x4, __builtin_amdgcn_ds_read_tr16_b64_v4i16((LAS s16x4*)p)); }
constexpr int KVP = 144;
constexpr int KV_BYTES = 384 * KVP;
constexpr size_t WS_ML = 173 * MiB;
__device__ __forceinline__ void attn_item(const bf16* Qh, const bf16* KVh, bf16* PROJ, float* ML, LAS unsigned char* L8, int item, int tid, int lane, int wave) {
    asm volatile("" : "+v"(lane));
    const int bh = item / 48, rem = item - bh * 48, p = rem >> 4, sub = rem & 15;
    const int b = bh >> 3, h = bh & 7;
    const int dsh = 2 * p, dil = 1 << dsh, nsh = 4 - dsh;
    const int r = sub >> nsh, qb = sub & ((1 << nsh) - 1);
    const int base = 256 * qb;
    const bf16* KVb = KVh + (size_t)(bh * 4096 + r) * 128;
#pragma unroll
    for (int i = 0; i < 12; ++i) { const int id = tid + 512 * i, row = id >> 4, ch = id & 15, idx = base - 128 + row;
        v4u kv = (v4u){0u, 0u, 0u, 0u};
        if (idx >= 0) kv = *(const v4u*)(KVb + (size_t)(dil * idx) * 128 + ch * 8);
        *(LAS v4u*)(L8 + ((ch & 8) ? KV_BYTES : 0) + row * KVP + (ch & 7) * 16) = kv; }
    const int ql = lane & 31, kh = lane >> 5;
    const int tq = r + dil * (base + 32 * wave + ql);
    const size_t tokq = (size_t)b * SEQ + tq;
    bf16x8 qf[4];
#pragma unroll
    for (int s = 0; s < 4; ++s) qf[s] = *(const bf16x8*)(Qh + ((size_t)bh * 4096 + tq) * 64 + 16 * s + 8 * kh);
    __syncthreads();
    f32x16 sc[5];
    {
        const LAS unsigned char* Kp = L8 + (32 * wave + ql) * KVP + kh * 16;
        bf16x8 kf[2][4];
#pragma unroll
        for (int s = 0; s < 4; ++s) kf[0][s] = *(const LAS bf16x8*)(Kp + s * 32);
#pragma unroll
        for (int kt = 0; kt < 5; ++kt) {
            if (kt + 1 < 5) {
#pragma unroll
                for (int s = 0; s < 4; ++s) kf[(kt + 1) & 1][s] = *(const LAS bf16x8*)(Kp + (kt + 1) * 32 * KVP + s * 32); }
            __builtin_amdgcn_sched_barrier(0);
            f32x16 acc = {};
#pragma unroll
            for (int s = 0; s < 4; ++s) acc = __builtin_amdgcn_mfma_f32_32x32x16_bf16(kf[kt & 1][s], qf[s], acc, 0, 0, 0);
            sc[kt] = acc;
            __builtin_amdgcn_sched_barrier(0);
        }
    }
    const float LOG2E = 1.4426950408889634f;
    const float c1 = 0.125f * LOG2E, c2 = exp2f(-(float)(h + 1)) * (float)dil * LOG2E;
    const float Al = -c2 * (float)(128 + ql - 4 * kh);
    float mx = -INFINITY;
#pragma unroll
    for (int kt = 0; kt < 5; ++kt)
#pragma unroll
        for (int rr = 0; rr < 16; ++rr) { const int kc = (rr & 3) + 8 * (rr >> 2);
            float v = fmaf(sc[kt][rr], c1, fmaf(c2, (float)(32 * kt + kc), Al));
            if (kt == 0) v = (kc + 4 * kh >= ql) ? v : -INFINITY;
            if (kt == 4) v = (kc + 4 * kh <= ql) ? v : -INFINITY;
            sc[kt][rr] = v; }
    if (base == 0) {
#pragma unroll
        for (int kt = 0; kt < 4; ++kt)
#pragma unroll
            for (int rr = 0; rr < 16; ++rr) { const int kidx = -128 + 32 * (wave + kt) + (rr & 3) + 8 * (rr >> 2) + 4 * kh; sc[kt][rr] = (kidx >= 0) ? sc[kt][rr] : -INFINITY; }
    }
#pragma unroll
    for (int kt = 0; kt < 5; ++kt)
#pragma unroll
        for (int rr = 0; rr < 16; ++rr) mx = fmaxf(mx, sc[kt][rr]);
    mx = fmaxf(mx, __shfl_xor(mx, 32));
    float lsum = 0.f;
#pragma unroll
    for (int kt = 0; kt < 5; ++kt)
#pragma unroll
        for (int rr = 0; rr < 16; ++rr) { const float pv = __builtin_amdgcn_exp2f(sc[kt][rr] - mx); sc[kt][rr] = pv; lsum += pv; }
    lsum += __shfl_xor(lsum, 32);
    f32x16 o[2]; o[0] = (f32x16){}; o[1] = (f32x16){};
    {
        const int q4 = (lane & 15) >> 2, pp = lane & 3, blk = (lane >> 4) & 1;
        const LAS unsigned char* Vb = L8 + KV_BYTES + (32 * wave + 4 * kh + q4) * KVP + (16 * blk + 4 * pp) * 2;
        s16x4 vf[3][4];
#define AT_LDV(set, step) do { const LAS unsigned char* vr_ = Vb + (16 * (step)) * KVP; vf[set][0] = vtr(vr_); vf[set][1] = vtr(vr_ + 8 * KVP); vf[set][2] = vtr(vr_ + 64); vf[set][3] = vtr(vr_ + 8 * KVP + 64); } while (0)
        AT_LDV(0, 0); AT_LDV(1, 1);
#pragma unroll
        for (int st = 0; st < 10; ++st) {
            if (st + 2 < 10) AT_LDV((st + 2) % 3, st + 2);
            __builtin_amdgcn_sched_barrier(0);
            const int kt = st >> 1, s2 = st & 1;
            v4u pw; pw.x = cvtpk(sc[kt][8 * s2 + 0], sc[kt][8 * s2 + 1]); pw.y = cvtpk(sc[kt][8 * s2 + 2], sc[kt][8 * s2 + 3]); pw.z = cvtpk(sc[kt][8 * s2 + 4], sc[kt][8 * s2 + 5]); pw.w = cvtpk(sc[kt][8 * s2 + 6], sc[kt][8 * s2 + 7]);
            const bf16x8 pb = __builtin_bit_cast(bf16x8, pw);
            const s16x4 l0 = vf[st % 3][0], h0 = vf[st % 3][1], l1 = vf[st % 3][2], h1 = vf[st % 3][3];
            o[0] = __builtin_amdgcn_mfma_f32_32x32x16_bf16((bf16x8){l0[0], l0[1], l0[2], l0[3], h0[0], h0[1], h0[2], h0[3]}, pb, o[0], 0, 0, 0);
            o[1] = __builtin_amdgcn_mfma_f32_32x32x16_bf16((bf16x8){l1[0], l1[1], l1[2], l1[3], h1[0], h1[1], h1[2], h1[3]}, pb, o[1], 0, 0, 0);
            __builtin_amdgcn_sched_barrier(0);
        }
#undef AT_LDV
    }
    const float inv = 1.0f / lsum;
    bf16* dst = PROJ + tokq * P2LD + p * 512 + h * 64 + 4 * kh;
#pragma unroll
    for (int c = 0; c < 2; ++c)
#pragma unroll
        for (int g = 0; g < 4; ++g) { v2u w; w.x = cvtpk(o[c][4 * g + 0] * inv, o[c][4 * g + 1] * inv); w.y = cvtpk(o[c][4 * g + 2] * inv, o[c][4 * g + 3] * inv);
            *(v2u*)(dst + 32 * c + 8 * g) = w; }
    if (kh == 0) { float* ml = ML + ((tokq * 8 + h) * 3 + p) * 2; *(f32x2*)ml = (f32x2){mx, lsum}; }
    __syncthreads();
}

#define XB_TMO      128
#define XB_XCNT(j)  (256  + 64 * (j))
#define XB_XSUB(j)  (1280 + 64 * (j))
#define XB_XGEN(j)  (2304 + 64 * (j))
#define XB_TOP      3328
#define XB_TOPGEN   3392
#define XCD_BAR_WORDS 3456
#define XB_SPIN_CAP (1u << 18)

__device__ __forceinline__ unsigned xb_ld(unsigned* p)              { return __hip_atomic_load(p, __ATOMIC_RELAXED, __HIP_MEMORY_SCOPE_AGENT); }
__device__ __forceinline__ unsigned xb_add(unsigned* p, unsigned v) { return __hip_atomic_fetch_add(p, v, __ATOMIC_RELAXED, __HIP_MEMORY_SCOPE_AGENT); }
__device__ __forceinline__ unsigned xb_xcc_id() { return (unsigned)__builtin_amdgcn_s_getreg((3 << 11) | 20) & 0xFu; }
#define XB_SPIN(cond, bar) do { unsigned _sp = 0; while (cond) { __builtin_amdgcn_s_sleep(1); \
    if ((++_sp & 255u) == 0u) { if (xb_ld(&(bar)[XB_TMO])) break; if (_sp > XB_SPIN_CAP) { atomicAdd(&(bar)[XB_TMO], 1u); break; } } } } while (0)

struct XcdBarrier {
    unsigned* bar; unsigned x;
    volatile LAS unsigned* st;
};

__device__ __forceinline__ XcdBarrier xcd_barrier_post(unsigned* bar, volatile LAS unsigned* st) {
    XcdBarrier b; b.bar = bar; b.x = xb_xcc_id(); b.st = st;
    if (threadIdx.x == 0) (void)xb_add(&bar[XB_XCNT(b.x)], 1u);
    return b;
}
__device__ __forceinline__ void xcd_barrier_complete(unsigned* bar, unsigned x, unsigned& nloc, unsigned& nx) {
    const unsigned G = gridDim.x * gridDim.y * gridDim.z;
    unsigned sum, cnt, mine, sp = 0u;
    for (;;) {
        sum = 0u; cnt = 0u; mine = 0u;
#pragma unroll
        for (unsigned j = 0; j < 16; ++j) { const unsigned c = xb_ld(&bar[XB_XCNT(j)]); sum += c; cnt += (c > 0u) ? 1u : 0u; mine = (j == x) ? c : mine; }
        if (sum == G) break;
        __builtin_amdgcn_s_sleep(1);
        if ((++sp & 255u) == 0u) { if (xb_ld(&bar[XB_TMO])) break; if (sp > XB_SPIN_CAP) { atomicAdd(&bar[XB_TMO], 1u); break; } }
    }
    nloc = mine > 0u ? mine : 1u; nx = cnt > 0u ? cnt : 1u;
}

__device__ __forceinline__ void xcd_barrier(const XcdBarrier& b) {
    asm volatile("s_waitcnt vmcnt(0)" ::: "memory");
    __syncthreads();
    if (threadIdx.x == 0) {
        unsigned* bar = b.bar;
        __builtin_amdgcn_s_waitcnt(0);
        unsigned nloc = b.st[0], nx = b.st[1];
        if (nloc == 0u) { xcd_barrier_complete(bar, b.x, nloc, nx); b.st[0] = nloc; b.st[1] = nx; }
        const unsigned old = xb_add(&bar[XB_XSUB(b.x)], 1u);
        const unsigned gen = old / nloc;
        if (old + 1u == (gen + 1u) * nloc) {
            __builtin_amdgcn_fence(__ATOMIC_RELEASE, "agent");
            asm volatile("s_waitcnt vmcnt(0)" ::: "memory");
            const unsigned og = xb_add(&bar[XB_TOP], 1u);
            const unsigned tg = og / nx;
            if (og + 1u == (tg + 1u) * nx) xb_add(&bar[XB_TOPGEN], 1u);
            else XB_SPIN(xb_ld(&bar[XB_TOPGEN]) == tg, bar);
            __builtin_amdgcn_fence(__ATOMIC_ACQUIRE, "agent");
            xb_add(&bar[XB_XGEN(b.x)], 1u);
            asm volatile("s_waitcnt vmcnt(0)" ::: "memory");
        } else {
            XB_SPIN(xb_ld(&bar[XB_XGEN(b.x)]) == gen, bar);
            __builtin_amdgcn_fence(__ATOMIC_ACQUIRE, "agent");
            asm volatile("s_waitcnt vmcnt(0)" ::: "memory");
        }
    }
    __syncthreads();
}

__global__ void __launch_bounds__(NWAVES * 64, 2) fwd_megakernel(Args a) {
    extern __shared__ __attribute__((aligned(16))) unsigned char lds[];
    cg::grid_group grid = cg::this_grid();
    LAS unsigned char* L8 = (LAS unsigned char*)lds;
    LAS float* L = (LAS float*)lds;
    const int tid = threadIdx.x, lane = tid & 63, wave = __builtin_amdgcn_readfirstlane(tid >> 6);
    const int G = gridDim.x, gw = blockIdx.x * NWAVES + wave, NGW = G * NWAVES;
    unsigned char* ws = a.ws;
    unsigned* ctl = (unsigned*)(ws + WS_CTL);
    const float* x = a.in[0];
    bf16* XN = (bf16*)(ws + WS_XN); bf16* ACT = (bf16*)(ws + WS_ACT); bf16* PROJ = ACT; bf16* MIX = XN;
    bf16* Wgu1 = (bf16*)(ws + WS_WGU1); bf16* Wd1 = (bf16*)(ws + WS_WD1); bf16* Win = (bf16*)(ws + WS_WIN); bf16* Wout = (bf16*)(ws + WS_WOUT);
    bf16* Wgu2 = (bf16*)(ws + WS_WGU2); bf16* Wd2 = (bf16*)(ws + WS_WD2);
    float* out = a.out;
    volatile LAS unsigned* xbst = (volatile LAS unsigned*)(L8 + LDS_BYTES - 64);
    if (tid < 2) xbst[tid] = 0u;
    __syncthreads();
    XcdBarrier bar = xcd_barrier_post(ctl + 1024, xbst);
#define GSYNC() xcd_barrier(bar)

    {
        const int lane = opq(tid) & 63;
        LAS float* scr = L + wave * 4096;
        constexpr int I_GU = (D / 64) * (NGU / 32), I_D = (FF / 64) * (D / 32), I_IN = (D / 64) * (NIN / 32), I_O = (D / 64) * (D / 32);
        constexpr int NITEMS = 2 * I_GU + 2 * I_D + I_IN + I_O;
        for (int it = gw; it < NITEMS; it += NGW) {
            int r = it;
            if (r < I_GU) { tr_gu(a.in[2], a.in[3], Wgu1, r, scr, lane); continue; } r -= I_GU;
            if (r < I_D) { tr_plain(a.in[4], FF, D, Wd1, r, scr, lane); continue; } r -= I_D;
            if (r < I_IN) { tr_win(a.in[6], Win, r, scr, lane); continue; } r -= I_IN;
            if (r < I_O) { tr_plain(a.in[11], D, D, Wout, r, scr, lane); continue; } r -= I_O;
            if (r < I_GU) { tr_gu(a.in[13], a.in[14], Wgu2, r, scr, lane); continue; } r -= I_GU;
            tr_plain(a.in[15], FF, D, Wd2, r, scr, lane);
        }
        for (int m = gw; m < M; m += NGW) { f32x4 v[4]; rms_row(x + (size_t)m * D, a.in[1], lane, v); store_row_bf16(XN + (size_t)m * D, lane, v); }
    }
    grid.sync();
    {
        pg8::Gemm g{XN, Wgu1, M, NGU, D}; pg8::StaticOrder S; S.init(M, NGU, G, (int)blockIdx.x);
        pg8::EpiSwiGLU E{ACT, FF};
        pg8::gemm_phase<pg8::EpiSwiGLU, pg8::StaticOrder, true, true>(L8, g, S, E);
    }
    GSYNC();
    {
        pg8::Gemm g{ACT, Wd1, M, D, FF}; pg8::StaticOrder S; S.init(M, D, G, (int)blockIdx.x);
        pg8::EpiRes E{x, out, D, 0.5f};
        pg8::gemm_phase<pg8::EpiRes, pg8::StaticOrder, true, true>(L8, g, S, E);
    }
    GSYNC();
    {
        const int lane = opq(tid) & 63;
        const float* w_in = a.in[6]; float* BD = (float*)(ws + WS_BD);
        for (int m = gw; m < M; m += NGW) {
            f32x4 v[4]; rms_row(out + (size_t)m * D, a.in[5], lane, v); store_row_bf16(XN + (size_t)m * D, lane, v);
            float acc[8];
#pragma unroll
            for (int o = 0; o < 8; ++o) acc[o] = 0.f;
#pragma unroll
            for (int j = 0; j < 4; ++j)
#pragma unroll
                for (int i = 0; i < 4; ++i) { const int k = 4 * (lane + 64 * j) + i; const f32x4 w0 = *(const f32x4*)(w_in + (size_t)k * WIN_COLS + 3072), w1 = *(const f32x4*)(w_in + (size_t)k * WIN_COLS + 3076);
                    const float hv = v[j][i];
                    acc[0] += hv * w0.x; acc[1] += hv * w0.y; acc[2] += hv * w0.z; acc[3] += hv * w0.w; acc[4] += hv * w1.x; acc[5] += hv * w1.y; acc[6] += hv * w1.z; acc[7] += hv * w1.w; }
#pragma unroll
            for (int o = 0; o < 8; ++o) acc[o] = wave_sum(acc[o]);
            if (lane == 0) { *(f32x4*)(BD + (size_t)m * 8) = (f32x4){acc[0], acc[1], acc[2], acc[3]}; *(f32x4*)(BD + (size_t)m * 8 + 4) = (f32x4){acc[4], acc[5], acc[6], acc[7]}; }
        }
    }
    GSYNC();
    {
        pg8::Gemm g{XN, Win, M, NIN, D}; pg8::StaticOrder S; S.init(M, NIN, G, (int)blockIdx.x);
        pg8::EpiProj E{(bf16*)(ws + WS_QH), (bf16*)(ws + WS_KVH), PROJ};
        pg8::gemm_phase<pg8::EpiProj, pg8::StaticOrder, true, true>(L8, g, S, E);
    }
    GSYNC();
    { const int tid_ = opq(tid); for (int ch = blockIdx.x; ch < 1024; ch += G) dn_prep_item(a, L8, ch, tid_, tid_ & 63, wave); }
    GSYNC();
    {
        const int tid_ = opq(tid), lane = tid_ & 63;
        for (int it = blockIdx.x; it < 64; it += G) dn_scan_mfma(a, L8, it, tid_, lane, wave);
        float* ML = (float*)(ws + WS_ML);
        if ((int)blockIdx.x >= 64 || G <= 64) {
            const int nb = (G > 64) ? G - 64 : G, j0 = (G > 64) ? (int)blockIdx.x - 64 : (int)blockIdx.x;
            for (int item = j0; item < 1536; item += nb) attn_item((const bf16*)(ws + WS_QH), (const bf16*)(ws + WS_KVH), PROJ, ML, L8, item, tid, lane, wave);
        }
    }
    GSYNC();
    {
        const int lane = opq(tid) & 63;
        const float* dn_norm = a.in[10];
        for (int m = gw; m < M; m += NGW) {
            bf16* op = MIX + (size_t)m * 1024 + 512 + 8 * lane; const bf16* gp = PROJ + (size_t)m * P2LD + 1536 + 8 * lane;
            const v4u ow = *(const v4u*)op, gwv = *(const v4u*)gp;
            float o[8] = {bflo(ow.x), bfhi(ow.x), bflo(ow.y), bfhi(ow.y), bflo(ow.z), bfhi(ow.z), bflo(ow.w), bfhi(ow.w)};
            float gt[8] = {bflo(gwv.x), bfhi(gwv.x), bflo(gwv.y), bfhi(gwv.y), bflo(gwv.z), bfhi(gwv.z), bflo(gwv.w), bfhi(gwv.w)};
            float ss = 0.f;
#pragma unroll
            for (int i = 0; i < 8; ++i) ss += o[i] * o[i];
            ss += __shfl_xor(ss, 1); ss += __shfl_xor(ss, 2); ss += __shfl_xor(ss, 4); ss += __shfl_xor(ss, 8);
            const float rs = 1.0f / sqrtf(ss * (1.f / 128.f) + 1e-6f);
            const int d0 = (8 * lane) & 127;
            float r[8];
#pragma unroll
            for (int i = 0; i < 8; ++i) r[i] = o[i] * rs * dn_norm[d0 + i] * (gt[i] / (1.f + __expf(-gt[i])));
            v4u w; w.x = pk2(r[0], r[1]); w.y = pk2(r[2], r[3]); w.z = pk2(r[4], r[5]); w.w = pk2(r[6], r[7]);
            *(v4u*)op = w;
            {
                const int ha = lane >> 3;
                const float* ml = (const float*)(ws + WS_ML) + ((size_t)m * 8 + ha) * 6;
                const f32x2 a0 = *(const f32x2*)ml, a1 = *(const f32x2*)(ml + 2), a2 = *(const f32x2*)(ml + 4);
                const float mm = fmaxf(a0.x, fmaxf(a1.x, a2.x));
                const float w0 = a0.y * __builtin_amdgcn_exp2f(a0.x - mm), w1 = a1.y * __builtin_amdgcn_exp2f(a1.x - mm), w2 = a2.y * __builtin_amdgcn_exp2f(a2.x - mm);
                const float iw = 1.0f / (w0 + w1 + w2);
                const bf16* pp = PROJ + (size_t)m * P2LD + 8 * lane;
                const v4u p0 = *(const v4u*)pp, p1 = *(const v4u*)(pp + 512), p2 = *(const v4u*)(pp + 1024);
                float rr[8];
                rr[0] = w0 * bflo(p0.x) + w1 * bflo(p1.x) + w2 * bflo(p2.x); rr[1] = w0 * bfhi(p0.x) + w1 * bfhi(p1.x) + w2 * bfhi(p2.x);
                rr[2] = w0 * bflo(p0.y) + w1 * bflo(p1.y) + w2 * bflo(p2.y); rr[3] = w0 * bfhi(p0.y) + w1 * bfhi(p1.y) + w2 * bfhi(p2.y);
                rr[4] = w0 * bflo(p0.z) + w1 * bflo(p1.z) + w2 * bflo(p2.z); rr[5] = w0 * bfhi(p0.z) + w1 * bfhi(p1.z) + w2 * bfhi(p2.z);
                rr[6] = w0 * bflo(p0.w) + w1 * bflo(p1.w) + w2 * bflo(p2.w); rr[7] = w0 * bfhi(p0.w) + w1 * bfhi(p1.w) + w2 * bfhi(p2.w);
                v4u wa; wa.x = pk2(rr[0] * iw, rr[1] * iw); wa.y = pk2(rr[2] * iw, rr[3] * iw); wa.z = pk2(rr[4] * iw, rr[5] * iw); wa.w = pk2(rr[6] * iw, rr[7] * iw);
                *(v4u*)(MIX + (size_t)m * 1024 + 8 * lane) = wa;
            }
        }
    }
    GSYNC();
    {
        pg8::Gemm g{MIX, Wout, M, D, D}; pg8::StaticOrder S; S.init(M, D, G, (int)blockIdx.x);
        pg8::EpiRes E{out, out, D, 1.0f};
        pg8::gemm_phase<pg8::EpiRes, pg8::StaticOrder, true, true>(L8, g, S, E);
    }
    GSYNC();
    { const int ln = opq(tid) & 63; for (int m = gw; m < M; m += NGW) { f32x4 v[4]; rms_row(out + (size_t)m * D, a.in[12], ln, v); store_row_bf16(XN + (size_t)m * D, ln, v); } }
    GSYNC();
    {
        pg8::Gemm g{XN, Wgu2, M, NGU, D}; pg8::StaticOrder S; S.init(M, NGU, G, (int)blockIdx.x);
        pg8::EpiSwiGLU E{ACT, FF};
        pg8::gemm_phase<pg8::EpiSwiGLU, pg8::StaticOrder, true, true>(L8, g, S, E);
    }
    GSYNC();
    {
        pg8::Gemm g{ACT, Wd2, M, D, FF}; pg8::StaticOrder S; S.init(M, D, G, (int)blockIdx.x);
        pg8::EpiRes E{out, out, D, 0.5f};
        pg8::gemm_phase<pg8::EpiRes, pg8::StaticOrder, true, true>(L8, g, S, E);
    }
    GSYNC();
    const int lnf = opq(tid) & 63;
    for (int m = gw; m < M; m += NGW) {
        f32x4 v[4]; rms_row(out + (size_t)m * D, a.in[16], lnf, v);
        f32x4* o = (f32x4*)(out + (size_t)m * D) + lnf;
#pragma unroll
        for (int j = 0; j < 4; ++j) o[64 * j] = v[j];
    }
}

extern "C" void kernel_launch(void* const* d_in, const int* in_sizes, int n_in, void* d_out, int out_size, void* d_ws, size_t ws_size, hipStream_t stream) {
    static int grid = 0;
    if (grid == 0) {
        if (n_in != 17 || in_sizes[0] != M * D || out_size != M * D || ws_size < WS_END) { fprintf(stderr, "kernel_launch: unexpected shapes (n_in %d in0 %d out %d ws %zu)\n", n_in, n_in > 0 ? in_sizes[0] : -1, out_size, ws_size); grid = -1; return; }
        int dev = 0, cus = 0, per_cu = 0;
        hipGetDevice(&dev); hipDeviceGetAttribute(&cus, hipDeviceAttributeMultiprocessorCount, dev);
        if (hipFuncSetAttribute((const void*)fwd_megakernel, hipFuncAttributeMaxDynamicSharedMemorySize, LDS_BYTES) != hipSuccess) { fprintf(stderr, "kernel_launch: hipFuncSetAttribute failed\n"); grid = -1; return; }
        if (hipOccupancyMaxActiveBlocksPerMultiprocessor(&per_cu, (const void*)fwd_megakernel, NWAVES * 64, LDS_BYTES) != hipSuccess || per_cu < 1) { fprintf(stderr, "kernel_launch: occupancy query says %d blocks/CU\n", per_cu); (void)hipGetLastError(); per_cu = 1; }
        grid = cus * 1;
        fprintf(stderr, "kernel_launch: cus %d per_cu %d grid %d\n", cus, per_cu, grid);
    }
    if (grid < 0) return;
    hipMemsetAsync((char*)d_ws + WS_CTL, 0, CTL_BYTES, stream);
    Args a{};
    for (int i = 0; i < 17; ++i) a.in[i] = (const float*)d_in[i];
    a.out = (float*)d_out; a.ws = (unsigned char*)d_ws;
    void* args[] = {&a};
    hipError_t e = hipLaunchCooperativeKernel((const void*)fwd_megakernel, dim3(grid), dim3(NWAVES * 64), args, LDS_BYTES, stream);
    if (e != hipSuccess) fprintf(stderr, "cooperative launch failed: %s (grid %d)\n", hipGetErrorString(e), grid);
}
```

```cpp
#include <hip/hip_runtime.h>
#include <hip/hip_cooperative_groups.h>
#include <cstdio>
#include <cstdint>
namespace cg = cooperative_groups;
namespace pg8 {
#define PG8_LAS __attribute__((address_space(3)))
typedef unsigned short bf16_t;
typedef short bf16x8 __attribute__((ext_vector_type(8)));
typedef float f32x4 __attribute__((ext_vector_type(4)));
typedef unsigned u32x4 __attribute__((ext_vector_type(4)));
constexpr int BM = 256, BK = 64, HALF = 128, HTB = HALF * BK * 2  , STAGE_BYTES = 8 * HTB, NXCD = 8, WGM = 8;

__host__ __device__ __forceinline__ int lds_byte(int r, int c) { const int st = (r >> 4) * 2 + (c >> 5), rr = r & 15, cc = c & 31, ob = rr * 64 + cc * 2; return st * 1024 + (ob ^ (((ob >> 9) & 1) << 5)); }
__host__ __device__ __forceinline__ void stage_rc(int b, int& R, int& C) { const int st = b / 1024, sb = b % 1024, swz = sb ^ (((sb >> 9) & 1) << 5); R = (st >> 1) * 16 + swz / 64; C = (st & 1) * 32 + (swz % 64) / 2; }
__host__ __device__ __forceinline__ int perm32(int rho) { const int n = rho >> 4, i = rho & 15; return 8 * (i >> 2) + 4 * n + (i & 3); }

struct Unit { int pm, pn; };
struct Gemm { const bf16_t* A; const bf16_t* Bt; int M, N, K; };

struct StaticOrder {
    int nM, nN, nwg, G, c;
    __host__ __device__ void init(int M, int N, int G_, int c_) { nM = M / BM; nN = N / BM; nwg = nM * nN; G = G_; c = c_; }
    __host__ __device__ bool next(int i, Unit& u) const {
        const long L = (long)i * G + c; if (L >= nwg) return false;
        int wgid = (int)L; { const int q = nwg / NXCD, r = nwg % NXCD, xcd = wgid % NXCD, off = wgid / NXCD; wgid = (xcd < r ? xcd * (q + 1) : r * (q + 1) + (xcd - r) * q) + off; }
        const int nig = WGM * nN, gid = wgid / nig, fm = gid * WGM, gsz = (nM - fm) < WGM ? (nM - fm) : WGM;
        u.pm = fm + ((wgid % nig) % gsz); u.pn = (wgid % nig) / gsz; return true;
    }
    __device__ __forceinline__ void a_ready(const Unit&) const {}
    __device__ __forceinline__ void done(const Unit&) const {}
};

__device__ __forceinline__ unsigned cvt_pk_bf16(float lo, float hi) { unsigned r; asm volatile("v_cvt_pk_bf16_f32 %0, %1, %2" : "=v"(r) : "v"(lo), "v"(hi)); return r; }
__device__ __forceinline__ float silu_f(float g) { return g * __builtin_amdgcn_rcpf(1.0f + __expf(-g)); }
struct EpiSwiGLU {
    static constexpr bool PERM = true, AFTER_DRAIN = false;
    bf16_t* O; int ldc;
    __device__ __forceinline__ void operator()(const f32x4 (&acc)[2][2][4][2], const Unit& u, int wr, int wc, int fr, int fq) const {
        const int row0 = u.pm * BM + wr * 64 + fr; const int col0 = u.pn * 128 + wc * 32 + 8 * fq;
#pragma unroll
        for (int ai = 0; ai < 2; ++ai)
#pragma unroll
            for (int m = 0; m < 4; ++m) { bf16_t* rowp = O + (size_t)(row0 + ai * HALF + m * 16) * ldc + col0;
                const f32x4 g0 = acc[ai][0][m][0], g1 = acc[ai][0][m][1], u0 = acc[ai][1][m][0], u1 = acc[ai][1][m][1];
                u32x4 w;
                w.x = cvt_pk_bf16(silu_f(g0[0]) * u0[0], silu_f(g0[1]) * u0[1]); w.y = cvt_pk_bf16(silu_f(g0[2]) * u0[2], silu_f(g0[3]) * u0[3]);
                w.z = cvt_pk_bf16(silu_f(g1[0]) * u1[0], silu_f(g1[1]) * u1[1]); w.w = cvt_pk_bf16(silu_f(g1[2]) * u1[2], silu_f(g1[3]) * u1[3]);
                *(u32x4*)rowp = w; }
    }
};
struct EpiRes {
    static constexpr bool PERM = false, AFTER_DRAIN = false;
    const float* base; float* out; int ldc; float scale;
    __device__ __forceinline__ void operator()(const f32x4 (&acc)[2][2][4][2], const Unit& u, int wr, int wc, int fr, int fq) const {
        const int row0 = u.pm * BM + wr * 64 + fr; const int col0 = u.pn * BM + wc * 32 + 4 * fq;
#pragma unroll
        for (int ai = 0; ai < 2; ++ai)
#pragma unroll
            for (int m = 0; m < 4; ++m) { const size_t off = (size_t)(row0 + ai * HALF + m * 16) * ldc + col0;
#pragma unroll
                for (int bj = 0; bj < 2; ++bj)
#pragma unroll
                    for (int n = 0; n < 2; ++n) { const f32x4 b = *(const f32x4*)(base + off + bj * HALF + n * 16); *(f32x4*)(out + off + bj * HALF + n * 16) = b + acc[ai][bj][m][n] * scale; }
                asm volatile("" ::: "memory"); }
    }
};
struct EpiProj {
    static constexpr bool PERM = true, AFTER_DRAIN = false;
    bf16_t* Qh; bf16_t* KVh; bf16_t* P2;
    __device__ __forceinline__ void operator()(const f32x4 (&acc)[2][2][4][2], const Unit& u, int wr, int wc, int fr, int fq) const {
        const int row0 = u.pm * BM + wr * 64 + fr;
#pragma unroll
        for (int ai = 0; ai < 2; ++ai)
#pragma unroll
            for (int m = 0; m < 4; ++m) { const int row = row0 + ai * HALF + m * 16, bb = row >> 12, t = row & 4095;
#pragma unroll
                for (int bj = 0; bj < 2; ++bj) { const int col = u.pn * BM + bj * HALF + wc * 32 + 8 * fq;
                    bf16_t* dst;
                    if (u.pn < 6) { const int sec = col >> 9, hc = col & 511, hh = hc >> 6, d = hc & 63; const size_t rt = (size_t)(bb * 8 + hh) * 4096 + t;
                        dst = (sec == 0) ? Qh + rt * 64 + d : KVh + rt * 128 + (sec - 1) * 64 + d; }
                    else dst = P2 + (size_t)row * 2048 + (col - 1536);
                    const f32x4 v0 = acc[ai][bj][m][0], v1 = acc[ai][bj][m][1]; u32x4 w;
                    w.x = cvt_pk_bf16(v0[0], v0[1]); w.y = cvt_pk_bf16(v0[2], v0[3]); w.z = cvt_pk_bf16(v1[0], v1[1]); w.w = cvt_pk_bf16(v1[2], v1[3]);
                    *(u32x4*)dst = w; } }
    }
};
struct EpiStoreBf16 {
    static constexpr bool PERM = true, AFTER_DRAIN = false;
    bf16_t* O; int ldc;
    __device__ __forceinline__ void operator()(const f32x4 (&acc)[2][2][4][2], const Unit& u, int wr, int wc, int fr, int fq) const {
        const int row0 = u.pm * BM + wr * 64 + fr; const int col0 = u.pn * BM + wc * 32 + 8 * fq;
#pragma unroll
        for (int ai = 0; ai < 2; ++ai)
#pragma unroll
            for (int m = 0; m < 4; ++m) { bf16_t* rowp = O + (size_t)(row0 + ai * HALF + m * 16) * ldc + col0;
#pragma unroll
                for (int bj = 0; bj < 2; ++bj) { const f32x4 v0 = acc[ai][bj][m][0], v1 = acc[ai][bj][m][1]; u32x4 w;
                    w.x = cvt_pk_bf16(v0[0], v0[1]); w.y = cvt_pk_bf16(v0[2], v0[3]); w.z = cvt_pk_bf16(v1[0], v1[1]); w.w = cvt_pk_bf16(v1[2], v1[3]);
                    *(u32x4*)(rowp + bj * HALF) = w; } }
    }
};
template <class Epi, class Sched, bool ALIGN_EPI = false, bool SP2 = false>
__device__ __forceinline__ void gemm_phase(PG8_LAS unsigned char* lds, const Gemm g, const Sched& S, const Epi& E) {
    const int tid = threadIdx.x, wid = __builtin_amdgcn_readfirstlane(tid >> 6), lane = tid & 63, wr = wid >> 2, wc = wid & 3, fr = lane & 15, fq = lane >> 4;
    const int K = g.K, nt = K / BK;
    unsigned voffA[2], voffB[2];
#pragma unroll
    for (int i = 0; i < 2; ++i) { int R, C; stage_rc(tid * 16 + i * 8192, R, C); const int Rb = Epi::PERM ? ((R & ~31) + perm32(R & 31)) : R;
        voffA[i] = (unsigned)(R * K + C) * 2u; voffB[i] = (unsigned)(Rb * K + C) * 2u; }
    const size_t kstep = (size_t)(BK * 2);
    const size_t hstep = (size_t)HALF * K * 2;
    const size_t tstep = 2 * hstep;
    const unsigned ldsw = (unsigned)wid * 1024u;
    const int aoff = lds_byte(wr * 64 + fr, fq * 8), boff = lds_byte(wc * 32 + fr, fq * 8);
#define PG8_SA(b, h) (((b) * 2 + (h)) * HTB)
#define PG8_SB(b, h) ((4 + (b) * 2 + (h)) * HTB)
#define PG8_STAGE(bufoff, gbase, voff) do { _Pragma("unroll") for (int _i = 0; _i < 2; ++_i) \
        __builtin_amdgcn_global_load_lds((const unsigned*)((const char*)(gbase) + (voff)[_i]), (PG8_LAS unsigned*)(lds + (bufoff) + ldsw + _i * 8192), 16, 0, 0); } while (0)
#define PG8_LDA(dst, b, h) do { _Pragma("unroll") for (int m = 0; m < 4; ++m) _Pragma("unroll") for (int k = 0; k < 2; ++k) dst[m][k] = *(const PG8_LAS bf16x8*)(lds + PG8_SA(b, h) + aoff + m * 2048 + k * 1024); } while (0)
#define PG8_LDB(dst, b, h) do { _Pragma("unroll") for (int n = 0; n < 2; ++n) _Pragma("unroll") for (int k = 0; k < 2; ++k) dst[n][k] = *(const PG8_LAS bf16x8*)(lds + PG8_SB(b, h) + boff + n * 2048 + k * 1024); } while (0)
#define PG8_MMA(ai, bj, At, Bt) do { __builtin_amdgcn_s_setprio(1); _Pragma("unroll") for (int m = 0; m < 4; ++m) _Pragma("unroll") for (int n = 0; n < 2; ++n) _Pragma("unroll") for (int k = 0; k < 2; ++k) \
        acc[ai][bj][m][n] = __builtin_amdgcn_mfma_f32_16x16x32_bf16(Bt[n][k], At[m][k], acc[ai][bj][m][n], 0, 0, 0); __builtin_amdgcn_s_setprio(0); } while (0)
#define PG8_WAIT_V(n) asm volatile("s_waitcnt vmcnt(" #n ")" ::: "memory")
#define PG8_WAIT_L(n) asm volatile("s_waitcnt lgkmcnt(" #n ")" ::: "memory")
#define PG8_BAR __builtin_amdgcn_s_barrier()
#define PG8_SCHED __builtin_amdgcn_sched_barrier(0)
    Unit cur, nxt; int ui = 0;
    if (!S.next(0, cur)) return;
    f32x4 acc[2][2][4][2];
#pragma unroll
    for (int a = 0; a < 2; ++a)
#pragma unroll
        for (int b = 0; b < 2; ++b)
#pragma unroll
            for (int m = 0; m < 4; ++m)
#pragma unroll
                for (int n = 0; n < 2; ++n) acc[a][b][m][n] = (f32x4){0.f, 0.f, 0.f, 0.f};
    bf16x8 At[4][2], B0[2][2], B1[2][2];
    const char* cA = (const char*)g.A + (size_t)cur.pm * tstep; const char* cB = (const char*)g.Bt + (size_t)cur.pn * tstep;
    S.a_ready(cur);
    if constexpr (SP2) {
        PG8_STAGE(PG8_SB(0, 0), cB, voffB); PG8_STAGE(PG8_SB(0, 1), cB + hstep, voffB); PG8_STAGE(PG8_SA(0, 0), cA, voffA); PG8_STAGE(PG8_SA(0, 1), cA + hstep, voffA);
        if (wr == 1) PG8_BAR;
        PG8_WAIT_V(2); PG8_BAR;
        PG8_STAGE(PG8_SB(1, 0), cB + kstep, voffB); PG8_STAGE(PG8_SA(1, 0), cA + kstep, voffA); PG8_STAGE(PG8_SB(1, 1), cB + hstep + kstep, voffB);
        PG8_WAIT_V(6); PG8_BAR;
    } else {
        PG8_STAGE(PG8_SB(0, 0), cB, voffB); PG8_STAGE(PG8_SA(0, 0), cA, voffA); PG8_STAGE(PG8_SB(0, 1), cB + hstep, voffB); PG8_STAGE(PG8_SA(0, 1), cA + hstep, voffA);
        if (wr == 1) PG8_BAR;
        PG8_WAIT_V(4); PG8_BAR;
        PG8_STAGE(PG8_SB(1, 0), cB + kstep, voffB); PG8_STAGE(PG8_SA(1, 0), cA + kstep, voffA); PG8_STAGE(PG8_SB(1, 1), cB + hstep + kstep, voffB);
        PG8_WAIT_V(6); PG8_BAR;
    }
    for (;;) {
        const bool has_next = S.next(ui + 1, nxt);
        const char* nA = has_next ? (const char*)g.A + (size_t)nxt.pm * tstep : cA; const char* nB = has_next ? (const char*)g.Bt + (size_t)nxt.pn * tstep : cB;
        for (int t = 0; t < nt; t += 2) {
            const bool last = (t == nt - 2);
            const char* a1 = cA + (size_t)(t + 1) * kstep;
            const char* a2 = last ? nA : cA + (size_t)(t + 2) * kstep; const char* b2 = last ? nB : cB + (size_t)(t + 2) * kstep;
            const char* a3 = a2 + kstep; const char* b3 = b2 + kstep;
            if (last && has_next) S.a_ready(nxt);
            if constexpr (SP2) {
            PG8_LDB(B0, 0, 0); PG8_LDB(B1, 0, 1); PG8_SCHED; PG8_LDA(At, 0, 0); PG8_STAGE(PG8_SA(1, 1), a1 + hstep, voffA);
            PG8_WAIT_V(8); PG8_WAIT_L(0); PG8_BAR; PG8_MMA(0, 0, At, B0); PG8_MMA(0, 1, At, B1); PG8_BAR; PG8_SCHED;
            PG8_LDA(At, 0, 1); PG8_STAGE(PG8_SB(0, 0), b2, voffB); PG8_STAGE(PG8_SB(0, 1), b2 + hstep, voffB); PG8_STAGE(PG8_SA(0, 0), a2, voffA);
            PG8_WAIT_V(8); PG8_WAIT_L(0); PG8_BAR; PG8_MMA(1, 0, At, B0); PG8_MMA(1, 1, At, B1); PG8_BAR; PG8_SCHED;
            PG8_LDB(B0, 1, 0); PG8_LDB(B1, 1, 1); PG8_SCHED; PG8_LDA(At, 1, 0); PG8_STAGE(PG8_SA(0, 1), a2 + hstep, voffA);
            PG8_WAIT_V(8); PG8_WAIT_L(0); PG8_BAR; PG8_MMA(0, 0, At, B0); PG8_MMA(0, 1, At, B1); PG8_BAR; PG8_SCHED;
            PG8_LDA(At, 1, 1); PG8_STAGE(PG8_SB(1, 0), b3, voffB); PG8_STAGE(PG8_SB(1, 1), b3 + hstep, voffB); PG8_STAGE(PG8_SA(1, 0), a3, voffA);
            PG8_WAIT_V(8); PG8_WAIT_L(0); PG8_BAR; PG8_MMA(1, 0, At, B0); PG8_MMA(1, 1, At, B1); PG8_BAR; PG8_SCHED;
            } else {
            PG8_LDB(B0, 0, 0); PG8_SCHED; PG8_LDA(At, 0, 0); PG8_STAGE(PG8_SA(1, 1), a1 + hstep, voffA);
            PG8_WAIT_L(8); PG8_BAR; PG8_WAIT_L(0); PG8_MMA(0, 0, At, B0); PG8_BAR; PG8_SCHED;
            PG8_LDB(B1, 0, 1); PG8_STAGE(PG8_SB(0, 0), b2, voffB);
            PG8_BAR; PG8_WAIT_L(0); PG8_MMA(0, 1, At, B1); PG8_BAR;
            PG8_LDA(At, 0, 1); PG8_STAGE(PG8_SA(0, 0), a2, voffA);
            PG8_BAR; PG8_WAIT_L(0); PG8_MMA(1, 0, At, B0); PG8_BAR; PG8_SCHED;
            PG8_STAGE(PG8_SB(0, 1), b2 + hstep, voffB);
            PG8_WAIT_V(6); PG8_BAR; PG8_MMA(1, 1, At, B1); PG8_BAR;
            PG8_LDB(B0, 1, 0); PG8_SCHED; PG8_LDA(At, 1, 0); PG8_STAGE(PG8_SA(0, 1), a2 + hstep, voffA);
            PG8_WAIT_L(8); PG8_BAR; PG8_WAIT_L(0); PG8_MMA(0, 0, At, B0); PG8_BAR; PG8_SCHED;
            PG8_LDB(B1, 1, 1); PG8_STAGE(PG8_SB(1, 0), b3, voffB);
            PG8_BAR; PG8_WAIT_L(0); PG8_MMA(0, 1, At, B1); PG8_BAR;
            PG8_LDA(At, 1, 1); PG8_STAGE(PG8_SA(1, 0), a3, voffA);
            PG8_BAR; PG8_WAIT_L(0); PG8_MMA(1, 0, At, B0); PG8_BAR; PG8_SCHED;
            PG8_STAGE(PG8_SB(1, 1), b3 + hstep, voffB);
            PG8_WAIT_V(6); PG8_BAR; PG8_MMA(1, 1, At, B1); PG8_BAR;
            }
        }
        if constexpr (ALIGN_EPI) { if (wr == 0) PG8_BAR; }
        if constexpr (!Epi::AFTER_DRAIN) { E(acc, cur, wr, wc, fr, fq); S.done(cur); }
        if (!has_next) break;
#pragma unroll
        for (int a = 0; a < 2; ++a)
#pragma unroll
            for (int b = 0; b < 2; ++b)
#pragma unroll
                for (int m = 0; m < 4; ++m)
#pragma unroll
                    for (int n = 0; n < 2; ++n) acc[a][b][m][n] = (f32x4){0.f, 0.f, 0.f, 0.f};
        cur = nxt; cA = nA; cB = nB; ++ui;
        if constexpr (ALIGN_EPI) { if (wr == 1) PG8_BAR; }
    }
    PG8_WAIT_V(0);
    if constexpr (!ALIGN_EPI) { if (wr == 0) PG8_BAR; }
    PG8_BAR;
    if constexpr (Epi::AFTER_DRAIN) { E.fused(acc, cur, wr, wc, fr, fq, lds, wid, lane); S.done(cur); }
#undef PG8_SA
#undef PG8_SB
#undef PG8_STAGE
#undef PG8_LDA
#undef PG8_LDB
#undef PG8_MMA
#undef PG8_WAIT_V
#undef PG8_WAIT_L
#undef PG8_BAR
#undef PG8_SCHED
}
}
constexpr int M = 16384, D = 1024, FF = 2816, NGU = 5632, NIN = 3584, SEQ = 4096;
constexpr int WIN_COLS = 3592;
constexpr size_t MiB = 1u << 20;
constexpr size_t WS_CTL = 0, CTL_BYTES = 65536;
constexpr size_t WS_WIN = 1 * MiB, WS_WOUT = 8 * MiB, WS_WGU2 = 10 * MiB, WS_WD2 = 21 * MiB;
constexpr size_t WS_XN = 27 * MiB;
constexpr size_t WS_ACT = 59 * MiB;
constexpr size_t WS_QH = 123 * MiB, WS_KVH = 139 * MiB;
constexpr int P2LD = 2048;
constexpr size_t WS_BD = 171 * MiB;
constexpr size_t WS_EG = 172 * MiB;
constexpr size_t WS_DN = 184 * MiB;
constexpr size_t WS_WGU1 = 184 * MiB, WS_WD1 = 195 * MiB;
constexpr size_t WS_QG = WS_DN, WS_KD = WS_DN + 16 * MiB, WS_U = WS_DN + 32 * MiB, WS_W = WS_DN + 48 * MiB, WS_A = WS_DN + 64 * MiB;
constexpr size_t WS_END = 256 * MiB;
constexpr int LDS_BYTES = 147456;
constexpr int NWAVES = 8;

#define GAS __attribute__((address_space(1)))
#define LAS __attribute__((address_space(3)))
typedef unsigned short bf16;
typedef unsigned v4u __attribute__((ext_vector_type(4)));
typedef unsigned v2u __attribute__((ext_vector_type(2)));
typedef float f32x4 __attribute__((ext_vector_type(4)));
typedef float f32x2 __attribute__((ext_vector_type(2)));
#define LDS_WAIT() asm volatile("s_waitcnt lgkmcnt(0)" ::: "memory")
__device__ __forceinline__ unsigned f2bf(float f) { unsigned u = __builtin_bit_cast(unsigned, f); return (u + 0x7fffu + ((u >> 16) & 1u)) >> 16; }
__device__ __forceinline__ unsigned pk2(float lo, float hi) { return f2bf(lo) | (f2bf(hi) << 16); }
__device__ __forceinline__ float bflo(unsigned u) { return __uint_as_float(u << 16); }
__device__ __forceinline__ float bfhi(unsigned u) { return __uint_as_float(u & 0xffff0000u); }
__device__ __forceinline__ float bf2f(bf16 v) { return __uint_as_float(((unsigned)v) << 16); }
__device__ __forceinline__ float wave_sum(float v) {
#pragma unroll
    for (int o = 1; o < 64; o <<= 1) v += __shfl_xor(v, o);
    return v;
}
__device__ __forceinline__ float wave_max(float v) {
#pragma unroll
    for (int o = 1; o < 64; o <<= 1) v = fmaxf(v, __shfl_xor(v, o));
    return v;
}

__device__ __forceinline__ int opq(int v) { asm volatile("" : "+v"(v)); return v; }
struct Args { const float* in[17]; float* out; unsigned char* ws; };

__device__ __forceinline__ void transpose_item(const float* src, int srcN, int srccol0, bf16* dst, int dstK, int dstrow0, int k0, LAS float* scr, int lane) {
#pragma unroll 8
    for (int i = 0; i < 32; ++i) { const int kk = 2 * i + (lane >> 5); scr[kk * 33 + (lane & 31)] = src[(size_t)(k0 + kk) * srcN + srccol0 + (lane & 31)]; }
    LDS_WAIT(); asm volatile("" ::: "memory");
    const int c = lane & 7;
#pragma unroll
    for (int j = 0; j < 4; ++j) { const int n = (lane >> 3) + 8 * j; const LAS float* s = scr + (8 * c) * 33 + n;
        v4u o; o.x = pk2(s[0 * 33], s[1 * 33]); o.y = pk2(s[2 * 33], s[3 * 33]); o.z = pk2(s[4 * 33], s[5 * 33]); o.w = pk2(s[6 * 33], s[7 * 33]);
        *(v4u*)(dst + (size_t)(dstrow0 + n) * dstK + k0 + 8 * c) = o; }
    LDS_WAIT(); asm volatile("" ::: "memory");
}
__device__ __forceinline__ void tr_gu(const float* gate, const float* up, bf16* dst, int r, LAS float* scr, int lane) {
    const int nblk = NGU / 32, kb = r / nblk, nb = r % nblk, dstrow0 = nb * 32, pn = dstrow0 >> 8, within = dstrow0 & 255;
    transpose_item(within < 128 ? gate : up, FF, pn * 128 + (within & 127), dst, D, dstrow0, kb * 64, scr, lane);
}
__device__ __forceinline__ void tr_plain(const float* src, int K, int N, bf16* dst, int r, LAS float* scr, int lane) {
    const int nblk = N / 32, kb = r / nblk, nb = r % nblk;
    transpose_item(src, N, nb * 32, dst, K, nb * 32, kb * 64, scr, lane);
}
__device__ __forceinline__ void tr_win(const float* src, bf16* dst, int r, LAS float* scr, int lane) {
    const int nblk = NIN / 32, kb = r / nblk, nb = r % nblk, dstrow0 = nb * 32;
    transpose_item(src, WIN_COLS, dstrow0 + (dstrow0 >= 3072 ? 8 : 0), dst, D, dstrow0, kb * 64, scr, lane);
}

__device__ __forceinline__ void rms_row(const float* xrow, const float* gain, int lane, f32x4 (&v)[4]) {
    const f32x4* xr = (const f32x4*)xrow + lane; const f32x4* gr = (const f32x4*)gain + lane;
    float s = 0.f;
#pragma unroll
    for (int j = 0; j < 4; ++j) { v[j] = xr[64 * j]; s += (v[j].x * v[j].x + v[j].y * v[j].y) + (v[j].z * v[j].z + v[j].w * v[j].w); }
    const float rs = 1.0f / sqrtf(wave_sum(s) * (1.f / D) + 1e-6f);
#pragma unroll
    for (int j = 0; j < 4; ++j) { const f32x4 g = gr[64 * j]; v[j] = v[j] * rs * g; }
}
__device__ __forceinline__ void store_row_bf16(bf16* orow, int lane, const f32x4 (&v)[4]) {
    v2u* o8 = (v2u*)orow + lane;
#pragma unroll
    for (int j = 0; j < 4; ++j) { v2u w; w.x = pk2(v[j].x, v[j].y); w.y = pk2(v[j].z, v[j].w); o8[64 * j] = w; }
}

__device__ __forceinline__ int kperm(int x) { return 8 * ((x & 15) >> 2) + 4 * (x >> 4) + (x & 3); }
typedef short bf16x8 __attribute__((ext_vector_type(8)));
typedef __bf16 bf16x2_t __attribute__((ext_vector_type(2)));
__device__ __forceinline__ unsigned cvtpk(float lo, float hi) { f32x2 v = {lo, hi}; bf16x2_t b = __builtin_convertvector(v, bf16x2_t); return __builtin_bit_cast(unsigned, b); }
constexpr int PQ = 0, PK = 17408, PVB = 34816, PKB = 53248, PAS = 71680, PTS = 88320, PMS = 104960, PTB = 121600, PGC = 130816;
__device__ __forceinline__ void dn_prep_item(const Args& a, LAS unsigned char* L8, int ch, int tid, int lane, int wave) {
    unsigned char* ws = a.ws;
    const bf16* PROJ = (const bf16*)(ws + WS_ACT);
    const float* BD = (const float*)(ws + WS_BD);
    const float* conv_w = a.in[7]; const float* a_log = a.in[8]; const float* dt_bias = a.in[9];
    const int bh = ch >> 6, n = ch & 63, b = bh >> 2, h = bh & 3;
    const int tok0 = b * SEQ + n * 64;
    LAS float* As = (LAS float*)(L8 + PAS); LAS float* Ts = (LAS float*)(L8 + PTS); LAS float* Ms = (LAS float*)(L8 + PMS);
    LAS float* gcs = (LAS float*)(L8 + PGC); LAS float* bts = gcs + 64;
    const int jl = lane & 15, kq = lane >> 4;
    unsigned raw[11][3];
#pragma unroll
    for (int i = 0; i < 11; ++i) { const int s = n * 64 + wave * 8 - 3 + i;
#pragma unroll
        for (int sec = 0; sec < 3; ++sec) raw[i][sec] = (s >= 0) ? *(const unsigned*)(PROJ + (size_t)(tok0 + wave * 8 - 3 + i) * P2LD + sec * 512 + h * 128 + 2 * lane) : 0u; }
    if (wave == 0) {
        const int tok = tok0 + lane;
        const float braw = BD[(size_t)tok * 8 + h], draw = BD[(size_t)tok * 8 + 4 + h] + dt_bias[h];
        const float sp = fmaxf(draw, 0.f) + log1pf(__expf(-fabsf(draw)));
        float g = -expf(a_log[h]) * sp;
#pragma unroll
        for (int o = 1; o < 64; o <<= 1) { const float t = __shfl_up(g, o); if (lane >= o) g += t; }
        gcs[lane] = g; bts[lane] = 1.0f / (1.0f + __expf(-braw));
        if (lane == 63) ((float*)(ws + WS_EG))[ch] = expf(g);
    }
    for (int i = tid; i < 64 * 65; i += 512) Ts[i] = 0.f;
    __syncthreads();
    {
        float cw[3][4][2];
#pragma unroll
        for (int sec = 0; sec < 3; ++sec)
#pragma unroll
            for (int j = 0; j < 4; ++j) { const f32x2 w = *(const f32x2*)(conv_w + j * 1536 + sec * 512 + h * 128 + 2 * lane); cw[sec][j][0] = w.x; cw[sec][j][1] = w.y; }
        const float glast = gcs[63];
        bf16* QG = (bf16*)(ws + WS_QG) + (size_t)ch * 8192; bf16* KD = (bf16*)(ws + WS_KD) + (size_t)ch * 8192;
#pragma unroll
        for (int rr = 0; rr < 8; ++rr) {
            const int r = wave * 8 + rr;
            float val[3][2];
#pragma unroll
            for (int sec = 0; sec < 3; ++sec) { float v0 = 0.f, v1 = 0.f;
#pragma unroll
                for (int j = 0; j < 4; ++j) { v0 += bflo(raw[rr + j][sec]) * cw[sec][j][0]; v1 += bfhi(raw[rr + j][sec]) * cw[sec][j][1]; }
                val[sec][0] = v0 / (1.f + __expf(-v0)); val[sec][1] = v1 / (1.f + __expf(-v1)); }
            const float ssq = wave_sum(val[0][0] * val[0][0] + val[0][1] * val[0][1]);
            const float ssk = wave_sum(val[1][0] * val[1][0] + val[1][1] * val[1][1]);
            const float rq = (1.0f / sqrtf(ssq + 1e-6f)) * 0.08838834764831845f, rk = 1.0f / sqrtf(ssk + 1e-6f);
            const float q0 = val[0][0] * rq, q1 = val[0][1] * rq, k0 = val[1][0] * rk, k1 = val[1][1] * rk;
            const float gr = gcs[r], be = bts[r], eq = __expf(gr), ek = __expf(glast - gr), bek = be * eq;
            *(LAS unsigned*)(L8 + PQ + r * 272 + 4 * lane) = cvtpk(q0, q1);
            *(LAS unsigned*)(L8 + PK + r * 272 + 4 * lane) = cvtpk(k0, k1);
            const unsigned vb = cvtpk(val[2][0] * be, val[2][1] * be), kb = cvtpk(k0 * bek, k1 * bek);
            *(LAS bf16*)(L8 + PVB + (2 * lane) * 144 + 2 * r) = (bf16)(vb & 0xffffu); *(LAS bf16*)(L8 + PVB + (2 * lane + 1) * 144 + 2 * r) = (bf16)(vb >> 16);
            *(LAS bf16*)(L8 + PKB + (2 * lane) * 144 + 2 * r) = (bf16)(kb & 0xffffu); *(LAS bf16*)(L8 + PKB + (2 * lane + 1) * 144 + 2 * r) = (bf16)(kb >> 16);
            const int d = 2 * lane;
            *(unsigned*)(QG + r * 128 + (d & 96) + kperm(d & 31)) = cvtpk(q0 * eq, q1 * eq);
            const int tp = (r & 32) + kperm(r & 31); const unsigned kd = cvtpk(k0 * ek, k1 * ek);
            KD[d * 64 + tp] = (bf16)(kd & 0xffffu); KD[(d + 1) * 64 + tp] = (bf16)(kd >> 16);
        }
    }
    __syncthreads();
    {
        bf16* Aout = (bf16*)(ws + WS_A) + (size_t)ch * 4096;
#pragma unroll
        for (int t2 = 0; t2 < 2; ++t2) {
            const int idx = 2 * wave + t2, ct = idx >> 2, jt = idx & 3;
            f32x4 acc1 = {0.f, 0.f, 0.f, 0.f}, acc2 = {0.f, 0.f, 0.f, 0.f};
#pragma unroll
            for (int ks = 0; ks < 4; ++ks) {
                const bf16x8 kc = *(const LAS bf16x8*)(L8 + PK + (16 * ct + jl) * 272 + (32 * ks + 8 * kq) * 2);
                const bf16x8 kj = *(const LAS bf16x8*)(L8 + PK + (16 * jt + jl) * 272 + (32 * ks + 8 * kq) * 2);
                const bf16x8 qc = *(const LAS bf16x8*)(L8 + PQ + (16 * ct + jl) * 272 + (32 * ks + 8 * kq) * 2);
                acc1 = __builtin_amdgcn_mfma_f32_16x16x32_bf16(kc, kj, acc1, 0, 0, 0);
                acc2 = __builtin_amdgcn_mfma_f32_16x16x32_bf16(kj, qc, acc2, 0, 0, 0);
            }
            { const int j = 16 * jt + jl; const float gj = gcs[j];
#pragma unroll
              for (int e = 0; e < 4; ++e) { const int c = 16 * ct + 4 * kq + e; As[c * 65 + j] = (j < c) ? bts[c] * acc1[e] * __expf(gcs[c] - gj) : 0.f; } }
            { const int c = 16 * ct + jl; const float gc_ = gcs[c]; float pv[4];
#pragma unroll
              for (int e = 0; e < 4; ++e) { const int j = 16 * jt + 4 * kq + e; pv[e] = (j <= c) ? acc2[e] * __expf(gc_ - gcs[j]) : 0.f; }
              v2u w; w.x = cvtpk(pv[0], pv[1]); w.y = cvtpk(pv[2], pv[3]);
              *(v2u*)(Aout + c * 64 + 32 * (jt >> 1) + 8 * kq + 4 * (jt & 1)) = w; }
        }
    }
    __syncthreads();
    if (wave == 0) {
        const int bb = lane >> 4, col = lane & 15;
        float xv[16];
#pragma unroll
        for (int c = 0; c < 16; ++c) { float s = (c == col) ? 1.f : 0.f;
#pragma unroll
            for (int j = 0; j < c; ++j) s -= As[(16 * bb + c) * 65 + 16 * bb + j] * xv[j];
            xv[c] = s; }
#pragma unroll
        for (int c = 0; c < 16; ++c) Ts[(16 * bb + c) * 65 + 16 * bb + col] = xv[c];
    }
    __syncthreads();
    {
        const int pr = tid >> 8, i = (tid >> 4) & 15, jj = tid & 15, hb = 32 * pr + 16, lb = 32 * pr;
        float s = 0.f;
#pragma unroll
        for (int k = 0; k < 16; ++k) s += As[(hb + i) * 65 + lb + k] * Ts[(lb + k) * 65 + lb + jj];
        Ms[(hb + i) * 65 + lb + jj] = s;
        __syncthreads();
        float t = 0.f;
#pragma unroll
        for (int k = 0; k < 16; ++k) t += Ts[(hb + i) * 65 + hb + k] * Ms[(hb + k) * 65 + lb + jj];
        Ts[(hb + i) * 65 + lb + jj] = -t;
    }
    __syncthreads();
    {
        const int i = tid >> 4, j0 = (tid & 15) * 2;
        float s0 = 0.f, s1 = 0.f;
#pragma unroll 8
        for (int k = 0; k < 32; ++k) { const float av = As[(32 + i) * 65 + k]; s0 += av * Ts[k * 65 + j0]; s1 += av * Ts[k * 65 + j0 + 1]; }
        Ms[(32 + i) * 65 + j0] = s0; Ms[(32 + i) * 65 + j0 + 1] = s1;
        __syncthreads();
        float t0 = 0.f, t1 = 0.f;
#pragma unroll 8
        for (int k = 0; k < 32; ++k) { const float tv = Ts[(32 + i) * 65 + 32 + k]; t0 += tv * Ms[(32 + k) * 65 + j0]; t1 += tv * Ms[(32 + k) * 65 + j0 + 1]; }
        __syncthreads();
        Ts[(32 + i) * 65 + j0] = -t0; Ts[(32 + i) * 65 + j0 + 1] = -t1;
    }
    __syncthreads();
#pragma unroll
    for (int i = 0; i < 4; ++i) { const int idx2 = tid + 512 * i, r = idx2 >> 5, c = (idx2 & 31) * 2;
        *(LAS unsigned*)(L8 + PTB + r * 144 + 2 * c) = cvtpk(Ts[r * 65 + c], Ts[r * 65 + c + 1]); }
    __syncthreads();
    {
        bf16* U = (bf16*)(ws + WS_U) + (size_t)ch * 8192; bf16* W = (bf16*)(ws + WS_W) + (size_t)ch * 8192;
        const int mt = wave & 3, ntb = 4 * (wave >> 2);
        bf16x8 ta[2];
#pragma unroll
        for (int ks = 0; ks < 2; ++ks) ta[ks] = *(const LAS bf16x8*)(L8 + PTB + (16 * mt + jl) * 144 + (32 * ks + 8 * kq) * 2);
#pragma unroll
        for (int q = 0; q < 4; ++q) { const int nt = ntb + q; f32x4 acc = {0.f, 0.f, 0.f, 0.f};
#pragma unroll
            for (int ks = 0; ks < 2; ++ks) { const bf16x8 vb = *(const LAS bf16x8*)(L8 + PVB + (16 * nt + jl) * 144 + (32 * ks + 8 * kq) * 2);
                acc = __builtin_amdgcn_mfma_f32_16x16x32_bf16(ta[ks], vb, acc, 0, 0, 0); }
            v2u w; w.x = cvtpk(acc[0], acc[1]); w.y = cvtpk(acc[2], acc[3]);
            *(v2u*)(U + (16 * nt + jl) * 64 + 16 * mt + 4 * kq) = w; }
        bf16x8 ka[2];
#pragma unroll
        for (int ks = 0; ks < 2; ++ks) ka[ks] = *(const LAS bf16x8*)(L8 + PKB + (16 * wave + jl) * 144 + (32 * ks + 8 * kq) * 2);
#pragma unroll
        for (int ctile = 0; ctile < 4; ++ctile) { f32x4 acc = {0.f, 0.f, 0.f, 0.f};
#pragma unroll
            for (int ks = 0; ks < 2; ++ks) { const bf16x8 tb = *(const LAS bf16x8*)(L8 + PTB + (16 * ctile + jl) * 144 + (32 * ks + 8 * kq) * 2);
                acc = __builtin_amdgcn_mfma_f32_16x16x32_bf16(ka[ks], tb, acc, 0, 0, 0); }
            v2u w; w.x = cvtpk(-acc[0], -acc[1]); w.y = cvtpk(-acc[2], -acc[3]);
            *(v2u*)(W + (16 * ctile + jl) * 128 + 32 * (wave >> 1) + 8 * kq + 4 * (wave & 1)) = w; }
    }
    __syncthreads();
}

__device__ __forceinline__ bf16x8 pack8(const f32x4& a, const f32x4& b) { v4u w; w.x = cvtpk(a[0], a[1]); w.y = cvtpk(a[2], a[3]); w.z = cvtpk(b[0], b[1]); w.w = cvtpk(b[2], b[3]); return __builtin_bit_cast(bf16x8, w); }
constexpr int SC_W = 0, SC_QG = 17408, SC_KDT = 34816, SC_A = 53248, SC_U = 62464, SC_BUF = 67072;
constexpr int SC_OUT = 2 * SC_BUF;
struct ScanRegs { v4u st[15]; };
__device__ __forceinline__ void sc_load(ScanRegs& R, const unsigned char* ws, int chx, int t, int qtr) {
    const unsigned vo = (unsigned)t * 16u;
    const unsigned char* pw = ws + WS_W + (size_t)chx * 16384; const unsigned char* pq = ws + WS_QG + (size_t)chx * 16384; const unsigned char* pk = ws + WS_KD + (size_t)chx * 16384;
    const unsigned char* pa = ws + WS_A + (size_t)chx * 8192; const unsigned char* pu = ws + WS_U + (size_t)chx * 16384 + qtr * 4096;
#define SC_LDG(k, p) do { R.st[k] = *(const v4u*)(p); __builtin_amdgcn_sched_barrier(0); } while (0)
    __builtin_amdgcn_sched_barrier(0);
    SC_LDG(0, pw + vo); SC_LDG(1, pw + 4096 + vo); SC_LDG(2, pw + 8192 + vo); SC_LDG(3, pw + 12288 + vo);
    SC_LDG(4, pq + vo); SC_LDG(5, pq + 4096 + vo); SC_LDG(6, pq + 8192 + vo); SC_LDG(7, pq + 12288 + vo);
    SC_LDG(8, pk + vo); SC_LDG(9, pk + 4096 + vo); SC_LDG(10, pk + 8192 + vo); SC_LDG(11, pk + 12288 + vo);
    SC_LDG(12, pa + vo); SC_LDG(13, pa + 4096 + vo); SC_LDG(14, pu + vo);
#undef SC_LDG
}
__device__ __forceinline__ void sc_write(const ScanRegs& R, LAS unsigned char* B_, int t) {
    LAS unsigned char* w16 = B_ + (t >> 4) * 272 + (t & 15) * 16;
    LAS unsigned char* k8 = B_ + (t >> 3) * 144 + (t & 7) * 16;
#define SC_STL(k, p) do { *(LAS v4u*)(p) = R.st[k]; __builtin_amdgcn_sched_barrier(0); } while (0)
    __builtin_amdgcn_sched_barrier(0);
    SC_STL(0, w16 + SC_W); SC_STL(1, w16 + SC_W + 16 * 272); SC_STL(2, w16 + SC_W + 32 * 272); SC_STL(3, w16 + SC_W + 48 * 272);
    SC_STL(4, w16 + SC_QG); SC_STL(5, w16 + SC_QG + 16 * 272); SC_STL(6, w16 + SC_QG + 32 * 272); SC_STL(7, w16 + SC_QG + 48 * 272);
    SC_STL(8, k8 + SC_KDT); SC_STL(9, k8 + SC_KDT + 32 * 144); SC_STL(10, k8 + SC_KDT + 64 * 144); SC_STL(11, k8 + SC_KDT + 96 * 144);
    SC_STL(12, k8 + SC_A); SC_STL(13, k8 + SC_A + 32 * 144); SC_STL(14, k8 + SC_U);
#undef SC_STL
}
#define SC_BARRIER() do { asm volatile("s_waitcnt lgkmcnt(0)" ::: "memory"); __builtin_amdgcn_s_barrier(); asm volatile("" ::: "memory"); } while (0)
__device__ __forceinline__ void sc_step_compute(LAS unsigned char* L8, int n, int jl, int kq, int wcol, float egv, f32x4 (&Sacc)[8]) {
    const float eg = __builtin_bit_cast(float, __builtin_amdgcn_readlane(__builtin_bit_cast(int, egv), n));
    const LAS unsigned char* B = L8 + (n & 1) * SC_BUF;
    bf16x8 sb[4];
#pragma unroll
    for (int ks = 0; ks < 4; ++ks) sb[ks] = pack8(Sacc[2 * ks], Sacc[2 * ks + 1]);
    f32x4 vn[4], oa[4];
#pragma unroll
    for (int mt = 0; mt < 4; ++mt) { const v2u u = *(const LAS v2u*)(B + SC_U + (wcol + jl) * 144 + (16 * mt + 4 * kq) * 2);
        vn[mt] = (f32x4){bflo(u.x), bfhi(u.x), bflo(u.y), bfhi(u.y)}; oa[mt] = (f32x4){0.f, 0.f, 0.f, 0.f}; }
    const LAS unsigned char* pW = B + SC_W + jl * 272 + kq * 16; const LAS unsigned char* pQ = B + SC_QG + jl * 272 + kq * 16;
    const LAS unsigned char* pK = B + SC_KDT + jl * 144 + kq * 16; const LAS unsigned char* pA = B + SC_A + jl * 144 + kq * 16;
#define SC_LD_WQ(dst, mt) do { _Pragma("unroll") for (int ks = 0; ks < 4; ++ks) { dst[ks] = *(const LAS bf16x8*)(pW + (mt) * 16 * 272 + ks * 64); dst[4 + ks] = *(const LAS bf16x8*)(pQ + (mt) * 16 * 272 + ks * 64); } } while (0)
#define SC_LD_K(dst, t0) do { _Pragma("unroll") for (int t = 0; t < 4; ++t) _Pragma("unroll") for (int k2 = 0; k2 < 2; ++k2) dst[2 * t + k2] = *(const LAS bf16x8*)(pK + ((t0) + t) * 16 * 144 + k2 * 64); } while (0)
#define SC_LD_A(dst) do { _Pragma("unroll") for (int mt = 0; mt < 4; ++mt) _Pragma("unroll") for (int k2 = 0; k2 < 2; ++k2) dst[2 * mt + k2] = *(const LAS bf16x8*)(pA + mt * 16 * 144 + k2 * 64); } while (0)
#define SC_MM_WQ(src, mt) do { _Pragma("unroll") for (int ks = 0; ks < 4; ++ks) { vn[mt] = __builtin_amdgcn_mfma_f32_16x16x32_bf16(src[ks], sb[ks], vn[mt], 0, 0, 0); oa[mt] = __builtin_amdgcn_mfma_f32_16x16x32_bf16(src[4 + ks], sb[ks], oa[mt], 0, 0, 0); } } while (0)
#define SC_MM_K(src, t0) do { _Pragma("unroll") for (int k2 = 0; k2 < 2; ++k2) _Pragma("unroll") for (int t = 0; t < 4; ++t) Sacc[(t0) + t] = __builtin_amdgcn_mfma_f32_16x16x32_bf16(src[2 * t + k2], vb[k2], Sacc[(t0) + t], 0, 0, 0); } while (0)
#define SC_MM_A(src) do { _Pragma("unroll") for (int k2 = 0; k2 < 2; ++k2) _Pragma("unroll") for (int mt = 0; mt < 4; ++mt) oa[mt] = __builtin_amdgcn_mfma_f32_16x16x32_bf16(src[2 * mt + k2], vb[k2], oa[mt], 0, 0, 0); } while (0)
#define SC_SB() __builtin_amdgcn_sched_barrier(0)
    bf16x8 fa[8], fb[8];
    SC_LD_WQ(fa, 0); SC_LD_WQ(fb, 1); SC_SB();
    SC_MM_WQ(fa, 0); SC_SB(); SC_LD_WQ(fa, 2); SC_SB();
    SC_MM_WQ(fb, 1); SC_SB(); SC_LD_WQ(fb, 3); SC_SB();
    SC_MM_WQ(fa, 2); SC_SB(); SC_LD_K(fa, 0); SC_SB();
    SC_MM_WQ(fb, 3); SC_SB(); SC_LD_K(fb, 4); SC_SB();
    bf16x8 vb[2];
    vb[0] = pack8(vn[0], vn[1]); vb[1] = pack8(vn[2], vn[3]);
#pragma unroll
    for (int T = 0; T < 8; ++T) Sacc[T] = Sacc[T] * eg;
    SC_SB();
    SC_MM_K(fa, 0); SC_SB(); SC_LD_A(fa); SC_SB();
    SC_MM_K(fb, 4); SC_SB();
    SC_MM_A(fa);
#undef SC_LD_WQ
#undef SC_LD_K
#undef SC_LD_A
#undef SC_MM_WQ
#undef SC_MM_K
#undef SC_MM_A
#undef SC_SB
    LAS unsigned char* ob = L8 + SC_OUT + (n & 1) * 4096 + (4 * kq) * 64 + (wcol + jl) * 2;
#pragma unroll
    for (int mt = 0; mt < 4; ++mt)
#pragma unroll
        for (int e = 0; e < 4; ++e) *(LAS bf16*)(ob + (16 * mt + e) * 64) = (bf16)f2bf(oa[mt][e]);
    SC_BARRIER();
}
__device__ __forceinline__ void sc_out_tile(LAS unsigned char* L8, bf16* MIX, int b, int h, int qtr, int n, int l_) {
    const LAS unsigned char* ob = L8 + SC_OUT + (n & 1) * 4096 + l_ * 64;
    const v4u w0 = *(const LAS v4u*)ob, w1 = *(const LAS v4u*)(ob + 16), w2 = *(const LAS v4u*)(ob + 32), w3 = *(const LAS v4u*)(ob + 48);
    bf16* gp = MIX + (size_t)(b * SEQ + n * 64 + l_) * 1024 + 512 + h * 128 + qtr * 32;
    *(v4u*)gp = w0; *(v4u*)(gp + 8) = w1; *(v4u*)(gp + 16) = w2; *(v4u*)(gp + 24) = w3;
}
__device__ __forceinline__ void dn_scan_mfma(const Args& a, LAS unsigned char* L8, int item, int tid, int lane, int wave) {
    unsigned char* ws = a.ws;
    const int xcd_ = item & 7, slot_ = item >> 3;
    const int bh = xcd_ * 2 + (slot_ >> 2), qtr = slot_ & 3, b = bh >> 2, h = bh & 3;
    if (wave < 2) {
        const int jl = lane & 15, kq = lane >> 4;
        f32x4 Sacc[8];
#pragma unroll
        for (int T = 0; T < 8; ++T) Sacc[T] = (f32x4){0.f, 0.f, 0.f, 0.f};
        const float egv = ((const float*)(ws + WS_EG))[bh * 64 + lane];
        asm volatile("s_waitcnt vmcnt(0)" ::: "memory");
        SC_BARRIER();
        for (int n = 0; n < 64; ++n) sc_step_compute(L8, n, jl, kq, wave * 16, egv, Sacc);
    } else if (wave < 6) {
        ScanRegs R0, R1, R2; const int t = tid - 128, c0 = bh * 64;
        sc_load(R0, ws, c0, t, qtr); sc_write(R0, L8, t);
        sc_load(R1, ws, c0 + 1, t, qtr); sc_load(R2, ws, c0 + 2, t, qtr); sc_load(R0, ws, c0 + 3, t, qtr);
        SC_BARRIER();
        for (int n = 0; n < 63; n += 3) {
            sc_write(R1, L8 + ((n + 1) & 1) * SC_BUF, t);
            sc_load(R1, ws, c0 + (n + 4 < 63 ? n + 4 : 63), t, qtr);
            SC_BARRIER();
            sc_write(R2, L8 + ((n + 2) & 1) * SC_BUF, t);
            sc_load(R2, ws, c0 + (n + 5 < 63 ? n + 5 : 63), t, qtr);
            SC_BARRIER();
            sc_write(R0, L8 + ((n + 3) & 1) * SC_BUF, t);
            sc_load(R0, ws, c0 + (n + 6 < 63 ? n + 6 : 63), t, qtr);
            SC_BARRIER();
        }
        SC_BARRIER();
    } else if (wave == 6) {
        SC_BARRIER();
        for (int n = 0; n < 64; ++n) SC_BARRIER();
    } else {
        bf16* MIX = (bf16*)(ws + WS_XN);
        SC_BARRIER();
        for (int n = 0; n < 64; ++n) { if (n > 0) sc_out_tile(L8, MIX, b, h, qtr, n - 1, lane); SC_BARRIER(); }
        sc_out_tile(L8, MIX, b, h, qtr, 63, lane);
    }
    __syncthreads();
}

typedef float f32x16 __attribute__((ext_vector_type(16)));
typedef short s16x4 __attribute__((ext_vector_type(4)));
__device__ __forceinline__ s16x4 vtr(const LAS unsigned char* p) { return __builtin_bit_cast(s16x4, __builtin_amdgcn_ds_read_tr16_b64_v4i16((LAS s16x4*)p)); }
constexpr int KVP = 144;
constexpr int KV_BYTES = 384 * KVP;
constexpr size_t WS_ML = 173 * MiB;
__device__ __forceinline__ void attn_item(const bf16* Qh, const bf16* KVh, bf16* PROJ, float* ML, LAS unsigned char* L8, int item, int tid, int lane, int wave) {
    asm volatile("" : "+v"(lane));
    const int bh = item / 48, rem = item - bh * 48, p = rem >> 4, sub = rem & 15;
    const int b = bh >> 3, h = bh & 7;
    const int dsh = 2 * p, dil = 1 << dsh, nsh = 4 - dsh;
    const int r = sub >> nsh, qb = sub & ((1 << nsh) - 1);
    const int base = 256 * qb;
    const bf16* KVb = KVh + (size_t)(bh * 4096 + r) * 128;
#pragma unroll
    for (int i = 0; i < 12; ++i) { const int id = tid + 512 * i, row = id >> 4, ch = id & 15, idx = base - 128 + row;
        v4u kv = (v4u){0u, 0u, 0u, 0u};
        if (idx >= 0) kv = *(const v4u*)(KVb + (size_t)(dil * idx) * 128 + ch * 8);
        *(LAS v4u*)(L8 + ((ch & 8) ? KV_BYTES : 0) + row * KVP + (ch & 7) * 16) = kv; }
    const int ql = lane & 31, kh = lane >> 5;
    const int tq = r + dil * (base + 32 * wave + ql);
    const size_t tokq = (size_t)b * SEQ + tq;
    bf16x8 qf[4];
#pragma unroll
    for (int s = 0; s < 4; ++s) qf[s] = *(const bf16x8*)(Qh + ((size_t)bh * 4096 + tq) * 64 + 16 * s + 8 * kh);
    __syncthreads();
    f32x16 sc[5];
    {
        const LAS unsigned char* Kp = L8 + (32 * wave + ql) * KVP + kh * 16;
        bf16x8 kf[2][4];
#pragma unroll
        for (int s = 0; s < 4; ++s) kf[0][s] = *(const LAS bf16x8*)(Kp + s * 32);
#pragma unroll
        for (int kt = 0; kt < 5; ++kt) {
            if (kt + 1 < 5) {
#pragma unroll
                for (int s = 0; s < 4; ++s) kf[(kt + 1) & 1][s] = *(const LAS bf16x8*)(Kp + (kt + 1) * 32 * KVP + s * 32); }
            __builtin_amdgcn_sched_barrier(0);
            f32x16 acc = {};
#pragma unroll
            for (int s = 0; s < 4; ++s) acc = __builtin_amdgcn_mfma_f32_32x32x16_bf16(kf[kt & 1][s], qf[s], acc, 0, 0, 0);
            sc[kt] = acc;
            __builtin_amdgcn_sched_barrier(0);
        }
    }
    const float LOG2E = 1.4426950408889634f;
    const float c1 = 0.125f * LOG2E, c2 = exp2f(-(float)(h + 1)) * (float)dil * LOG2E;
    const float Al = -c2 * (float)(128 + ql - 4 * kh);
    float mx = -INFINITY;
#pragma unroll
    for (int kt = 0; kt < 5; ++kt)
#pragma unroll
        for (int rr = 0; rr < 16; ++rr) { const int kc = (rr & 3) + 8 * (rr >> 2);
            float v = fmaf(sc[kt][rr], c1, fmaf(c2, (float)(32 * kt + kc), Al));
            if (kt == 0) v = (kc + 4 * kh >= ql) ? v : -INFINITY;
            if (kt == 4) v = (kc + 4 * kh <= ql) ? v : -INFINITY;
            sc[kt][rr] = v; }
    if (base == 0) {
#pragma unroll
        for (int kt = 0; kt < 4; ++kt)
#pragma unroll
            for (int rr = 0; rr < 16; ++rr) { const int kidx = -128 + 32 * (wave + kt) + (rr & 3) + 8 * (rr >> 2) + 4 * kh; sc[kt][rr] = (kidx >= 0) ? sc[kt][rr] : -INFINITY; }
    }
#pragma unroll
    for (int kt = 0; kt < 5; ++kt)
#pragma unroll
        for (int rr = 0; rr < 16; ++rr) mx = fmaxf(mx, sc[kt][rr]);
    mx = fmaxf(mx, __shfl_xor(mx, 32));
    float lsum = 0.f;
#pragma unroll
    for (int kt = 0; kt < 5; ++kt)
#pragma unroll
        for (int rr = 0; rr < 16; ++rr) { const float pv = __builtin_amdgcn_exp2f(sc[kt][rr] - mx); sc[kt][rr] = pv; lsum += pv; }
    lsum += __shfl_xor(lsum, 32);
    f32x16 o[2]; o[0] = (f32x16){}; o[1] = (f32x16){};
    {
        const int q4 = (lane & 15) >> 2, pp = lane & 3, blk = (lane >> 4) & 1;
        const LAS unsigned char* Vb = L8 + KV_BYTES + (32 * wave + 4 * kh + q4) * KVP + (16 * blk + 4 * pp) * 2;
        s16x4 vf[3][4];
#define AT_LDV(set, step) do { const LAS unsigned char* vr_ = Vb + (16 * (step)) * KVP; vf[set][0] = vtr(vr_); vf[set][1] = vtr(vr_ + 8 * KVP); vf[set][2] = vtr(vr_ + 64); vf[set][3] = vtr(vr_ + 8 * KVP + 64); } while (0)
        AT_LDV(0, 0); AT_LDV(1, 1);
#pragma unroll
        for (int st = 0; st < 10; ++st) {
            if (st + 2 < 10) AT_LDV((st + 2) % 3, st + 2);
            __builtin_amdgcn_sched_barrier(0);
            const int kt = st >> 1, s2 = st & 1;
            v4u pw; pw.x = cvtpk(sc[kt][8 * s2 + 0], sc[kt][8 * s2 + 1]); pw.y = cvtpk(sc[kt][8 * s2 + 2], sc[kt][8 * s2 + 3]); pw.z = cvtpk(sc[kt][8 * s2 + 4], sc[kt][8 * s2 + 5]); pw.w = cvtpk(sc[kt][8 * s2 + 6], sc[kt][8 * s2 + 7]);
            const bf16x8 pb = __builtin_bit_cast(bf16x8, pw);
            const s16x4 l0 = vf[st % 3][0], h0 = vf[st % 3][1], l1 = vf[st % 3][2], h1 = vf[st % 3][3];
            o[0] = __builtin_amdgcn_mfma_f32_32x32x16_bf16((bf16x8){l0[0], l0[1], l0[2], l0[3], h0[0], h0[1], h0[2], h0[3]}, pb, o[0], 0, 0, 0);
            o[1] = __builtin_amdgcn_mfma_f32_32x32x16_bf16((bf16x8){l1[0], l1[1], l1[2], l1[3], h1[0], h1[1], h1[2], h1[3]}, pb, o[1], 0, 0, 0);
            __builtin_amdgcn_sched_barrier(0);
        }
#undef AT_LDV
    }
    const float inv = 1.0f / lsum;
    bf16* dst = PROJ + tokq * P2LD + p * 512 + h * 64 + 4 * kh;
#pragma unroll
    for (int c = 0; c < 2; ++c)
#pragma unroll
        for (int g = 0; g < 4; ++g) { v2u w; w.x = cvtpk(o[c][4 * g + 0] * inv, o[c][4 * g + 1] * inv); w.y = cvtpk(o[c][4 * g + 2] * inv, o[c][4 * g + 3] * inv);
            *(v2u*)(dst + 32 * c + 8 * g) = w; }
    if (kh == 0) { float* ml = ML + ((tokq * 8 + h) * 3 + p) * 2; *(f32x2*)ml = (f32x2){mx, lsum}; }
    __syncthreads();
}

#define XB_TMO      128
#define XB_XCNT(j)  (256  + 64 * (j))
#define XB_XSUB(j)  (1280 + 64 * (j))
#define XB_XGEN(j)  (2304 + 64 * (j))
#define XB_TOP      3328
#define XB_TOPGEN   3392
#define XCD_BAR_WORDS 3456
#define XB_SPIN_CAP (1u << 18)

__device__ __forceinline__ unsigned xb_ld(unsigned* p)              { return __hip_atomic_load(p, __ATOMIC_RELAXED, __HIP_MEMORY_SCOPE_AGENT); }
__device__ __forceinline__ unsigned xb_add(unsigned* p, unsigned v) { return __hip_atomic_fetch_add(p, v, __ATOMIC_RELAXED, __HIP_MEMORY_SCOPE_AGENT); }
__device__ __forceinline__ unsigned xb_xcc_id() { return (unsigned)__builtin_amdgcn_s_getreg((3 << 11) | 20) & 0xFu; }
#define XB_SPIN(cond, bar) do { unsigned _sp = 0; while (cond) { __builtin_amdgcn_s_sleep(1); \
    if ((++_sp & 255u) == 0u) { if (xb_ld(&(bar)[XB_TMO])) break; if (_sp > XB_SPIN_CAP) { atomicAdd(&(bar)[XB_TMO], 1u); break; } } } } while (0)

struct XcdBarrier {
    unsigned* bar; unsigned x;
    volatile LAS unsigned* st;
};

__device__ __forceinline__ XcdBarrier xcd_barrier_post(unsigned* bar, volatile LAS unsigned* st) {
    XcdBarrier b; b.bar = bar; b.x = xb_xcc_id(); b.st = st;
    if (threadIdx.x == 0) (void)xb_add(&bar[XB_XCNT(b.x)], 1u);
    return b;
}
__device__ __forceinline__ void xcd_barrier_complete(unsigned* bar, unsigned x, unsigned& nloc, unsigned& nx) {
    const unsigned G = gridDim.x * gridDim.y * gridDim.z;
    unsigned sum, cnt, mine, sp = 0u;
    for (;;) {
        sum = 0u; cnt = 0u; mine = 0u;
#pragma unroll
        for (unsigned j = 0; j < 16; ++j) { const unsigned c = xb_ld(&bar[XB_XCNT(j)]); sum += c; cnt += (c > 0u) ? 1u : 0u; mine = (j == x) ? c : mine; }
        if (sum == G) break;
        __builtin_amdgcn_s_sleep(1);
        if ((++sp & 255u) == 0u) { if (xb_ld(&bar[XB_TMO])) break; if (sp > XB_SPIN_CAP) { atomicAdd(&bar[XB_TMO], 1u); break; } }
    }
    nloc = mine > 0u ? mine : 1u; nx = cnt > 0u ? cnt : 1u;
}

__device__ __forceinline__ void xcd_barrier(const XcdBarrier& b) {
    asm volatile("s_waitcnt vmcnt(0)" ::: "memory");
    __syncthreads();
    if (threadIdx.x == 0) {
        unsigned* bar = b.bar;
        __builtin_amdgcn_s_waitcnt(0);
        unsigned nloc = b.st[0], nx = b.st[1];
        if (nloc == 0u) { xcd_barrier_complete(bar, b.x, nloc, nx); b.st[0] = nloc; b.st[1] = nx; }
        const unsigned old = xb_add(&bar[XB_XSUB(b.x)], 1u);
        const unsigned gen = old / nloc;
        if (old + 1u == (gen + 1u) * nloc) {
            __builtin_amdgcn_fence(__ATOMIC_RELEASE, "agent");
            asm volatile("s_waitcnt vmcnt(0)" ::: "memory");
            const unsigned og = xb_add(&bar[XB_TOP], 1u);
            const unsigned tg = og / nx;
            if (og + 1u == (tg + 1u) * nx) xb_add(&bar[XB_TOPGEN], 1u);
            else XB_SPIN(xb_ld(&bar[XB_TOPGEN]) == tg, bar);
            __builtin_amdgcn_fence(__ATOMIC_ACQUIRE, "agent");
            xb_add(&bar[XB_XGEN(b.x)], 1u);
            asm volatile("s_waitcnt vmcnt(0)" ::: "memory");
        } else {
            XB_SPIN(xb_ld(&bar[XB_XGEN(b.x)]) == gen, bar);
            __builtin_amdgcn_fence(__ATOMIC_ACQUIRE, "agent");
            asm volatile("s_waitcnt vmcnt(0)" ::: "memory");
        }
    }
    __syncthreads();
}

__global__ void __launch_bounds__(NWAVES * 64, 2) fwd_megakernel(Args a) {
    extern __shared__ __attribute__((aligned(16))) unsigned char lds[];
    cg::grid_group grid = cg::this_grid();
    LAS unsigned char* L8 = (LAS unsigned char*)lds;
    LAS float* L = (LAS float*)lds;
    const int tid = threadIdx.x, lane = tid & 63, wave = __builtin_amdgcn_readfirstlane(tid >> 6);
    const int G = gridDim.x, gw = blockIdx.x * NWAVES + wave, NGW = G * NWAVES;
    unsigned char* ws = a.ws;
    unsigned* ctl = (unsigned*)(ws + WS_CTL);
    const float* x = a.in[0];
    bf16* XN = (bf16*)(ws + WS_XN); bf16* ACT = (bf16*)(ws + WS_ACT); bf16* PROJ = ACT; bf16* MIX = XN;
    bf16* Wgu1 = (bf16*)(ws + WS_WGU1); bf16* Wd1 = (bf16*)(ws + WS_WD1); bf16* Win = (bf16*)(ws + WS_WIN); bf16* Wout = (bf16*)(ws + WS_WOUT);
    bf16* Wgu2 = (bf16*)(ws + WS_WGU2); bf16* Wd2 = (bf16*)(ws + WS_WD2);
    float* out = a.out;
    volatile LAS unsigned* xbst = (volatile LAS unsigned*)(L8 + LDS_BYTES - 64);
    if (tid < 2) xbst[tid] = 0u;
    __syncthreads();
    XcdBarrier bar = xcd_barrier_post(ctl + 1024, xbst);
#define GSYNC() xcd_barrier(bar)

    {
        const int lane = opq(tid) & 63;
        LAS float* scr = L + wave * 4096;
        constexpr int I_GU = (D / 64) * (NGU / 32), I_D = (FF / 64) * (D / 32), I_IN = (D / 64) * (NIN / 32), I_O = (D / 64) * (D / 32);
        constexpr int NITEMS = 2 * I_GU + 2 * I_D + I_IN + I_O;
        for (int it = gw; it < NITEMS; it += NGW) {
            int r = it;
            if (r < I_GU) { tr_gu(a.in[2], a.in[3], Wgu1, r, scr, lane); continue; } r -= I_GU;
            if (r < I_D) { tr_plain(a.in[4], FF, D, Wd1, r, scr, lane); continue; } r -= I_D;
            if (r < I_IN) { tr_win(a.in[6], Win, r, scr, lane); continue; } r -= I_IN;
            if (r < I_O) { tr_plain(a.in[11], D, D, Wout, r, scr, lane); continue; } r -= I_O;
            if (r < I_GU) { tr_gu(a.in[13], a.in[14], Wgu2, r, scr, lane); continue; } r -= I_GU;
            tr_plain(a.in[15], FF, D, Wd2, r, scr, lane);
        }
        for (int m = gw; m < M; m += NGW) { f32x4 v[4]; rms_row(x + (size_t)m * D, a.in[1], lane, v); store_row_bf16(XN + (size_t)m * D, lane, v); }
    }
    grid.sync();
    {
        pg8::Gemm g{XN, Wgu1, M, NGU, D}; pg8::StaticOrder S; S.init(M, NGU, G, (int)blockIdx.x);
        pg8::EpiSwiGLU E{ACT, FF};
        pg8::gemm_phase<pg8::EpiSwiGLU, pg8::StaticOrder, true, true>(L8, g, S, E);
    }
    GSYNC();
    {
        pg8::Gemm g{ACT, Wd1, M, D, FF}; pg8::StaticOrder S; S.init(M, D, G, (int)blockIdx.x);
        pg8::EpiRes E{x, out, D, 0.5f};
        pg8::gemm_phase<pg8::EpiRes, pg8::StaticOrder, true, true>(L8, g, S, E);
    }
    GSYNC();
    {
        const int lane = opq(tid) & 63;
        const float* w_in = a.in[6]; float* BD = (float*)(ws + WS_BD);
        for (int m = gw; m < M; m += NGW) {
            f32x4 v[4]; rms_row(out + (size_t)m * D, a.in[5], lane, v); store_row_bf16(XN + (size_t)m * D, lane, v);
            float acc[8];
#pragma unroll
            for (int o = 0; o < 8; ++o) acc[o] = 0.f;
#pragma unroll
            for (int j = 0; j < 4; ++j)
#pragma unroll
                for (int i = 0; i < 4; ++i) { const int k = 4 * (lane + 64 * j) + i; const f32x4 w0 = *(const f32x4*)(w_in + (size_t)k * WIN_COLS + 3072), w1 = *(const f32x4*)(w_in + (size_t)k * WIN_COLS + 3076);
                    const float hv = v[j][i];
                    acc[0] += hv * w0.x; acc[1] += hv * w0.y; acc[2] += hv * w0.z; acc[3] += hv * w0.w; acc[4] += hv * w1.x; acc[5] += hv * w1.y; acc[6] += hv * w1.z; acc[7] += hv * w1.w; }
#pragma unroll
            for (int o = 0; o < 8; ++o) acc[o] = wave_sum(acc[o]);
            if (lane == 0) { *(f32x4*)(BD + (size_t)m * 8) = (f32x4){acc[0], acc[1], acc[2], acc[3]}; *(f32x4*)(BD + (size_t)m * 8 + 4) = (f32x4){acc[4], acc[5], acc[6], acc[7]}; }
        }
    }
    GSYNC();
    {
        pg8::Gemm g{XN, Win, M, NIN, D}; pg8::StaticOrder S; S.init(M, NIN, G, (int)blockIdx.x);
        pg8::EpiProj E{(bf16*)(ws + WS_QH), (bf16*)(ws + WS_KVH), PROJ};
        pg8::gemm_phase<pg8::EpiProj, pg8::StaticOrder, true, true>(L8, g, S, E);
    }
    GSYNC();
    { const int tid_ = opq(tid); for (int ch = blockIdx.x; ch < 1024; ch += G) dn_prep_item(a, L8, ch, tid_, tid_ & 63, wave); }
    GSYNC();
    {
        const int tid_ = opq(tid), lane = tid_ & 63;
        for (int it = blockIdx.x; it < 64; it += G) dn_scan_mfma(a, L8, it, tid_, lane, wave);
        float* ML = (float*)(ws + WS_ML);
        if ((int)blockIdx.x >= 64 || G <= 64) {
            const int nb = (G > 64) ? G - 64 : G, j0 = (G > 64) ? (int)blockIdx.x - 64 : (int)blockIdx.x;
            for (int item = j0; item < 1536; item += nb) attn_item((const bf16*)(ws + WS_QH), (const bf16*)(ws + WS_KVH), PROJ, ML, L8, item, tid, lane, wave);
        }
    }
    GSYNC();
    {
        const int lane = opq(tid) & 63;
        const float* dn_norm = a.in[10];
        for (int m = gw; m < M; m += NGW) {
            bf16* op = MIX + (size_t)m * 1024 + 512 + 8 * lane; const bf16* gp = PROJ + (size_t)m * P2LD + 1536 + 8 * lane;
            const v4u ow = *(const v4u*)op, gwv = *(const v4u*)gp;
            float o[8] = {bflo(ow.x), bfhi(ow.x), bflo(ow.y), bfhi(ow.y), bflo(ow.z), bfhi(ow.z), bflo(ow.w), bfhi(ow.w)};
            float gt[8] = {bflo(gwv.x), bfhi(gwv.x), bflo(gwv.y), bfhi(gwv.y), bflo(gwv.z), bfhi(gwv.z), bflo(gwv.w), bfhi(gwv.w)};
            float ss = 0.f;
#pragma unroll
            for (int i = 0; i < 8; ++i) ss += o[i] * o[i];
            ss += __shfl_xor(ss, 1); ss += __shfl_xor(ss, 2); ss += __shfl_xor(ss, 4); ss += __shfl_xor(ss, 8);
            const float rs = 1.0f / sqrtf(ss * (1.f / 128.f) + 1e-6f);
            const int d0 = (8 * lane) & 127;
            float r[8];
#pragma unroll
            for (int i = 0; i < 8; ++i) r[i] = o[i] * rs * dn_norm[d0 + i] * (gt[i] / (1.f + __expf(-gt[i])));
            v4u w; w.x = pk2(r[0], r[1]); w.y = pk2(r[2], r[3]); w.z = pk2(r[4], r[5]); w.w = pk2(r[6], r[7]);
            *(v4u*)op = w;
            {
                const int ha = lane >> 3;
                const float* ml = (const float*)(ws + WS_ML) + ((size_t)m * 8 + ha) * 6;
                const f32x2 a0 = *(const f32x2*)ml, a1 = *(const f32x2*)(ml + 2), a2 = *(const f32x2*)(ml + 4);
                const float mm = fmaxf(a0.x, fmaxf(a1.x, a2.x));
                const float w0 = a0.y * __builtin_amdgcn_exp2f(a0.x - mm), w1 = a1.y * __builtin_amdgcn_exp2f(a1.x - mm), w2 = a2.y * __builtin_amdgcn_exp2f(a2.x - mm);
                const float iw = 1.0f / (w0 + w1 + w2);
                const bf16* pp = PROJ + (size_t)m * P2LD + 8 * lane;
                const v4u p0 = *(const v4u*)pp, p1 = *(const v4u*)(pp + 512), p2 = *(const v4u*)(pp + 1024);
                float rr[8];
                rr[0] = w0 * bflo(p0.x) + w1 * bflo(p1.x) + w2 * bflo(p2.x); rr[1] = w0 * bfhi(p0.x) + w1 * bfhi(p1.x) + w2 * bfhi(p2.x);
                rr[2] = w0 * bflo(p0.y) + w1 * bflo(p1.y) + w2 * bflo(p2.y); rr[3] = w0 * bfhi(p0.y) + w1 * bfhi(p1.y) + w2 * bfhi(p2.y);
                rr[4] = w0 * bflo(p0.z) + w1 * bflo(p1.z) + w2 * bflo(p2.z); rr[5] = w0 * bfhi(p0.z) + w1 * bfhi(p1.z) + w2 * bfhi(p2.z);
                rr[6] = w0 * bflo(p0.w) + w1 * bflo(p1.w) + w2 * bflo(p2.w); rr[7] = w0 * bfhi(p0.w) + w1 * bfhi(p1.w) + w2 * bfhi(p2.w);
                v4u wa; wa.x = pk2(rr[0] * iw, rr[1] * iw); wa.y = pk2(rr[2] * iw, rr[3] * iw); wa.z = pk2(rr[4] * iw, rr[5] * iw); wa.w = pk2(rr[6] * iw, rr[7] * iw);
                *(v4u*)(MIX + (size_t)m * 1024 + 8 * lane) = wa;
            }
        }
    }
    GSYNC();
    {
        pg8::Gemm g{MIX, Wout, M, D, D}; pg8::StaticOrder S; S.init(M, D, G, (int)blockIdx.x);
        pg8::EpiRes E{out, out, D, 1.0f};
        pg8::gemm_phase<pg8::EpiRes, pg8::StaticOrder, true, true>(L8, g, S, E);
    }
    GSYNC();
    { const int ln = opq(tid) & 63; for (int m = gw; m < M; m += NGW) { f32x4 v[4]; rms_row(out + (size_t)m * D, a.in[12], ln, v); store_row_bf16(XN + (size_t)m * D, ln, v); } }
    GSYNC();
    {
        pg8::Gemm g{XN, Wgu2, M, NGU, D}; pg8::StaticOrder S; S.init(M, NGU, G, (int)blockIdx.x);
        pg8::EpiSwiGLU E{ACT, FF};
        pg8::gemm_phase<pg8::EpiSwiGLU, pg8::StaticOrder, true, true>(L8, g, S, E);
    }
    GSYNC();
    {
        pg8::Gemm g{ACT, Wd2, M, D, FF}; pg8::StaticOrder S; S.init(M, D, G, (int)blockIdx.x);
        pg8::EpiRes E{out, out, D, 0.5f};
        pg8::gemm_phase<pg8::EpiRes, pg8::StaticOrder, true, true>(L8, g, S, E);
    }
    GSYNC();
    const int lnf = opq(tid) & 63;
    for (int m = gw; m < M; m += NGW) {
        f32x4 v[4]; rms_row(out + (size_t)m * D, a.in[16], lnf, v);
        f32x4* o = (f32x4*)(out + (size_t)m * D) + lnf;
#pragma unroll
        for (int j = 0; j < 4; ++j) o[64 * j] = v[j];
    }
}

extern "C" void kernel_launch(void* const* d_in, const int* in_sizes, int n_in, void* d_out, int out_size, void* d_ws, size_t ws_size, hipStream_t stream) {
    static int grid = 0;
    if (grid == 0) {
        if (n_in != 17 || in_sizes[0] != M * D || out_size != M * D || ws_size < WS_END) { fprintf(stderr, "kernel_launch: unexpected shapes (n_in %d in0 %d out %d ws %zu)\n", n_in, n_in > 0 ? in_sizes[0] : -1, out_size, ws_size); grid = -1; return; }
        int dev = 0, cus = 0, per_cu = 0;
        hipGetDevice(&dev); hipDeviceGetAttribute(&cus, hipDeviceAttributeMultiprocessorCount, dev);
        if (hipFuncSetAttribute((const void*)fwd_megakernel, hipFuncAttributeMaxDynamicSharedMemorySize, LDS_BYTES) != hipSuccess) { fprintf(stderr, "kernel_launch: hipFuncSetAttribute failed\n"); grid = -1; return; }
        if (hipOccupancyMaxActiveBlocksPerMultiprocessor(&per_cu, (const void*)fwd_megakernel, NWAVES * 64, LDS_BYTES) != hipSuccess || per_cu < 1) { fprintf(stderr, "kernel_launch: occupancy query says %d blocks/CU\n", per_cu); (void)hipGetLastError(); per_cu = 1; }
        grid = cus * 1;
        fprintf(stderr, "kernel_launch: cus %d per_cu %d grid %d\n", cus, per_cu, grid);
    }
    if (grid < 0) return;
    hipMemsetAsync((char*)d_ws + WS_CTL, 0, CTL_BYTES, stream);
    Args a{};
    for (int i = 0; i < 17; ++i) a.in[i] = (const float*)d_in[i];
    a.out = (float*)d_out; a.ws = (unsigned char*)d_ws;
    void* args[] = {&a};
    hipError_t e = hipLaunchCooperativeKernel((const void*)fwd_megakernel, dim3(grid), dim3(NWAVES * 64), args, LDS_BYTES, stream);
    if (e != hipSuccess) fprintf(stderr, "cooperative launch failed: %s (grid %d)\n", hipGetErrorString(e), grid);
}
```

```cpp
#include <hip/hip_runtime.h>
#include <hip/hip_cooperative_groups.h>
#include <cstdio>
#include <cstdint>
namespace cg = cooperative_groups;
namespace pg8 {
#define PG8_LAS __attribute__((address_space(3)))
typedef unsigned short bf16_t;
typedef short bf16x8 __attribute__((ext_vector_type(8)));
typedef float f32x4 __attribute__((ext_vector_type(4)));
typedef unsigned u32x4 __attribute__((ext_vector_type(4)));
constexpr int BM = 256, BK = 64, HALF = 128, HTB = HALF * BK * 2  , STAGE_BYTES = 8 * HTB, NXCD = 8, WGM = 8;

__host__ __device__ __forceinline__ int lds_byte(int r, int c) { const int st = (r >> 4) * 2 + (c >> 5), rr = r & 15, cc = c & 31, ob = rr * 64 + cc * 2; return st * 1024 + (ob ^ (((ob >> 9) & 1) << 5)); }
__host__ __device__ __forceinline__ void stage_rc(int b, int& R, int& C) { const int st = b / 1024, sb = b % 1024, swz = sb ^ (((sb >> 9) & 1) << 5); R = (st >> 1) * 16 + swz / 64; C = (st & 1) * 32 + (swz % 64) / 2; }
__host__ __device__ __forceinline__ int perm32(int rho) { const int n = rho >> 4, i = rho & 15; return 8 * (i >> 2) + 4 * n + (i & 3); }

struct Unit { int pm, pn; };
struct Gemm { const bf16_t* A; const bf16_t* Bt; int M, N, K; };

struct StaticOrder {
    int nM, nN, nwg, G, c;
    __host__ __device__ void init(int M, int N, int G_, int c_) { nM = M / BM; nN = N / BM; nwg = nM * nN; G = G_; c = c_; }
    __host__ __device__ bool next(int i, Unit& u) const {
        const long L = (long)i * G + c; if (L >= nwg) return false;
        int wgid = (int)L; { const int q = nwg / NXCD, r = nwg % NXCD, xcd = wgid % NXCD, off = wgid / NXCD; wgid = (xcd < r ? xcd * (q + 1) : r * (q + 1) + (xcd - r) * q) + off; }
        const int nig = WGM * nN, gid = wgid / nig, fm = gid * WGM, gsz = (nM - fm) < WGM ? (nM - fm) : WGM;
        u.pm = fm + ((wgid % nig) % gsz); u.pn = (wgid % nig) / gsz; return true;
    }
    __device__ __forceinline__ void a_ready(const Unit&) const {}
    __device__ __forceinline__ void done(const Unit&) const {}
};

__device__ __forceinline__ unsigned cvt_pk_bf16(float lo, float hi) { unsigned r; asm volatile("v_cvt_pk_bf16_f32 %0, %1, %2" : "=v"(r) : "v"(lo), "v"(hi)); return r; }
__device__ __forceinline__ float silu_f(float g) { return g * __builtin_amdgcn_rcpf(1.0f + __expf(-g)); }
__device__ __forceinline__ float row_rs(const float* SS, int row) {
    const f32x4* sp = (const f32x4*)(SS + (size_t)row * 16); const f32x4 a = sp[0], b = sp[1], c = sp[2], d = sp[3];
    const float s = ((a[0] + a[1]) + (a[2] + a[3])) + ((b[0] + b[1]) + (b[2] + b[3])) + ((c[0] + c[1]) + (c[2] + c[3])) + ((d[0] + d[1]) + (d[2] + d[3]));
    return 1.0f / sqrtf(s * (1.0f / 1024.0f) + 1e-6f);
}
template <bool RS> struct EpiSwiGLU {
    static constexpr bool PERM = true, AFTER_DRAIN = false;
    bf16_t* O; int ldc; const float* SS;
    __device__ __forceinline__ void operator()(const f32x4 (&acc)[2][2][4][2], const Unit& u, int wr, int wc, int fr, int fq) const {
        const int row0 = u.pm * BM + wr * 64 + fr; const int col0 = u.pn * 128 + wc * 32 + 8 * fq;
#pragma unroll
        for (int ai = 0; ai < 2; ++ai)
#pragma unroll
            for (int m = 0; m < 4; ++m) { const int row = row0 + ai * HALF + m * 16; bf16_t* rowp = O + (size_t)row * ldc + col0;
                const float rs = RS ? row_rs(SS, row) : 1.0f;
                const f32x4 g0 = acc[ai][0][m][0] * rs, g1 = acc[ai][0][m][1] * rs, u0 = acc[ai][1][m][0] * rs, u1 = acc[ai][1][m][1] * rs;
                u32x4 w;
                w.x = cvt_pk_bf16(silu_f(g0[0]) * u0[0], silu_f(g0[1]) * u0[1]); w.y = cvt_pk_bf16(silu_f(g0[2]) * u0[2], silu_f(g0[3]) * u0[3]);
                w.z = cvt_pk_bf16(silu_f(g1[0]) * u1[0], silu_f(g1[1]) * u1[1]); w.w = cvt_pk_bf16(silu_f(g1[2]) * u1[2], silu_f(g1[3]) * u1[3]);
                *(u32x4*)rowp = w; }
    }
};
template <bool XB> struct EpiRes {
    static constexpr bool PERM = false, AFTER_DRAIN = false;
    const float* base; float* out; int ldc; float scale; bf16_t* xb; float* SS;
    __device__ __forceinline__ void operator()(const f32x4 (&acc)[2][2][4][2], const Unit& u, int wr, int wc, int fr, int fq) const {
        const int row0 = u.pm * BM + wr * 64 + fr; const int col0 = u.pn * BM + wc * 32 + 4 * fq;
#pragma unroll
        for (int ai = 0; ai < 2; ++ai)
#pragma unroll
            for (int m = 0; m < 4; ++m) { const int row = row0 + ai * HALF + m * 16; const size_t off = (size_t)row * ldc + col0; float ss = 0.f;
#pragma unroll
                for (int bj = 0; bj < 2; ++bj)
#pragma unroll
                    for (int n = 0; n < 2; ++n) { const f32x4 b = *(const f32x4*)(base + off + bj * HALF + n * 16); const f32x4 v = b + acc[ai][bj][m][n] * scale; *(f32x4*)(out + off + bj * HALF + n * 16) = v;
                        if (XB) { ss += (v[0] * v[0] + v[1] * v[1]) + (v[2] * v[2] + v[3] * v[3]);
                            unsigned lo = cvt_pk_bf16(v[0], v[1]), hi = cvt_pk_bf16(v[2], v[3]); unsigned long long pk = ((unsigned long long)hi << 32) | lo;
                            *(unsigned long long*)(xb + off + bj * HALF + n * 16) = pk; } }
                if (XB) { ss += __shfl_xor(ss, 16); ss += __shfl_xor(ss, 32); if (fq == 0) SS[(size_t)row * 16 + u.pn * 4 + wc] = ss; }
                asm volatile("" ::: "memory"); }
    }
};
struct EpiProj {
    static constexpr bool PERM = true, AFTER_DRAIN = false;
    bf16_t* Qh; bf16_t* KVh; bf16_t* P2; float* BD; const float* SS;
    __device__ __forceinline__ void operator()(const f32x4 (&acc)[2][2][4][2], const Unit& u, int wr, int wc, int fr, int fq) const {
        const int row0 = u.pm * BM + wr * 64 + fr;
        if (u.pn == 14) {
            if (wc == 0 && fq == 0) {
#pragma unroll
                for (int ai = 0; ai < 2; ++ai)
#pragma unroll
                    for (int m = 0; m < 4; ++m) { const int row = row0 + ai * HALF + m * 16; const float rs = row_rs(SS, row);
                        *(f32x4*)(BD + (size_t)row * 8) = acc[ai][0][m][0] * rs; *(f32x4*)(BD + (size_t)row * 8 + 4) = acc[ai][0][m][1] * rs; }
            }
            return;
        }
#pragma unroll
        for (int ai = 0; ai < 2; ++ai)
#pragma unroll
            for (int m = 0; m < 4; ++m) { const int row = row0 + ai * HALF + m * 16, bb = row >> 12, t = row & 4095; const float rs = row_rs(SS, row);
#pragma unroll
                for (int bj = 0; bj < 2; ++bj) { const int col = u.pn * BM + bj * HALF + wc * 32 + 8 * fq;
                    bf16_t* dst;
                    if (u.pn < 6) { const int sec = col >> 9, hc = col & 511, hh = hc >> 6, d = hc & 63; const size_t rt = (size_t)(bb * 8 + hh) * 4096 + t;
                        dst = (sec == 0) ? Qh + rt * 64 + d : KVh + rt * 128 + (sec - 1) * 64 + d; }
                    else dst = P2 + (size_t)row * 2048 + (col - 1536);
                    const f32x4 v0 = acc[ai][bj][m][0] * rs, v1 = acc[ai][bj][m][1] * rs; u32x4 w;
                    w.x = cvt_pk_bf16(v0[0], v0[1]); w.y = cvt_pk_bf16(v0[2], v0[3]); w.z = cvt_pk_bf16(v1[0], v1[1]); w.w = cvt_pk_bf16(v1[2], v1[3]);
                    *(u32x4*)dst = w; } }
    }
};
struct EpiStoreBf16 {
    static constexpr bool PERM = true, AFTER_DRAIN = false;
    bf16_t* O; int ldc;
    __device__ __forceinline__ void operator()(const f32x4 (&acc)[2][2][4][2], const Unit& u, int wr, int wc, int fr, int fq) const {
        const int row0 = u.pm * BM + wr * 64 + fr; const int col0 = u.pn * BM + wc * 32 + 8 * fq;
#pragma unroll
        for (int ai = 0; ai < 2; ++ai)
#pragma unroll
            for (int m = 0; m < 4; ++m) { bf16_t* rowp = O + (size_t)(row0 + ai * HALF + m * 16) * ldc + col0;
#pragma unroll
                for (int bj = 0; bj < 2; ++bj) { const f32x4 v0 = acc[ai][bj][m][0], v1 = acc[ai][bj][m][1]; u32x4 w;
                    w.x = cvt_pk_bf16(v0[0], v0[1]); w.y = cvt_pk_bf16(v0[2], v0[3]); w.z = cvt_pk_bf16(v1[0], v1[1]); w.w = cvt_pk_bf16(v1[2], v1[3]);
                    *(u32x4*)(rowp + bj * HALF) = w; } }
    }
};
template <class Epi, class Sched, bool ALIGN_EPI = false, bool SP2 = false>
__device__ __forceinline__ void gemm_phase(PG8_LAS unsigned char* lds, const Gemm g, const Sched& S, const Epi& E) {
    const int tid = threadIdx.x, wid = __builtin_amdgcn_readfirstlane(tid >> 6), lane = tid & 63, wr = wid >> 2, wc = wid & 3, fr = lane & 15, fq = lane >> 4;
    const int K = g.K, nt = K / BK;
    unsigned voffA[2], voffB[2];
#pragma unroll
    for (int i = 0; i < 2; ++i) { int R, C; stage_rc(tid * 16 + i * 8192, R, C); const int Rb = Epi::PERM ? ((R & ~31) + perm32(R & 31)) : R;
        voffA[i] = (unsigned)(R * K + C) * 2u; voffB[i] = (unsigned)(Rb * K + C) * 2u; }
    const size_t kstep = (size_t)(BK * 2);
    const size_t hstep = (size_t)HALF * K * 2;
    const size_t tstep = 2 * hstep;
    const unsigned ldsw = (unsigned)wid * 1024u;
    const int aoff = lds_byte(wr * 64 + fr, fq * 8), boff = lds_byte(wc * 32 + fr, fq * 8);
#define PG8_SA(b, h) (((b) * 2 + (h)) * HTB)
#define PG8_SB(b, h) ((4 + (b) * 2 + (h)) * HTB)
#define PG8_STAGE(bufoff, gbase, voff) do { _Pragma("unroll") for (int _i = 0; _i < 2; ++_i) \
        __builtin_amdgcn_global_load_lds((const unsigned*)((const char*)(gbase) + (voff)[_i]), (PG8_LAS unsigned*)(lds + (bufoff) + ldsw + _i * 8192), 16, 0, 0); } while (0)
#define PG8_LDA(dst, b, h) do { _Pragma("unroll") for (int m = 0; m < 4; ++m) _Pragma("unroll") for (int k = 0; k < 2; ++k) dst[m][k] = *(const PG8_LAS bf16x8*)(lds + PG8_SA(b, h) + aoff + m * 2048 + k * 1024); } while (0)
#define PG8_LDB(dst, b, h) do { _Pragma("unroll") for (int n = 0; n < 2; ++n) _Pragma("unroll") for (int k = 0; k < 2; ++k) dst[n][k] = *(const PG8_LAS bf16x8*)(lds + PG8_SB(b, h) + boff + n * 2048 + k * 1024); } while (0)
#define PG8_MMA(ai, bj, At, Bt) do { __builtin_amdgcn_s_setprio(1); _Pragma("unroll") for (int m = 0; m < 4; ++m) _Pragma("unroll") for (int n = 0; n < 2; ++n) _Pragma("unroll") for (int k = 0; k < 2; ++k) \
        acc[ai][bj][m][n] = __builtin_amdgcn_mfma_f32_16x16x32_bf16(Bt[n][k], At[m][k], acc[ai][bj][m][n], 0, 0, 0); __builtin_amdgcn_s_setprio(0); } while (0)
#define PG8_WAIT_V(n) asm volatile("s_waitcnt vmcnt(" #n ")" ::: "memory")
#define PG8_WAIT_L(n) asm volatile("s_waitcnt lgkmcnt(" #n ")" ::: "memory")
#define PG8_BAR __builtin_amdgcn_s_barrier()
#define PG8_SCHED __builtin_amdgcn_sched_barrier(0)
    Unit cur, nxt; int ui = 0;
    if (!S.next(0, cur)) return;
    f32x4 acc[2][2][4][2];
#pragma unroll
    for (int a = 0; a < 2; ++a)
#pragma unroll
        for (int b = 0; b < 2; ++b)
#pragma unroll
            for (int m = 0; m < 4; ++m)
#pragma unroll
                for (int n = 0; n < 2; ++n) acc[a][b][m][n] = (f32x4){0.f, 0.f, 0.f, 0.f};
    bf16x8 At[4][2], B0[2][2], B1[2][2];
    const char* cA = (const char*)g.A + (size_t)cur.pm * tstep; const char* cB = (const char*)g.Bt + (size_t)cur.pn * tstep;
    S.a_ready(cur);
    if constexpr (SP2) {
        PG8_STAGE(PG8_SB(0, 0), cB, voffB); PG8_STAGE(PG8_SB(0, 1), cB + hstep, voffB); PG8_STAGE(PG8_SA(0, 0), cA, voffA); PG8_STAGE(PG8_SA(0, 1), cA + hstep, voffA);
        if (wr == 1) PG8_BAR;
        PG8_WAIT_V(2); PG8_BAR;
        PG8_STAGE(PG8_SB(1, 0), cB + kstep, voffB); PG8_STAGE(PG8_SA(1, 0), cA + kstep, voffA); PG8_STAGE(PG8_SB(1, 1), cB + hstep + kstep, voffB);
        PG8_WAIT_V(6); PG8_BAR;
    } else {
        PG8_STAGE(PG8_SB(0, 0), cB, voffB); PG8_STAGE(PG8_SA(0, 0), cA, voffA); PG8_STAGE(PG8_SB(0, 1), cB + hstep, voffB); PG8_STAGE(PG8_SA(0, 1), cA + hstep, voffA);
        if (wr == 1) PG8_BAR;
        PG8_WAIT_V(4); PG8_BAR;
        PG8_STAGE(PG8_SB(1, 0), cB + kstep, voffB); PG8_STAGE(PG8_SA(1, 0), cA + kstep, voffA); PG8_STAGE(PG8_SB(1, 1), cB + hstep + kstep, voffB);
        PG8_WAIT_V(6); PG8_BAR;
    }
    for (;;) {
        const bool has_next = S.next(ui + 1, nxt);
        const char* nA = has_next ? (const char*)g.A + (size_t)nxt.pm * tstep : cA; const char* nB = has_next ? (const char*)g.Bt + (size_t)nxt.pn * tstep : cB;
        for (int t = 0; t < nt; t += 2) {
            const bool last = (t == nt - 2);
            const char* a1 = cA + (size_t)(t + 1) * kstep;
            const char* a2 = last ? nA : cA + (size_t)(t + 2) * kstep; const char* b2 = last ? nB : cB + (size_t)(t + 2) * kstep;
            const char* a3 = a2 + kstep; const char* b3 = b2 + kstep;
            if (last && has_next) S.a_ready(nxt);
            if constexpr (SP2) {
            PG8_LDB(B0, 0, 0); PG8_LDB(B1, 0, 1); PG8_SCHED; PG8_LDA(At, 0, 0); PG8_STAGE(PG8_SA(1, 1), a1 + hstep, voffA);
            PG8_WAIT_V(8); PG8_WAIT_L(0); PG8_BAR; PG8_MMA(0, 0, At, B0); PG8_MMA(0, 1, At, B1); PG8_BAR; PG8_SCHED;
            PG8_LDA(At, 0, 1); PG8_STAGE(PG8_SB(0, 0), b2, voffB); PG8_STAGE(PG8_SB(0, 1), b2 + hstep, voffB); PG8_STAGE(PG8_SA(0, 0), a2, voffA);
            PG8_WAIT_V(8); PG8_WAIT_L(0); PG8_BAR; PG8_MMA(1, 0, At, B0); PG8_MMA(1, 1, At, B1); PG8_BAR; PG8_SCHED;
            PG8_LDB(B0, 1, 0); PG8_LDB(B1, 1, 1); PG8_SCHED; PG8_LDA(At, 1, 0); PG8_STAGE(PG8_SA(0, 1), a2 + hstep, voffA);
            PG8_WAIT_V(8); PG8_WAIT_L(0); PG8_BAR; PG8_MMA(0, 0, At, B0); PG8_MMA(0, 1, At, B1); PG8_BAR; PG8_SCHED;
            PG8_LDA(At, 1, 1); PG8_STAGE(PG8_SB(1, 0), b3, voffB); PG8_STAGE(PG8_SB(1, 1), b3 + hstep, voffB); PG8_STAGE(PG8_SA(1, 0), a3, voffA);
            PG8_WAIT_V(8); PG8_WAIT_L(0); PG8_BAR; PG8_MMA(1, 0, At, B0); PG8_MMA(1, 1, At, B1); PG8_BAR; PG8_SCHED;
            } else {
            PG8_LDB(B0, 0, 0); PG8_SCHED; PG8_LDA(At, 0, 0); PG8_STAGE(PG8_SA(1, 1), a1 + hstep, voffA);
            PG8_WAIT_L(8); PG8_BAR; PG8_WAIT_L(0); PG8_MMA(0, 0, At, B0); PG8_BAR; PG8_SCHED;
            PG8_LDB(B1, 0, 1); PG8_STAGE(PG8_SB(0, 0), b2, voffB);
            PG8_BAR; PG8_WAIT_L(0); PG8_MMA(0, 1, At, B1); PG8_BAR;
            PG8_LDA(At, 0, 1); PG8_STAGE(PG8_SA(0, 0), a2, voffA);
            PG8_BAR; PG8_WAIT_L(0); PG8_MMA(1, 0, At, B0); PG8_BAR; PG8_SCHED;
            PG8_STAGE(PG8_SB(0, 1), b2 + hstep, voffB);
            PG8_WAIT_V(6); PG8_BAR; PG8_MMA(1, 1, At, B1); PG8_BAR;
            PG8_LDB(B0, 1, 0); PG8_SCHED; PG8_LDA(At, 1, 0); PG8_STAGE(PG8_SA(0, 1), a2 + hstep, voffA);
            PG8_WAIT_L(8); PG8_BAR; PG8_WAIT_L(0); PG8_MMA(0, 0, At, B0); PG8_BAR; PG8_SCHED;
            PG8_LDB(B1, 1, 1); PG8_STAGE(PG8_SB(1, 0), b3, voffB);
            PG8_BAR; PG8_WAIT_L(0); PG8_MMA(0, 1, At, B1); PG8_BAR;
            PG8_LDA(At, 1, 1); PG8_STAGE(PG8_SA(1, 0), a3, voffA);
            PG8_BAR; PG8_WAIT_L(0); PG8_MMA(1, 0, At, B0); PG8_BAR; PG8_SCHED;
            PG8_STAGE(PG8_SB(1, 1), b3 + hstep, voffB);
            PG8_WAIT_V(6); PG8_BAR; PG8_MMA(1, 1, At, B1); PG8_BAR;
            }
        }
        if constexpr (ALIGN_EPI) { if (wr == 0) PG8_BAR; }
        if constexpr (!Epi::AFTER_DRAIN) { E(acc, cur, wr, wc, fr, fq); S.done(cur); }
        if (!has_next) break;
#pragma unroll
        for (int a = 0; a < 2; ++a)
#pragma unroll
            for (int b = 0; b < 2; ++b)
#pragma unroll
                for (int m = 0; m < 4; ++m)
#pragma unroll
                    for (int n = 0; n < 2; ++n) acc[a][b][m][n] = (f32x4){0.f, 0.f, 0.f, 0.f};
        cur = nxt; cA = nA; cB = nB; ++ui;
        if constexpr (ALIGN_EPI) { if (wr == 1) PG8_BAR; }
    }
    PG8_WAIT_V(0);
    if constexpr (!ALIGN_EPI) { if (wr == 0) PG8_BAR; }
    PG8_BAR;
    if constexpr (Epi::AFTER_DRAIN) { E.fused(acc, cur, wr, wc, fr, fq, lds, wid, lane); S.done(cur); }
#undef PG8_SA
#undef PG8_SB
#undef PG8_STAGE
#undef PG8_LDA
#undef PG8_LDB
#undef PG8_MMA
#undef PG8_WAIT_V
#undef PG8_WAIT_L
#undef PG8_BAR
#undef PG8_SCHED
}
}
constexpr int M = 16384, D = 1024, FF = 2816, NGU = 5632, NIN = 3840, SEQ = 4096;
constexpr int WIN_COLS = 3592;
constexpr size_t MiB = 1u << 20;
constexpr size_t WS_CTL = 0, CTL_BYTES = 65536;
constexpr size_t WS_WIN = MiB / 4, WS_WOUT = 8 * MiB, WS_WGU2 = 10 * MiB, WS_WD2 = 21 * MiB;
constexpr size_t WS_XN = 27 * MiB;
constexpr size_t WS_ACT = 59 * MiB;
constexpr size_t WS_QH = 123 * MiB, WS_KVH = 139 * MiB;
constexpr int P2LD = 2048;
constexpr size_t WS_BD = 171 * MiB;
constexpr size_t WS_EG = 172 * MiB;
constexpr size_t WS_DN = 184 * MiB;
constexpr size_t WS_WGU1 = 184 * MiB, WS_WD1 = 195 * MiB;
constexpr size_t WS_QG = WS_DN, WS_KD = WS_DN + 16 * MiB, WS_U = WS_DN + 32 * MiB, WS_W = WS_DN + 48 * MiB, WS_A = WS_DN + 64 * MiB;
constexpr size_t WS_END = 256 * MiB;
constexpr int LDS_BYTES = 147456;
constexpr int NWAVES = 8;

#define GAS __attribute__((address_space(1)))
#define LAS __attribute__((address_space(3)))
typedef unsigned short bf16;
typedef unsigned v4u __attribute__((ext_vector_type(4)));
typedef unsigned v2u __attribute__((ext_vector_type(2)));
typedef float f32x4 __attribute__((ext_vector_type(4)));
typedef float f32x2 __attribute__((ext_vector_type(2)));
#define LDS_WAIT() asm volatile("s_waitcnt lgkmcnt(0)" ::: "memory")
__device__ __forceinline__ unsigned f2bf(float f) { unsigned u = __builtin_bit_cast(unsigned, f); return (u + 0x7fffu + ((u >> 16) & 1u)) >> 16; }
__device__ __forceinline__ unsigned pk2(float lo, float hi) { return f2bf(lo) | (f2bf(hi) << 16); }
__device__ __forceinline__ float bflo(unsigned u) { return __uint_as_float(u << 16); }
__device__ __forceinline__ float bfhi(unsigned u) { return __uint_as_float(u & 0xffff0000u); }
__device__ __forceinline__ float bf2f(bf16 v) { return __uint_as_float(((unsigned)v) << 16); }
__device__ __forceinline__ float wave_sum(float v) {
#pragma unroll
    for (int o = 1; o < 64; o <<= 1) v += __shfl_xor(v, o);
    return v;
}
__device__ __forceinline__ float wave_max(float v) {
#pragma unroll
    for (int o = 1; o < 64; o <<= 1) v = fmaxf(v, __shfl_xor(v, o));
    return v;
}

__device__ __forceinline__ int opq(int v) { asm volatile("" : "+v"(v)); return v; }
struct Args { const float* in[17]; float* out; unsigned char* ws; };

__device__ __forceinline__ void transpose_item(const float* src, int srcN, int srccol0, bf16* dst, int dstK, int dstrow0, int k0, LAS float* scr, int lane, const float* gain = nullptr, int nvalid = 32) {
#pragma unroll 8
    for (int i = 0; i < 32; ++i) { const int kk = 2 * i + (lane >> 5); float v = ((lane & 31) < nvalid) ? src[(size_t)(k0 + kk) * srcN + srccol0 + (lane & 31)] : 0.f; if (gain) v *= gain[k0 + kk]; scr[kk * 33 + (lane & 31)] = v; }
    LDS_WAIT(); asm volatile("" ::: "memory");
    const int c = lane & 7;
#pragma unroll
    for (int j = 0; j < 4; ++j) { const int n = (lane >> 3) + 8 * j; const LAS float* s = scr + (8 * c) * 33 + n;
        v4u o; o.x = pk2(s[0 * 33], s[1 * 33]); o.y = pk2(s[2 * 33], s[3 * 33]); o.z = pk2(s[4 * 33], s[5 * 33]); o.w = pk2(s[6 * 33], s[7 * 33]);
        *(v4u*)(dst + (size_t)(dstrow0 + n) * dstK + k0 + 8 * c) = o; }
    LDS_WAIT(); asm volatile("" ::: "memory");
}
__device__ __forceinline__ void tr_gu(const float* gate, const float* up, bf16* dst, int r, LAS float* scr, int lane, const float* gain = nullptr) {
    const int nblk = NGU / 32, kb = r / nblk, nb = r % nblk, dstrow0 = nb * 32, pn = dstrow0 >> 8, within = dstrow0 & 255;
    transpose_item(within < 128 ? gate : up, FF, pn * 128 + (within & 127), dst, D, dstrow0, kb * 64, scr, lane, gain);
}
__device__ __forceinline__ void tr_plain(const float* src, int K, int N, bf16* dst, int r, LAS float* scr, int lane) {
    const int nblk = N / 32, kb = r / nblk, nb = r % nblk;
    transpose_item(src, N, nb * 32, dst, K, nb * 32, kb * 64, scr, lane);
}
__device__ __forceinline__ void tr_win(const float* src, bf16* dst, int r, LAS float* scr, int lane, const float* gain) {
    const int nblk = NIN / 32, kb = r / nblk, nb = r % nblk, dstrow0 = nb * 32;
    const int srccol0 = dstrow0 < 3072 ? dstrow0 : (dstrow0 < 3584 ? dstrow0 + 8 : 3072), nvalid = dstrow0 < 3584 ? 32 : (dstrow0 == 3584 ? 8 : 0);
    transpose_item(src, WIN_COLS, srccol0, dst, D, dstrow0, kb * 64, scr, lane, gain, nvalid);
}

__device__ __forceinline__ void rms_row(const float* xrow, const float* gain, int lane, f32x4 (&v)[4]) {
    const f32x4* xr = (const f32x4*)xrow + lane; const f32x4* gr = (const f32x4*)gain + lane;
    float s = 0.f;
#pragma unroll
    for (int j = 0; j < 4; ++j) { v[j] = xr[64 * j]; s += (v[j].x * v[j].x + v[j].y * v[j].y) + (v[j].z * v[j].z + v[j].w * v[j].w); }
    const float rs = 1.0f / sqrtf(wave_sum(s) * (1.f / D) + 1e-6f);
#pragma unroll
    for (int j = 0; j < 4; ++j) { const f32x4 g = gr[64 * j]; v[j] = v[j] * rs * g; }
}
__device__ __forceinline__ void store_row_bf16(bf16* orow, int lane, const f32x4 (&v)[4]) {
    v2u* o8 = (v2u*)orow + lane;
#pragma unroll
    for (int j = 0; j < 4; ++j) { v2u w; w.x = pk2(v[j].x, v[j].y); w.y = pk2(v[j].z, v[j].w); o8[64 * j] = w; }
}

__device__ __forceinline__ int kperm(int x) { return 8 * ((x & 15) >> 2) + 4 * (x >> 4) + (x & 3); }
typedef short bf16x8 __attribute__((ext_vector_type(8)));
typedef __bf16 bf16x2_t __attribute__((ext_vector_type(2)));
__device__ __forceinline__ unsigned cvtpk(float lo, float hi) { f32x2 v = {lo, hi}; bf16x2_t b = __builtin_convertvector(v, bf16x2_t); return __builtin_bit_cast(unsigned, b); }
constexpr int PQ = 0, PK = 17408, PVB = 34816, PKB = 53248, PAS = 71680, PTS = 88320, PMS = 104960, PTB = 121600, PGC = 130816;
__device__ __forceinline__ void dn_prep_item(const Args& a, LAS unsigned char* L8, int ch, int tid, int lane, int wave) {
    unsigned char* ws = a.ws;
    const bf16* PROJ = (const bf16*)(ws + WS_ACT);
    const float* BD = (const float*)(ws + WS_BD);
    const float* conv_w = a.in[7]; const float* a_log = a.in[8]; const float* dt_bias = a.in[9];
    const int bh = ch >> 6, n = ch & 63, b = bh >> 2, h = bh & 3;
    const int tok0 = b * SEQ + n * 64;
    LAS float* As = (LAS float*)(L8 + PAS); LAS float* Ts = (LAS float*)(L8 + PTS); LAS float* Ms = (LAS float*)(L8 + PMS);
    LAS float* gcs = (LAS float*)(L8 + PGC); LAS float* bts = gcs + 64;
    const int jl = lane & 15, kq = lane >> 4;
    unsigned raw[11][3];
#pragma unroll
    for (int i = 0; i < 11; ++i) { const int s = n * 64 + wave * 8 - 3 + i;
#pragma unroll
        for (int sec = 0; sec < 3; ++sec) raw[i][sec] = (s >= 0) ? *(const unsigned*)(PROJ + (size_t)(tok0 + wave * 8 - 3 + i) * P2LD + sec * 512 + h * 128 + 2 * lane) : 0u; }
    if (wave == 0) {
        const int tok = tok0 + lane;
        const float braw = BD[(size_t)tok * 8 + h], draw = BD[(size_t)tok * 8 + 4 + h] + dt_bias[h];
        const float sp = fmaxf(draw, 0.f) + log1pf(__expf(-fabsf(draw)));
        float g = -expf(a_log[h]) * sp;
#pragma unroll
        for (int o = 1; o < 64; o <<= 1) { const float t = __shfl_up(g, o); if (lane >= o) g += t; }
        gcs[lane] = g; bts[lane] = 1.0f / (1.0f + __expf(-braw));
        if (lane == 63) ((float*)(ws + WS_EG))[ch] = expf(g);
    }
    for (int i = tid; i < 64 * 65; i += 512) Ts[i] = 0.f;
    __syncthreads();
    {
        float cw[3][4][2];
#pragma unroll
        for (int sec = 0; sec < 3; ++sec)
#pragma unroll
            for (int j = 0; j < 4; ++j) { const f32x2 w = *(const f32x2*)(conv_w + j * 1536 + sec * 512 + h * 128 + 2 * lane); cw[sec][j][0] = w.x; cw[sec][j][1] = w.y; }
        const float glast = gcs[63];
        bf16* QG = (bf16*)(ws + WS_QG) + (size_t)ch * 8192; bf16* KD = (bf16*)(ws + WS_KD) + (size_t)ch * 8192;
#pragma unroll
        for (int rr = 0; rr < 8; ++rr) {
            const int r = wave * 8 + rr;
            float val[3][2];
#pragma unroll
            for (int sec = 0; sec < 3; ++sec) { float v0 = 0.f, v1 = 0.f;
#pragma unroll
                for (int j = 0; j < 4; ++j) { v0 += bflo(raw[rr + j][sec]) * cw[sec][j][0]; v1 += bfhi(raw[rr + j][sec]) * cw[sec][j][1]; }
                val[sec][0] = v0 / (1.f + __expf(-v0)); val[sec][1] = v1 / (1.f + __expf(-v1)); }
            const float ssq = wave_sum(val[0][0] * val[0][0] + val[0][1] * val[0][1]);
            const float ssk = wave_sum(val[1][0] * val[1][0] + val[1][1] * val[1][1]);
            const float rq = (1.0f / sqrtf(ssq + 1e-6f)) * 0.08838834764831845f, rk = 1.0f / sqrtf(ssk + 1e-6f);
            const float q0 = val[0][0] * rq, q1 = val[0][1] * rq, k0 = val[1][0] * rk, k1 = val[1][1] * rk;
            const float gr = gcs[r], be = bts[r], eq = __expf(gr), ek = __expf(glast - gr), bek = be * eq;
            *(LAS unsigned*)(L8 + PQ + r * 272 + 4 * lane) = cvtpk(q0, q1);
            *(LAS unsigned*)(L8 + PK + r * 272 + 4 * lane) = cvtpk(k0, k1);
            const unsigned vb = cvtpk(val[2][0] * be, val[2][1] * be), kb = cvtpk(k0 * bek, k1 * bek);
            *(LAS bf16*)(L8 + PVB + (2 * lane) * 144 + 2 * r) = (bf16)(vb & 0xffffu); *(LAS bf16*)(L8 + PVB + (2 * lane + 1) * 144 + 2 * r) = (bf16)(vb >> 16);
            *(LAS bf16*)(L8 + PKB + (2 * lane) * 144 + 2 * r) = (bf16)(kb & 0xffffu); *(LAS bf16*)(L8 + PKB + (2 * lane + 1) * 144 + 2 * r) = (bf16)(kb >> 16);
            const int d = 2 * lane;
            *(unsigned*)(QG + r * 128 + (d & 96) + kperm(d & 31)) = cvtpk(q0 * eq, q1 * eq);
            const int tp = (r & 32) + kperm(r & 31); const unsigned kd = cvtpk(k0 * ek, k1 * ek);
            KD[d * 64 + tp] = (bf16)(kd & 0xffffu); KD[(d + 1) * 64 + tp] = (bf16)(kd >> 16);
        }
    }
    __syncthreads();
    {
        bf16* Aout = (bf16*)(ws + WS_A) + (size_t)ch * 4096;
#pragma unroll
        for (int t2 = 0; t2 < 2; ++t2) {
            const int idx = 2 * wave + t2, ct = idx >> 2, jt = idx & 3;
            f32x4 acc1 = {0.f, 0.f, 0.f, 0.f}, acc2 = {0.f, 0.f, 0.f, 0.f};
#pragma unroll
            for (int ks = 0; ks < 4; ++ks) {
                const bf16x8 kc = *(const LAS bf16x8*)(L8 + PK + (16 * ct + jl) * 272 + (32 * ks + 8 * kq) * 2);
                const bf16x8 kj = *(const LAS bf16x8*)(L8 + PK + (16 * jt + jl) * 272 + (32 * ks + 8 * kq) * 2);
                const bf16x8 qc = *(const LAS bf16x8*)(L8 + PQ + (16 * ct + jl) * 272 + (32 * ks + 8 * kq) * 2);
                acc1 = __builtin_amdgcn_mfma_f32_16x16x32_bf16(kc, kj, acc1, 0, 0, 0);
                acc2 = __builtin_amdgcn_mfma_f32_16x16x32_bf16(kj, qc, acc2, 0, 0, 0);
            }
            { const int j = 16 * jt + jl; const float gj = gcs[j];
#pragma unroll
              for (int e = 0; e < 4; ++e) { const int c = 16 * ct + 4 * kq + e; As[c * 65 + j] = (j < c) ? bts[c] * acc1[e] * __expf(gcs[c] - gj) : 0.f; } }
            { const int c = 16 * ct + jl; const float gc_ = gcs[c]; float pv[4];
#pragma unroll
              for (int e = 0; e < 4; ++e) { const int j = 16 * jt + 4 * kq + e; pv[e] = (j <= c) ? acc2[e] * __expf(gc_ - gcs[j]) : 0.f; }
              v2u w; w.x = cvtpk(pv[0], pv[1]); w.y = cvtpk(pv[2], pv[3]);
              *(v2u*)(Aout + c * 64 + 32 * (jt >> 1) + 8 * kq + 4 * (jt & 1)) = w; }
        }
    }
    __syncthreads();
    if (wave == 0) {
        const int bb = lane >> 4, col = lane & 15;
        float xv[16];
#pragma unroll
        for (int c = 0; c < 16; ++c) { float s = (c == col) ? 1.f : 0.f;
#pragma unroll
            for (int j = 0; j < c; ++j) s -= As[(16 * bb + c) * 65 + 16 * bb + j] * xv[j];
            xv[c] = s; }
#pragma unroll
        for (int c = 0; c < 16; ++c) Ts[(16 * bb + c) * 65 + 16 * bb + col] = xv[c];
    }
    __syncthreads();
    {
        const int pr = tid >> 8, i = (tid >> 4) & 15, jj = tid & 15, hb = 32 * pr + 16, lb = 32 * pr;
        float s = 0.f;
#pragma unroll
        for (int k = 0; k < 16; ++k) s += As[(hb + i) * 65 + lb + k] * Ts[(lb + k) * 65 + lb + jj];
        Ms[(hb + i) * 65 + lb + jj] = s;
        __syncthreads();
        float t = 0.f;
#pragma unroll
        for (int k = 0; k < 16; ++k) t += Ts[(hb + i) * 65 + hb + k] * Ms[(hb + k) * 65 + lb + jj];
        Ts[(hb + i) * 65 + lb + jj] = -t;
    }
    __syncthreads();
    {
        const int i = tid >> 4, j0 = (tid & 15) * 2;
        float s0 = 0.f, s1 = 0.f;
#pragma unroll 8
        for (int k = 0; k < 32; ++k) { const float av = As[(32 + i) * 65 + k]; s0 += av * Ts[k * 65 + j0]; s1 += av * Ts[k * 65 + j0 + 1]; }
        Ms[(32 + i) * 65 + j0] = s0; Ms[(32 + i) * 65 + j0 + 1] = s1;
        __syncthreads();
        float t0 = 0.f, t1 = 0.f;
#pragma unroll 8
        for (int k = 0; k < 32; ++k) { const float tv = Ts[(32 + i) * 65 + 32 + k]; t0 += tv * Ms[(32 + k) * 65 + j0]; t1 += tv * Ms[(32 + k) * 65 + j0 + 1]; }
        __syncthreads();
        Ts[(32 + i) * 65 + j0] = -t0; Ts[(32 + i) * 65 + j0 + 1] = -t1;
    }
    __syncthreads();
#pragma unroll
    for (int i = 0; i < 4; ++i) { const int idx2 = tid + 512 * i, r = idx2 >> 5, c = (idx2 & 31) * 2;
        *(LAS unsigned*)(L8 + PTB + r * 144 + 2 * c) = cvtpk(Ts[r * 65 + c], Ts[r * 65 + c + 1]); }
    __syncthreads();
    {
        bf16* U = (bf16*)(ws + WS_U) + (size_t)ch * 8192; bf16* W = (bf16*)(ws + WS_W) + (size_t)ch * 8192;
        const int mt = wave & 3, ntb = 4 * (wave >> 2);
        bf16x8 ta[2];
#pragma unroll
        for (int ks = 0; ks < 2; ++ks) ta[ks] = *(const LAS bf16x8*)(L8 + PTB + (16 * mt + jl) * 144 + (32 * ks + 8 * kq) * 2);
#pragma unroll
        for (int q = 0; q < 4; ++q) { const int nt = ntb + q; f32x4 acc = {0.f, 0.f, 0.f, 0.f};
#pragma unroll
            for (int ks = 0; ks < 2; ++ks) { const bf16x8 vb = *(const LAS bf16x8*)(L8 + PVB + (16 * nt + jl) * 144 + (32 * ks + 8 * kq) * 2);
                acc = __builtin_amdgcn_mfma_f32_16x16x32_bf16(ta[ks], vb, acc, 0, 0, 0); }
            v2u w; w.x = cvtpk(acc[0], acc[1]); w.y = cvtpk(acc[2], acc[3]);
            *(v2u*)(U + (16 * nt + jl) * 64 + 16 * mt + 4 * kq) = w; }
        bf16x8 ka[2];
#pragma unroll
        for (int ks = 0; ks < 2; ++ks) ka[ks] = *(const LAS bf16x8*)(L8 + PKB + (16 * wave + jl) * 144 + (32 * ks + 8 * kq) * 2);
#pragma unroll
        for (int ctile = 0; ctile < 4; ++ctile) { f32x4 acc = {0.f, 0.f, 0.f, 0.f};
#pragma unroll
            for (int ks = 0; ks < 2; ++ks) { const bf16x8 tb = *(const LAS bf16x8*)(L8 + PTB + (16 * ctile + jl) * 144 + (32 * ks + 8 * kq) * 2);
                acc = __builtin_amdgcn_mfma_f32_16x16x32_bf16(ka[ks], tb, acc, 0, 0, 0); }
            v2u w; w.x = cvtpk(-acc[0], -acc[1]); w.y = cvtpk(-acc[2], -acc[3]);
            *(v2u*)(W + (16 * ctile + jl) * 128 + 32 * (wave >> 1) + 8 * kq + 4 * (wave & 1)) = w; }
    }
    __syncthreads();
}

__device__ __forceinline__ bf16x8 pack8(const f32x4& a, const f32x4& b) { v4u w; w.x = cvtpk(a[0], a[1]); w.y = cvtpk(a[2], a[3]); w.z = cvtpk(b[0], b[1]); w.w = cvtpk(b[2], b[3]); return __builtin_bit_cast(bf16x8, w); }
constexpr int SC_W = 0, SC_QG = 17408, SC_KDT = 34816, SC_A = 53248, SC_U = 62464, SC_BUF = 67072;
constexpr int SC_OUT = 2 * SC_BUF;
struct ScanRegs { v4u st[15]; };
__device__ __forceinline__ void sc_load(ScanRegs& R, const unsigned char* ws, int chx, int t, int qtr) {
    const unsigned vo = (unsigned)t * 16u;
    const unsigned char* pw = ws + WS_W + (size_t)chx * 16384; const unsigned char* pq = ws + WS_QG + (size_t)chx * 16384; const unsigned char* pk = ws + WS_KD + (size_t)chx * 16384;
    const unsigned char* pa = ws + WS_A + (size_t)chx * 8192; const unsigned char* pu = ws + WS_U + (size_t)chx * 16384 + qtr * 4096;
#define SC_LDG(k, p) do { R.st[k] = *(const v4u*)(p); __builtin_amdgcn_sched_barrier(0); } while (0)
    __builtin_amdgcn_sched_barrier(0);
    SC_LDG(0, pw + vo); SC_LDG(1, pw + 4096 + vo); SC_LDG(2, pw + 8192 + vo); SC_LDG(3, pw + 12288 + vo);
    SC_LDG(4, pq + vo); SC_LDG(5, pq + 4096 + vo); SC_LDG(6, pq + 8192 + vo); SC_LDG(7, pq + 12288 + vo);
    SC_LDG(8, pk + vo); SC_LDG(9, pk + 4096 + vo); SC_LDG(10, pk + 8192 + vo); SC_LDG(11, pk + 12288 + vo);
    SC_LDG(12, pa + vo); SC_LDG(13, pa + 4096 + vo); SC_LDG(14, pu + vo);
#undef SC_LDG
}
__device__ __forceinline__ void sc_write(const ScanRegs& R, LAS unsigned char* B_, int t) {
    LAS unsigned char* w16 = B_ + (t >> 4) * 272 + (t & 15) * 16;
    LAS unsigned char* k8 = B_ + (t >> 3) * 144 + (t & 7) * 16;
#define SC_STL(k, p) do { *(LAS v4u*)(p) = R.st[k]; __builtin_amdgcn_sched_barrier(0); } while (0)
    __builtin_amdgcn_sched_barrier(0);
    SC_STL(0, w16 + SC_W); SC_STL(1, w16 + SC_W + 16 * 272); SC_STL(2, w16 + SC_W + 32 * 272); SC_STL(3, w16 + SC_W + 48 * 272);
    SC_STL(4, w16 + SC_QG); SC_STL(5, w16 + SC_QG + 16 * 272); SC_STL(6, w16 + SC_QG + 32 * 272); SC_STL(7, w16 + SC_QG + 48 * 272);
    SC_STL(8, k8 + SC_KDT); SC_STL(9, k8 + SC_KDT + 32 * 144); SC_STL(10, k8 + SC_KDT + 64 * 144); SC_STL(11, k8 + SC_KDT + 96 * 144);
    SC_STL(12, k8 + SC_A); SC_STL(13, k8 + SC_A + 32 * 144); SC_STL(14, k8 + SC_U);
#undef SC_STL
}
#define SC_BARRIER() do { asm volatile("s_waitcnt lgkmcnt(0)" ::: "memory"); __builtin_amdgcn_s_barrier(); asm volatile("" ::: "memory"); } while (0)
__device__ __forceinline__ void sc_step_compute(LAS unsigned char* L8, int n, int jl, int kq, int wcol, float egv, f32x4 (&Sacc)[8]) {
    const float eg = __builtin_bit_cast(float, __builtin_amdgcn_readlane(__builtin_bit_cast(int, egv), n));
    const LAS unsigned char* B = L8 + (n & 1) * SC_BUF;
    bf16x8 sb[4];
#pragma unroll
    for (int ks = 0; ks < 4; ++ks) sb[ks] = pack8(Sacc[2 * ks], Sacc[2 * ks + 1]);
    f32x4 vn[4], oa[4];
#pragma unroll
    for (int mt = 0; mt < 4; ++mt) { const v2u u = *(const LAS v2u*)(B + SC_U + (wcol + jl) * 144 + (16 * mt + 4 * kq) * 2);
        vn[mt] = (f32x4){bflo(u.x), bfhi(u.x), bflo(u.y), bfhi(u.y)}; oa[mt] = (f32x4){0.f, 0.f, 0.f, 0.f}; }
    const LAS unsigned char* pW = B + SC_W + jl * 272 + kq * 16; const LAS unsigned char* pQ = B + SC_QG + jl * 272 + kq * 16;
    const LAS unsigned char* pK = B + SC_KDT + jl * 144 + kq * 16; const LAS unsigned char* pA = B + SC_A + jl * 144 + kq * 16;
#define SC_LD_WQ(dst, mt) do { _Pragma("unroll") for (int ks = 0; ks < 4; ++ks) { dst[ks] = *(const LAS bf16x8*)(pW + (mt) * 16 * 272 + ks * 64); dst[4 + ks] = *(const LAS bf16x8*)(pQ + (mt) * 16 * 272 + ks * 64); } } while (0)
#define SC_LD_K(dst, t0) do { _Pragma("unroll") for (int t = 0; t < 4; ++t) _Pragma("unroll") for (int k2 = 0; k2 < 2; ++k2) dst[2 * t + k2] = *(const LAS bf16x8*)(pK + ((t0) + t) * 16 * 144 + k2 * 64); } while (0)
#define SC_LD_A(dst) do { _Pragma("unroll") for (int mt = 0; mt < 4; ++mt) _Pragma("unroll") for (int k2 = 0; k2 < 2; ++k2) dst[2 * mt + k2] = *(const LAS bf16x8*)(pA + mt * 16 * 144 + k2 * 64); } while (0)
#define SC_MM_WQ(src, mt) do { _Pragma("unroll") for (int ks = 0; ks < 4; ++ks) { vn[mt] = __builtin_amdgcn_mfma_f32_16x16x32_bf16(src[ks], sb[ks], vn[mt], 0, 0, 0); oa[mt] = __builtin_amdgcn_mfma_f32_16x16x32_bf16(src[4 + ks], sb[ks], oa[mt], 0, 0, 0); } } while (0)
#define SC_MM_K(src, t0) do { _Pragma("unroll") for (int k2 = 0; k2 < 2; ++k2) _Pragma("unroll") for (int t = 0; t < 4; ++t) Sacc[(t0) + t] = __builtin_amdgcn_mfma_f32_16x16x32_bf16(src[2 * t + k2], vb[k2], Sacc[(t0) + t], 0, 0, 0); } while (0)
#define SC_MM_A(src) do { _Pragma("unroll") for (int k2 = 0; k2 < 2; ++k2) _Pragma("unroll") for (int mt = 0; mt < 4; ++mt) oa[mt] = __builtin_amdgcn_mfma_f32_16x16x32_bf16(src[2 * mt + k2], vb[k2], oa[mt], 0, 0, 0); } while (0)
#define SC_SB() __builtin_amdgcn_sched_barrier(0)
    bf16x8 fa[8], fb[8];
    SC_LD_WQ(fa, 0); SC_LD_WQ(fb, 1); SC_SB();
    SC_MM_WQ(fa, 0); SC_SB(); SC_LD_WQ(fa, 2); SC_SB();
    SC_MM_WQ(fb, 1); SC_SB(); SC_LD_WQ(fb, 3); SC_SB();
    SC_MM_WQ(fa, 2); SC_SB(); SC_LD_K(fa, 0); SC_SB();
    SC_MM_WQ(fb, 3); SC_SB(); SC_LD_K(fb, 4); SC_SB();
    bf16x8 vb[2];
    vb[0] = pack8(vn[0], vn[1]); vb[1] = pack8(vn[2], vn[3]);
#pragma unroll
    for (int T = 0; T < 8; ++T) Sacc[T] = Sacc[T] * eg;
    SC_SB();
    SC_MM_K(fa, 0); SC_SB(); SC_LD_A(fa); SC_SB();
    SC_MM_K(fb, 4); SC_SB();
    SC_MM_A(fa);
#undef SC_LD_WQ
#undef SC_LD_K
#undef SC_LD_A
#undef SC_MM_WQ
#undef SC_MM_K
#undef SC_MM_A
#undef SC_SB
    LAS unsigned char* ob = L8 + SC_OUT + (n & 1) * 4096 + (4 * kq) * 64 + (wcol + jl) * 2;
#pragma unroll
    for (int mt = 0; mt < 4; ++mt)
#pragma unroll
        for (int e = 0; e < 4; ++e) *(LAS bf16*)(ob + (16 * mt + e) * 64) = (bf16)f2bf(oa[mt][e]);
    SC_BARRIER();
}
__device__ __forceinline__ void sc_out_tile(LAS unsigned char* L8, bf16* MIX, int b, int h, int qtr, int n, int l_) {
    const LAS unsigned char* ob = L8 + SC_OUT + (n & 1) * 4096 + l_ * 64;
    const v4u w0 = *(const LAS v4u*)ob, w1 = *(const LAS v4u*)(ob + 16), w2 = *(const LAS v4u*)(ob + 32), w3 = *(const LAS v4u*)(ob + 48);
    bf16* gp = MIX + (size_t)(b * SEQ + n * 64 + l_) * 1024 + 512 + h * 128 + qtr * 32;
    *(v4u*)gp = w0; *(v4u*)(gp + 8) = w1; *(v4u*)(gp + 16) = w2; *(v4u*)(gp + 24) = w3;
}
__device__ __forceinline__ void dn_scan_mfma(const Args& a, LAS unsigned char* L8, int item, int tid, int lane, int wave) {
    unsigned char* ws = a.ws;
    const int xcd_ = item & 7, slot_ = item >> 3;
    const int bh = xcd_ * 2 + (slot_ >> 2), qtr = slot_ & 3, b = bh >> 2, h = bh & 3;
    if (wave < 2) {
        const int jl = lane & 15, kq = lane >> 4;
        f32x4 Sacc[8];
#pragma unroll
        for (int T = 0; T < 8; ++T) Sacc[T] = (f32x4){0.f, 0.f, 0.f, 0.f};
        const float egv = ((const float*)(ws + WS_EG))[bh * 64 + lane];
        asm volatile("s_waitcnt vmcnt(0)" ::: "memory");
        SC_BARRIER();
        for (int n = 0; n < 64; ++n) sc_step_compute(L8, n, jl, kq, wave * 16, egv, Sacc);
    } else if (wave < 6) {
        ScanRegs R0, R1, R2; const int t = tid - 128, c0 = bh * 64;
        sc_load(R0, ws, c0, t, qtr); sc_write(R0, L8, t);
        sc_load(R1, ws, c0 + 1, t, qtr); sc_load(R2, ws, c0 + 2, t, qtr); sc_load(R0, ws, c0 + 3, t, qtr);
        SC_BARRIER();
        for (int n = 0; n < 63; n += 3) {
            sc_write(R1, L8 + ((n + 1) & 1) * SC_BUF, t);
            sc_load(R1, ws, c0 + (n + 4 < 63 ? n + 4 : 63), t, qtr);
            SC_BARRIER();
            sc_write(R2, L8 + ((n + 2) & 1) * SC_BUF, t);
            sc_load(R2, ws, c0 + (n + 5 < 63 ? n + 5 : 63), t, qtr);
            SC_BARRIER();
            sc_write(R0, L8 + ((n + 3) & 1) * SC_BUF, t);
            sc_load(R0, ws, c0 + (n + 6 < 63 ? n + 6 : 63), t, qtr);
            SC_BARRIER();
        }
        SC_BARRIER();
    } else if (wave == 6) {
        SC_BARRIER();
        for (int n = 0; n < 64; ++n) SC_BARRIER();
    } else {
        bf16* MIX = (bf16*)(ws + WS_XN);
        SC_BARRIER();
        for (int n = 0; n < 64; ++n) { if (n > 0) sc_out_tile(L8, MIX, b, h, qtr, n - 1, lane); SC_BARRIER(); }
        sc_out_tile(L8, MIX, b, h, qtr, 63, lane);
    }
    __syncthreads();
}

typedef float f32x16 __attribute__((ext_vector_type(16)));
typedef short s16x4 __attribute__((ext_vector_type(4)));
__device__ __forceinline__ s16x4 vtr(const LAS unsigned char* p) { return __builtin_bit_cast(s16x4, __builtin_amdgcn_ds_read_tr16_b64_v4i16((LAS s16x4*)p)); }
constexpr int KVP = 144;
constexpr int KV_BYTES = 384 * KVP;
constexpr size_t WS_ML = 173 * MiB;
constexpr size_t WS_SS = 176 * MiB;
constexpr size_t WS_XNB2 = 184 * MiB;
__device__ __forceinline__ void attn_item(const bf16* Qh, const bf16* KVh, bf16* PROJ, float* ML, LAS unsigned char* L8, int item, int tid, int lane, int wave) {
    asm volatile("" : "+v"(lane));
    const int bh = item / 48, rem = item - bh * 48, p = rem >> 4, sub = rem & 15;
    const int b = bh >> 3, h = bh & 7;
    const int dsh = 2 * p, dil = 1 << dsh, nsh = 4 - dsh;
    const int r = sub >> nsh, qb = sub & ((1 << nsh) - 1);
    const int base = 256 * qb;
    const bf16* KVb = KVh + (size_t)(bh * 4096 + r) * 128;
#pragma unroll
    for (int i = 0; i < 12; ++i) { const int id = tid + 512 * i, row = id >> 4, ch = id & 15, idx = base - 128 + row;
        v4u kv = (v4u){0u, 0u, 0u, 0u};
        if (idx >= 0) kv = *(const v4u*)(KVb + (size_t)(dil * idx) * 128 + ch * 8);
        *(LAS v4u*)(L8 + ((ch & 8) ? KV_BYTES : 0) + row * KVP + (ch & 7) * 16) = kv; }
    const int ql = lane & 31, kh = lane >> 5;
    const int tq = r + dil * (base + 32 * wave + ql);
    const size_t tokq = (size_t)b * SEQ + tq;
    bf16x8 qf[4];
#pragma unroll
    for (int s = 0; s < 4; ++s) qf[s] = *(const bf16x8*)(Qh + ((size_t)bh * 4096 + tq) * 64 + 16 * s + 8 * kh);
    __syncthreads();
    f32x16 sc[5];
    {
        const LAS unsigned char* Kp = L8 + (32 * wave + ql) * KVP + kh * 16;
        bf16x8 kf[2][4];
#pragma unroll
        for (int s = 0; s < 4; ++s) kf[0][s] = *(const LAS bf16x8*)(Kp + s * 32);
#pragma unroll
        for (int kt = 0; kt < 5; ++kt) {
            if (kt + 1 < 5) {
#pragma unroll
                for (int s = 0; s < 4; ++s) kf[(kt + 1) & 1][s] = *(const LAS bf16x8*)(Kp + (kt + 1) * 32 * KVP + s * 32); }
            __builtin_amdgcn_sched_barrier(0);
            f32x16 acc = {};
#pragma unroll
            for (int s = 0; s < 4; ++s) acc = __builtin_amdgcn_mfma_f32_32x32x16_bf16(kf[kt & 1][s], qf[s], acc, 0, 0, 0);
            sc[kt] = acc;
            __builtin_amdgcn_sched_barrier(0);
        }
    }
    const float LOG2E = 1.4426950408889634f;
    const float c1 = 0.125f * LOG2E, c2 = exp2f(-(float)(h + 1)) * (float)dil * LOG2E;
    const float Al = -c2 * (float)(128 + ql - 4 * kh);
    float mx = -INFINITY;
#pragma unroll
    for (int kt = 0; kt < 5; ++kt)
#pragma unroll
        for (int rr = 0; rr < 16; ++rr) { const int kc = (rr & 3) + 8 * (rr >> 2);
            float v = fmaf(sc[kt][rr], c1, fmaf(c2, (float)(32 * kt + kc), Al));
            if (kt == 0) v = (kc + 4 * kh >= ql) ? v : -INFINITY;
            if (kt == 4) v = (kc + 4 * kh <= ql) ? v : -INFINITY;
            sc[kt][rr] = v; }
    if (base == 0) {
#pragma unroll
        for (int kt = 0; kt < 4; ++kt)
#pragma unroll
            for (int rr = 0; rr < 16; ++rr) { const int kidx = -128 + 32 * (wave + kt) + (rr & 3) + 8 * (rr >> 2) + 4 * kh; sc[kt][rr] = (kidx >= 0) ? sc[kt][rr] : -INFINITY; }
    }
#pragma unroll
    for (int kt = 0; kt < 5; ++kt)
#pragma unroll
        for (int rr = 0; rr < 16; ++rr) mx = fmaxf(mx, sc[kt][rr]);
    mx = fmaxf(mx, __shfl_xor(mx, 32));
    float lsum = 0.f;
#pragma unroll
    for (int kt = 0; kt < 5; ++kt)
#pragma unroll
        for (int rr = 0; rr < 16; ++rr) { const float pv = __builtin_amdgcn_exp2f(sc[kt][rr] - mx); sc[kt][rr] = pv; lsum += pv; }
    lsum += __shfl_xor(lsum, 32);
    f32x16 o[2]; o[0] = (f32x16){}; o[1] = (f32x16){};
    {
        const int q4 = (lane & 15) >> 2, pp = lane & 3, blk = (lane >> 4) & 1;
        const LAS unsigned char* Vb = L8 + KV_BYTES + (32 * wave + 4 * kh + q4) * KVP + (16 * blk + 4 * pp) * 2;
        s16x4 vf[3][4];
#define AT_LDV(set, step) do { const LAS unsigned char* vr_ = Vb + (16 * (step)) * KVP; vf[set][0] = vtr(vr_); vf[set][1] = vtr(vr_ + 8 * KVP); vf[set][2] = vtr(vr_ + 64); vf[set][3] = vtr(vr_ + 8 * KVP + 64); } while (0)
        AT_LDV(0, 0); AT_LDV(1, 1);
#pragma unroll
        for (int st = 0; st < 10; ++st) {
            if (st + 2 < 10) AT_LDV((st + 2) % 3, st + 2);
            __builtin_amdgcn_sched_barrier(0);
            const int kt = st >> 1, s2 = st & 1;
            v4u pw; pw.x = cvtpk(sc[kt][8 * s2 + 0], sc[kt][8 * s2 + 1]); pw.y = cvtpk(sc[kt][8 * s2 + 2], sc[kt][8 * s2 + 3]); pw.z = cvtpk(sc[kt][8 * s2 + 4], sc[kt][8 * s2 + 5]); pw.w = cvtpk(sc[kt][8 * s2 + 6], sc[kt][8 * s2 + 7]);
            const bf16x8 pb = __builtin_bit_cast(bf16x8, pw);
            const s16x4 l0 = vf[st % 3][0], h0 = vf[st % 3][1], l1 = vf[st % 3][2], h1 = vf[st % 3][3];
            o[0] = __builtin_amdgcn_mfma_f32_32x32x16_bf16((bf16x8){l0[0], l0[1], l0[2], l0[3], h0[0], h0[1], h0[2], h0[3]}, pb, o[0], 0, 0, 0);
            o[1] = __builtin_amdgcn_mfma_f32_32x32x16_bf16((bf16x8){l1[0], l1[1], l1[2], l1[3], h1[0], h1[1], h1[2], h1[3]}, pb, o[1], 0, 0, 0);
            __builtin_amdgcn_sched_barrier(0);
        }
#undef AT_LDV
    }
    const float inv = 1.0f / lsum;
    bf16* dst = PROJ + tokq * P2LD + p * 512 + h * 64 + 4 * kh;
#pragma unroll
    for (int c = 0; c < 2; ++c)
#pragma unroll
        for (int g = 0; g < 4; ++g) { v2u w; w.x = cvtpk(o[c][4 * g + 0] * inv, o[c][4 * g + 1] * inv); w.y = cvtpk(o[c][4 * g + 2] * inv, o[c][4 * g + 3] * inv);
            *(v2u*)(dst + 32 * c + 8 * g) = w; }
    if (kh == 0) { float* ml = ML + ((tokq * 8 + h) * 3 + p) * 2; *(f32x2*)ml = (f32x2){mx, lsum}; }
    __syncthreads();
}

#define XB_TMO      128
#define XB_XCNT(j)  (256  + 64 * (j))
#define XB_XSUB(j)  (1280 + 64 * (j))
#define XB_XGEN(j)  (2304 + 64 * (j))
#define XB_TOP      3328
#define XB_TOPGEN   3392
#define XCD_BAR_WORDS 3456
#define XB_SPIN_CAP (1u << 18)

__device__ __forceinline__ unsigned xb_ld(unsigned* p)              { return __hip_atomic_load(p, __ATOMIC_RELAXED, __HIP_MEMORY_SCOPE_AGENT); }
__device__ __forceinline__ unsigned xb_add(unsigned* p, unsigned v) { return __hip_atomic_fetch_add(p, v, __ATOMIC_RELAXED, __HIP_MEMORY_SCOPE_AGENT); }
__device__ __forceinline__ unsigned xb_xcc_id() { return (unsigned)__builtin_amdgcn_s_getreg((3 << 11) | 20) & 0xFu; }
#define XB_SPIN(cond, bar) do { unsigned _sp = 0; while (cond) { __builtin_amdgcn_s_sleep(1); \
    if ((++_sp & 255u) == 0u) { if (xb_ld(&(bar)[XB_TMO])) break; if (_sp > XB_SPIN_CAP) { atomicAdd(&(bar)[XB_TMO], 1u); break; } } } } while (0)

struct XcdBarrier {
    unsigned* bar; unsigned x;
    volatile LAS unsigned* st;
};

__device__ __forceinline__ XcdBarrier xcd_barrier_post(unsigned* bar, volatile LAS unsigned* st) {
    XcdBarrier b; b.bar = bar; b.x = xb_xcc_id(); b.st = st;
    if (threadIdx.x == 0) (void)xb_add(&bar[XB_XCNT(b.x)], 1u);
    return b;
}
__device__ __forceinline__ void xcd_barrier_complete(unsigned* bar, unsigned x, unsigned& nloc, unsigned& nx) {
    const unsigned G = gridDim.x * gridDim.y * gridDim.z;
    unsigned sum, cnt, mine, sp = 0u;
    for (;;) {
        sum = 0u; cnt = 0u; mine = 0u;
#pragma unroll
        for (unsigned j = 0; j < 16; ++j) { const unsigned c = xb_ld(&bar[XB_XCNT(j)]); sum += c; cnt += (c > 0u) ? 1u : 0u; mine = (j == x) ? c : mine; }
        if (sum == G) break;
        __builtin_amdgcn_s_sleep(1);
        if ((++sp & 255u) == 0u) { if (xb_ld(&bar[XB_TMO])) break; if (sp > XB_SPIN_CAP) { atomicAdd(&bar[XB_TMO], 1u); break; } }
    }
    nloc = mine > 0u ? mine : 1u; nx = cnt > 0u ? cnt : 1u;
}

__device__ __forceinline__ void xcd_barrier(const XcdBarrier& b) {
    asm volatile("s_waitcnt vmcnt(0)" ::: "memory");
    __syncthreads();
    if (threadIdx.x == 0) {
        unsigned* bar = b.bar;
        __builtin_amdgcn_s_waitcnt(0);
        unsigned nloc = b.st[0], nx = b.st[1];
        if (nloc == 0u) { xcd_barrier_complete(bar, b.x, nloc, nx); b.st[0] = nloc; b.st[1] = nx; }
        const unsigned old = xb_add(&bar[XB_XSUB(b.x)], 1u);
        const unsigned gen = old / nloc;
        if (old + 1u == (gen + 1u) * nloc) {
            __builtin_amdgcn_fence(__ATOMIC_RELEASE, "agent");
            asm volatile("s_waitcnt vmcnt(0)" ::: "memory");
            const unsigned og = xb_add(&bar[XB_TOP], 1u);
            const unsigned tg = og / nx;
            if (og + 1u == (tg + 1u) * nx) xb_add(&bar[XB_TOPGEN], 1u);
            else XB_SPIN(xb_ld(&bar[XB_TOPGEN]) == tg, bar);
            __builtin_amdgcn_fence(__ATOMIC_ACQUIRE, "agent");
            xb_add(&bar[XB_XGEN(b.x)], 1u);
            asm volatile("s_waitcnt vmcnt(0)" ::: "memory");
        } else {
            XB_SPIN(xb_ld(&bar[XB_XGEN(b.x)]) == gen, bar);
            __builtin_amdgcn_fence(__ATOMIC_ACQUIRE, "agent");
            asm volatile("s_waitcnt vmcnt(0)" ::: "memory");
        }
    }
    __syncthreads();
}

__global__ void __launch_bounds__(NWAVES * 64, 2) fwd_megakernel(Args a) {
    extern __shared__ __attribute__((aligned(16))) unsigned char lds[];
    cg::grid_group grid = cg::this_grid();
    LAS unsigned char* L8 = (LAS unsigned char*)lds;
    LAS float* L = (LAS float*)lds;
    const int tid = threadIdx.x, lane = tid & 63, wave = __builtin_amdgcn_readfirstlane(tid >> 6);
    const int G = gridDim.x, gw = blockIdx.x * NWAVES + wave, NGW = G * NWAVES;
    unsigned char* ws = a.ws;
    unsigned* ctl = (unsigned*)(ws + WS_CTL);
    const float* x = a.in[0];
    bf16* XN = (bf16*)(ws + WS_XN); bf16* ACT = (bf16*)(ws + WS_ACT); bf16* PROJ = ACT; bf16* MIX = XN;
    bf16* Wgu1 = (bf16*)(ws + WS_WGU1); bf16* Wd1 = (bf16*)(ws + WS_WD1); bf16* Win = (bf16*)(ws + WS_WIN); bf16* Wout = (bf16*)(ws + WS_WOUT);
    bf16* Wgu2 = (bf16*)(ws + WS_WGU2); bf16* Wd2 = (bf16*)(ws + WS_WD2);
    float* out = a.out;
    volatile LAS unsigned* xbst = (volatile LAS unsigned*)(L8 + LDS_BYTES - 64);
    if (tid < 2) xbst[tid] = 0u;
    __syncthreads();
    XcdBarrier bar = xcd_barrier_post(ctl + 1024, xbst);
#define GSYNC() xcd_barrier(bar)

    {
        const int lane = opq(tid) & 63;
        LAS float* scr = L + wave * 4096;
        constexpr int I_GU = (D / 64) * (NGU / 32), I_D = (FF / 64) * (D / 32), I_IN = (D / 64) * (NIN / 32), I_O = (D / 64) * (D / 32);
        constexpr int NITEMS = 2 * I_GU + 2 * I_D + I_IN + I_O;
        for (int it = gw; it < NITEMS; it += NGW) {
            int r = it;
            if (r < I_GU) { tr_gu(a.in[2], a.in[3], Wgu1, r, scr, lane); continue; } r -= I_GU;
            if (r < I_D) { tr_plain(a.in[4], FF, D, Wd1, r, scr, lane); continue; } r -= I_D;
            if (r < I_IN) { tr_win(a.in[6], Win, r, scr, lane, a.in[5]); continue; } r -= I_IN;
            if (r < I_O) { tr_plain(a.in[11], D, D, Wout, r, scr, lane); continue; } r -= I_O;
            if (r < I_GU) { tr_gu(a.in[13], a.in[14], Wgu2, r, scr, lane, a.in[12]); continue; } r -= I_GU;
            tr_plain(a.in[15], FF, D, Wd2, r, scr, lane);
        }
        for (int m = gw; m < M; m += NGW) { f32x4 v[4]; rms_row(x + (size_t)m * D, a.in[1], lane, v); store_row_bf16(XN + (size_t)m * D, lane, v); }
    }
    grid.sync();
    {
        pg8::Gemm g{XN, Wgu1, M, NGU, D}; pg8::StaticOrder S; S.init(M, NGU, G, (int)blockIdx.x);
        pg8::EpiSwiGLU<false> E{ACT, FF, nullptr};
        pg8::gemm_phase<pg8::EpiSwiGLU<false>, pg8::StaticOrder, true, true>(L8, g, S, E);
    }
    GSYNC();
    {
        pg8::Gemm g{ACT, Wd1, M, D, FF}; pg8::StaticOrder S; S.init(M, D, G, (int)blockIdx.x);
        pg8::EpiRes<true> E{x, out, D, 0.5f, XN, (float*)(ws + WS_SS)};
        pg8::gemm_phase<pg8::EpiRes<true>, pg8::StaticOrder, true, true>(L8, g, S, E);
    }
    GSYNC();
    {
        pg8::Gemm g{XN, Win, M, NIN, D}; pg8::StaticOrder S; S.init(M, NIN, G, (int)blockIdx.x);
        pg8::EpiProj E{(bf16*)(ws + WS_QH), (bf16*)(ws + WS_KVH), PROJ, (float*)(ws + WS_BD), (const float*)(ws + WS_SS)};
        pg8::gemm_phase<pg8::EpiProj, pg8::StaticOrder, true, true>(L8, g, S, E);
    }
    GSYNC();
    { const int tid_ = opq(tid); for (int ch = blockIdx.x; ch < 1024; ch += G) dn_prep_item(a, L8, ch, tid_, tid_ & 63, wave); }
    GSYNC();
    {
        const int tid_ = opq(tid), lane = tid_ & 63;
        for (int it = blockIdx.x; it < 64; it += G) dn_scan_mfma(a, L8, it, tid_, lane, wave);
        float* ML = (float*)(ws + WS_ML);
        if ((int)blockIdx.x >= 64 || G <= 64) {
            const int nb = (G > 64) ? G - 64 : G, j0 = (G > 64) ? (int)blockIdx.x - 64 : (int)blockIdx.x;
            for (int item = j0; item < 1536; item += nb) attn_item((const bf16*)(ws + WS_QH), (const bf16*)(ws + WS_KVH), PROJ, ML, L8, item, tid, lane, wave);
        }
    }
    GSYNC();
    {
        const int lane = opq(tid) & 63;
        const float* dn_norm = a.in[10];
        for (int m = gw; m < M; m += NGW) {
            bf16* op = MIX + (size_t)m * 1024 + 512 + 8 * lane; const bf16* gp = PROJ + (size_t)m * P2LD + 1536 + 8 * lane;
            const v4u ow = *(const v4u*)op, gwv = *(const v4u*)gp;
            float o[8] = {bflo(ow.x), bfhi(ow.x), bflo(ow.y), bfhi(ow.y), bflo(ow.z), bfhi(ow.z), bflo(ow.w), bfhi(ow.w)};
            float gt[8] = {bflo(gwv.x), bfhi(gwv.x), bflo(gwv.y), bfhi(gwv.y), bflo(gwv.z), bfhi(gwv.z), bflo(gwv.w), bfhi(gwv.w)};
            float ss = 0.f;
#pragma unroll
            for (int i = 0; i < 8; ++i) ss += o[i] * o[i];
            ss += __shfl_xor(ss, 1); ss += __shfl_xor(ss, 2); ss += __shfl_xor(ss, 4); ss += __shfl_xor(ss, 8);
            const float rs = 1.0f / sqrtf(ss * (1.f / 128.f) + 1e-6f);
            const int d0 = (8 * lane) & 127;
            float r[8];
#pragma unroll
            for (int i = 0; i < 8; ++i) r[i] = o[i] * rs * dn_norm[d0 + i] * (gt[i] / (1.f + __expf(-gt[i])));
            v4u w; w.x = pk2(r[0], r[1]); w.y = pk2(r[2], r[3]); w.z = pk2(r[4], r[5]); w.w = pk2(r[6], r[7]);
            *(v4u*)op = w;
            {
                const int ha = lane >> 3;
                const float* ml = (const float*)(ws + WS_ML) + ((size_t)m * 8 + ha) * 6;
                const f32x2 a0 = *(const f32x2*)ml, a1 = *(const f32x2*)(ml + 2), a2 = *(const f32x2*)(ml + 4);
                const float mm = fmaxf(a0.x, fmaxf(a1.x, a2.x));
                const float w0 = a0.y * __builtin_amdgcn_exp2f(a0.x - mm), w1 = a1.y * __builtin_amdgcn_exp2f(a1.x - mm), w2 = a2.y * __builtin_amdgcn_exp2f(a2.x - mm);
                const float iw = 1.0f / (w0 + w1 + w2);
                const bf16* pp = PROJ + (size_t)m * P2LD + 8 * lane;
                const v4u p0 = *(const v4u*)pp, p1 = *(const v4u*)(pp + 512), p2 = *(const v4u*)(pp + 1024);
                float rr[8];
                rr[0] = w0 * bflo(p0.x) + w1 * bflo(p1.x) + w2 * bflo(p2.x); rr[1] = w0 * bfhi(p0.x) + w1 * bfhi(p1.x) + w2 * bfhi(p2.x);
                rr[2] = w0 * bflo(p0.y) + w1 * bflo(p1.y) + w2 * bflo(p2.y); rr[3] = w0 * bfhi(p0.y) + w1 * bfhi(p1.y) + w2 * bfhi(p2.y);
                rr[4] = w0 * bflo(p0.z) + w1 * bflo(p1.z) + w2 * bflo(p2.z); rr[5] = w0 * bfhi(p0.z) + w1 * bfhi(p1.z) + w2 * bfhi(p2.z);
                rr[6] = w0 * bflo(p0.w) + w1 * bflo(p1.w) + w2 * bflo(p2.w); rr[7] = w0 * bfhi(p0.w) + w1 * bfhi(p1.w) + w2 * bfhi(p2.w);
                v4u wa; wa.x = pk2(rr[0] * iw, rr[1] * iw); wa.y = pk2(rr[2] * iw, rr[3] * iw); wa.z = pk2(rr[4] * iw, rr[5] * iw); wa.w = pk2(rr[6] * iw, rr[7] * iw);
                *(v4u*)(MIX + (size_t)m * 1024 + 8 * lane) = wa;
            }
        }
    }
    GSYNC();
    {
        pg8::Gemm g{MIX, Wout, M, D, D}; pg8::StaticOrder S; S.init(M, D, G, (int)blockIdx.x);
        pg8::EpiRes<true> E{out, out, D, 1.0f, (bf16*)(ws + WS_XNB2), (float*)(ws + WS_SS)};
        pg8::gemm_phase<pg8::EpiRes<true>, pg8::StaticOrder, true, true>(L8, g, S, E);
    }
    GSYNC();
    {
        pg8::Gemm g{(const bf16*)(ws + WS_XNB2), Wgu2, M, NGU, D}; pg8::StaticOrder S; S.init(M, NGU, G, (int)blockIdx.x);
        pg8::EpiSwiGLU<true> E{ACT, FF, (const float*)(ws + WS_SS)};
        pg8::gemm_phase<pg8::EpiSwiGLU<true>, pg8::StaticOrder, true, true>(L8, g, S, E);
    }
    GSYNC();
    {
        pg8::Gemm g{ACT, Wd2, M, D, FF}; pg8::StaticOrder S; S.init(M, D, G, (int)blockIdx.x);
        pg8::EpiRes<false> E{out, out, D, 0.5f, nullptr, nullptr};
        pg8::gemm_phase<pg8::EpiRes<false>, pg8::StaticOrder, true, true>(L8, g, S, E);
    }
    GSYNC();
    const int lnf = opq(tid) & 63;
    for (int m = gw; m < M; m += NGW) {
        f32x4 v[4]; rms_row(out + (size_t)m * D, a.in[16], lnf, v);
        f32x4* o = (f32x4*)(out + (size_t)m * D) + lnf;
#pragma unroll
        for (int j = 0; j < 4; ++j) o[64 * j] = v[j];
    }
}

extern "C" void kernel_launch(void* const* d_in, const int* in_sizes, int n_in, void* d_out, int out_size, void* d_ws, size_t ws_size, hipStream_t stream) {
    static int grid = 0;
    if (grid == 0) {
        if (n_in != 17 || in_sizes[0] != M * D || out_size != M * D || ws_size < WS_END) { fprintf(stderr, "kernel_launch: unexpected shapes (n_in %d in0 %d out %d ws %zu)\n", n_in, n_in > 0 ? in_sizes[0] : -1, out_size, ws_size); grid = -1; return; }
        int dev = 0, cus = 0, per_cu = 0;
        hipGetDevice(&dev); hipDeviceGetAttribute(&cus, hipDeviceAttributeMultiprocessorCount, dev);
        if (hipFuncSetAttribute((const void*)fwd_megakernel, hipFuncAttributeMaxDynamicSharedMemorySize, LDS_BYTES) != hipSuccess) { fprintf(stderr, "kernel_launch: hipFuncSetAttribute failed\n"); grid = -1; return; }
        if (hipOccupancyMaxActiveBlocksPerMultiprocessor(&per_cu, (const void*)fwd_megakernel, NWAVES * 64, LDS_BYTES) != hipSuccess || per_cu < 1) { fprintf(stderr, "kernel_launch: occupancy query says %d blocks/CU\n", per_cu); (void)hipGetLastError(); per_cu = 1; }
        grid = cus * 1;
        fprintf(stderr, "kernel_launch: cus %d per_cu %d grid %d\n", cus, per_cu, grid);
    }
    if (grid < 0) return;
    hipMemsetAsync((char*)d_ws + WS_CTL, 0, CTL_BYTES, stream);
    Args a{};
    for (int i = 0; i < 17; ++i) a.in[i] = (const float*)d_in[i];
    a.out = (float*)d_out; a.ws = (unsigned char*)d_ws;
    void* args[] = {&a};
    hipError_t e = hipLaunchCooperativeKernel((const void*)fwd_megakernel, dim3(grid), dim3(NWAVES * 64), args, LDS_BYTES, stream);
    if (e != hipSuccess) fprintf(stderr, "cooperative launch failed: %s (grid %d)\n", hipGetErrorString(e), grid);
}
```

```cpp
#include <hip/hip_runtime.h>
#include <hip/hip_cooperative_groups.h>
#include <cstdio>
#include <cstdint>
namespace cg = cooperative_groups;
namespace pg8 {
#define PG8_LAS __attribute__((address_space(3)))
typedef unsigned short bf16_t;
typedef short bf16x8 __attribute__((ext_vector_type(8)));
typedef float f32x4 __attribute__((ext_vector_type(4)));
typedef unsigned u32x4 __attribute__((ext_vector_type(4)));
constexpr int BM = 256, BK = 64, HALF = 128, HTB = HALF * BK * 2  , STAGE_BYTES = 8 * HTB, NXCD = 8, WGM = 8;

__host__ __device__ __forceinline__ int lds_byte(int r, int c) { const int st = (r >> 4) * 2 + (c >> 5), rr = r & 15, cc = c & 31, ob = rr * 64 + cc * 2; return st * 1024 + (ob ^ (((ob >> 9) & 1) << 5)); }
__host__ __device__ __forceinline__ void stage_rc(int b, int& R, int& C) { const int st = b / 1024, sb = b % 1024, swz = sb ^ (((sb >> 9) & 1) << 5); R = (st >> 1) * 16 + swz / 64; C = (st & 1) * 32 + (swz % 64) / 2; }
__host__ __device__ __forceinline__ int perm32(int rho) { const int n = rho >> 4, i = rho & 15; return 8 * (i >> 2) + 4 * n + (i & 3); }

struct Unit { int pm, pn; };
struct Gemm { const bf16_t* A; const bf16_t* Bt; int M, N, K; };

struct StaticOrder {
    int nM, nN, nwg, G, c;
    __host__ __device__ void init(int M, int N, int G_, int c_) { nM = M / BM; nN = N / BM; nwg = nM * nN; G = G_; c = c_; }
    __host__ __device__ bool next(int i, Unit& u) const {
        const long L = (long)i * G + c; if (L >= nwg) return false;
        int wgid = (int)L; { const int q = nwg / NXCD, r = nwg % NXCD, xcd = wgid % NXCD, off = wgid / NXCD; wgid = (xcd < r ? xcd * (q + 1) : r * (q + 1) + (xcd - r) * q) + off; }
        const int nig = WGM * nN, gid = wgid / nig, fm = gid * WGM, gsz = (nM - fm) < WGM ? (nM - fm) : WGM;
        u.pm = fm + ((wgid % nig) % gsz); u.pn = (wgid % nig) / gsz; return true;
    }
    __device__ __forceinline__ void a_ready(const Unit&) const {}
    __device__ __forceinline__ void done(const Unit&) const {}
};

__device__ __forceinline__ unsigned cvt_pk_bf16(float lo, float hi) { unsigned r; asm volatile("v_cvt_pk_bf16_f32 %0, %1, %2" : "=v"(r) : "v"(lo), "v"(hi)); return r; }
__device__ __forceinline__ float silu_f(float g) { return g * __builtin_amdgcn_rcpf(1.0f + __expf(-g)); }
__device__ __forceinline__ float row_rs(const float* SS, int row) {
    const f32x4* sp = (const f32x4*)(SS + (size_t)row * 16); const f32x4 a = sp[0], b = sp[1], c = sp[2], d = sp[3];
    const float s = ((a[0] + a[1]) + (a[2] + a[3])) + ((b[0] + b[1]) + (b[2] + b[3])) + ((c[0] + c[1]) + (c[2] + c[3])) + ((d[0] + d[1]) + (d[2] + d[3]));
    return 1.0f / sqrtf(s * (1.0f / 1024.0f) + 1e-6f);
}
template <bool RS> struct EpiSwiGLU {
    static constexpr bool PERM = true, AFTER_DRAIN = false;
    bf16_t* O; int ldc; const float* SS;
    __device__ __forceinline__ void operator()(const f32x4 (&acc)[2][2][4][2], const Unit& u, int wr, int wc, int fr, int fq) const {
        const int row0 = u.pm * BM + wr * 64 + fr; const int col0 = u.pn * 128 + wc * 32 + 8 * fq;
#pragma unroll
        for (int ai = 0; ai < 2; ++ai)
#pragma unroll
            for (int m = 0; m < 4; ++m) { const int row = row0 + ai * HALF + m * 16; bf16_t* rowp = O + (size_t)row * ldc + col0;
                const float rs = RS ? row_rs(SS, row) : 1.0f;
                const f32x4 g0 = acc[ai][0][m][0] * rs, g1 = acc[ai][0][m][1] * rs, u0 = acc[ai][1][m][0] * rs, u1 = acc[ai][1][m][1] * rs;
                u32x4 w;
                w.x = cvt_pk_bf16(silu_f(g0[0]) * u0[0], silu_f(g0[1]) * u0[1]); w.y = cvt_pk_bf16(silu_f(g0[2]) * u0[2], silu_f(g0[3]) * u0[3]);
                w.z = cvt_pk_bf16(silu_f(g1[0]) * u1[0], silu_f(g1[1]) * u1[1]); w.w = cvt_pk_bf16(silu_f(g1[2]) * u1[2], silu_f(g1[3]) * u1[3]);
                *(u32x4*)rowp = w; }
    }
};
template <bool XB> struct EpiRes {
    static constexpr bool PERM = false, AFTER_DRAIN = false;
    const float* base; float* out; int ldc; float scale; bf16_t* xb; float* SS;
    __device__ __forceinline__ void operator()(const f32x4 (&acc)[2][2][4][2], const Unit& u, int wr, int wc, int fr, int fq) const {
        const int row0 = u.pm * BM + wr * 64 + fr; const int col0 = u.pn * BM + wc * 32 + 4 * fq;
#pragma unroll
        for (int ai = 0; ai < 2; ++ai)
#pragma unroll
            for (int m = 0; m < 4; ++m) { const int row = row0 + ai * HALF + m * 16; const size_t off = (size_t)row * ldc + col0; float ss = 0.f;
#pragma unroll
                for (int bj = 0; bj < 2; ++bj)
#pragma unroll
                    for (int n = 0; n < 2; ++n) { const f32x4 b = *(const f32x4*)(base + off + bj * HALF + n * 16); const f32x4 v = b + acc[ai][bj][m][n] * scale; *(f32x4*)(out + off + bj * HALF + n * 16) = v;
                        if (XB) { ss += (v[0] * v[0] + v[1] * v[1]) + (v[2] * v[2] + v[3] * v[3]);
                            unsigned lo = cvt_pk_bf16(v[0], v[1]), hi = cvt_pk_bf16(v[2], v[3]); unsigned long long pk = ((unsigned long long)hi << 32) | lo;
                            *(unsigned long long*)(xb + off + bj * HALF + n * 16) = pk; } }
                if (XB) { ss += __shfl_xor(ss, 16); ss += __shfl_xor(ss, 32); if (fq == 0) SS[(size_t)row * 16 + u.pn * 4 + wc] = ss; }
                asm volatile("" ::: "memory"); }
    }
};
struct EpiProj {
    static constexpr bool PERM = true, AFTER_DRAIN = false;
    bf16_t* Qh; bf16_t* KVh; bf16_t* P2; float* BD; const float* SS;
    __device__ __forceinline__ void operator()(const f32x4 (&acc)[2][2][4][2], const Unit& u, int wr, int wc, int fr, int fq) const {
        const int row0 = u.pm * BM + wr * 64 + fr;
        if (u.pn == 14) {
            if (wc == 0 && fq == 0) {
#pragma unroll
                for (int ai = 0; ai < 2; ++ai)
#pragma unroll
                    for (int m = 0; m < 4; ++m) { const int row = row0 + ai * HALF + m * 16; const float rs = row_rs(SS, row);
                        *(f32x4*)(BD + (size_t)row * 8) = acc[ai][0][m][0] * rs; *(f32x4*)(BD + (size_t)row * 8 + 4) = acc[ai][0][m][1] * rs; }
            }
            return;
        }
#pragma unroll
        for (int ai = 0; ai < 2; ++ai)
#pragma unroll
            for (int m = 0; m < 4; ++m) { const int row = row0 + ai * HALF + m * 16, bb = row >> 12, t = row & 4095; const float rs = row_rs(SS, row);
#pragma unroll
                for (int bj = 0; bj < 2; ++bj) { const int col = u.pn * BM + bj * HALF + wc * 32 + 8 * fq;
                    bf16_t* dst;
                    if (u.pn < 6) { const int sec = col >> 9, hc = col & 511, hh = hc >> 6, d = hc & 63; const size_t rt = (size_t)(bb * 8 + hh) * 4096 + t;
                        dst = (sec == 0) ? Qh + rt * 64 + d : KVh + rt * 128 + (sec - 1) * 64 + d; }
                    else dst = P2 + (size_t)row * 2048 + (col - 1536);
                    const f32x4 v0 = acc[ai][bj][m][0] * rs, v1 = acc[ai][bj][m][1] * rs; u32x4 w;
                    w.x = cvt_pk_bf16(v0[0], v0[1]); w.y = cvt_pk_bf16(v0[2], v0[3]); w.z = cvt_pk_bf16(v1[0], v1[1]); w.w = cvt_pk_bf16(v1[2], v1[3]);
                    *(u32x4*)dst = w; } }
    }
};
struct EpiStoreBf16 {
    static constexpr bool PERM = true, AFTER_DRAIN = false;
    bf16_t* O; int ldc;
    __device__ __forceinline__ void operator()(const f32x4 (&acc)[2][2][4][2], const Unit& u, int wr, int wc, int fr, int fq) const {
        const int row0 = u.pm * BM + wr * 64 + fr; const int col0 = u.pn * BM + wc * 32 + 8 * fq;
#pragma unroll
        for (int ai = 0; ai < 2; ++ai)
#pragma unroll
            for (int m = 0; m < 4; ++m) { bf16_t* rowp = O + (size_t)(row0 + ai * HALF + m * 16) * ldc + col0;
#pragma unroll
                for (int bj = 0; bj < 2; ++bj) { const f32x4 v0 = acc[ai][bj][m][0], v1 = acc[ai][bj][m][1]; u32x4 w;
                    w.x = cvt_pk_bf16(v0[0], v0[1]); w.y = cvt_pk_bf16(v0[2], v0[3]); w.z = cvt_pk_bf16(v1[0], v1[1]); w.w = cvt_pk_bf16(v1[2], v1[3]);
                    *(u32x4*)(rowp + bj * HALF) = w; } }
    }
};
template <class Epi, class Sched, bool ALIGN_EPI = false, bool SP2 = false>
__device__ __forceinline__ void gemm_phase(PG8_LAS unsigned char* lds, const Gemm g, const Sched& S, const Epi& E) {
    const int tid = threadIdx.x, wid = __builtin_amdgcn_readfirstlane(tid >> 6), lane = tid & 63, wr = wid >> 2, wc = wid & 3, fr = lane & 15, fq = lane >> 4;
    const int K = g.K, nt = K / BK;
    unsigned voffA[2], voffB[2];
#pragma unroll
    for (int i = 0; i < 2; ++i) { int R, C; stage_rc(tid * 16 + i * 8192, R, C); const int Rb = Epi::PERM ? ((R & ~31) + perm32(R & 31)) : R;
        voffA[i] = (unsigned)(R * K + C) * 2u; voffB[i] = (unsigned)(Rb * K + C) * 2u; }
    const size_t kstep = (size_t)(BK * 2);
    const size_t hstep = (size_t)HALF * K * 2;
    const size_t tstep = 2 * hstep;
    const unsigned ldsw = (unsigned)wid * 1024u;
    const int aoff = lds_byte(wr * 64 + fr, fq * 8), boff = lds_byte(wc * 32 + fr, fq * 8);
#define PG8_SA(b, h) (((b) * 2 + (h)) * HTB)
#define PG8_SB(b, h) ((4 + (b) * 2 + (h)) * HTB)
#define PG8_STAGE(bufoff, gbase, voff) do { _Pragma("unroll") for (int _i = 0; _i < 2; ++_i) \
        __builtin_amdgcn_global_load_lds((const unsigned*)((const char*)(gbase) + (voff)[_i]), (PG8_LAS unsigned*)(lds + (bufoff) + ldsw + _i * 8192), 16, 0, 0); } while (0)
#define PG8_LDA(dst, b, h) do { _Pragma("unroll") for (int m = 0; m < 4; ++m) _Pragma("unroll") for (int k = 0; k < 2; ++k) dst[m][k] = *(const PG8_LAS bf16x8*)(lds + PG8_SA(b, h) + aoff + m * 2048 + k * 1024); } while (0)
#define PG8_LDB(dst, b, h) do { _Pragma("unroll") for (int n = 0; n < 2; ++n) _Pragma("unroll") for (int k = 0; k < 2; ++k) dst[n][k] = *(const PG8_LAS bf16x8*)(lds + PG8_SB(b, h) + boff + n * 2048 + k * 1024); } while (0)
#define PG8_MMA(ai, bj, At, Bt) do { __builtin_amdgcn_s_setprio(1); _Pragma("unroll") for (int m = 0; m < 4; ++m) _Pragma("unroll") for (int n = 0; n < 2; ++n) _Pragma("unroll") for (int k = 0; k < 2; ++k) \
        acc[ai][bj][m][n] = __builtin_amdgcn_mfma_f32_16x16x32_bf16(Bt[n][k], At[m][k], acc[ai][bj][m][n], 0, 0, 0); __builtin_amdgcn_s_setprio(0); } while (0)
#define PG8_WAIT_V(n) asm volatile("s_waitcnt vmcnt(" #n ")" ::: "memory")
#define PG8_WAIT_L(n) asm volatile("s_waitcnt lgkmcnt(" #n ")" ::: "memory")
#define PG8_BAR __builtin_amdgcn_s_barrier()
#define PG8_SCHED __builtin_amdgcn_sched_barrier(0)
    Unit cur, nxt; int ui = 0;
    if (!S.next(0, cur)) return;
    f32x4 acc[2][2][4][2];
#pragma unroll
    for (int a = 0; a < 2; ++a)
#pragma unroll
        for (int b = 0; b < 2; ++b)
#pragma unroll
            for (int m = 0; m < 4; ++m)
#pragma unroll
                for (int n = 0; n < 2; ++n) acc[a][b][m][n] = (f32x4){0.f, 0.f, 0.f, 0.f};
    bf16x8 At[4][2], B0[2][2], B1[2][2];
    const char* cA = (const char*)g.A + (size_t)cur.pm * tstep; const char* cB = (const char*)g.Bt + (size_t)cur.pn * tstep;
    S.a_ready(cur);
    if constexpr (SP2) {
        PG8_STAGE(PG8_SB(0, 0), cB, voffB); PG8_STAGE(PG8_SB(0, 1), cB + hstep, voffB); PG8_STAGE(PG8_SA(0, 0), cA, voffA); PG8_STAGE(PG8_SA(0, 1), cA + hstep, voffA);
        if (wr == 1) PG8_BAR;
        PG8_WAIT_V(2); PG8_BAR;
        PG8_STAGE(PG8_SB(1, 0), cB + kstep, voffB); PG8_STAGE(PG8_SA(1, 0), cA + kstep, voffA); PG8_STAGE(PG8_SB(1, 1), cB + hstep + kstep, voffB);
        PG8_WAIT_V(6); PG8_BAR;
    } else {
        PG8_STAGE(PG8_SB(0, 0), cB, voffB); PG8_STAGE(PG8_SA(0, 0), cA, voffA); PG8_STAGE(PG8_SB(0, 1), cB + hstep, voffB); PG8_STAGE(PG8_SA(0, 1), cA + hstep, voffA);
        if (wr == 1) PG8_BAR;
        PG8_WAIT_V(4); PG8_BAR;
        PG8_STAGE(PG8_SB(1, 0), cB + kstep, voffB); PG8_STAGE(PG8_SA(1, 0), cA + kstep, voffA); PG8_STAGE(PG8_SB(1, 1), cB + hstep + kstep, voffB);
        PG8_WAIT_V(6); PG8_BAR;
    }
    for (;;) {
        const bool has_next = S.next(ui + 1, nxt);
        const char* nA = has_next ? (const char*)g.A + (size_t)nxt.pm * tstep : cA; const char* nB = has_next ? (const char*)g.Bt + (size_t)nxt.pn * tstep : cB;
        for (int t = 0; t < nt; t += 2) {
            const bool last = (t == nt - 2);
            const char* a1 = cA + (size_t)(t + 1) * kstep;
            const char* a2 = last ? nA : cA + (size_t)(t + 2) * kstep; const char* b2 = last ? nB : cB + (size_t)(t + 2) * kstep;
            const char* a3 = a2 + kstep; const char* b3 = b2 + kstep;
            if (last && has_next) S.a_ready(nxt);
            if constexpr (SP2) {
            PG8_LDB(B0, 0, 0); PG8_LDB(B1, 0, 1); PG8_SCHED; PG8_LDA(At, 0, 0); PG8_STAGE(PG8_SA(1, 1), a1 + hstep, voffA);
            PG8_WAIT_V(8); PG8_WAIT_L(0); PG8_BAR; PG8_MMA(0, 0, At, B0); PG8_MMA(0, 1, At, B1); PG8_BAR; PG8_SCHED;
            PG8_LDA(At, 0, 1); PG8_STAGE(PG8_SB(0, 0), b2, voffB); PG8_STAGE(PG8_SB(0, 1), b2 + hstep, voffB); PG8_STAGE(PG8_SA(0, 0), a2, voffA);
            PG8_WAIT_V(8); PG8_WAIT_L(0); PG8_BAR; PG8_MMA(1, 0, At, B0); PG8_MMA(1, 1, At, B1); PG8_BAR; PG8_SCHED;
            PG8_LDB(B0, 1, 0); PG8_LDB(B1, 1, 1); PG8_SCHED; PG8_LDA(At, 1, 0); PG8_STAGE(PG8_SA(0, 1), a2 + hstep, voffA);
            PG8_WAIT_V(8); PG8_WAIT_L(0); PG8_BAR; PG8_MMA(0, 0, At, B0); PG8_MMA(0, 1, At, B1); PG8_BAR; PG8_SCHED;
            PG8_LDA(At, 1, 1); PG8_STAGE(PG8_SB(1, 0), b3, voffB); PG8_STAGE(PG8_SB(1, 1), b3 + hstep, voffB); PG8_STAGE(PG8_SA(1, 0), a3, voffA);
            PG8_WAIT_V(8); PG8_WAIT_L(0); PG8_BAR; PG8_MMA(1, 0, At, B0); PG8_MMA(1, 1, At, B1); PG8_BAR; PG8_SCHED;
            } else {
            PG8_LDB(B0, 0, 0); PG8_SCHED; PG8_LDA(At, 0, 0); PG8_STAGE(PG8_SA(1, 1), a1 + hstep, voffA);
            PG8_WAIT_L(8); PG8_BAR; PG8_WAIT_L(0); PG8_MMA(0, 0, At, B0); PG8_BAR; PG8_SCHED;
            PG8_LDB(B1, 0, 1); PG8_STAGE(PG8_SB(0, 0), b2, voffB);
            PG8_BAR; PG8_WAIT_L(0); PG8_MMA(0, 1, At, B1); PG8_BAR;
            PG8_LDA(At, 0, 1); PG8_STAGE(PG8_SA(0, 0), a2, voffA);
            PG8_BAR; PG8_WAIT_L(0); PG8_MMA(1, 0, At, B0); PG8_BAR; PG8_SCHED;
            PG8_STAGE(PG8_SB(0, 1), b2 + hstep, voffB);
            PG8_WAIT_V(6); PG8_BAR; PG8_MMA(1, 1, At, B1); PG8_BAR;
            PG8_LDB(B0, 1, 0); PG8_SCHED; PG8_LDA(At, 1, 0); PG8_STAGE(PG8_SA(0, 1), a2 + hstep, voffA);
            PG8_WAIT_L(8); PG8_BAR; PG8_WAIT_L(0); PG8_MMA(0, 0, At, B0); PG8_BAR; PG8_SCHED;
            PG8_LDB(B1, 1, 1); PG8_STAGE(PG8_SB(1, 0), b3, voffB);
            PG8_BAR; PG8_WAIT_L(0); PG8_MMA(0, 1, At, B1); PG8_BAR;
            PG8_LDA(At, 1, 1); PG8_STAGE(PG8_SA(1, 0), a3, voffA);
            PG8_BAR; PG8_WAIT_L(0); PG8_MMA(1, 0, At, B0); PG8_BAR; PG8_SCHED;
            PG8_STAGE(PG8_SB(1, 1), b3 + hstep, voffB);
            PG8_WAIT_V(6); PG8_BAR; PG8_MMA(1, 1, At, B1); PG8_BAR;
            }
        }
        if constexpr (ALIGN_EPI) { if (wr == 0) PG8_BAR; }
        if constexpr (!Epi::AFTER_DRAIN) { E(acc, cur, wr, wc, fr, fq); S.done(cur); }
        if (!has_next) break;
#pragma unroll
        for (int a = 0; a < 2; ++a)
#pragma unroll
            for (int b = 0; b < 2; ++b)
#pragma unroll
                for (int m = 0; m < 4; ++m)
#pragma unroll
                    for (int n = 0; n < 2; ++n) acc[a][b][m][n] = (f32x4){0.f, 0.f, 0.f, 0.f};
        cur = nxt; cA = nA; cB = nB; ++ui;
        if constexpr (ALIGN_EPI) { if (wr == 1) PG8_BAR; }
    }
    PG8_WAIT_V(0);
    if constexpr (!ALIGN_EPI) { if (wr == 0) PG8_BAR; }
    PG8_BAR;
    if constexpr (Epi::AFTER_DRAIN) { E.fused(acc, cur, wr, wc, fr, fq, lds, wid, lane); S.done(cur); }
#undef PG8_SA
#undef PG8_SB
#undef PG8_STAGE
#undef PG8_LDA
#undef PG8_LDB
#undef PG8_MMA
#undef PG8_WAIT_V
#undef PG8_WAIT_L
#undef PG8_BAR
#undef PG8_SCHED
}
}
constexpr int M = 16384, D = 1024, FF = 2816, NGU = 5632, NIN = 3840, SEQ = 4096;
constexpr int WIN_COLS = 3592;
constexpr size_t MiB = 1u << 20;
constexpr size_t WS_CTL = 0, CTL_BYTES = 65536;
constexpr size_t WS_WIN = MiB / 4, WS_WOUT = 8 * MiB, WS_WGU2 = 10 * MiB, WS_WD2 = 21 * MiB;
constexpr size_t WS_XN = 27 * MiB;
constexpr size_t WS_ACT = 59 * MiB;
constexpr size_t WS_QH = 123 * MiB, WS_KVH = 139 * MiB;
constexpr int P2LD = 2048;
constexpr size_t WS_BD = 171 * MiB;
constexpr size_t WS_EG = 172 * MiB;
constexpr size_t WS_DN = 184 * MiB;
constexpr size_t WS_WGU1 = 184 * MiB, WS_WD1 = 195 * MiB;
constexpr size_t WS_QG = WS_DN, WS_KD = WS_DN + 16 * MiB, WS_U = WS_DN + 32 * MiB, WS_W = WS_DN + 48 * MiB, WS_A = WS_DN + 64 * MiB;
constexpr size_t WS_END = 256 * MiB;
constexpr int LDS_BYTES = 147456;
constexpr int NWAVES = 8;

#define GAS __attribute__((address_space(1)))
#define LAS __attribute__((address_space(3)))
typedef unsigned short bf16;
typedef unsigned v4u __attribute__((ext_vector_type(4)));
typedef unsigned v2u __attribute__((ext_vector_type(2)));
typedef float f32x4 __attribute__((ext_vector_type(4)));
typedef float f32x2 __attribute__((ext_vector_type(2)));
#define LDS_WAIT() asm volatile("s_waitcnt lgkmcnt(0)" ::: "memory")
__device__ __forceinline__ unsigned f2bf(float f) { unsigned u = __builtin_bit_cast(unsigned, f); return (u + 0x7fffu + ((u >> 16) & 1u)) >> 16; }
__device__ __forceinline__ unsigned pk2(float lo, float hi) { return f2bf(lo) | (f2bf(hi) << 16); }
__device__ __forceinline__ float bflo(unsigned u) { return __uint_as_float(u << 16); }
__device__ __forceinline__ float bfhi(unsigned u) { return __uint_as_float(u & 0xffff0000u); }
__device__ __forceinline__ float bf2f(bf16 v) { return __uint_as_float(((unsigned)v) << 16); }
__device__ __forceinline__ float wave_sum(float v) {
#pragma unroll
    for (int o = 1; o < 64; o <<= 1) v += __shfl_xor(v, o);
    return v;
}
__device__ __forceinline__ float wave_max(float v) {
#pragma unroll
    for (int o = 1; o < 64; o <<= 1) v = fmaxf(v, __shfl_xor(v, o));
    return v;
}

__device__ __forceinline__ int opq(int v) { asm volatile("" : "+v"(v)); return v; }
struct Args { const float* in[17]; float* out; unsigned char* ws; };

__device__ __forceinline__ void transpose_item(const float* src, int srcN, int srccol0, bf16* dst, int dstK, int dstrow0, int k0, LAS float* scr, int lane, const float* gain = nullptr, int nvalid = 32) {
    const int c4 = (lane & 7) * 4, r0 = lane >> 3;
    f32x4 v[8];
#pragma unroll
    for (int i = 0; i < 8; ++i) v[i] = (c4 < nvalid) ? *(const f32x4*)(src + (size_t)(k0 + r0 + 8 * i) * srcN + srccol0 + c4) : (f32x4){0.f, 0.f, 0.f, 0.f};
    if (gain) {
#pragma unroll
        for (int i = 0; i < 8; ++i) v[i] = v[i] * gain[k0 + r0 + 8 * i]; }
#pragma unroll
    for (int i = 0; i < 8; ++i) { LAS float* p = scr + (r0 + 8 * i) * 33 + c4; p[0] = v[i][0]; p[1] = v[i][1]; p[2] = v[i][2]; p[3] = v[i][3]; }
    LDS_WAIT(); asm volatile("" ::: "memory");
    const int c = lane & 7;
#pragma unroll
    for (int j = 0; j < 4; ++j) { const int n = (lane >> 3) + 8 * j; const LAS float* s = scr + (8 * c) * 33 + n;
        v4u o; o.x = pk2(s[0 * 33], s[1 * 33]); o.y = pk2(s[2 * 33], s[3 * 33]); o.z = pk2(s[4 * 33], s[5 * 33]); o.w = pk2(s[6 * 33], s[7 * 33]);
        *(v4u*)(dst + (size_t)(dstrow0 + n) * dstK + k0 + 8 * c) = o; }
    LDS_WAIT(); asm volatile("" ::: "memory");
}
__device__ __forceinline__ void tr_gu(const float* gate, const float* up, bf16* dst, int r, LAS float* scr, int lane, const float* gain = nullptr) {
    const int nblk = NGU / 32, kb = r / nblk, nb = r % nblk, dstrow0 = nb * 32, pn = dstrow0 >> 8, within = dstrow0 & 255;
    transpose_item(within < 128 ? gate : up, FF, pn * 128 + (within & 127), dst, D, dstrow0, kb * 64, scr, lane, gain);
}
__device__ __forceinline__ void tr_plain(const float* src, int K, int N, bf16* dst, int r, LAS float* scr, int lane) {
    const int nblk = N / 32, kb = r / nblk, nb = r % nblk;
    transpose_item(src, N, nb * 32, dst, K, nb * 32, kb * 64, scr, lane);
}
__device__ __forceinline__ void tr_win(const float* src, bf16* dst, int r, LAS float* scr, int lane, const float* gain) {
    const int nblk = NIN / 32, kb = r / nblk, nb = r % nblk, dstrow0 = nb * 32;
    const int srccol0 = dstrow0 < 3072 ? dstrow0 : (dstrow0 < 3584 ? dstrow0 + 8 : 3072), nvalid = dstrow0 < 3584 ? 32 : (dstrow0 == 3584 ? 8 : 0);
    transpose_item(src, WIN_COLS, srccol0, dst, D, dstrow0, kb * 64, scr, lane, gain, nvalid);
}

__device__ __forceinline__ void rms_row(const float* xrow, const float* gain, int lane, f32x4 (&v)[4]) {
    const f32x4* xr = (const f32x4*)xrow + lane; const f32x4* gr = (const f32x4*)gain + lane;
    float s = 0.f;
#pragma unroll
    for (int j = 0; j < 4; ++j) { v[j] = xr[64 * j]; s += (v[j].x * v[j].x + v[j].y * v[j].y) + (v[j].z * v[j].z + v[j].w * v[j].w); }
    const float rs = 1.0f / sqrtf(wave_sum(s) * (1.f / D) + 1e-6f);
#pragma unroll
    for (int j = 0; j < 4; ++j) { const f32x4 g = gr[64 * j]; v[j] = v[j] * rs * g; }
}
__device__ __forceinline__ void store_row_bf16(bf16* orow, int lane, const f32x4 (&v)[4]) {
    v2u* o8 = (v2u*)orow + lane;
#pragma unroll
    for (int j = 0; j < 4; ++j) { v2u w; w.x = pk2(v[j].x, v[j].y); w.y = pk2(v[j].z, v[j].w); o8[64 * j] = w; }
}

__device__ __forceinline__ int kperm(int x) { return 8 * ((x & 15) >> 2) + 4 * (x >> 4) + (x & 3); }
typedef short bf16x8 __attribute__((ext_vector_type(8)));
typedef __bf16 bf16x2_t __attribute__((ext_vector_type(2)));
__device__ __forceinline__ unsigned cvtpk(float lo, float hi) { f32x2 v = {lo, hi}; bf16x2_t b = __builtin_convertvector(v, bf16x2_t); return __builtin_bit_cast(unsigned, b); }
constexpr int PQ = 0, PK = 17408, PVB = 34816, PKB = 53248, PAS = 71680, PTS = 88320, PMS = 104960, PTB = 121600, PGC = 130816;
__device__ __forceinline__ void dn_prep_item(const Args& a, LAS unsigned char* L8, int ch, int tid, int lane, int wave) {
    unsigned char* ws = a.ws;
    const bf16* PROJ = (const bf16*)(ws + WS_ACT);
    const float* BD = (const float*)(ws + WS_BD);
    const float* conv_w = a.in[7]; const float* a_log = a.in[8]; const float* dt_bias = a.in[9];
    const int bh = ch >> 6, n = ch & 63, b = bh >> 2, h = bh & 3;
    const int tok0 = b * SEQ + n * 64;
    LAS float* As = (LAS float*)(L8 + PAS); LAS float* Ts = (LAS float*)(L8 + PTS); LAS float* Ms = (LAS float*)(L8 + PMS);
    LAS float* gcs = (LAS float*)(L8 + PGC); LAS float* bts = gcs + 64;
    const int jl = lane & 15, kq = lane >> 4;
    unsigned raw[11][3];
#pragma unroll
    for (int i = 0; i < 11; ++i) { const int s = n * 64 + wave * 8 - 3 + i;
#pragma unroll
        for (int sec = 0; sec < 3; ++sec) raw[i][sec] = (s >= 0) ? *(const unsigned*)(PROJ + (size_t)(tok0 + wave * 8 - 3 + i) * P2LD + sec * 512 + h * 128 + 2 * lane) : 0u; }
    if (wave == 0) {
        const int tok = tok0 + lane;
        const float braw = BD[(size_t)tok * 8 + h], draw = BD[(size_t)tok * 8 + 4 + h] + dt_bias[h];
        const float sp = fmaxf(draw, 0.f) + log1pf(__expf(-fabsf(draw)));
        float g = -expf(a_log[h]) * sp;
#pragma unroll
        for (int o = 1; o < 64; o <<= 1) { const float t = __shfl_up(g, o); if (lane >= o) g += t; }
        gcs[lane] = g; bts[lane] = 1.0f / (1.0f + __expf(-braw));
        if (lane == 63) ((float*)(ws + WS_EG))[ch] = expf(g);
    }
    for (int i = tid; i < 64 * 65; i += 512) Ts[i] = 0.f;
    __syncthreads();
    {
        float cw[3][4][2];
#pragma unroll
        for (int sec = 0; sec < 3; ++sec)
#pragma unroll
            for (int j = 0; j < 4; ++j) { const f32x2 w = *(const f32x2*)(conv_w + j * 1536 + sec * 512 + h * 128 + 2 * lane); cw[sec][j][0] = w.x; cw[sec][j][1] = w.y; }
        const float glast = gcs[63];
        bf16* QG = (bf16*)(ws + WS_QG) + (size_t)ch * 8192; bf16* KD = (bf16*)(ws + WS_KD) + (size_t)ch * 8192;
#pragma unroll
        for (int rr = 0; rr < 8; ++rr) {
            const int r = wave * 8 + rr;
            float val[3][2];
#pragma unroll
            for (int sec = 0; sec < 3; ++sec) { float v0 = 0.f, v1 = 0.f;
#pragma unroll
                for (int j = 0; j < 4; ++j) { v0 += bflo(raw[rr + j][sec]) * cw[sec][j][0]; v1 += bfhi(raw[rr + j][sec]) * cw[sec][j][1]; }
                val[sec][0] = v0 / (1.f + __expf(-v0)); val[sec][1] = v1 / (1.f + __expf(-v1)); }
            const float ssq = wave_sum(val[0][0] * val[0][0] + val[0][1] * val[0][1]);
            const float ssk = wave_sum(val[1][0] * val[1][0] + val[1][1] * val[1][1]);
            const float rq = (1.0f / sqrtf(ssq + 1e-6f)) * 0.08838834764831845f, rk = 1.0f / sqrtf(ssk + 1e-6f);
            const float q0 = val[0][0] * rq, q1 = val[0][1] * rq, k0 = val[1][0] * rk, k1 = val[1][1] * rk;
            const float gr = gcs[r], be = bts[r], eq = __expf(gr), ek = __expf(glast - gr), bek = be * eq;
            *(LAS unsigned*)(L8 + PQ + r * 272 + 4 * lane) = cvtpk(q0, q1);
            *(LAS unsigned*)(L8 + PK + r * 272 + 4 * lane) = cvtpk(k0, k1);
            const unsigned vb = cvtpk(val[2][0] * be, val[2][1] * be), kb = cvtpk(k0 * bek, k1 * bek);
            *(LAS bf16*)(L8 + PVB + (2 * lane) * 144 + 2 * r) = (bf16)(vb & 0xffffu); *(LAS bf16*)(L8 + PVB + (2 * lane + 1) * 144 + 2 * r) = (bf16)(vb >> 16);
            *(LAS bf16*)(L8 + PKB + (2 * lane) * 144 + 2 * r) = (bf16)(kb & 0xffffu); *(LAS bf16*)(L8 + PKB + (2 * lane + 1) * 144 + 2 * r) = (bf16)(kb >> 16);
            const int d = 2 * lane;
            *(unsigned*)(QG + r * 128 + (d & 96) + kperm(d & 31)) = cvtpk(q0 * eq, q1 * eq);
            const int tp = (r & 32) + kperm(r & 31); const unsigned kd = cvtpk(k0 * ek, k1 * ek);
            KD[d * 64 + tp] = (bf16)(kd & 0xffffu); KD[(d + 1) * 64 + tp] = (bf16)(kd >> 16);
        }
    }
    __syncthreads();
    {
        bf16* Aout = (bf16*)(ws + WS_A) + (size_t)ch * 4096;
#pragma unroll
        for (int t2 = 0; t2 < 2; ++t2) {
            const int idx = 2 * wave + t2, ct = idx >> 2, jt = idx & 3;
            f32x4 acc1 = {0.f, 0.f, 0.f, 0.f}, acc2 = {0.f, 0.f, 0.f, 0.f};
#pragma unroll
            for (int ks = 0; ks < 4; ++ks) {
                const bf16x8 kc = *(const LAS bf16x8*)(L8 + PK + (16 * ct + jl) * 272 + (32 * ks + 8 * kq) * 2);
                const bf16x8 kj = *(const LAS bf16x8*)(L8 + PK + (16 * jt + jl) * 272 + (32 * ks + 8 * kq) * 2);
                const bf16x8 qc = *(const LAS bf16x8*)(L8 + PQ + (16 * ct + jl) * 272 + (32 * ks + 8 * kq) * 2);
                acc1 = __builtin_amdgcn_mfma_f32_16x16x32_bf16(kc, kj, acc1, 0, 0, 0);
                acc2 = __builtin_amdgcn_mfma_f32_16x16x32_bf16(kj, qc, acc2, 0, 0, 0);
            }
            { const int j = 16 * jt + jl; const float gj = gcs[j];
#pragma unroll
              for (int e = 0; e < 4; ++e) { const int c = 16 * ct + 4 * kq + e; As[c * 65 + j] = (j < c) ? bts[c] * acc1[e] * __expf(gcs[c] - gj) : 0.f; } }
            { const int c = 16 * ct + jl; const float gc_ = gcs[c]; float pv[4];
#pragma unroll
              for (int e = 0; e < 4; ++e) { const int j = 16 * jt + 4 * kq + e; pv[e] = (j <= c) ? acc2[e] * __expf(gc_ - gcs[j]) : 0.f; }
              v2u w; w.x = cvtpk(pv[0], pv[1]); w.y = cvtpk(pv[2], pv[3]);
              *(v2u*)(Aout + c * 64 + 32 * (jt >> 1) + 8 * kq + 4 * (jt & 1)) = w; }
        }
    }
    __syncthreads();
    if (wave == 0) {
        const int bb = lane >> 4, col = lane & 15;
        float xv[16];
#pragma unroll
        for (int c = 0; c < 16; ++c) { float s = (c == col) ? 1.f : 0.f;
#pragma unroll
            for (int j = 0; j < c; ++j) s -= As[(16 * bb + c) * 65 + 16 * bb + j] * xv[j];
            xv[c] = s; }
#pragma unroll
        for (int c = 0; c < 16; ++c) Ts[(16 * bb + c) * 65 + 16 * bb + col] = xv[c];
    }
    __syncthreads();
    {
        const int pr = tid >> 8, i = (tid >> 4) & 15, jj = tid & 15, hb = 32 * pr + 16, lb = 32 * pr;
        float s = 0.f;
#pragma unroll
        for (int k = 0; k < 16; ++k) s += As[(hb + i) * 65 + lb + k] * Ts[(lb + k) * 65 + lb + jj];
        Ms[(hb + i) * 65 + lb + jj] = s;
        __syncthreads();
        float t = 0.f;
#pragma unroll
        for (int k = 0; k < 16; ++k) t += Ts[(hb + i) * 65 + hb + k] * Ms[(hb + k) * 65 + lb + jj];
        Ts[(hb + i) * 65 + lb + jj] = -t;
    }
    __syncthreads();
    {
        const int i = tid >> 4, j0 = (tid & 15) * 2;
        float s0 = 0.f, s1 = 0.f;
#pragma unroll 8
        for (int k = 0; k < 32; ++k) { const float av = As[(32 + i) * 65 + k]; s0 += av * Ts[k * 65 + j0]; s1 += av * Ts[k * 65 + j0 + 1]; }
        Ms[(32 + i) * 65 + j0] = s0; Ms[(32 + i) * 65 + j0 + 1] = s1;
        __syncthreads();
        float t0 = 0.f, t1 = 0.f;
#pragma unroll 8
        for (int k = 0; k < 32; ++k) { const float tv = Ts[(32 + i) * 65 + 32 + k]; t0 += tv * Ms[(32 + k) * 65 + j0]; t1 += tv * Ms[(32 + k) * 65 + j0 + 1]; }
        __syncthreads();
        Ts[(32 + i) * 65 + j0] = -t0; Ts[(32 + i) * 65 + j0 + 1] = -t1;
    }
    __syncthreads();
#pragma unroll
    for (int i = 0; i < 4; ++i) { const int idx2 = tid + 512 * i, r = idx2 >> 5, c = (idx2 & 31) * 2;
        *(LAS unsigned*)(L8 + PTB + r * 144 + 2 * c) = cvtpk(Ts[r * 65 + c], Ts[r * 65 + c + 1]); }
    __syncthreads();
    {
        bf16* U = (bf16*)(ws + WS_U) + (size_t)ch * 8192; bf16* W = (bf16*)(ws + WS_W) + (size_t)ch * 8192;
        const int mt = wave & 3, ntb = 4 * (wave >> 2);
        bf16x8 ta[2];
#pragma unroll
        for (int ks = 0; ks < 2; ++ks) ta[ks] = *(const LAS bf16x8*)(L8 + PTB + (16 * mt + jl) * 144 + (32 * ks + 8 * kq) * 2);
#pragma unroll
        for (int q = 0; q < 4; ++q) { const int nt = ntb + q; f32x4 acc = {0.f, 0.f, 0.f, 0.f};
#pragma unroll
            for (int ks = 0; ks < 2; ++ks) { const bf16x8 vb = *(const LAS bf16x8*)(L8 + PVB + (16 * nt + jl) * 144 + (32 * ks + 8 * kq) * 2);
                acc = __builtin_amdgcn_mfma_f32_16x16x32_bf16(ta[ks], vb, acc, 0, 0, 0); }
            v2u w; w.x = cvtpk(acc[0], acc[1]); w.y = cvtpk(acc[2], acc[3]);
            *(v2u*)(U + (16 * nt + jl) * 64 + 16 * mt + 4 * kq) = w; }
        bf16x8 ka[2];
#pragma unroll
        for (int ks = 0; ks < 2; ++ks) ka[ks] = *(const LAS bf16x8*)(L8 + PKB + (16 * wave + jl) * 144 + (32 * ks + 8 * kq) * 2);
#pragma unroll
        for (int ctile = 0; ctile < 4; ++ctile) { f32x4 acc = {0.f, 0.f, 0.f, 0.f};
#pragma unroll
            for (int ks = 0; ks < 2; ++ks) { const bf16x8 tb = *(const LAS bf16x8*)(L8 + PTB + (16 * ctile + jl) * 144 + (32 * ks + 8 * kq) * 2);
                acc = __builtin_amdgcn_mfma_f32_16x16x32_bf16(ka[ks], tb, acc, 0, 0, 0); }
            v2u w; w.x = cvtpk(-acc[0], -acc[1]); w.y = cvtpk(-acc[2], -acc[3]);
            *(v2u*)(W + (16 * ctile + jl) * 128 + 32 * (wave >> 1) + 8 * kq + 4 * (wave & 1)) = w; }
    }
    __syncthreads();
}

__device__ __forceinline__ bf16x8 pack8(const f32x4& a, const f32x4& b) { v4u w; w.x = cvtpk(a[0], a[1]); w.y = cvtpk(a[2], a[3]); w.z = cvtpk(b[0], b[1]); w.w = cvtpk(b[2], b[3]); return __builtin_bit_cast(bf16x8, w); }
constexpr int SC_W = 0, SC_QG = 17408, SC_KDT = 34816, SC_A = 53248, SC_U = 62464, SC_BUF = 67072;
constexpr int SC_OUT = 2 * SC_BUF;
struct ScanRegs { v4u st[15]; };
__device__ __forceinline__ void sc_load(ScanRegs& R, const unsigned char* ws, int chx, int t, int qtr) {
    const unsigned vo = (unsigned)t * 16u;
    const unsigned char* pw = ws + WS_W + (size_t)chx * 16384; const unsigned char* pq = ws + WS_QG + (size_t)chx * 16384; const unsigned char* pk = ws + WS_KD + (size_t)chx * 16384;
    const unsigned char* pa = ws + WS_A + (size_t)chx * 8192; const unsigned char* pu = ws + WS_U + (size_t)chx * 16384 + qtr * 4096;
#define SC_LDG(k, p) do { R.st[k] = *(const v4u*)(p); __builtin_amdgcn_sched_barrier(0); } while (0)
    __builtin_amdgcn_sched_barrier(0);
    SC_LDG(0, pw + vo); SC_LDG(1, pw + 4096 + vo); SC_LDG(2, pw + 8192 + vo); SC_LDG(3, pw + 12288 + vo);
    SC_LDG(4, pq + vo); SC_LDG(5, pq + 4096 + vo); SC_LDG(6, pq + 8192 + vo); SC_LDG(7, pq + 12288 + vo);
    SC_LDG(8, pk + vo); SC_LDG(9, pk + 4096 + vo); SC_LDG(10, pk + 8192 + vo); SC_LDG(11, pk + 12288 + vo);
    SC_LDG(12, pa + vo); SC_LDG(13, pa + 4096 + vo); SC_LDG(14, pu + vo);
#undef SC_LDG
}
__device__ __forceinline__ void sc_write(const ScanRegs& R, LAS unsigned char* B_, int t) {
    LAS unsigned char* w16 = B_ + (t >> 4) * 272 + (t & 15) * 16;
    LAS unsigned char* k8 = B_ + (t >> 3) * 144 + (t & 7) * 16;
#define SC_STL(k, p) do { *(LAS v4u*)(p) = R.st[k]; __builtin_amdgcn_sched_barrier(0); } while (0)
    __builtin_amdgcn_sched_barrier(0);
    SC_STL(0, w16 + SC_W); SC_STL(1, w16 + SC_W + 16 * 272); SC_STL(2, w16 + SC_W + 32 * 272); SC_STL(3, w16 + SC_W + 48 * 272);
    SC_STL(4, w16 + SC_QG); SC_STL(5, w16 + SC_QG + 16 * 272); SC_STL(6, w16 + SC_QG + 32 * 272); SC_STL(7, w16 + SC_QG + 48 * 272);
    SC_STL(8, k8 + SC_KDT); SC_STL(9, k8 + SC_KDT + 32 * 144); SC_STL(10, k8 + SC_KDT + 64 * 144); SC_STL(11, k8 + SC_KDT + 96 * 144);
    SC_STL(12, k8 + SC_A); SC_STL(13, k8 + SC_A + 32 * 144); SC_STL(14, k8 + SC_U);
#undef SC_STL
}
#define SC_BARRIER() do { asm volatile("s_waitcnt lgkmcnt(0)" ::: "memory"); __builtin_amdgcn_s_barrier(); asm volatile("" ::: "memory"); } while (0)
__device__ __forceinline__ void sc_step_compute(LAS unsigned char* L8, int n, int jl, int kq, int wcol, float egv, f32x4 (&Sacc)[8]) {
    const float eg = __builtin_bit_cast(float, __builtin_amdgcn_readlane(__builtin_bit_cast(int, egv), n));
    const LAS unsigned char* B = L8 + (n & 1) * SC_BUF;
    bf16x8 sb[4];
#pragma unroll
    for (int ks = 0; ks < 4; ++ks) sb[ks] = pack8(Sacc[2 * ks], Sacc[2 * ks + 1]);
    f32x4 vn[4], oa[4];
#pragma unroll
    for (int mt = 0; mt < 4; ++mt) { const v2u u = *(const LAS v2u*)(B + SC_U + (wcol + jl) * 144 + (16 * mt + 4 * kq) * 2);
        vn[mt] = (f32x4){bflo(u.x), bfhi(u.x), bflo(u.y), bfhi(u.y)}; oa[mt] = (f32x4){0.f, 0.f, 0.f, 0.f}; }
    const LAS unsigned char* pW = B + SC_W + jl * 272 + kq * 16; const LAS unsigned char* pQ = B + SC_QG + jl * 272 + kq * 16;
    const LAS unsigned char* pK = B + SC_KDT + jl * 144 + kq * 16; const LAS unsigned char* pA = B + SC_A + jl * 144 + kq * 16;
#define SC_LD_WQ(dst, mt) do { _Pragma("unroll") for (int ks = 0; ks < 4; ++ks) { dst[ks] = *(const LAS bf16x8*)(pW + (mt) * 16 * 272 + ks * 64); dst[4 + ks] = *(const LAS bf16x8*)(pQ + (mt) * 16 * 272 + ks * 64); } } while (0)
#define SC_LD_K(dst, t0) do { _Pragma("unroll") for (int t = 0; t < 4; ++t) _Pragma("unroll") for (int k2 = 0; k2 < 2; ++k2) dst[2 * t + k2] = *(const LAS bf16x8*)(pK + ((t0) + t) * 16 * 144 + k2 * 64); } while (0)
#define SC_LD_A(dst) do { _Pragma("unroll") for (int mt = 0; mt < 4; ++mt) _Pragma("unroll") for (int k2 = 0; k2 < 2; ++k2) dst[2 * mt + k2] = *(const LAS bf16x8*)(pA + mt * 16 * 144 + k2 * 64); } while (0)
#define SC_MM_WQ(src, mt) do { _Pragma("unroll") for (int ks = 0; ks < 4; ++ks) { vn[mt] = __builtin_amdgcn_mfma_f32_16x16x32_bf16(src[ks], sb[ks], vn[mt], 0, 0, 0); oa[mt] = __builtin_amdgcn_mfma_f32_16x16x32_bf16(src[4 + ks], sb[ks], oa[mt], 0, 0, 0); } } while (0)
#define SC_MM_K(src, t0) do { _Pragma("unroll") for (int k2 = 0; k2 < 2; ++k2) _Pragma("unroll") for (int t = 0; t < 4; ++t) Sacc[(t0) + t] = __builtin_amdgcn_mfma_f32_16x16x32_bf16(src[2 * t + k2], vb[k2], Sacc[(t0) + t], 0, 0, 0); } while (0)
#define SC_MM_A(src) do { _Pragma("unroll") for (int k2 = 0; k2 < 2; ++k2) _Pragma("unroll") for (int mt = 0; mt < 4; ++mt) oa[mt] = __builtin_amdgcn_mfma_f32_16x16x32_bf16(src[2 * mt + k2], vb[k2], oa[mt], 0, 0, 0); } while (0)
#define SC_SB() __builtin_amdgcn_sched_barrier(0)
    bf16x8 fa[8], fb[8];
    SC_LD_WQ(fa, 0); SC_LD_WQ(fb, 1); SC_SB();
    SC_MM_WQ(fa, 0); SC_SB(); SC_LD_WQ(fa, 2); SC_SB();
    SC_MM_WQ(fb, 1); SC_SB(); SC_LD_WQ(fb, 3); SC_SB();
    SC_MM_WQ(fa, 2); SC_SB(); SC_LD_K(fa, 0); SC_SB();
    SC_MM_WQ(fb, 3); SC_SB(); SC_LD_K(fb, 4); SC_SB();
    bf16x8 vb[2];
    vb[0] = pack8(vn[0], vn[1]); vb[1] = pack8(vn[2], vn[3]);
#pragma unroll
    for (int T = 0; T < 8; ++T) Sacc[T] = Sacc[T] * eg;
    SC_SB();
    SC_MM_K(fa, 0); SC_SB(); SC_LD_A(fa); SC_SB();
    SC_MM_K(fb, 4); SC_SB();
    SC_MM_A(fa);
#undef SC_LD_WQ
#undef SC_LD_K
#undef SC_LD_A
#undef SC_MM_WQ
#undef SC_MM_K
#undef SC_MM_A
#undef SC_SB
    LAS unsigned char* ob = L8 + SC_OUT + (n & 1) * 4096 + (4 * kq) * 64 + (wcol + jl) * 2;
#pragma unroll
    for (int mt = 0; mt < 4; ++mt)
#pragma unroll
        for (int e = 0; e < 4; ++e) *(LAS bf16*)(ob + (16 * mt + e) * 64) = (bf16)f2bf(oa[mt][e]);
    SC_BARRIER();
}
__device__ __forceinline__ void sc_out_tile(LAS unsigned char* L8, bf16* MIX, int b, int h, int qtr, int n, int l_) {
    const LAS unsigned char* ob = L8 + SC_OUT + (n & 1) * 4096 + l_ * 64;
    const v4u w0 = *(const LAS v4u*)ob, w1 = *(const LAS v4u*)(ob + 16), w2 = *(const LAS v4u*)(ob + 32), w3 = *(const LAS v4u*)(ob + 48);
    bf16* gp = MIX + (size_t)(b * SEQ + n * 64 + l_) * 1024 + 512 + h * 128 + qtr * 32;
    *(v4u*)gp = w0; *(v4u*)(gp + 8) = w1; *(v4u*)(gp + 16) = w2; *(v4u*)(gp + 24) = w3;
}
__device__ __forceinline__ void dn_scan_mfma(const Args& a, LAS unsigned char* L8, int item, int tid, int lane, int wave) {
    unsigned char* ws = a.ws;
    const int xcd_ = item & 7, slot_ = item >> 3;
    const int bh = xcd_ * 2 + (slot_ >> 2), qtr = slot_ & 3, b = bh >> 2, h = bh & 3;
    if (wave < 2) {
        const int jl = lane & 15, kq = lane >> 4;
        f32x4 Sacc[8];
#pragma unroll
        for (int T = 0; T < 8; ++T) Sacc[T] = (f32x4){0.f, 0.f, 0.f, 0.f};
        const float egv = ((const float*)(ws + WS_EG))[bh * 64 + lane];
        asm volatile("s_waitcnt vmcnt(0)" ::: "memory");
        SC_BARRIER();
        for (int n = 0; n < 64; ++n) sc_step_compute(L8, n, jl, kq, wave * 16, egv, Sacc);
    } else if (wave < 6) {
        ScanRegs R0, R1, R2; const int t = tid - 128, c0 = bh * 64;
        sc_load(R0, ws, c0, t, qtr); sc_write(R0, L8, t);
        sc_load(R1, ws, c0 + 1, t, qtr); sc_load(R2, ws, c0 + 2, t, qtr); sc_load(R0, ws, c0 + 3, t, qtr);
        SC_BARRIER();
        for (int n = 0; n < 63; n += 3) {
            sc_write(R1, L8 + ((n + 1) & 1) * SC_BUF, t);
            sc_load(R1, ws, c0 + (n + 4 < 63 ? n + 4 : 63), t, qtr);
            SC_BARRIER();
            sc_write(R2, L8 + ((n + 2) & 1) * SC_BUF, t);
            sc_load(R2, ws, c0 + (n + 5 < 63 ? n + 5 : 63), t, qtr);
            SC_BARRIER();
            sc_write(R0, L8 + ((n + 3) & 1) * SC_BUF, t);
            sc_load(R0, ws, c0 + (n + 6 < 63 ? n + 6 : 63), t, qtr);
            SC_BARRIER();
        }
        SC_BARRIER();
    } else if (wave == 6) {
        SC_BARRIER();
        for (int n = 0; n < 64; ++n) SC_BARRIER();
    } else {
        bf16* MIX = (bf16*)(ws + WS_XN);
        SC_BARRIER();
        for (int n = 0; n < 64; ++n) { if (n > 0) sc_out_tile(L8, MIX, b, h, qtr, n - 1, lane); SC_BARRIER(); }
        sc_out_tile(L8, MIX, b, h, qtr, 63, lane);
    }
    __syncthreads();
}

typedef float f32x16 __attribute__((ext_vector_type(16)));
typedef short s16x4 __attribute__((ext_vector_type(4)));
__device__ __forceinline__ s16x4 vtr(const LAS unsigned char* p) { return __builtin_bit_cast(s16x4, __builtin_amdgcn_ds_read_tr16_b64_v4i16((LAS s16x4*)p)); }
constexpr int KVP = 144;
constexpr int KV_BYTES = 384 * KVP;
constexpr size_t WS_ML = 173 * MiB;
constexpr size_t WS_SS = 176 * MiB;
constexpr size_t WS_XNB2 = 184 * MiB;
__device__ __forceinline__ void attn_item(const bf16* Qh, const bf16* KVh, bf16* PROJ, float* ML, LAS unsigned char* L8, int item, int tid, int lane, int wave) {
    asm volatile("" : "+v"(lane));
    const int bh = item / 48, rem = item - bh * 48, p = rem >> 4, sub = rem & 15;
    const int b = bh >> 3, h = bh & 7;
    const int dsh = 2 * p, dil = 1 << dsh, nsh = 4 - dsh;
    const int r = sub >> nsh, qb = sub & ((1 << nsh) - 1);
    const int base = 256 * qb;
    const bf16* KVb = KVh + (size_t)(bh * 4096 + r) * 128;
#pragma unroll
    for (int i = 0; i < 12; ++i) { const int id = tid + 512 * i, row = id >> 4, ch = id & 15, idx = base - 128 + row;
        v4u kv = (v4u){0u, 0u, 0u, 0u};
        if (idx >= 0) kv = *(const v4u*)(KVb + (size_t)(dil * idx) * 128 + ch * 8);
        *(LAS v4u*)(L8 + ((ch & 8) ? KV_BYTES : 0) + row * KVP + (ch & 7) * 16) = kv; }
    const int ql = lane & 31, kh = lane >> 5;
    const int tq = r + dil * (base + 32 * wave + ql);
    const size_t tokq = (size_t)b * SEQ + tq;
    bf16x8 qf[4];
#pragma unroll
    for (int s = 0; s < 4; ++s) qf[s] = *(const bf16x8*)(Qh + ((size_t)bh * 4096 + tq) * 64 + 16 * s + 8 * kh);
    __syncthreads();
    f32x16 sc[5];
    {
        const LAS unsigned char* Kp = L8 + (32 * wave + ql) * KVP + kh * 16;
        bf16x8 kf[2][4];
#pragma unroll
        for (int s = 0; s < 4; ++s) kf[0][s] = *(const LAS bf16x8*)(Kp + s * 32);
#pragma unroll
        for (int kt = 0; kt < 5; ++kt) {
            if (kt + 1 < 5) {
#pragma unroll
                for (int s = 0; s < 4; ++s) kf[(kt + 1) & 1][s] = *(const LAS bf16x8*)(Kp + (kt + 1) * 32 * KVP + s * 32); }
            __builtin_amdgcn_sched_barrier(0);
            f32x16 acc = {};
#pragma unroll
            for (int s = 0; s < 4; ++s) acc = __builtin_amdgcn_mfma_f32_32x32x16_bf16(kf[kt & 1][s], qf[s], acc, 0, 0, 0);
            sc[kt] = acc;
            __builtin_amdgcn_sched_barrier(0);
        }
    }
    const float LOG2E = 1.4426950408889634f;
    const float c1 = 0.125f * LOG2E, c2 = exp2f(-(float)(h + 1)) * (float)dil * LOG2E;
    const float Al = -c2 * (float)(128 + ql - 4 * kh);
    float mx = -INFINITY;
#pragma unroll
    for (int kt = 0; kt < 5; ++kt)
#pragma unroll
        for (int rr = 0; rr < 16; ++rr) { const int kc = (rr & 3) + 8 * (rr >> 2);
            float v = fmaf(sc[kt][rr], c1, fmaf(c2, (float)(32 * kt + kc), Al));
            if (kt == 0) v = (kc + 4 * kh >= ql) ? v : -INFINITY;
            if (kt == 4) v = (kc + 4 * kh <= ql) ? v : -INFINITY;
            sc[kt][rr] = v; }
    if (base == 0) {
#pragma unroll
        for (int kt = 0; kt < 4; ++kt)
#pragma unroll
            for (int rr = 0; rr < 16; ++rr) { const int kidx = -128 + 32 * (wave + kt) + (rr & 3) + 8 * (rr >> 2) + 4 * kh; sc[kt][rr] = (kidx >= 0) ? sc[kt][rr] : -INFINITY; }
    }
#pragma unroll
    for (int kt = 0; kt < 5; ++kt)
#pragma unroll
        for (int rr = 0; rr < 16; ++rr) mx = fmaxf(mx, sc[kt][rr]);
    mx = fmaxf(mx, __shfl_xor(mx, 32));
    float lsum = 0.f;
#pragma unroll
    for (int kt = 0; kt < 5; ++kt)
#pragma unroll
        for (int rr = 0; rr < 16; ++rr) { const float pv = __builtin_amdgcn_exp2f(sc[kt][rr] - mx); sc[kt][rr] = pv; lsum += pv; }
    lsum += __shfl_xor(lsum, 32);
    f32x16 o[2]; o[0] = (f32x16){}; o[1] = (f32x16){};
    {
        const int q4 = (lane & 15) >> 2, pp = lane & 3, blk = (lane >> 4) & 1;
        const LAS unsigned char* Vb = L8 + KV_BYTES + (32 * wave + 4 * kh + q4) * KVP + (16 * blk + 4 * pp) * 2;
        s16x4 vf[3][4];
#define AT_LDV(set, step) do { const LAS unsigned char* vr_ = Vb + (16 * (step)) * KVP; vf[set][0] = vtr(vr_); vf[set][1] = vtr(vr_ + 8 * KVP); vf[set][2] = vtr(vr_ + 64); vf[set][3] = vtr(vr_ + 8 * KVP + 64); } while (0)
        AT_LDV(0, 0); AT_LDV(1, 1);
#pragma unroll
        for (int st = 0; st < 10; ++st) {
            if (st + 2 < 10) AT_LDV((st + 2) % 3, st + 2);
            __builtin_amdgcn_sched_barrier(0);
            const int kt = st >> 1, s2 = st & 1;
            v4u pw; pw.x = cvtpk(sc[kt][8 * s2 + 0], sc[kt][8 * s2 + 1]); pw.y = cvtpk(sc[kt][8 * s2 + 2], sc[kt][8 * s2 + 3]); pw.z = cvtpk(sc[kt][8 * s2 + 4], sc[kt][8 * s2 + 5]); pw.w = cvtpk(sc[kt][8 * s2 + 6], sc[kt][8 * s2 + 7]);
            const bf16x8 pb = __builtin_bit_cast(bf16x8, pw);
            const s16x4 l0 = vf[st % 3][0], h0 = vf[st % 3][1], l1 = vf[st % 3][2], h1 = vf[st % 3][3];
            o[0] = __builtin_amdgcn_mfma_f32_32x32x16_bf16((bf16x8){l0[0], l0[1], l0[2], l0[3], h0[0], h0[1], h0[2], h0[3]}, pb, o[0], 0, 0, 0);
            o[1] = __builtin_amdgcn_mfma_f32_32x32x16_bf16((bf16x8){l1[0], l1[1], l1[2], l1[3], h1[0], h1[1], h1[2], h1[3]}, pb, o[1], 0, 0, 0);
            __builtin_amdgcn_sched_barrier(0);
        }
#undef AT_LDV
    }
    const float inv = 1.0f / lsum;
    bf16* dst = PROJ + tokq * P2LD + p * 512 + h * 64 + 4 * kh;
#pragma unroll
    for (int c = 0; c < 2; ++c)
#pragma unroll
        for (int g = 0; g < 4; ++g) { v2u w; w.x = cvtpk(o[c][4 * g + 0] * inv, o[c][4 * g + 1] * inv); w.y = cvtpk(o[c][4 * g + 2] * inv, o[c][4 * g + 3] * inv);
            *(v2u*)(dst + 32 * c + 8 * g) = w; }
    if (kh == 0) { float* ml = ML + ((tokq * 8 + h) * 3 + p) * 2; *(f32x2*)ml = (f32x2){mx, lsum}; }
    __syncthreads();
}

#define XB_TMO      128
#define XB_XCNT(j)  (256  + 64 * (j))
#define XB_XSUB(j)  (1280 + 64 * (j))
#define XB_XGEN(j)  (2304 + 64 * (j))
#define XB_TOP      3328
#define XB_TOPGEN   3392
#define XCD_BAR_WORDS 3456
#define XB_SPIN_CAP (1u << 18)

__device__ __forceinline__ unsigned xb_ld(unsigned* p)              { return __hip_atomic_load(p, __ATOMIC_RELAXED, __HIP_MEMORY_SCOPE_AGENT); }
__device__ __forceinline__ unsigned xb_add(unsigned* p, unsigned v) { return __hip_atomic_fetch_add(p, v, __ATOMIC_RELAXED, __HIP_MEMORY_SCOPE_AGENT); }
__device__ __forceinline__ unsigned xb_xcc_id() { return (unsigned)__builtin_amdgcn_s_getreg((3 << 11) | 20) & 0xFu; }
#define XB_SPIN(cond, bar) do { unsigned _sp = 0; while (cond) { __builtin_amdgcn_s_sleep(1); \
    if ((++_sp & 255u) == 0u) { if (xb_ld(&(bar)[XB_TMO])) break; if (_sp > XB_SPIN_CAP) { atomicAdd(&(bar)[XB_TMO], 1u); break; } } } } while (0)

struct XcdBarrier {
    unsigned* bar; unsigned x;
    volatile LAS unsigned* st;
};

__device__ __forceinline__ XcdBarrier xcd_barrier_post(unsigned* bar, volatile LAS unsigned* st) {
    XcdBarrier b; b.bar = bar; b.x = xb_xcc_id(); b.st = st;
    if (threadIdx.x == 0) (void)xb_add(&bar[XB_XCNT(b.x)], 1u);
    return b;
}
__device__ __forceinline__ void xcd_barrier_complete(unsigned* bar, unsigned x, unsigned& nloc, unsigned& nx) {
    const unsigned G = gridDim.x * gridDim.y * gridDim.z;
    unsigned sum, cnt, mine, sp = 0u;
    for (;;) {
        sum = 0u; cnt = 0u; mine = 0u;
#pragma unroll
        for (unsigned j = 0; j < 16; ++j) { const unsigned c = xb_ld(&bar[XB_XCNT(j)]); sum += c; cnt += (c > 0u) ? 1u : 0u; mine = (j == x) ? c : mine; }
        if (sum == G) break;
        __builtin_amdgcn_s_sleep(1);
        if ((++sp & 255u) == 0u) { if (xb_ld(&bar[XB_TMO])) break; if (sp > XB_SPIN_CAP) { atomicAdd(&bar[XB_TMO], 1u); break; } }
    }
    nloc = mine > 0u ? mine : 1u; nx = cnt > 0u ? cnt : 1u;
}

__device__ __forceinline__ void xcd_barrier(const XcdBarrier& b) {
    asm volatile("s_waitcnt vmcnt(0)" ::: "memory");
    __syncthreads();
    if (threadIdx.x == 0) {
        unsigned* bar = b.bar;
        __builtin_amdgcn_s_waitcnt(0);
        unsigned nloc = b.st[0], nx = b.st[1];
        if (nloc == 0u) { xcd_barrier_complete(bar, b.x, nloc, nx); b.st[0] = nloc; b.st[1] = nx; }
        const unsigned old = xb_add(&bar[XB_XSUB(b.x)], 1u);
        const unsigned gen = old / nloc;
        if (old + 1u == (gen + 1u) * nloc) {
            __builtin_amdgcn_fence(__ATOMIC_RELEASE, "agent");
            asm volatile("s_waitcnt vmcnt(0)" ::: "memory");
            const unsigned og = xb_add(&bar[XB_TOP], 1u);
            const unsigned tg = og / nx;
            if (og + 1u == (tg + 1u) * nx) xb_add(&bar[XB_TOPGEN], 1u);
            else XB_SPIN(xb_ld(&bar[XB_TOPGEN]) == tg, bar);
            __builtin_amdgcn_fence(__ATOMIC_ACQUIRE, "agent");
            xb_add(&bar[XB_XGEN(b.x)], 1u);
            asm volatile("s_waitcnt vmcnt(0)" ::: "memory");
        } else {
            XB_SPIN(xb_ld(&bar[XB_XGEN(b.x)]) == gen, bar);
            __builtin_amdgcn_fence(__ATOMIC_ACQUIRE, "agent");
            asm volatile("s_waitcnt vmcnt(0)" ::: "memory");
        }
    }
    __syncthreads();
}

__global__ void __launch_bounds__(NWAVES * 64, 2) fwd_megakernel(Args a) {
    extern __shared__ __attribute__((aligned(16))) unsigned char lds[];
    cg::grid_group grid = cg::this_grid();
    LAS unsigned char* L8 = (LAS unsigned char*)lds;
    LAS float* L = (LAS float*)lds;
    const int tid = threadIdx.x, lane = tid & 63, wave = __builtin_amdgcn_readfirstlane(tid >> 6);
    const int G = gridDim.x, gw = blockIdx.x * NWAVES + wave, NGW = G * NWAVES;
    unsigned char* ws = a.ws;
    unsigned* ctl = (unsigned*)(ws + WS_CTL);
    const float* x = a.in[0];
    bf16* XN = (bf16*)(ws + WS_XN); bf16* ACT = (bf16*)(ws + WS_ACT); bf16* PROJ = ACT; bf16* MIX = XN;
    bf16* Wgu1 = (bf16*)(ws + WS_WGU1); bf16* Wd1 = (bf16*)(ws + WS_WD1); bf16* Win = (bf16*)(ws + WS_WIN); bf16* Wout = (bf16*)(ws + WS_WOUT);
    bf16* Wgu2 = (bf16*)(ws + WS_WGU2); bf16* Wd2 = (bf16*)(ws + WS_WD2);
    float* out = a.out;
    volatile LAS unsigned* xbst = (volatile LAS unsigned*)(L8 + LDS_BYTES - 64);
    if (tid < 2) xbst[tid] = 0u;
    __syncthreads();
    XcdBarrier bar = xcd_barrier_post(ctl + 1024, xbst);
#define GSYNC() xcd_barrier(bar)

    {
        const int lane = opq(tid) & 63;
        LAS float* scr = L + wave * 4096;
        constexpr int I_GU = (D / 64) * (NGU / 32), I_D = (FF / 64) * (D / 32), I_IN = (D / 64) * (NIN / 32), I_O = (D / 64) * (D / 32);
        constexpr int NITEMS = 2 * I_GU + 2 * I_D + I_IN + I_O;
        for (int it = gw; it < NITEMS; it += NGW) {
            int r = it;
            if (r < I_GU) { tr_gu(a.in[2], a.in[3], Wgu1, r, scr, lane); continue; } r -= I_GU;
            if (r < I_D) { tr_plain(a.in[4], FF, D, Wd1, r, scr, lane); continue; } r -= I_D;
            if (r < I_IN) { tr_win(a.in[6], Win, r, scr, lane, a.in[5]); continue; } r -= I_IN;
            if (r < I_O) { tr_plain(a.in[11], D, D, Wout, r, scr, lane); continue; } r -= I_O;
            if (r < I_GU) { tr_gu(a.in[13], a.in[14], Wgu2, r, scr, lane, a.in[12]); continue; } r -= I_GU;
            tr_plain(a.in[15], FF, D, Wd2, r, scr, lane);
        }
        for (int m = gw; m < M; m += NGW) { f32x4 v[4]; rms_row(x + (size_t)m * D, a.in[1], lane, v); store_row_bf16(XN + (size_t)m * D, lane, v); }
    }
    grid.sync();
    {
        pg8::Gemm g{XN, Wgu1, M, NGU, D}; pg8::StaticOrder S; S.init(M, NGU, G, (int)blockIdx.x);
        pg8::EpiSwiGLU<false> E{ACT, FF, nullptr};
        pg8::gemm_phase<pg8::EpiSwiGLU<false>, pg8::StaticOrder, true, true>(L8, g, S, E);
    }
    GSYNC();
    {
        pg8::Gemm g{ACT, Wd1, M, D, FF}; pg8::StaticOrder S; S.init(M, D, G, (int)blockIdx.x);
        pg8::EpiRes<true> E{x, out, D, 0.5f, XN, (float*)(ws + WS_SS)};
        pg8::gemm_phase<pg8::EpiRes<true>, pg8::StaticOrder, true, true>(L8, g, S, E);
    }
    GSYNC();
    {
        pg8::Gemm g{XN, Win, M, NIN, D}; pg8::StaticOrder S; S.init(M, NIN, G, (int)blockIdx.x);
        pg8::EpiProj E{(bf16*)(ws + WS_QH), (bf16*)(ws + WS_KVH), PROJ, (float*)(ws + WS_BD), (const float*)(ws + WS_SS)};
        pg8::gemm_phase<pg8::EpiProj, pg8::StaticOrder, true, true>(L8, g, S, E);
    }
    GSYNC();
    { const int tid_ = opq(tid); for (int ch = blockIdx.x; ch < 1024; ch += G) dn_prep_item(a, L8, ch, tid_, tid_ & 63, wave); }
    GSYNC();
    {
        const int tid_ = opq(tid), lane = tid_ & 63;
        for (int it = blockIdx.x; it < 64; it += G) dn_scan_mfma(a, L8, it, tid_, lane, wave);
        float* ML = (float*)(ws + WS_ML);
        if ((int)blockIdx.x >= 64 || G <= 64) {
            const int nb = (G > 64) ? G - 64 : G, j0 = (G > 64) ? (int)blockIdx.x - 64 : (int)blockIdx.x;
            for (int item = j0; item < 1536; item += nb) attn_item((const bf16*)(ws + WS_QH), (const bf16*)(ws + WS_KVH), PROJ, ML, L8, item, tid, lane, wave);
        }
    }
    GSYNC();
    {
        const int lane = opq(tid) & 63;
        const float* dn_norm = a.in[10];
        for (int m = gw; m < M; m += NGW) {
            bf16* op = MIX + (size_t)m * 1024 + 512 + 8 * lane; const bf16* gp = PROJ + (size_t)m * P2LD + 1536 + 8 * lane;
            const v4u ow = *(const v4u*)op, gwv = *(const v4u*)gp;
            float o[8] = {bflo(ow.x), bfhi(ow.x), bflo(ow.y), bfhi(ow.y), bflo(ow.z), bfhi(ow.z), bflo(ow.w), bfhi(ow.w)};
            float gt[8] = {bflo(gwv.x), bfhi(gwv.x), bflo(gwv.y), bfhi(gwv.y), bflo(gwv.z), bfhi(gwv.z), bflo(gwv.w), bfhi(gwv.w)};
            float ss = 0.f;
#pragma unroll
            for (int i = 0; i < 8; ++i) ss += o[i] * o[i];
            ss += __shfl_xor(ss, 1); ss += __shfl_xor(ss, 2); ss += __shfl_xor(ss, 4); ss += __shfl_xor(ss, 8);
            const float rs = 1.0f / sqrtf(ss * (1.f / 128.f) + 1e-6f);
            const int d0 = (8 * lane) & 127;
            float r[8];
#pragma unroll
            for (int i = 0; i < 8; ++i) r[i] = o[i] * rs * dn_norm[d0 + i] * (gt[i] / (1.f + __expf(-gt[i])));
            v4u w; w.x = pk2(r[0], r[1]); w.y = pk2(r[2], r[3]); w.z = pk2(r[4], r[5]); w.w = pk2(r[6], r[7]);
            *(v4u*)op = w;
            {
                const int ha = lane >> 3;
                const float* ml = (const float*)(ws + WS_ML) + ((size_t)m * 8 + ha) * 6;
                const f32x2 a0 = *(const f32x2*)ml, a1 = *(const f32x2*)(ml + 2), a2 = *(const f32x2*)(ml + 4);
                const float mm = fmaxf(a0.x, fmaxf(a1.x, a2.x));
                const float w0 = a0.y * __builtin_amdgcn_exp2f(a0.x - mm), w1 = a1.y * __builtin_amdgcn_exp2f(a1.x - mm), w2 = a2.y * __builtin_amdgcn_exp2f(a2.x - mm);
                const float iw = 1.0f / (w0 + w1 + w2);
                const bf16* pp = PROJ + (size_t)m * P2LD + 8 * lane;
                const v4u p0 = *(const v4u*)pp, p1 = *(const v4u*)(pp + 512), p2 = *(const v4u*)(pp + 1024);
                float rr[8];
                rr[0] = w0 * bflo(p0.x) + w1 * bflo(p1.x) + w2 * bflo(p2.x); rr[1] = w0 * bfhi(p0.x) + w1 * bfhi(p1.x) + w2 * bfhi(p2.x);
                rr[2] = w0 * bflo(p0.y) + w1 * bflo(p1.y) + w2 * bflo(p2.y); rr[3] = w0 * bfhi(p0.y) + w1 * bfhi(p1.y) + w2 * bfhi(p2.y);
                rr[4] = w0 * bflo(p0.z) + w1 * bflo(p1.z) + w2 * bflo(p2.z); rr[5] = w0 * bfhi(p0.z) + w1 * bfhi(p1.z) + w2 * bfhi(p2.z);
                rr[6] = w0 * bflo(p0.w) + w1 * bflo(p1.w) + w2 * bflo(p2.w); rr[7] = w0 * bfhi(p0.w) + w1 * bfhi(p1.w) + w2 * bfhi(p2.w);
                v4u wa; wa.x = pk2(rr[0] * iw, rr[1] * iw); wa.y = pk2(rr[2] * iw, rr[3] * iw); wa.z = pk2(rr[4] * iw, rr[5] * iw); wa.w = pk2(rr[6] * iw, rr[7] * iw);
                *(v4u*)(MIX + (size_t)m * 1024 + 8 * lane) = wa;
            }
        }
    }
    GSYNC();
    {
        pg8::Gemm g{MIX, Wout, M, D, D}; pg8::StaticOrder S; S.init(M, D, G, (int)blockIdx.x);
        pg8::EpiRes<true> E{out, out, D, 1.0f, (bf16*)(ws + WS_XNB2), (float*)(ws + WS_SS)};
        pg8::gemm_phase<pg8::EpiRes<true>, pg8::StaticOrder, true, true>(L8, g, S, E);
    }
    GSYNC();
    {
        pg8::Gemm g{(const bf16*)(ws + WS_XNB2), Wgu2, M, NGU, D}; pg8::StaticOrder S; S.init(M, NGU, G, (int)blockIdx.x);
        pg8::EpiSwiGLU<true> E{ACT, FF, (const float*)(ws + WS_SS)};
        pg8::gemm_phase<pg8::EpiSwiGLU<true>, pg8::StaticOrder, true, true>(L8, g, S, E);
    }
    GSYNC();
    {
        pg8::Gemm g{ACT, Wd2, M, D, FF}; pg8::StaticOrder S; S.init(M, D, G, (int)blockIdx.x);
        pg8::EpiRes<false> E{out, out, D, 0.5f, nullptr, nullptr};
        pg8::gemm_phase<pg8::EpiRes<false>, pg8::StaticOrder, true, true>(L8, g, S, E);
    }
    GSYNC();
    const int lnf = opq(tid) & 63;
    for (int m = gw; m < M; m += NGW) {
        f32x4 v[4]; rms_row(out + (size_t)m * D, a.in[16], lnf, v);
        f32x4* o = (f32x4*)(out + (size_t)m * D) + lnf;
#pragma unroll
        for (int j = 0; j < 4; ++j) o[64 * j] = v[j];
    }
}

extern "C" void kernel_launch(void* const* d_in, const int* in_sizes, int n_in, void* d_out, int out_size, void* d_ws, size_t ws_size, hipStream_t stream) {
    static int grid = 0;
    if (grid == 0) {
        if (n_in != 17 || in_sizes[0] != M * D || out_size != M * D || ws_size < WS_END) { fprintf(stderr, "kernel_launch: unexpected shapes (n_in %d in0 %d out %d ws %zu)\n", n_in, n_in > 0 ? in_sizes[0] : -1, out_size, ws_size); grid = -1; return; }
        int dev = 0, cus = 0, per_cu = 0;
        hipGetDevice(&dev); hipDeviceGetAttribute(&cus, hipDeviceAttributeMultiprocessorCount, dev);
        if (hipFuncSetAttribute((const void*)fwd_megakernel, hipFuncAttributeMaxDynamicSharedMemorySize, LDS_BYTES) != hipSuccess) { fprintf(stderr, "kernel_launch: hipFuncSetAttribute failed\n"); grid = -1; return; }
        if (hipOccupancyMaxActiveBlocksPerMultiprocessor(&per_cu, (const void*)fwd_megakernel, NWAVES * 64, LDS_BYTES) != hipSuccess || per_cu < 1) { fprintf(stderr, "kernel_launch: occupancy query says %d blocks/CU\n", per_cu); (void)hipGetLastError(); per_cu = 1; }
        grid = cus * 1;
        fprintf(stderr, "kernel_launch: cus %d per_cu %d grid %d\n", cus, per_cu, grid);
    }
    if (grid < 0) return;
    hipMemsetAsync((char*)d_ws + WS_CTL, 0, CTL_BYTES, stream);
    Args a{};
    for (int i = 0; i < 17; ++i) a.in[i] = (const float*)d_in[i];
    a.out = (float*)d_out; a.ws = (unsigned char*)d_ws;
    void* args[] = {&a};
    hipError_t e = hipLaunchCooperativeKernel((const void*)fwd_megakernel, dim3(grid), dim3(NWAVES * 64), args, LDS_BYTES, stream);
    if (e != hipSuccess) fprintf(stderr, "cooperative launch failed: %s (grid %d)\n", hipGetErrorString(e), grid);
}
```

```cpp
#include <hip/hip_runtime.h>
#include <hip/hip_cooperative_groups.h>
#include <cstdio>
#include <cstdint>
namespace cg = cooperative_groups;
namespace pg8 {
#define PG8_LAS __attribute__((address_space(3)))
typedef unsigned short bf16_t;
typedef short bf16x8 __attribute__((ext_vector_type(8)));
typedef float f32x4 __attribute__((ext_vector_type(4)));
typedef unsigned u32x4 __attribute__((ext_vector_type(4)));
constexpr int BM = 256, BK = 64, HALF = 128, HTB = HALF * BK * 2  , STAGE_BYTES = 8 * HTB, NXCD = 8, WGM = 8;

__host__ __device__ __forceinline__ int lds_byte(int r, int c) { const int st = (r >> 4) * 2 + (c >> 5), rr = r & 15, cc = c & 31, ob = rr * 64 + cc * 2; return st * 1024 + (ob ^ (((ob >> 9) & 1) << 5)); }
__host__ __device__ __forceinline__ void stage_rc(int b, int& R, int& C) { const int st = b / 1024, sb = b % 1024, swz = sb ^ (((sb >> 9) & 1) << 5); R = (st >> 1) * 16 + swz / 64; C = (st & 1) * 32 + (swz % 64) / 2; }
__host__ __device__ __forceinline__ int perm32(int rho) { const int n = rho >> 4, i = rho & 15; return 8 * (i >> 2) + 4 * n + (i & 3); }

struct Unit { int pm, pn; };
struct Gemm { const bf16_t* A; const bf16_t* Bt; int M, N, K; };

struct StaticOrder {
    int nM, nN, nwg, G, c;
    __host__ __device__ void init(int M, int N, int G_, int c_) { nM = M / BM; nN = N / BM; nwg = nM * nN; G = G_; c = c_; }
    __host__ __device__ bool next(int i, Unit& u) const {
        const long L = (long)i * G + c; if (L >= nwg) return false;
        int wgid = (int)L; { const int q = nwg / NXCD, r = nwg % NXCD, xcd = wgid % NXCD, off = wgid / NXCD; wgid = (xcd < r ? xcd * (q + 1) : r * (q + 1) + (xcd - r) * q) + off; }
        const int nig = WGM * nN, gid = wgid / nig, fm = gid * WGM, gsz = (nM - fm) < WGM ? (nM - fm) : WGM;
        u.pm = fm + ((wgid % nig) % gsz); u.pn = (wgid % nig) / gsz; return true;
    }
    __device__ __forceinline__ void a_ready(const Unit&) const {}
    __device__ __forceinline__ void done(const Unit&) const {}
};

__device__ __forceinline__ unsigned cvt_pk_bf16(float lo, float hi) { unsigned r; asm volatile("v_cvt_pk_bf16_f32 %0, %1, %2" : "=v"(r) : "v"(lo), "v"(hi)); return r; }
__device__ __forceinline__ float silu_f(float g) { return g * __builtin_amdgcn_rcpf(1.0f + __expf(-g)); }
__device__ __forceinline__ float row_rs(const float* SS, int row) {
    const f32x4* sp = (const f32x4*)(SS + (size_t)row * 16); const f32x4 a = sp[0], b = sp[1], c = sp[2], d = sp[3];
    const float s = ((a[0] + a[1]) + (a[2] + a[3])) + ((b[0] + b[1]) + (b[2] + b[3])) + ((c[0] + c[1]) + (c[2] + c[3])) + ((d[0] + d[1]) + (d[2] + d[3]));
    return 1.0f / sqrtf(s * (1.0f / 1024.0f) + 1e-6f);
}
template <bool RS> struct EpiSwiGLU {
    static constexpr bool PERM = true, AFTER_DRAIN = false;
    bf16_t* O; int ldc; const float* SS;
    __device__ __forceinline__ void operator()(const f32x4 (&acc)[2][2][4][2], const Unit& u, int wr, int wc, int fr, int fq) const {
        const int row0 = u.pm * BM + wr * 64 + fr; const int col0 = u.pn * 128 + wc * 32 + 8 * fq;
#pragma unroll
        for (int ai = 0; ai < 2; ++ai)
#pragma unroll
            for (int m = 0; m < 4; ++m) { const int row = row0 + ai * HALF + m * 16; bf16_t* rowp = O + (size_t)row * ldc + col0;
                const float rs = RS ? row_rs(SS, row) : 1.0f;
                const f32x4 g0 = acc[ai][0][m][0] * rs, g1 = acc[ai][0][m][1] * rs, u0 = acc[ai][1][m][0] * rs, u1 = acc[ai][1][m][1] * rs;
                u32x4 w;
                w.x = cvt_pk_bf16(silu_f(g0[0]) * u0[0], silu_f(g0[1]) * u0[1]); w.y = cvt_pk_bf16(silu_f(g0[2]) * u0[2], silu_f(g0[3]) * u0[3]);
                w.z = cvt_pk_bf16(silu_f(g1[0]) * u1[0], silu_f(g1[1]) * u1[1]); w.w = cvt_pk_bf16(silu_f(g1[2]) * u1[2], silu_f(g1[3]) * u1[3]);
                *(u32x4*)rowp = w; }
    }
};
template <bool XB> struct EpiRes {
    static constexpr bool PERM = false, AFTER_DRAIN = false;
    const float* base; float* out; int ldc; float scale; bf16_t* xb; float* SS;
    __device__ __forceinline__ void operator()(const f32x4 (&acc)[2][2][4][2], const Unit& u, int wr, int wc, int fr, int fq) const {
        const int row0 = u.pm * BM + wr * 64 + fr; const int col0 = u.pn * BM + wc * 32 + 4 * fq;
#pragma unroll
        for (int ai = 0; ai < 2; ++ai)
#pragma unroll
            for (int m = 0; m < 4; ++m) { const int row = row0 + ai * HALF + m * 16; const size_t off = (size_t)row * ldc + col0; float ss = 0.f;
#pragma unroll
                for (int bj = 0; bj < 2; ++bj)
#pragma unroll
                    for (int n = 0; n < 2; ++n) { const f32x4 b = *(const f32x4*)(base + off + bj * HALF + n * 16); const f32x4 v = b + acc[ai][bj][m][n] * scale; *(f32x4*)(out + off + bj * HALF + n * 16) = v;
                        if (XB) { ss += (v[0] * v[0] + v[1] * v[1]) + (v[2] * v[2] + v[3] * v[3]);
                            unsigned lo = cvt_pk_bf16(v[0], v[1]), hi = cvt_pk_bf16(v[2], v[3]); unsigned long long pk = ((unsigned long long)hi << 32) | lo;
                            *(unsigned long long*)(xb + off + bj * HALF + n * 16) = pk; } }
                if (XB) { ss += __shfl_xor(ss, 16); ss += __shfl_xor(ss, 32); if (fq == 0) SS[(size_t)row * 16 + u.pn * 4 + wc] = ss; }
                asm volatile("" ::: "memory"); }
    }
};
struct EpiProj {
    static constexpr bool PERM = true, AFTER_DRAIN = false;
    bf16_t* Qh; bf16_t* KVh; bf16_t* P2; float* BD; const float* SS;
    __device__ __forceinline__ void operator()(const f32x4 (&acc)[2][2][4][2], const Unit& u, int wr, int wc, int fr, int fq) const {
        const int row0 = u.pm * BM + wr * 64 + fr;
        if (u.pn == 14) {
            if (wc == 0 && fq == 0) {
#pragma unroll
                for (int ai = 0; ai < 2; ++ai)
#pragma unroll
                    for (int m = 0; m < 4; ++m) { const int row = row0 + ai * HALF + m * 16; const float rs = row_rs(SS, row);
                        *(f32x4*)(BD + (size_t)row * 8) = acc[ai][0][m][0] * rs; *(f32x4*)(BD + (size_t)row * 8 + 4) = acc[ai][0][m][1] * rs; }
            }
            return;
        }
#pragma unroll
        for (int ai = 0; ai < 2; ++ai)
#pragma unroll
            for (int m = 0; m < 4; ++m) { const int row = row0 + ai * HALF + m * 16, bb = row >> 12, t = row & 4095; const float rs = row_rs(SS, row);
#pragma unroll
                for (int bj = 0; bj < 2; ++bj) { const int col = u.pn * BM + bj * HALF + wc * 32 + 8 * fq;
                    bf16_t* dst;
                    if (u.pn < 6) { const int sec = col >> 9, hc = col & 511, hh = hc >> 6, d = hc & 63; const size_t rt = (size_t)(bb * 8 + hh) * 4096 + t;
                        dst = (sec == 0) ? Qh + rt * 64 + d : KVh + rt * 128 + (sec - 1) * 64 + d; }
                    else dst = P2 + (size_t)row * 2048 + (col - 1536);
                    const f32x4 v0 = acc[ai][bj][m][0] * rs, v1 = acc[ai][bj][m][1] * rs; u32x4 w;
                    w.x = cvt_pk_bf16(v0[0], v0[1]); w.y = cvt_pk_bf16(v0[2], v0[3]); w.z = cvt_pk_bf16(v1[0], v1[1]); w.w = cvt_pk_bf16(v1[2], v1[3]);
                    *(u32x4*)dst = w; } }
    }
};
struct EpiStoreBf16 {
    static constexpr bool PERM = true, AFTER_DRAIN = false;
    bf16_t* O; int ldc;
    __device__ __forceinline__ void operator()(const f32x4 (&acc)[2][2][4][2], const Unit& u, int wr, int wc, int fr, int fq) const {
        const int row0 = u.pm * BM + wr * 64 + fr; const int col0 = u.pn * BM + wc * 32 + 8 * fq;
#pragma unroll
        for (int ai = 0; ai < 2; ++ai)
#pragma unroll
            for (int m = 0; m < 4; ++m) { bf16_t* rowp = O + (size_t)(row0 + ai * HALF + m * 16) * ldc + col0;
#pragma unroll
                for (int bj = 0; bj < 2; ++bj) { const f32x4 v0 = acc[ai][bj][m][0], v1 = acc[ai][bj][m][1]; u32x4 w;
                    w.x = cvt_pk_bf16(v0[0], v0[1]); w.y = cvt_pk_bf16(v0[2], v0[3]); w.z = cvt_pk_bf16(v1[0], v1[1]); w.w = cvt_pk_bf16(v1[2], v1[3]);
                    *(u32x4*)(rowp + bj * HALF) = w; } }
    }
};
template <class Epi, class Sched, bool ALIGN_EPI = false, bool SP2 = false>
__device__ __forceinline__ void gemm_phase(PG8_LAS unsigned char* lds, const Gemm g, const Sched& S, const Epi& E) {
    const int tid = threadIdx.x, wid = __builtin_amdgcn_readfirstlane(tid >> 6), lane = tid & 63, wr = wid >> 2, wc = wid & 3, fr = lane & 15, fq = lane >> 4;
    const int K = g.K, nt = K / BK;
    unsigned voffA[2], voffB[2];
#pragma unroll
    for (int i = 0; i < 2; ++i) { int R, C; stage_rc(tid * 16 + i * 8192, R, C); const int Rb = Epi::PERM ? ((R & ~31) + perm32(R & 31)) : R;
        voffA[i] = (unsigned)(R * K + C) * 2u; voffB[i] = (unsigned)(Rb * K + C) * 2u; }
    const size_t kstep = (size_t)(BK * 2);
    const size_t hstep = (size_t)HALF * K * 2;
    const size_t tstep = 2 * hstep;
    const unsigned ldsw = (unsigned)wid * 1024u;
    const int aoff = lds_byte(wr * 64 + fr, fq * 8), boff = lds_byte(wc * 32 + fr, fq * 8);
#define PG8_SA(b, h) (((b) * 2 + (h)) * HTB)
#define PG8_SB(b, h) ((4 + (b) * 2 + (h)) * HTB)
#define PG8_STAGE(bufoff, gbase, voff) do { _Pragma("unroll") for (int _i = 0; _i < 2; ++_i) \
        __builtin_amdgcn_global_load_lds((const unsigned*)((const char*)(gbase) + (voff)[_i]), (PG8_LAS unsigned*)(lds + (bufoff) + ldsw + _i * 8192), 16, 0, 0); } while (0)
#define PG8_LDA(dst, b, h) do { _Pragma("unroll") for (int m = 0; m < 4; ++m) _Pragma("unroll") for (int k = 0; k < 2; ++k) dst[m][k] = *(const PG8_LAS bf16x8*)(lds + PG8_SA(b, h) + aoff + m * 2048 + k * 1024); } while (0)
#define PG8_LDB(dst, b, h) do { _Pragma("unroll") for (int n = 0; n < 2; ++n) _Pragma("unroll") for (int k = 0; k < 2; ++k) dst[n][k] = *(const PG8_LAS bf16x8*)(lds + PG8_SB(b, h) + boff + n * 2048 + k * 1024); } while (0)
#define PG8_MMA(ai, bj, At, Bt) do { __builtin_amdgcn_s_setprio(1); _Pragma("unroll") for (int m = 0; m < 4; ++m) _Pragma("unroll") for (int n = 0; n < 2; ++n) _Pragma("unroll") for (int k = 0; k < 2; ++k) \
        acc[ai][bj][m][n] = __builtin_amdgcn_mfma_f32_16x16x32_bf16(Bt[n][k], At[m][k], acc[ai][bj][m][n], 0, 0, 0); __builtin_amdgcn_s_setprio(0); } while (0)
#define PG8_WAIT_V(n) asm volatile("s_waitcnt vmcnt(" #n ")" ::: "memory")
#define PG8_WAIT_L(n) asm volatile("s_waitcnt lgkmcnt(" #n ")" ::: "memory")
#define PG8_BAR __builtin_amdgcn_s_barrier()
#define PG8_SCHED __builtin_amdgcn_sched_barrier(0)
    Unit cur, nxt; int ui = 0;
    if (!S.next(0, cur)) return;
    f32x4 acc[2][2][4][2];
#pragma unroll
    for (int a = 0; a < 2; ++a)
#pragma unroll
        for (int b = 0; b < 2; ++b)
#pragma unroll
            for (int m = 0; m < 4; ++m)
#pragma unroll
                for (int n = 0; n < 2; ++n) acc[a][b][m][n] = (f32x4){0.f, 0.f, 0.f, 0.f};
    bf16x8 At[4][2], B0[2][2], B1[2][2];
    const char* cA = (const char*)g.A + (size_t)cur.pm * tstep; const char* cB = (const char*)g.Bt + (size_t)cur.pn * tstep;
    S.a_ready(cur);
    if constexpr (SP2) {
        PG8_STAGE(PG8_SB(0, 0), cB, voffB); PG8_STAGE(PG8_SB(0, 1), cB + hstep, voffB); PG8_STAGE(PG8_SA(0, 0), cA, voffA); PG8_STAGE(PG8_SA(0, 1), cA + hstep, voffA);
        if (wr == 1) PG8_BAR;
        PG8_WAIT_V(2); PG8_BAR;
        PG8_STAGE(PG8_SB(1, 0), cB + kstep, voffB); PG8_STAGE(PG8_SA(1, 0), cA + kstep, voffA); PG8_STAGE(PG8_SB(1, 1), cB + hstep + kstep, voffB);
        PG8_WAIT_V(6); PG8_BAR;
    } else {
        PG8_STAGE(PG8_SB(0, 0), cB, voffB); PG8_STAGE(PG8_SA(0, 0), cA, voffA); PG8_STAGE(PG8_SB(0, 1), cB + hstep, voffB); PG8_STAGE(PG8_SA(0, 1), cA + hstep, voffA);
        if (wr == 1) PG8_BAR;
        PG8_WAIT_V(4); PG8_BAR;
        PG8_STAGE(PG8_SB(1, 0), cB + kstep, voffB); PG8_STAGE(PG8_SA(1, 0), cA + kstep, voffA); PG8_STAGE(PG8_SB(1, 1), cB + hstep + kstep, voffB);
        PG8_WAIT_V(6); PG8_BAR;
    }
    for (;;) {
        const bool has_next = S.next(ui + 1, nxt);
        const char* nA = has_next ? (const char*)g.A + (size_t)nxt.pm * tstep : cA; const char* nB = has_next ? (const char*)g.Bt + (size_t)nxt.pn * tstep : cB;
        for (int t = 0; t < nt; t += 2) {
            const bool last = (t == nt - 2);
            const char* a1 = cA + (size_t)(t + 1) * kstep;
            const char* a2 = last ? nA : cA + (size_t)(t + 2) * kstep; const char* b2 = last ? nB : cB + (size_t)(t + 2) * kstep;
            const char* a3 = a2 + kstep; const char* b3 = b2 + kstep;
            if (last && has_next) S.a_ready(nxt);
            if constexpr (SP2) {
            PG8_LDB(B0, 0, 0); PG8_LDB(B1, 0, 1); PG8_SCHED; PG8_LDA(At, 0, 0); PG8_STAGE(PG8_SA(1, 1), a1 + hstep, voffA);
            PG8_WAIT_V(8); PG8_WAIT_L(0); PG8_BAR; PG8_MMA(0, 0, At, B0); PG8_MMA(0, 1, At, B1); PG8_BAR; PG8_SCHED;
            PG8_LDA(At, 0, 1); PG8_STAGE(PG8_SB(0, 0), b2, voffB); PG8_STAGE(PG8_SB(0, 1), b2 + hstep, voffB); PG8_STAGE(PG8_SA(0, 0), a2, voffA);
            PG8_WAIT_V(8); PG8_WAIT_L(0); PG8_BAR; PG8_MMA(1, 0, At, B0); PG8_MMA(1, 1, At, B1); PG8_BAR; PG8_SCHED;
            PG8_LDB(B0, 1, 0); PG8_LDB(B1, 1, 1); PG8_SCHED; PG8_LDA(At, 1, 0); PG8_STAGE(PG8_SA(0, 1), a2 + hstep, voffA);
            PG8_WAIT_V(8); PG8_WAIT_L(0); PG8_BAR; PG8_MMA(0, 0, At, B0); PG8_MMA(0, 1, At, B1); PG8_BAR; PG8_SCHED;
            PG8_LDA(At, 1, 1); PG8_STAGE(PG8_SB(1, 0), b3, voffB); PG8_STAGE(PG8_SB(1, 1), b3 + hstep, voffB); PG8_STAGE(PG8_SA(1, 0), a3, voffA);
            PG8_WAIT_V(8); PG8_WAIT_L(0); PG8_BAR; PG8_MMA(1, 0, At, B0); PG8_MMA(1, 1, At, B1); PG8_BAR; PG8_SCHED;
            } else {
            PG8_LDB(B0, 0, 0); PG8_SCHED; PG8_LDA(At, 0, 0); PG8_STAGE(PG8_SA(1, 1), a1 + hstep, voffA);
            PG8_WAIT_L(8); PG8_BAR; PG8_WAIT_L(0); PG8_MMA(0, 0, At, B0); PG8_BAR; PG8_SCHED;
            PG8_LDB(B1, 0, 1); PG8_STAGE(PG8_SB(0, 0), b2, voffB);
            PG8_BAR; PG8_WAIT_L(0); PG8_MMA(0, 1, At, B1); PG8_BAR;
            PG8_LDA(At, 0, 1); PG8_STAGE(PG8_SA(0, 0), a2, voffA);
            PG8_BAR; PG8_WAIT_L(0); PG8_MMA(1, 0, At, B0); PG8_BAR; PG8_SCHED;
            PG8_STAGE(PG8_SB(0, 1), b2 + hstep, voffB);
            PG8_WAIT_V(6); PG8_BAR; PG8_MMA(1, 1, At, B1); PG8_BAR;
            PG8_LDB(B0, 1, 0); PG8_SCHED; PG8_LDA(At, 1, 0); PG8_STAGE(PG8_SA(0, 1), a2 + hstep, voffA);
            PG8_WAIT_L(8); PG8_BAR; PG8_WAIT_L(0); PG8_MMA(0, 0, At, B0); PG8_BAR; PG8_SCHED;
            PG8_LDB(B1, 1, 1); PG8_STAGE(PG8_SB(1, 0), b3, voffB);
            PG8_BAR; PG8_WAIT_L(0); PG8_MMA(0, 1, At, B1); PG8_BAR;
            PG8_LDA(At, 1, 1); PG8_STAGE(PG8_SA(1, 0), a3, voffA);
            PG8_BAR; PG8_WAIT_L(0); PG8_MMA(1, 0, At, B0); PG8_BAR; PG8_SCHED;
            PG8_STAGE(PG8_SB(1, 1), b3 + hstep, voffB);
            PG8_WAIT_V(6); PG8_BAR; PG8_MMA(1, 1, At, B1); PG8_BAR;
            }
        }
        if constexpr (ALIGN_EPI) { if (wr == 0) PG8_BAR; }
        if constexpr (!Epi::AFTER_DRAIN) { E(acc, cur, wr, wc, fr, fq); S.done(cur); }
        if (!has_next) break;
#pragma unroll
        for (int a = 0; a < 2; ++a)
#pragma unroll
            for (int b = 0; b < 2; ++b)
#pragma unroll
                for (int m = 0; m < 4; ++m)
#pragma unroll
                    for (int n = 0; n < 2; ++n) acc[a][b][m][n] = (f32x4){0.f, 0.f, 0.f, 0.f};
        cur = nxt; cA = nA; cB = nB; ++ui;
        if constexpr (ALIGN_EPI) { if (wr == 1) PG8_BAR; }
    }
    PG8_WAIT_V(0);
    if constexpr (!ALIGN_EPI) { if (wr == 0) PG8_BAR; }
    PG8_BAR;
    if constexpr (Epi::AFTER_DRAIN) { E.fused(acc, cur, wr, wc, fr, fq, lds, wid, lane); S.done(cur); }
#undef PG8_SA
#undef PG8_SB
#undef PG8_STAGE
#undef PG8_LDA
#undef PG8_LDB
#undef PG8_MMA
#undef PG8_WAIT_V
#undef PG8_WAIT_L
#undef PG8_BAR
#undef PG8_SCHED
}
}
constexpr int M = 16384, D = 1024, FF = 2816, NGU = 5632, NIN = 3840, SEQ = 4096;
constexpr int WIN_COLS = 3592;
constexpr size_t MiB = 1u << 20;
constexpr size_t WS_CTL = 0, CTL_BYTES = 65536;
constexpr size_t WS_WIN = MiB / 4, WS_WOUT = 8 * MiB, WS_WGU2 = 10 * MiB, WS_WD2 = 21 * MiB;
constexpr size_t WS_XN = 27 * MiB;
constexpr size_t WS_ACT = 59 * MiB;
constexpr size_t WS_QH = 123 * MiB, WS_KVH = 139 * MiB;
constexpr int P2LD = 2048;
constexpr size_t WS_BD = 171 * MiB;
constexpr size_t WS_EG = 172 * MiB;
constexpr size_t WS_DN = 184 * MiB;
constexpr size_t WS_WGU1 = 184 * MiB, WS_WD1 = 195 * MiB;
constexpr size_t WS_QG = WS_DN, WS_KD = WS_DN + 16 * MiB, WS_U = WS_DN + 32 * MiB, WS_W = WS_DN + 48 * MiB, WS_A = WS_DN + 64 * MiB;
constexpr size_t WS_END = 256 * MiB;
constexpr int LDS_BYTES = 147456;
constexpr int NWAVES = 8;

#define GAS __attribute__((address_space(1)))
#define LAS __attribute__((address_space(3)))
typedef unsigned short bf16;
typedef unsigned v4u __attribute__((ext_vector_type(4)));
typedef unsigned v2u __attribute__((ext_vector_type(2)));
typedef float f32x4 __attribute__((ext_vector_type(4)));
typedef float f32x2 __attribute__((ext_vector_type(2)));
#define LDS_WAIT() asm volatile("s_waitcnt lgkmcnt(0)" ::: "memory")
__device__ __forceinline__ unsigned f2bf(float f) { unsigned u = __builtin_bit_cast(unsigned, f); return (u + 0x7fffu + ((u >> 16) & 1u)) >> 16; }
__device__ __forceinline__ unsigned pk2(float lo, float hi) { return f2bf(lo) | (f2bf(hi) << 16); }
__device__ __forceinline__ float bflo(unsigned u) { return __uint_as_float(u << 16); }
__device__ __forceinline__ float bfhi(unsigned u) { return __uint_as_float(u & 0xffff0000u); }
__device__ __forceinline__ float bf2f(bf16 v) { return __uint_as_float(((unsigned)v) << 16); }
__device__ __forceinline__ float wave_sum(float v) {
#pragma unroll
    for (int o = 1; o < 64; o <<= 1) v += __shfl_xor(v, o);
    return v;
}
__device__ __forceinline__ float wave_max(float v) {
#pragma unroll
    for (int o = 1; o < 64; o <<= 1) v = fmaxf(v, __shfl_xor(v, o));
    return v;
}

__device__ __forceinline__ int opq(int v) { asm volatile("" : "+v"(v)); return v; }
struct Args { const float* in[17]; float* out; unsigned char* ws; };

__device__ __forceinline__ void transpose_item(const float* src, int srcN, int srccol0, bf16* dst, int dstK, int dstrow0, int k0, LAS float* scr, int lane, const float* gain = nullptr, int nvalid = 32) {
    const int c4 = (lane & 7) * 4, r0 = lane >> 3;
    f32x4 v[8];
#pragma unroll
    for (int i = 0; i < 8; ++i) v[i] = (c4 < nvalid) ? *(const f32x4*)(src + (size_t)(k0 + r0 + 8 * i) * srcN + srccol0 + c4) : (f32x4){0.f, 0.f, 0.f, 0.f};
    if (gain) {
#pragma unroll
        for (int i = 0; i < 8; ++i) v[i] = v[i] * gain[k0 + r0 + 8 * i]; }
#pragma unroll
    for (int i = 0; i < 8; ++i) { LAS float* p = scr + (r0 + 8 * i) * 33 + c4; p[0] = v[i][0]; p[1] = v[i][1]; p[2] = v[i][2]; p[3] = v[i][3]; }
    LDS_WAIT(); asm volatile("" ::: "memory");
    const int c = lane & 7;
#pragma unroll
    for (int j = 0; j < 4; ++j) { const int n = (lane >> 3) + 8 * j; const LAS float* s = scr + (8 * c) * 33 + n;
        v4u o; o.x = pk2(s[0 * 33], s[1 * 33]); o.y = pk2(s[2 * 33], s[3 * 33]); o.z = pk2(s[4 * 33], s[5 * 33]); o.w = pk2(s[6 * 33], s[7 * 33]);
        *(v4u*)(dst + (size_t)(dstrow0 + n) * dstK + k0 + 8 * c) = o; }
    LDS_WAIT(); asm volatile("" ::: "memory");
}
__device__ __forceinline__ void tr_gu(const float* gate, const float* up, bf16* dst, int r, LAS float* scr, int lane, const float* gain = nullptr) {
    const int nblk = NGU / 32, kb = r / nblk, nb = r % nblk, dstrow0 = nb * 32, pn = dstrow0 >> 8, within = dstrow0 & 255;
    transpose_item(within < 128 ? gate : up, FF, pn * 128 + (within & 127), dst, D, dstrow0, kb * 64, scr, lane, gain);
}
__device__ __forceinline__ void tr_plain(const float* src, int K, int N, bf16* dst, int r, LAS float* scr, int lane) {
    const int nblk = N / 32, kb = r / nblk, nb = r % nblk;
    transpose_item(src, N, nb * 32, dst, K, nb * 32, kb * 64, scr, lane);
}
__device__ __forceinline__ void tr_win(const float* src, bf16* dst, int r, LAS float* scr, int lane, const float* gain) {
    const int nblk = NIN / 32, kb = r / nblk, nb = r % nblk, dstrow0 = nb * 32;
    const int srccol0 = dstrow0 < 3072 ? dstrow0 : (dstrow0 < 3584 ? dstrow0 + 8 : 3072), nvalid = dstrow0 < 3584 ? 32 : (dstrow0 == 3584 ? 8 : 0);
    transpose_item(src, WIN_COLS, srccol0, dst, D, dstrow0, kb * 64, scr, lane, gain, nvalid);
}

__device__ __forceinline__ void rms_row(const float* xrow, const float* gain, int lane, f32x4 (&v)[4]) {
    const f32x4* xr = (const f32x4*)xrow + lane; const f32x4* gr = (const f32x4*)gain + lane;
    float s = 0.f;
#pragma unroll
    for (int j = 0; j < 4; ++j) { v[j] = xr[64 * j]; s += (v[j].x * v[j].x + v[j].y * v[j].y) + (v[j].z * v[j].z + v[j].w * v[j].w); }
    const float rs = 1.0f / sqrtf(wave_sum(s) * (1.f / D) + 1e-6f);
#pragma unroll
    for (int j = 0; j < 4; ++j) { const f32x4 g = gr[64 * j]; v[j] = v[j] * rs * g; }
}
__device__ __forceinline__ void store_row_bf16(bf16* orow, int lane, const f32x4 (&v)[4]) {
    v2u* o8 = (v2u*)orow + lane;
#pragma unroll
    for (int j = 0; j < 4; ++j) { v2u w; w.x = pk2(v[j].x, v[j].y); w.y = pk2(v[j].z, v[j].w); o8[64 * j] = w; }
}

__device__ __forceinline__ int kperm(int x) { return 8 * ((x & 15) >> 2) + 4 * (x >> 4) + (x & 3); }
typedef short bf16x8 __attribute__((ext_vector_type(8)));
typedef __bf16 bf16x2_t __attribute__((ext_vector_type(2)));
__device__ __forceinline__ unsigned cvtpk(float lo, float hi) { f32x2 v = {lo, hi}; bf16x2_t b = __builtin_convertvector(v, bf16x2_t); return __builtin_bit_cast(unsigned, b); }
constexpr int PQ = 0, PK = 17408, PVB = 34816, PKB = 53248, PAS = 71680, PTS = 88320, PMS = 104960, PTB = 121600, PGC = 130816;
__device__ __forceinline__ void dn_prep_item(const Args& a, LAS unsigned char* L8, int ch, int tid, int lane, int wave) {
    unsigned char* ws = a.ws;
    const bf16* PROJ = (const bf16*)(ws + WS_ACT);
    const float* BD = (const float*)(ws + WS_BD);
    const float* conv_w = a.in[7]; const float* a_log = a.in[8]; const float* dt_bias = a.in[9];
    const int bh = ch >> 6, n = ch & 63, b = bh >> 2, h = bh & 3;
    const int tok0 = b * SEQ + n * 64;
    LAS float* As = (LAS float*)(L8 + PAS); LAS float* Ts = (LAS float*)(L8 + PTS); LAS float* Ms = (LAS float*)(L8 + PMS);
    LAS float* gcs = (LAS float*)(L8 + PGC); LAS float* bts = gcs + 64;
    const int jl = lane & 15, kq = lane >> 4;
    unsigned raw[11][3];
#pragma unroll
    for (int i = 0; i < 11; ++i) { const int s = n * 64 + wave * 8 - 3 + i;
#pragma unroll
        for (int sec = 0; sec < 3; ++sec) raw[i][sec] = (s >= 0) ? *(const unsigned*)(PROJ + (size_t)(tok0 + wave * 8 - 3 + i) * P2LD + sec * 512 + h * 128 + 2 * lane) : 0u; }
    if (wave == 0) {
        const int tok = tok0 + lane;
        const float braw = BD[(size_t)tok * 8 + h], draw = BD[(size_t)tok * 8 + 4 + h] + dt_bias[h];
        const float sp = fmaxf(draw, 0.f) + log1pf(__expf(-fabsf(draw)));
        float g = -expf(a_log[h]) * sp;
#pragma unroll
        for (int o = 1; o < 64; o <<= 1) { const float t = __shfl_up(g, o); if (lane >= o) g += t; }
        gcs[lane] = g; bts[lane] = 1.0f / (1.0f + __expf(-braw));
        if (lane == 63) ((float*)(ws + WS_EG))[ch] = expf(g);
    }
    for (int i = tid; i < 64 * 65; i += 512) Ts[i] = 0.f;
    __syncthreads();
    {
        float cw[3][4][2];
#pragma unroll
        for (int sec = 0; sec < 3; ++sec)
#pragma unroll
            for (int j = 0; j < 4; ++j) { const f32x2 w = *(const f32x2*)(conv_w + j * 1536 + sec * 512 + h * 128 + 2 * lane); cw[sec][j][0] = w.x; cw[sec][j][1] = w.y; }
        const float glast = gcs[63];
        bf16* QG = (bf16*)(ws + WS_QG) + (size_t)ch * 8192; bf16* KD = (bf16*)(ws + WS_KD) + (size_t)ch * 8192;
#pragma unroll
        for (int rr = 0; rr < 8; ++rr) {
            const int r = wave * 8 + rr;
            float val[3][2];
#pragma unroll
            for (int sec = 0; sec < 3; ++sec) { float v0 = 0.f, v1 = 0.f;
#pragma unroll
                for (int j = 0; j < 4; ++j) { v0 += bflo(raw[rr + j][sec]) * cw[sec][j][0]; v1 += bfhi(raw[rr + j][sec]) * cw[sec][j][1]; }
                val[sec][0] = v0 / (1.f + __expf(-v0)); val[sec][1] = v1 / (1.f + __expf(-v1)); }
            const float ssq = wave_sum(val[0][0] * val[0][0] + val[0][1] * val[0][1]);
            const float ssk = wave_sum(val[1][0] * val[1][0] + val[1][1] * val[1][1]);
            const float rq = (1.0f / sqrtf(ssq + 1e-6f)) * 0.08838834764831845f, rk = 1.0f / sqrtf(ssk + 1e-6f);
            const float q0 = val[0][0] * rq, q1 = val[0][1] * rq, k0 = val[1][0] * rk, k1 = val[1][1] * rk;
            const float gr = gcs[r], be = bts[r], eq = __expf(gr), ek = __expf(glast - gr), bek = be * eq;
            *(LAS unsigned*)(L8 + PQ + r * 272 + 4 * lane) = cvtpk(q0, q1);
            *(LAS unsigned*)(L8 + PK + r * 272 + 4 * lane) = cvtpk(k0, k1);
            const unsigned vb = cvtpk(val[2][0] * be, val[2][1] * be), kb = cvtpk(k0 * bek, k1 * bek);
            *(LAS bf16*)(L8 + PVB + (2 * lane) * 144 + 2 * r) = (bf16)(vb & 0xffffu); *(LAS bf16*)(L8 + PVB + (2 * lane + 1) * 144 + 2 * r) = (bf16)(vb >> 16);
            *(LAS bf16*)(L8 + PKB + (2 * lane) * 144 + 2 * r) = (bf16)(kb & 0xffffu); *(LAS bf16*)(L8 + PKB + (2 * lane + 1) * 144 + 2 * r) = (bf16)(kb >> 16);
            const int d = 2 * lane;
            *(unsigned*)(QG + r * 128 + (d & 96) + kperm(d & 31)) = cvtpk(q0 * eq, q1 * eq);
            const int tp = (r & 32) + kperm(r & 31); const unsigned kd = cvtpk(k0 * ek, k1 * ek);
            KD[d * 64 + tp] = (bf16)(kd & 0xffffu); KD[(d + 1) * 64 + tp] = (bf16)(kd >> 16);
        }
    }
    __syncthreads();
    {
        bf16* Aout = (bf16*)(ws + WS_A) + (size_t)ch * 4096;
#pragma unroll
        for (int t2 = 0; t2 < 2; ++t2) {
            const int idx = 2 * wave + t2, ct = idx >> 2, jt = idx & 3;
            f32x4 acc1 = {0.f, 0.f, 0.f, 0.f}, acc2 = {0.f, 0.f, 0.f, 0.f};
#pragma unroll
            for (int ks = 0; ks < 4; ++ks) {
                const bf16x8 kc = *(const LAS bf16x8*)(L8 + PK + (16 * ct + jl) * 272 + (32 * ks + 8 * kq) * 2);
                const bf16x8 kj = *(const LAS bf16x8*)(L8 + PK + (16 * jt + jl) * 272 + (32 * ks + 8 * kq) * 2);
                const bf16x8 qc = *(const LAS bf16x8*)(L8 + PQ + (16 * ct + jl) * 272 + (32 * ks + 8 * kq) * 2);
                acc1 = __builtin_amdgcn_mfma_f32_16x16x32_bf16(kc, kj, acc1, 0, 0, 0);
                acc2 = __builtin_amdgcn_mfma_f32_16x16x32_bf16(kj, qc, acc2, 0, 0, 0);
            }
            { const int j = 16 * jt + jl; const float gj = gcs[j];
#pragma unroll
              for (int e = 0; e < 4; ++e) { const int c = 16 * ct + 4 * kq + e; As[c * 65 + j] = (j < c) ? bts[c] * acc1[e] * __expf(gcs[c] - gj) : 0.f; } }
            { const int c = 16 * ct + jl; const float gc_ = gcs[c]; float pv[4];
#pragma unroll
              for (int e = 0; e < 4; ++e) { const int j = 16 * jt + 4 * kq + e; pv[e] = (j <= c) ? acc2[e] * __expf(gc_ - gcs[j]) : 0.f; }
              v2u w; w.x = cvtpk(pv[0], pv[1]); w.y = cvtpk(pv[2], pv[3]);
              *(v2u*)(Aout + c * 64 + 32 * (jt >> 1) + 8 * kq + 4 * (jt & 1)) = w; }
        }
    }
    __syncthreads();
    if (wave == 0) {
        const int bb = lane >> 4, col = lane & 15;
        float xv[16];
#pragma unroll
        for (int c = 0; c < 16; ++c) { float s = (c == col) ? 1.f : 0.f;
#pragma unroll
            for (int j = 0; j < c; ++j) s -= As[(16 * bb + c) * 65 + 16 * bb + j] * xv[j];
            xv[c] = s; }
#pragma unroll
        for (int c = 0; c < 16; ++c) Ts[(16 * bb + c) * 65 + 16 * bb + col] = xv[c];
    }
    __syncthreads();
    {
        const int pr = tid >> 8, i = (tid >> 4) & 15, jj = tid & 15, hb = 32 * pr + 16, lb = 32 * pr;
        float s = 0.f;
#pragma unroll
        for (int k = 0; k < 16; ++k) s += As[(hb + i) * 65 + lb + k] * Ts[(lb + k) * 65 + lb + jj];
        Ms[(hb + i) * 65 + lb + jj] = s;
        __syncthreads();
        float t = 0.f;
#pragma unroll
        for (int k = 0; k < 16; ++k) t += Ts[(hb + i) * 65 + hb + k] * Ms[(hb + k) * 65 + lb + jj];
        Ts[(hb + i) * 65 + lb + jj] = -t;
    }
    __syncthreads();
    {
        const int i = tid >> 4, j0 = (tid & 15) * 2;
        float s0 = 0.f, s1 = 0.f;
#pragma unroll 8
        for (int k = 0; k < 32; ++k) { const float av = As[(32 + i) * 65 + k]; s0 += av * Ts[k * 65 + j0]; s1 += av * Ts[k * 65 + j0 + 1]; }
        Ms[(32 + i) * 65 + j0] = s0; Ms[(32 + i) * 65 + j0 + 1] = s1;
        __syncthreads();
        float t0 = 0.f, t1 = 0.f;
#pragma unroll 8
        for (int k = 0; k < 32; ++k) { const float tv = Ts[(32 + i) * 65 + 32 + k]; t0 += tv * Ms[(32 + k) * 65 + j0]; t1 += tv * Ms[(32 + k) * 65 + j0 + 1]; }
        __syncthreads();
        Ts[(32 + i) * 65 + j0] = -t0; Ts[(32 + i) * 65 + j0 + 1] = -t1;
    }
    __syncthreads();
#pragma unroll
    for (int i = 0; i < 4; ++i) { const int idx2 = tid + 512 * i, r = idx2 >> 5, c = (idx2 & 31) * 2;
        *(LAS unsigned*)(L8 + PTB + r * 144 + 2 * c) = cvtpk(Ts[r * 65 + c], Ts[r * 65 + c + 1]); }
    __syncthreads();
    {
        bf16* U = (bf16*)(ws + WS_U) + (size_t)ch * 8192; bf16* W = (bf16*)(ws + WS_W) + (size_t)ch * 8192;
        const int mt = wave & 3, ntb = 4 * (wave >> 2);
        bf16x8 ta[2];
#pragma unroll
        for (int ks = 0; ks < 2; ++ks) ta[ks] = *(const LAS bf16x8*)(L8 + PTB + (16 * mt + jl) * 144 + (32 * ks + 8 * kq) * 2);
#pragma unroll
        for (int q = 0; q < 4; ++q) { const int nt = ntb + q; f32x4 acc = {0.f, 0.f, 0.f, 0.f};
#pragma unroll
            for (int ks = 0; ks < 2; ++ks) { const bf16x8 vb = *(const LAS bf16x8*)(L8 + PVB + (16 * nt + jl) * 144 + (32 * ks + 8 * kq) * 2);
                acc = __builtin_amdgcn_mfma_f32_16x16x32_bf16(ta[ks], vb, acc, 0, 0, 0); }
            v2u w; w.x = cvtpk(acc[0], acc[1]); w.y = cvtpk(acc[2], acc[3]);
            *(v2u*)(U + (16 * nt + jl) * 64 + 16 * mt + 4 * kq) = w; }
        bf16x8 ka[2];
#pragma unroll
        for (int ks = 0; ks < 2; ++ks) ka[ks] = *(const LAS bf16x8*)(L8 + PKB + (16 * wave + jl) * 144 + (32 * ks + 8 * kq) * 2);
#pragma unroll
        for (int ctile = 0; ctile < 4; ++ctile) { f32x4 acc = {0.f, 0.f, 0.f, 0.f};
#pragma unroll
            for (int ks = 0; ks < 2; ++ks) { const bf16x8 tb = *(const LAS bf16x8*)(L8 + PTB + (16 * ctile + jl) * 144 + (32 * ks + 8 * kq) * 2);
                acc = __builtin_amdgcn_mfma_f32_16x16x32_bf16(ka[ks], tb, acc, 0, 0, 0); }
            v2u w; w.x = cvtpk(-acc[0], -acc[1]); w.y = cvtpk(-acc[2], -acc[3]);
            *(v2u*)(W + (16 * ctile + jl) * 128 + 32 * (wave >> 1) + 8 * kq + 4 * (wave & 1)) = w; }
    }
    __syncthreads();
}

__device__ __forceinline__ bf16x8 pack8(const f32x4& a, const f32x4& b) { v4u w; w.x = cvtpk(a[0], a[1]); w.y = cvtpk(a[2], a[3]); w.z = cvtpk(b[0], b[1]); w.w = cvtpk(b[2], b[3]); return __builtin_bit_cast(bf16x8, w); }
constexpr int SC_W = 0, SC_QG = 17408, SC_KDT = 34816, SC_A = 53248, SC_U = 62464, SC_BUF = 67072;
constexpr int SC_OUT = 2 * SC_BUF;
struct ScanRegs { v4u st[15]; };
__device__ __forceinline__ void sc_load(ScanRegs& R, const unsigned char* ws, int chx, int t, int qtr) {
    const unsigned vo = (unsigned)t * 16u;
    const unsigned char* pw = ws + WS_W + (size_t)chx * 16384; const unsigned char* pq = ws + WS_QG + (size_t)chx * 16384; const unsigned char* pk = ws + WS_KD + (size_t)chx * 16384;
    const unsigned char* pa = ws + WS_A + (size_t)chx * 8192; const unsigned char* pu = ws + WS_U + (size_t)chx * 16384 + qtr * 4096;
#define SC_LDG(k, p) do { R.st[k] = *(const v4u*)(p); __builtin_amdgcn_sched_barrier(0); } while (0)
    __builtin_amdgcn_sched_barrier(0);
    SC_LDG(0, pw + vo); SC_LDG(1, pw + 4096 + vo); SC_LDG(2, pw + 8192 + vo); SC_LDG(3, pw + 12288 + vo);
    SC_LDG(4, pq + vo); SC_LDG(5, pq + 4096 + vo); SC_LDG(6, pq + 8192 + vo); SC_LDG(7, pq + 12288 + vo);
    SC_LDG(8, pk + vo); SC_LDG(9, pk + 4096 + vo); SC_LDG(10, pk + 8192 + vo); SC_LDG(11, pk + 12288 + vo);
    SC_LDG(12, pa + vo); SC_LDG(13, pa + 4096 + vo); SC_LDG(14, pu + vo);
#undef SC_LDG
}
__device__ __forceinline__ void sc_write(const ScanRegs& R, LAS unsigned char* B_, int t) {
    LAS unsigned char* w16 = B_ + (t >> 4) * 272 + (t & 15) * 16;
    LAS unsigned char* k8 = B_ + (t >> 3) * 144 + (t & 7) * 16;
#define SC_STL(k, p) do { *(LAS v4u*)(p) = R.st[k]; __builtin_amdgcn_sched_barrier(0); } while (0)
    __builtin_amdgcn_sched_barrier(0);
    SC_STL(0, w16 + SC_W); SC_STL(1, w16 + SC_W + 16 * 272); SC_STL(2, w16 + SC_W + 32 * 272); SC_STL(3, w16 + SC_W + 48 * 272);
    SC_STL(4, w16 + SC_QG); SC_STL(5, w16 + SC_QG + 16 * 272); SC_STL(6, w16 + SC_QG + 32 * 272); SC_STL(7, w16 + SC_QG + 48 * 272);
    SC_STL(8, k8 + SC_KDT); SC_STL(9, k8 + SC_KDT + 32 * 144); SC_STL(10, k8 + SC_KDT + 64 * 144); SC_STL(11, k8 + SC_KDT + 96 * 144);
    SC_STL(12, k8 + SC_A); SC_STL(13, k8 + SC_A + 32 * 144); SC_STL(14, k8 + SC_U);
#undef SC_STL
}
#define SC_BARRIER() do { asm volatile("s_waitcnt lgkmcnt(0)" ::: "memory"); __builtin_amdgcn_s_barrier(); asm volatile("" ::: "memory"); } while (0)
__device__ __forceinline__ void sc_step_compute(LAS unsigned char* L8, int n, int jl, int kq, int wcol, float egv, f32x4 (&Sacc)[8]) {
    const float eg = __builtin_bit_cast(float, __builtin_amdgcn_readlane(__builtin_bit_cast(int, egv), n));
    const LAS unsigned char* B = L8 + (n & 1) * SC_BUF;
    bf16x8 sb[4];
#pragma unroll
    for (int ks = 0; ks < 4; ++ks) sb[ks] = pack8(Sacc[2 * ks], Sacc[2 * ks + 1]);
    f32x4 vn[4], oa[4];
#pragma unroll
    for (int mt = 0; mt < 4; ++mt) { const v2u u = *(const LAS v2u*)(B + SC_U + (wcol + jl) * 144 + (16 * mt + 4 * kq) * 2);
        vn[mt] = (f32x4){bflo(u.x), bfhi(u.x), bflo(u.y), bfhi(u.y)}; oa[mt] = (f32x4){0.f, 0.f, 0.f, 0.f}; }
    const LAS unsigned char* pW = B + SC_W + jl * 272 + kq * 16; const LAS unsigned char* pQ = B + SC_QG + jl * 272 + kq * 16;
    const LAS unsigned char* pK = B + SC_KDT + jl * 144 + kq * 16; const LAS unsigned char* pA = B + SC_A + jl * 144 + kq * 16;
#define SC_LD_WQ(dst, mt) do { _Pragma("unroll") for (int ks = 0; ks < 4; ++ks) { dst[ks] = *(const LAS bf16x8*)(pW + (mt) * 16 * 272 + ks * 64); dst[4 + ks] = *(const LAS bf16x8*)(pQ + (mt) * 16 * 272 + ks * 64); } } while (0)
#define SC_LD_K(dst, t0) do { _Pragma("unroll") for (int t = 0; t < 4; ++t) _Pragma("unroll") for (int k2 = 0; k2 < 2; ++k2) dst[2 * t + k2] = *(const LAS bf16x8*)(pK + ((t0) + t) * 16 * 144 + k2 * 64); } while (0)
#define SC_LD_A(dst) do { _Pragma("unroll") for (int mt = 0; mt < 4; ++mt) _Pragma("unroll") for (int k2 = 0; k2 < 2; ++k2) dst[2 * mt + k2] = *(const LAS bf16x8*)(pA + mt * 16 * 144 + k2 * 64); } while (0)
#define SC_MM_WQ(src, mt) do { _Pragma("unroll") for (int ks = 0; ks < 4; ++ks) { vn[mt] = __builtin_amdgcn_mfma_f32_16x16x32_bf16(src[ks], sb[ks], vn[mt], 0, 0, 0); oa[mt] = __builtin_amdgcn_mfma_f32_16x16x32_bf16(src[4 + ks], sb[ks], oa[mt], 0, 0, 0); } } while (0)
#define SC_MM_K(src, t0) do { _Pragma("unroll") for (int k2 = 0; k2 < 2; ++k2) _Pragma("unroll") for (int t = 0; t < 4; ++t) Sacc[(t0) + t] = __builtin_amdgcn_mfma_f32_16x16x32_bf16(src[2 * t + k2], vb[k2], Sacc[(t0) + t], 0, 0, 0); } while (0)
#define SC_MM_A(src) do { _Pragma("unroll") for (int k2 = 0; k2 < 2; ++k2) _Pragma("unroll") for (int mt = 0; mt < 4; ++mt) oa[mt] = __builtin_amdgcn_mfma_f32_16x16x32_bf16(src[2 * mt + k2], vb[k2], oa[mt], 0, 0, 0); } while (0)
#define SC_SB() __builtin_amdgcn_sched_barrier(0)
    bf16x8 fa[8], fb[8];
    SC_LD_WQ(fa, 0); SC_LD_WQ(fb, 1); SC_SB();
    SC_MM_WQ(fa, 0); SC_SB(); SC_LD_WQ(fa, 2); SC_SB();
    SC_MM_WQ(fb, 1); SC_SB(); SC_LD_WQ(fb, 3); SC_SB();
    SC_MM_WQ(fa, 2); SC_SB(); SC_LD_K(fa, 0); SC_SB();
    SC_MM_WQ(fb, 3); SC_SB(); SC_LD_K(fb, 4); SC_SB();
    bf16x8 vb[2];
    vb[0] = pack8(vn[0], vn[1]); vb[1] = pack8(vn[2], vn[3]);
#pragma unroll
    for (int T = 0; T < 8; ++T) Sacc[T] = Sacc[T] * eg;
    SC_SB();
    SC_MM_K(fa, 0); SC_SB(); SC_LD_A(fa); SC_SB();
    SC_MM_K(fb, 4); SC_SB();
    SC_MM_A(fa);
#undef SC_LD_WQ
#undef SC_LD_K
#undef SC_LD_A
#undef SC_MM_WQ
#undef SC_MM_K
#undef SC_MM_A
#undef SC_SB
    LAS unsigned char* ob = L8 + SC_OUT + (n & 1) * 4096 + (4 * kq) * 64 + (wcol + jl) * 2;
#pragma unroll
    for (int mt = 0; mt < 4; ++mt)
#pragma unroll
        for (int e = 0; e < 4; ++e) *(LAS bf16*)(ob + (16 * mt + e) * 64) = (bf16)f2bf(oa[mt][e]);
    SC_BARRIER();
}
__device__ __forceinline__ void sc_out_tile(LAS unsigned char* L8, bf16* MIX, int b, int h, int qtr, int n, int l_) {
    const LAS unsigned char* ob = L8 + SC_OUT + (n & 1) * 4096 + l_ * 64;
    const v4u w0 = *(const LAS v4u*)ob, w1 = *(const LAS v4u*)(ob + 16), w2 = *(const LAS v4u*)(ob + 32), w3 = *(const LAS v4u*)(ob + 48);
    bf16* gp = MIX + (size_t)(b * SEQ + n * 64 + l_) * 1024 + 512 + h * 128 + qtr * 32;
    *(v4u*)gp = w0; *(v4u*)(gp + 8) = w1; *(v4u*)(gp + 16) = w2; *(v4u*)(gp + 24) = w3;
}
__device__ __forceinline__ void dn_scan_mfma(const Args& a, LAS unsigned char* L8, int item, int tid, int lane, int wave) {
    unsigned char* ws = a.ws;
    const int xcd_ = item & 7, slot_ = item >> 3;
    const int bh = xcd_ * 2 + (slot_ >> 2), qtr = slot_ & 3, b = bh >> 2, h = bh & 3;
    if (wave < 2) {
        const int jl = lane & 15, kq = lane >> 4;
        f32x4 Sacc[8];
#pragma unroll
        for (int T = 0; T < 8; ++T) Sacc[T] = (f32x4){0.f, 0.f, 0.f, 0.f};
        const float egv = ((const float*)(ws + WS_EG))[bh * 64 + lane];
        asm volatile("s_waitcnt vmcnt(0)" ::: "memory");
        SC_BARRIER();
        for (int n = 0; n < 64; ++n) sc_step_compute(L8, n, jl, kq, wave * 16, egv, Sacc);
    } else if (wave < 6) {
        ScanRegs R0, R1, R2; const int t = tid - 128, c0 = bh * 64;
        sc_load(R0, ws, c0, t, qtr); sc_write(R0, L8, t);
        sc_load(R1, ws, c0 + 1, t, qtr); sc_load(R2, ws, c0 + 2, t, qtr); sc_load(R0, ws, c0 + 3, t, qtr);
        SC_BARRIER();
        for (int n = 0; n < 63; n += 3) {
            sc_write(R1, L8 + ((n + 1) & 1) * SC_BUF, t);
            sc_load(R1, ws, c0 + (n + 4 < 63 ? n + 4 : 63), t, qtr);
            SC_BARRIER();
            sc_write(R2, L8 + ((n + 2) & 1) * SC_BUF, t);
            sc_load(R2, ws, c0 + (n + 5 < 63 ? n + 5 : 63), t, qtr);
            SC_BARRIER();
            sc_write(R0, L8 + ((n + 3) & 1) * SC_BUF, t);
            sc_load(R0, ws, c0 + (n + 6 < 63 ? n + 6 : 63), t, qtr);
            SC_BARRIER();
        }
        SC_BARRIER();
    } else if (wave == 6) {
        SC_BARRIER();
        for (int n = 0; n < 64; ++n) SC_BARRIER();
    } else {
        bf16* MIX = (bf16*)(ws + WS_XN);
        SC_BARRIER();
        for (int n = 0; n < 64; ++n) { if (n > 0) sc_out_tile(L8, MIX, b, h, qtr, n - 1, lane); SC_BARRIER(); }
        sc_out_tile(L8, MIX, b, h, qtr, 63, lane);
    }
    __syncthreads();
}

typedef float f32x16 __attribute__((ext_vector_type(16)));
typedef short s16x4 __attribute__((ext_vector_type(4)));
__device__ __forceinline__ s16x4 vtr(const LAS unsigned char* p) { return __builtin_bit_cast(s16x4, __builtin_amdgcn_ds_read_tr16_b64_v4i16((LAS s16x4*)p)); }
constexpr int KVP = 144;
constexpr int KV_BYTES = 384 * KVP;
constexpr size_t WS_ML = 173 * MiB;
constexpr size_t WS_SS = 176 * MiB;
constexpr size_t WS_XNB2 = 184 * MiB;
__device__ __forceinline__ void attn_item(const bf16* Qh, const bf16* KVh, bf16* PROJ, float* ML, LAS unsigned char* L8, int item, int tid, int lane, int wave) {
    asm volatile("" : "+v"(lane));
    const int bh = item / 48, rem = item - bh * 48, p = rem >> 4, sub = rem & 15;
    const int b = bh >> 3, h = bh & 7;
    const int dsh = 2 * p, dil = 1 << dsh, nsh = 4 - dsh;
    const int r = sub >> nsh, qb = sub & ((1 << nsh) - 1);
    const int base = 256 * qb;
    const bf16* KVb = KVh + (size_t)(bh * 4096 + r) * 128;
#pragma unroll
    for (int i = 0; i < 12; ++i) { const int id = tid + 512 * i, row = id >> 4, ch = id & 15, idx = base - 128 + row;
        v4u kv = (v4u){0u, 0u, 0u, 0u};
        if (idx >= 0) kv = *(const v4u*)(KVb + (size_t)(dil * idx) * 128 + ch * 8);
        *(LAS v4u*)(L8 + ((ch & 8) ? KV_BYTES : 0) + row * KVP + (ch & 7) * 16) = kv; }
    const int ql = lane & 31, kh = lane >> 5;
    const int tq = r + dil * (base + 32 * wave + ql);
    const size_t tokq = (size_t)b * SEQ + tq;
    bf16x8 qf[4];
#pragma unroll
    for (int s = 0; s < 4; ++s) qf[s] = *(const bf16x8*)(Qh + ((size_t)bh * 4096 + tq) * 64 + 16 * s + 8 * kh);
    __syncthreads();
    f32x16 sc[5];
    {
        const LAS unsigned char* Kp = L8 + (32 * wave + ql) * KVP + kh * 16;
        bf16x8 kf[2][4];
#pragma unroll
        for (int s = 0; s < 4; ++s) kf[0][s] = *(const LAS bf16x8*)(Kp + s * 32);
#pragma unroll
        for (int kt = 0; kt < 5; ++kt) {
            if (kt + 1 < 5) {
#pragma unroll
                for (int s = 0; s < 4; ++s) kf[(kt + 1) & 1][s] = *(const LAS bf16x8*)(Kp + (kt + 1) * 32 * KVP + s * 32); }
            __builtin_amdgcn_sched_barrier(0);
            f32x16 acc = {};
#pragma unroll
            for (int s = 0; s < 4; ++s) acc = __builtin_amdgcn_mfma_f32_32x32x16_bf16(kf[kt & 1][s], qf[s], acc, 0, 0, 0);
            sc[kt] = acc;
            __builtin_amdgcn_sched_barrier(0);
        }
    }
    const float LOG2E = 1.4426950408889634f;
    const float c1 = 0.125f * LOG2E, c2 = exp2f(-(float)(h + 1)) * (float)dil * LOG2E;
    const float Al = -c2 * (float)(128 + ql - 4 * kh);
    float mx = -INFINITY;
#pragma unroll
    for (int kt = 0; kt < 5; ++kt)
#pragma unroll
        for (int rr = 0; rr < 16; ++rr) { const int kc = (rr & 3) + 8 * (rr >> 2);
            float v = fmaf(sc[kt][rr], c1, fmaf(c2, (float)(32 * kt + kc), Al));
            if (kt == 0) v = (kc + 4 * kh >= ql) ? v : -INFINITY;
            if (kt == 4) v = (kc + 4 * kh <= ql) ? v : -INFINITY;
            sc[kt][rr] = v; }
    if (base == 0) {
#pragma unroll
        for (int kt = 0; kt < 4; ++kt)
#pragma unroll
            for (int rr = 0; rr < 16; ++rr) { const int kidx = -128 + 32 * (wave + kt) + (rr & 3) + 8 * (rr >> 2) + 4 * kh; sc[kt][rr] = (kidx >= 0) ? sc[kt][rr] : -INFINITY; }
    }
#pragma unroll
    for (int kt = 0; kt < 5; ++kt)
#pragma unroll
        for (int rr = 0; rr < 16; ++rr) mx = fmaxf(mx, sc[kt][rr]);
    mx = fmaxf(mx, __shfl_xor(mx, 32));
    float lsum = 0.f;
#pragma unroll
    for (int kt = 0; kt < 5; ++kt)
#pragma unroll
        for (int rr = 0; rr < 16; ++rr) { const float pv = __builtin_amdgcn_exp2f(sc[kt][rr] - mx); sc[kt][rr] = pv; lsum += pv; }
    lsum += __shfl_xor(lsum, 32);
    f32x16 o[2]; o[0] = (f32x16){}; o[1] = (f32x16){};
    {
        const int q4 = (lane & 15) >> 2, pp = lane & 3, blk = (lane >> 4) & 1;
        const LAS unsigned char* Vb = L8 + KV_BYTES + (32 * wave + 4 * kh + q4) * KVP + (16 * blk + 4 * pp) * 2;
        s16x4 vf[3][4];
#define AT_LDV(set, step) do { const LAS unsigned char* vr_ = Vb + (16 * (step)) * KVP; vf[set][0] = vtr(vr_); vf[set][1] = vtr(vr_ + 8 * KVP); vf[set][2] = vtr(vr_ + 64); vf[set][3] = vtr(vr_ + 8 * KVP + 64); } while (0)
        AT_LDV(0, 0); AT_LDV(1, 1);
#pragma unroll
        for (int st = 0; st < 10; ++st) {
            if (st + 2 < 10) AT_LDV((st + 2) % 3, st + 2);
            __builtin_amdgcn_sched_barrier(0);
            const int kt = st >> 1, s2 = st & 1;
            v4u pw; pw.x = cvtpk(sc[kt][8 * s2 + 0], sc[kt][8 * s2 + 1]); pw.y = cvtpk(sc[kt][8 * s2 + 2], sc[kt][8 * s2 + 3]); pw.z = cvtpk(sc[kt][8 * s2 + 4], sc[kt][8 * s2 + 5]); pw.w = cvtpk(sc[kt][8 * s2 + 6], sc[kt][8 * s2 + 7]);
            const bf16x8 pb = __builtin_bit_cast(bf16x8, pw);
            const s16x4 l0 = vf[st % 3][0], h0 = vf[st % 3][1], l1 = vf[st % 3][2], h1 = vf[st % 3][3];
            o[0] = __builtin_amdgcn_mfma_f32_32x32x16_bf16((bf16x8){l0[0], l0[1], l0[2], l0[3], h0[0], h0[1], h0[2], h0[3]}, pb, o[0], 0, 0, 0);
            o[1] = __builtin_amdgcn_mfma_f32_32x32x16_bf16((bf16x8){l1[0], l1[1], l1[2], l1[3], h1[0], h1[1], h1[2], h1[3]}, pb, o[1], 0, 0, 0);
            __builtin_amdgcn_sched_barrier(0);
        }
#undef AT_LDV
    }
    const float inv = 1.0f / lsum;
    bf16* dst = PROJ + tokq * P2LD + p * 512 + h * 64 + 4 * kh;
#pragma unroll
    for (int c = 0; c < 2; ++c)
#pragma unroll
        for (int g = 0; g < 4; ++g) { v2u w; w.x = cvtpk(o[c][4 * g + 0] * inv, o[c][4 * g + 1] * inv); w.y = cvtpk(o[c][4 * g + 2] * inv, o[c][4 * g + 3] * inv);
            *(v2u*)(dst + 32 * c + 8 * g) = w; }
    if (kh == 0) { float* ml = ML + ((tokq * 8 + h) * 3 + p) * 2; *(f32x2*)ml = (f32x2){mx, lsum}; }
    __syncthreads();
}

#define XB_TMO      128
#define XB_XCNT(j)  (256  + 64 * (j))
#define XB_XSUB(j)  (1280 + 64 * (j))
#define XB_XGEN(j)  (2304 + 64 * (j))
#define XB_TOP      3328
#define XB_TOPGEN   3392
#define XCD_BAR_WORDS 3456
#define XB_SPIN_CAP (1u << 18)

__device__ __forceinline__ unsigned xb_ld(unsigned* p)              { return __hip_atomic_load(p, __ATOMIC_RELAXED, __HIP_MEMORY_SCOPE_AGENT); }
__device__ __forceinline__ unsigned xb_add(unsigned* p, unsigned v) { return __hip_atomic_fetch_add(p, v, __ATOMIC_RELAXED, __HIP_MEMORY_SCOPE_AGENT); }
__device__ __forceinline__ unsigned xb_xcc_id() { return (unsigned)__builtin_amdgcn_s_getreg((3 << 11) | 20) & 0xFu; }
#define XB_SPIN(cond, bar) do { unsigned _sp = 0; while (cond) { __builtin_amdgcn_s_sleep(1); \
    if ((++_sp & 255u) == 0u) { if (xb_ld(&(bar)[XB_TMO])) break; if (_sp > XB_SPIN_CAP) { atomicAdd(&(bar)[XB_TMO], 1u); break; } } } } while (0)

struct XcdBarrier {
    unsigned* bar; unsigned x;
    volatile LAS unsigned* st;
};

__device__ __forceinline__ XcdBarrier xcd_barrier_post(unsigned* bar, volatile LAS unsigned* st) {
    XcdBarrier b; b.bar = bar; b.x = xb_xcc_id(); b.st = st;
    if (threadIdx.x == 0) (void)xb_add(&bar[XB_XCNT(b.x)], 1u);
    return b;
}
__device__ __forceinline__ void xcd_barrier_complete(unsigned* bar, unsigned x, unsigned& nloc, unsigned& nx) {
    const unsigned G = gridDim.x * gridDim.y * gridDim.z;
    unsigned sum, cnt, mine, sp = 0u;
    for (;;) {
        sum = 0u; cnt = 0u; mine = 0u;
#pragma unroll
        for (unsigned j = 0; j < 16; ++j) { const unsigned c = xb_ld(&bar[XB_XCNT(j)]); sum += c; cnt += (c > 0u) ? 1u : 0u; mine = (j == x) ? c : mine; }
        if (sum == G) break;
        __builtin_amdgcn_s_sleep(1);
        if ((++sp & 255u) == 0u) { if (xb_ld(&bar[XB_TMO])) break; if (sp > XB_SPIN_CAP) { atomicAdd(&bar[XB_TMO], 1u); break; } }
    }
    nloc = mine > 0u ? mine : 1u; nx = cnt > 0u ? cnt : 1u;
}

__device__ __forceinline__ void xcd_barrier(const XcdBarrier& b) {
    asm volatile("s_waitcnt vmcnt(0)" ::: "memory");
    __syncthreads();
    if (threadIdx.x == 0) {
        unsigned* bar = b.bar;
        __builtin_amdgcn_s_waitcnt(0);
        unsigned nloc = b.st[0], nx = b.st[1];
        if (nloc == 0u) { xcd_barrier_complete(bar, b.x, nloc, nx); b.st[0] = nloc; b.st[1] = nx; }
        const unsigned old = xb_add(&bar[XB_XSUB(b.x)], 1u);
        const unsigned gen = old / nloc;
        if (old + 1u == (gen + 1u) * nloc) {
            __builtin_amdgcn_fence(__ATOMIC_RELEASE, "agent");
            asm volatile("s_waitcnt vmcnt(0)" ::: "memory");
            const unsigned og = xb_add(&bar[XB_TOP], 1u);
            const unsigned tg = og / nx;
            if (og + 1u == (tg + 1u) * nx) xb_add(&bar[XB_TOPGEN], 1u);
            else XB_SPIN(xb_ld(&bar[XB_TOPGEN]) == tg, bar);
            __builtin_amdgcn_fence(__ATOMIC_ACQUIRE, "agent");
            xb_add(&bar[XB_XGEN(b.x)], 1u);
            asm volatile("s_waitcnt vmcnt(0)" ::: "memory");
        } else {
            XB_SPIN(xb_ld(&bar[XB_XGEN(b.x)]) == gen, bar);
            __builtin_amdgcn_fence(__ATOMIC_ACQUIRE, "agent");
            asm volatile("s_waitcnt vmcnt(0)" ::: "memory");
        }
    }
    __syncthreads();
}

__global__ void __launch_bounds__(NWAVES * 64, 2) fwd_megakernel(Args a) {
    extern __shared__ __attribute__((aligned(16))) unsigned char lds[];
    cg::grid_group grid = cg::this_grid();
    LAS unsigned char* L8 = (LAS unsigned char*)lds;
    LAS float* L = (LAS float*)lds;
    const int tid = threadIdx.x, lane = tid & 63, wave = __builtin_amdgcn_readfirstlane(tid >> 6);
    const int G = gridDim.x, gw = blockIdx.x * NWAVES + wave, NGW = G * NWAVES;
    unsigned char* ws = a.ws;
    unsigned* ctl = (unsigned*)(ws + WS_CTL);
    const float* x = a.in[0];
    bf16* XN = (bf16*)(ws + WS_XN); bf16* ACT = (bf16*)(ws + WS_ACT); bf16* PROJ = ACT; bf16* MIX = XN;
    bf16* Wgu1 = (bf16*)(ws + WS_WGU1); bf16* Wd1 = (bf16*)(ws + WS_WD1); bf16* Win = (bf16*)(ws + WS_WIN); bf16* Wout = (bf16*)(ws + WS_WOUT);
    bf16* Wgu2 = (bf16*)(ws + WS_WGU2); bf16* Wd2 = (bf16*)(ws + WS_WD2);
    float* out = a.out;
    volatile LAS unsigned* xbst = (volatile LAS unsigned*)(L8 + LDS_BYTES - 64);
    if (tid < 2) xbst[tid] = 0u;
    __syncthreads();
    XcdBarrier bar = xcd_barrier_post(ctl + 1024, xbst);
#define GSYNC() xcd_barrier(bar)

    {
        const int lane = opq(tid) & 63;
        LAS float* scr = L + wave * 4096;
        constexpr int I_GU = (D / 64) * (NGU / 32), I_D = (FF / 64) * (D / 32), I_IN = (D / 64) * (NIN / 32), I_O = (D / 64) * (D / 32);
        for (int it = gw; it < I_GU; it += NGW) tr_gu(a.in[2], a.in[3], Wgu1, it, scr, lane);
        for (int m = gw; m < M; m += NGW) { f32x4 v[4]; rms_row(x + (size_t)m * D, a.in[1], lane, v); store_row_bf16(XN + (size_t)m * D, lane, v); }
    }
    grid.sync();
    {
        pg8::Gemm g{XN, Wgu1, M, NGU, D}; pg8::StaticOrder S; S.init(M, NGU, G, (int)blockIdx.x);
        pg8::EpiSwiGLU<false> E{ACT, FF, nullptr};
        pg8::gemm_phase<pg8::EpiSwiGLU<false>, pg8::StaticOrder, true, true>(L8, g, S, E);
        {
            constexpr int I_D = (FF / 64) * (D / 32), I_IN = (D / 64) * (NIN / 32), I_O = (D / 64) * (D / 32);
            const int rem = ((M / 256) * (NGU / 256)) % G, nbf = rem ? G - rem : G, jf = rem ? (int)blockIdx.x - rem : (int)blockIdx.x;
            if (jf >= 0) { const int lane_f = opq(tid) & 63; LAS float* scr = L + wave * 4096;
                for (int it = jf * NWAVES + wave; it < I_D + I_IN + I_O; it += nbf * NWAVES) { int r = it;
                    if (r < I_D) { tr_plain(a.in[4], FF, D, Wd1, r, scr, lane_f); continue; } r -= I_D;
                    if (r < I_IN) { tr_win(a.in[6], Win, r, scr, lane_f, a.in[5]); continue; } r -= I_IN;
                    tr_plain(a.in[11], D, D, Wout, r, scr, lane_f); } }
        }
    }
    GSYNC();
    {
        pg8::Gemm g{ACT, Wd1, M, D, FF}; pg8::StaticOrder S; S.init(M, D, G, (int)blockIdx.x);
        pg8::EpiRes<true> E{x, out, D, 0.5f, XN, (float*)(ws + WS_SS)};
        pg8::gemm_phase<pg8::EpiRes<true>, pg8::StaticOrder, true, true>(L8, g, S, E);
    }
    GSYNC();
    {
        pg8::Gemm g{XN, Win, M, NIN, D}; pg8::StaticOrder S; S.init(M, NIN, G, (int)blockIdx.x);
        pg8::EpiProj E{(bf16*)(ws + WS_QH), (bf16*)(ws + WS_KVH), PROJ, (float*)(ws + WS_BD), (const float*)(ws + WS_SS)};
        pg8::gemm_phase<pg8::EpiProj, pg8::StaticOrder, true, true>(L8, g, S, E);
        {
            constexpr int I_GU = (D / 64) * (NGU / 32), I_D = (FF / 64) * (D / 32);
            const int rem = ((M / 256) * (NIN / 256)) % G, nbf = rem ? G - rem : G, jf = rem ? (int)blockIdx.x - rem : (int)blockIdx.x;
            if (jf >= 0) { const int lane_f = opq(tid) & 63; LAS float* scr = L + wave * 4096;
                for (int it = jf * NWAVES + wave; it < I_GU + I_D; it += nbf * NWAVES) {
                    if (it < I_GU) tr_gu(a.in[13], a.in[14], Wgu2, it, scr, lane_f, a.in[12]); else tr_plain(a.in[15], FF, D, Wd2, it - I_GU, scr, lane_f); } }
        }
    }
    GSYNC();
    { const int tid_ = opq(tid); for (int ch = blockIdx.x; ch < 1024; ch += G) dn_prep_item(a, L8, ch, tid_, tid_ & 63, wave); }
    GSYNC();
    {
        const int tid_ = opq(tid), lane = tid_ & 63;
        for (int it = blockIdx.x; it < 64; it += G) dn_scan_mfma(a, L8, it, tid_, lane, wave);
        float* ML = (float*)(ws + WS_ML);
        if ((int)blockIdx.x >= 64 || G <= 64) {
            const int nb = (G > 64) ? G - 64 : G, j0 = (G > 64) ? (int)blockIdx.x - 64 : (int)blockIdx.x;
            for (int item = j0; item < 1536; item += nb) attn_item((const bf16*)(ws + WS_QH), (const bf16*)(ws + WS_KVH), PROJ, ML, L8, item, tid, lane, wave);
        }
    }
    GSYNC();
    {
        const int lane = opq(tid) & 63;
        const float* dn_norm = a.in[10];
        for (int m = gw; m < M; m += NGW) {
            bf16* op = MIX + (size_t)m * 1024 + 512 + 8 * lane; const bf16* gp = PROJ + (size_t)m * P2LD + 1536 + 8 * lane;
            const v4u ow = *(const v4u*)op, gwv = *(const v4u*)gp;
            float o[8] = {bflo(ow.x), bfhi(ow.x), bflo(ow.y), bfhi(ow.y), bflo(ow.z), bfhi(ow.z), bflo(ow.w), bfhi(ow.w)};
            float gt[8] = {bflo(gwv.x), bfhi(gwv.x), bflo(gwv.y), bfhi(gwv.y), bflo(gwv.z), bfhi(gwv.z), bflo(gwv.w), bfhi(gwv.w)};
            float ss = 0.f;
#pragma unroll
            for (int i = 0; i < 8; ++i) ss += o[i] * o[i];
            ss += __shfl_xor(ss, 1); ss += __shfl_xor(ss, 2); ss += __shfl_xor(ss, 4); ss += __shfl_xor(ss, 8);
            const float rs = 1.0f / sqrtf(ss * (1.f / 128.f) + 1e-6f);
            const int d0 = (8 * lane) & 127;
            float r[8];
#pragma unroll
            for (int i = 0; i < 8; ++i) r[i] = o[i] * rs * dn_norm[d0 + i] * (gt[i] / (1.f + __expf(-gt[i])));
            v4u w; w.x = pk2(r[0], r[1]); w.y = pk2(r[2], r[3]); w.z = pk2(r[4], r[5]); w.w = pk2(r[6], r[7]);
            *(v4u*)op = w;
            {
                const int ha = lane >> 3;
                const float* ml = (const float*)(ws + WS_ML) + ((size_t)m * 8 + ha) * 6;
                const f32x2 a0 = *(const f32x2*)ml, a1 = *(const f32x2*)(ml + 2), a2 = *(const f32x2*)(ml + 4);
                const float mm = fmaxf(a0.x, fmaxf(a1.x, a2.x));
                const float w0 = a0.y * __builtin_amdgcn_exp2f(a0.x - mm), w1 = a1.y * __builtin_amdgcn_exp2f(a1.x - mm), w2 = a2.y * __builtin_amdgcn_exp2f(a2.x - mm);
                const float iw = 1.0f / (w0 + w1 + w2);
                const bf16* pp = PROJ + (size_t)m * P2LD + 8 * lane;
                const v4u p0 = *(const v4u*)pp, p1 = *(const v4u*)(pp + 512), p2 = *(const v4u*)(pp + 1024);
                float rr[8];
                rr[0] = w0 * bflo(p0.x) + w1 * bflo(p1.x) + w2 * bflo(p2.x); rr[1] = w0 * bfhi(p0.x) + w1 * bfhi(p1.x) + w2 * bfhi(p2.x);
                rr[2] = w0 * bflo(p0.y) + w1 * bflo(p1.y) + w2 * bflo(p2.y); rr[3] = w0 * bfhi(p0.y) + w1 * bfhi(p1.y) + w2 * bfhi(p2.y);
                rr[4] = w0 * bflo(p0.z) + w1 * bflo(p1.z) + w2 * bflo(p2.z); rr[5] = w0 * bfhi(p0.z) + w1 * bfhi(p1.z) + w2 * bfhi(p2.z);
                rr[6] = w0 * bflo(p0.w) + w1 * bflo(p1.w) + w2 * bflo(p2.w); rr[7] = w0 * bfhi(p0.w) + w1 * bfhi(p1.w) + w2 * bfhi(p2.w);
                v4u wa; wa.x = pk2(rr[0] * iw, rr[1] * iw); wa.y = pk2(rr[2] * iw, rr[3] * iw); wa.z = pk2(rr[4] * iw, rr[5] * iw); wa.w = pk2(rr[6] * iw, rr[7] * iw);
                *(v4u*)(MIX + (size_t)m * 1024 + 8 * lane) = wa;
            }
        }
    }
    GSYNC();
    {
        pg8::Gemm g{MIX, Wout, M, D, D}; pg8::StaticOrder S; S.init(M, D, G, (int)blockIdx.x);
        pg8::EpiRes<true> E{out, out, D, 1.0f, (bf16*)(ws + WS_XNB2), (float*)(ws + WS_SS)};
        pg8::gemm_phase<pg8::EpiRes<true>, pg8::StaticOrder, true, true>(L8, g, S, E);
    }
    GSYNC();
    {
        pg8::Gemm g{(const bf16*)(ws + WS_XNB2), Wgu2, M, NGU, D}; pg8::StaticOrder S; S.init(M, NGU, G, (int)blockIdx.x);
        pg8::EpiSwiGLU<true> E{ACT, FF, (const float*)(ws + WS_SS)};
        pg8::gemm_phase<pg8::EpiSwiGLU<true>, pg8::StaticOrder, true, true>(L8, g, S, E);
    }
    GSYNC();
    {
        pg8::Gemm g{ACT, Wd2, M, D, FF}; pg8::StaticOrder S; S.init(M, D, G, (int)blockIdx.x);
        pg8::EpiRes<false> E{out, out, D, 0.5f, nullptr, nullptr};
        pg8::gemm_phase<pg8::EpiRes<false>, pg8::StaticOrder, true, true>(L8, g, S, E);
    }
    GSYNC();
    const int lnf = opq(tid) & 63;
    for (int m = gw; m < M; m += NGW) {
        f32x4 v[4]; rms_row(out + (size_t)m * D, a.in[16], lnf, v);
        f32x4* o = (f32x4*)(out + (size_t)m * D) + lnf;
#pragma unroll
        for (int j = 0; j < 4; ++j) o[64 * j] = v[j];
    }
}

extern "C" void kernel_launch(void* const* d_in, const int* in_sizes, int n_in, void* d_out, int out_size, void* d_ws, size_t ws_size, hipStream_t stream) {
    static int grid = 0;
    if (grid == 0) {
        if (n_in != 17 || in_sizes[0] != M * D || out_size != M * D || ws_size < WS_END) { fprintf(stderr, "kernel_launch: unexpected shapes (n_in %d in0 %d out %d ws %zu)\n", n_in, n_in > 0 ? in_sizes[0] : -1, out_size, ws_size); grid = -1; return; }
        int dev = 0, cus = 0, per_cu = 0;
        hipGetDevice(&dev); hipDeviceGetAttribute(&cus, hipDeviceAttributeMultiprocessorCount, dev);
        if (hipFuncSetAttribute((const void*)fwd_megakernel, hipFuncAttributeMaxDynamicSharedMemorySize, LDS_BYTES) != hipSuccess) { fprintf(stderr, "kernel_launch: hipFuncSetAttribute failed\n"); grid = -1; return; }
        if (hipOccupancyMaxActiveBlocksPerMultiprocessor(&per_cu, (const void*)fwd_megakernel, NWAVES * 64, LDS_BYTES) != hipSuccess || per_cu < 1) { fprintf(stderr, "kernel_launch: occupancy query says %d blocks/CU\n", per_cu); (void)hipGetLastError(); per_cu = 1; }
        grid = cus * 1;
        fprintf(stderr, "kernel_launch: cus %d per_cu %d grid %d\n", cus, per_cu, grid);
    }
    if (grid < 0) return;
    hipMemsetAsync((char*)d_ws + WS_CTL, 0, CTL_BYTES, stream);
    Args a{};
    for (int i = 0; i < 17; ++i) a.in[i] = (const float*)d_in[i];
    a.out = (float*)d_out; a.ws = (unsigned char*)d_ws;
    void* args[] = {&a};
    hipError_t e = hipLaunchCooperativeKernel((const void*)fwd_megakernel, dim3(grid), dim3(NWAVES * 64), args, LDS_BYTES, stream);
    if (e != hipSuccess) fprintf(stderr, "cooperative launch failed: %s (grid %d)\n", hipGetErrorString(e), grid);
}
```

```cpp
#include <hip/hip_runtime.h>
#include <hip/hip_cooperative_groups.h>
#include <cstdio>
#include <cstdint>
namespace cg = cooperative_groups;
namespace pg8 {
#define PG8_LAS __attribute__((address_space(3)))
typedef unsigned short bf16_t;
typedef short bf16x8 __attribute__((ext_vector_type(8)));
typedef float f32x4 __attribute__((ext_vector_type(4)));
typedef unsigned u32x4 __attribute__((ext_vector_type(4)));
constexpr int BM = 256, BK = 64, HALF = 128, HTB = HALF * BK * 2  , STAGE_BYTES = 8 * HTB, NXCD = 8, WGM = 8;

__host__ __device__ __forceinline__ int lds_byte(int r, int c) { const int st = (r >> 4) * 2 + (c >> 5), rr = r & 15, cc = c & 31, ob = rr * 64 + cc * 2; return st * 1024 + (ob ^ (((ob >> 9) & 1) << 5)); }
__host__ __device__ __forceinline__ void stage_rc(int b, int& R, int& C) { const int st = b / 1024, sb = b % 1024, swz = sb ^ (((sb >> 9) & 1) << 5); R = (st >> 1) * 16 + swz / 64; C = (st & 1) * 32 + (swz % 64) / 2; }
__host__ __device__ __forceinline__ int perm32(int rho) { const int n = rho >> 4, i = rho & 15; return 8 * (i >> 2) + 4 * n + (i & 3); }

struct Unit { int pm, pn; };
struct Gemm { const bf16_t* A; const bf16_t* Bt; int M, N, K; };

struct StaticOrder {
    int nM, nN, nwg, G, c;
    __host__ __device__ void init(int M, int N, int G_, int c_) { nM = M / BM; nN = N / BM; nwg = nM * nN; G = G_; c = c_; }
    __host__ __device__ bool next(int i, Unit& u) const {
        const long L = (long)i * G + c; if (L >= nwg) return false;
        int wgid = (int)L; { const int q = nwg / NXCD, r = nwg % NXCD, xcd = wgid % NXCD, off = wgid / NXCD; wgid = (xcd < r ? xcd * (q + 1) : r * (q + 1) + (xcd - r) * q) + off; }
        const int nig = WGM * nN, gid = wgid / nig, fm = gid * WGM, gsz = (nM - fm) < WGM ? (nM - fm) : WGM;
        u.pm = fm + ((wgid % nig) % gsz); u.pn = (wgid % nig) / gsz; return true;
    }
    __device__ __forceinline__ void a_ready(const Unit&) const {}
    __device__ __forceinline__ void done(const Unit&) const {}
};

__device__ __forceinline__ unsigned cvt_pk_bf16(float lo, float hi) { unsigned r; asm volatile("v_cvt_pk_bf16_f32 %0, %1, %2" : "=v"(r) : "v"(lo), "v"(hi)); return r; }
__device__ __forceinline__ float silu_f(float g) { return g * __builtin_amdgcn_rcpf(1.0f + __expf(-g)); }
__device__ __forceinline__ float row_rs(const float* SS, int row) {
    const f32x4* sp = (const f32x4*)(SS + (size_t)row * 16); const f32x4 a = sp[0], b = sp[1], c = sp[2], d = sp[3];
    const float s = ((a[0] + a[1]) + (a[2] + a[3])) + ((b[0] + b[1]) + (b[2] + b[3])) + ((c[0] + c[1]) + (c[2] + c[3])) + ((d[0] + d[1]) + (d[2] + d[3]));
    return 1.0f / sqrtf(s * (1.0f / 1024.0f) + 1e-6f);
}
template <bool RS> struct EpiSwiGLU {
    static constexpr bool PERM = true, AFTER_DRAIN = false;
    bf16_t* O; int ldc; const float* SS;
    __device__ __forceinline__ void operator()(const f32x4 (&acc)[2][2][4][2], const Unit& u, int wr, int wc, int fr, int fq) const {
        const int row0 = u.pm * BM + wr * 64 + fr; const int col0 = u.pn * 128 + wc * 32 + 8 * fq;
#pragma unroll
        for (int ai = 0; ai < 2; ++ai)
#pragma unroll
            for (int m = 0; m < 4; ++m) { const int row = row0 + ai * HALF + m * 16; bf16_t* rowp = O + (size_t)row * ldc + col0;
                const float rs = RS ? row_rs(SS, row) : 1.0f;
                const f32x4 g0 = acc[ai][0][m][0] * rs, g1 = acc[ai][0][m][1] * rs, u0 = acc[ai][1][m][0] * rs, u1 = acc[ai][1][m][1] * rs;
                u32x4 w;
                w.x = cvt_pk_bf16(silu_f(g0[0]) * u0[0], silu_f(g0[1]) * u0[1]); w.y = cvt_pk_bf16(silu_f(g0[2]) * u0[2], silu_f(g0[3]) * u0[3]);
                w.z = cvt_pk_bf16(silu_f(g1[0]) * u1[0], silu_f(g1[1]) * u1[1]); w.w = cvt_pk_bf16(silu_f(g1[2]) * u1[2], silu_f(g1[3]) * u1[3]);
                *(u32x4*)rowp = w; }
    }
};
template <bool XB> struct EpiRes {
    static constexpr bool PERM = false, AFTER_DRAIN = false;
    const float* base; float* out; int ldc; float scale; bf16_t* xb; float* SS;
    __device__ __forceinline__ void operator()(const f32x4 (&acc)[2][2][4][2], const Unit& u, int wr, int wc, int fr, int fq) const {
        const int row0 = u.pm * BM + wr * 64 + fr; const int col0 = u.pn * BM + wc * 32 + 4 * fq;
#pragma unroll
        for (int ai = 0; ai < 2; ++ai)
#pragma unroll
            for (int m = 0; m < 4; ++m) { const int row = row0 + ai * HALF + m * 16; const size_t off = (size_t)row * ldc + col0; float ss = 0.f;
#pragma unroll
                for (int bj = 0; bj < 2; ++bj)
#pragma unroll
                    for (int n = 0; n < 2; ++n) { const f32x4 b = *(const f32x4*)(base + off + bj * HALF + n * 16); const f32x4 v = b + acc[ai][bj][m][n] * scale; *(f32x4*)(out + off + bj * HALF + n * 16) = v;
                        if (XB) { ss += (v[0] * v[0] + v[1] * v[1]) + (v[2] * v[2] + v[3] * v[3]);
                            unsigned lo = cvt_pk_bf16(v[0], v[1]), hi = cvt_pk_bf16(v[2], v[3]); unsigned long long pk = ((unsigned long long)hi << 32) | lo;
                            *(unsigned long long*)(xb + off + bj * HALF + n * 16) = pk; } }
                if (XB) { ss += __shfl_xor(ss, 16); ss += __shfl_xor(ss, 32); if (fq == 0) SS[(size_t)row * 16 + u.pn * 4 + wc] = ss; }
                asm volatile("" ::: "memory"); }
    }
};
struct EpiProj {
    static constexpr bool PERM = true, AFTER_DRAIN = false;
    bf16_t* Qh; bf16_t* KVh; bf16_t* P2; float* BD; const float* SS;
    __device__ __forceinline__ void operator()(const f32x4 (&acc)[2][2][4][2], const Unit& u, int wr, int wc, int fr, int fq) const {
        const int row0 = u.pm * BM + wr * 64 + fr;
        if (u.pn == 14) {
            if (wc == 0 && fq == 0) {
#pragma unroll
                for (int ai = 0; ai < 2; ++ai)
#pragma unroll
                    for (int m = 0; m < 4; ++m) { const int row = row0 + ai * HALF + m * 16; const float rs = row_rs(SS, row);
                        *(f32x4*)(BD + (size_t)row * 8) = acc[ai][0][m][0] * rs; *(f32x4*)(BD + (size_t)row * 8 + 4) = acc[ai][0][m][1] * rs; }
            }
            return;
        }
#pragma unroll
        for (int ai = 0; ai < 2; ++ai)
#pragma unroll
            for (int m = 0; m < 4; ++m) { const int row = row0 + ai * HALF + m * 16, bb = row >> 12, t = row & 4095; const float rs = row_rs(SS, row);
#pragma unroll
                for (int bj = 0; bj < 2; ++bj) { const int col = u.pn * BM + bj * HALF + wc * 32 + 8 * fq;
                    bf16_t* dst;
                    if (u.pn < 6) { const int sec = col >> 9, hc = col & 511, hh = hc >> 6, d = hc & 63; const size_t rt = (size_t)(bb * 8 + hh) * 4096 + t;
                        dst = (sec == 0) ? Qh + rt * 64 + d : KVh + rt * 128 + (sec - 1) * 64 + d; }
                    else dst = P2 + (size_t)row * 2048 + (col - 1536);
                    const f32x4 v0 = acc[ai][bj][m][0] * rs, v1 = acc[ai][bj][m][1] * rs; u32x4 w;
                    w.x = cvt_pk_bf16(v0[0], v0[1]); w.y = cvt_pk_bf16(v0[2], v0[3]); w.z = cvt_pk_bf16(v1[0], v1[1]); w.w = cvt_pk_bf16(v1[2], v1[3]);
                    *(u32x4*)dst = w; } }
    }
};
struct EpiStoreBf16 {
    static constexpr bool PERM = true, AFTER_DRAIN = false;
    bf16_t* O; int ldc;
    __device__ __forceinline__ void operator()(const f32x4 (&acc)[2][2][4][2], const Unit& u, int wr, int wc, int fr, int fq) const {
        const int row0 = u.pm * BM + wr * 64 + fr; const int col0 = u.pn * BM + wc * 32 + 8 * fq;
#pragma unroll
        for (int ai = 0; ai < 2; ++ai)
#pragma unroll
            for (int m = 0; m < 4; ++m) { bf16_t* rowp = O + (size_t)(row0 + ai * HALF + m * 16) * ldc + col0;
#pragma unroll
                for (int bj = 0; bj < 2; ++bj) { const f32x4 v0 = acc[ai][bj][m][0], v1 = acc[ai][bj][m][1]; u32x4 w;
                    w.x = cvt_pk_bf16(v0[0], v0[1]); w.y = cvt_pk_bf16(v0[2], v0[3]); w.z = cvt_pk_bf16(v1[0], v1[1]); w.w = cvt_pk_bf16(v1[2], v1[3]);
                    *(u32x4*)(rowp + bj * HALF) = w; } }
    }
};
template <class Epi, class Sched, bool ALIGN_EPI = false, bool SP2 = false>
__device__ __forceinline__ void gemm_phase(PG8_LAS unsigned char* lds, const Gemm g, const Sched& S, const Epi& E) {
    const int tid = threadIdx.x, wid = __builtin_amdgcn_readfirstlane(tid >> 6), lane = tid & 63, wr = wid >> 2, wc = wid & 3, fr = lane & 15, fq = lane >> 4;
    const int K = g.K, nt = K / BK;
    unsigned voffA[2], voffB[2];
#pragma unroll
    for (int i = 0; i < 2; ++i) { int R, C; stage_rc(tid * 16 + i * 8192, R, C); const int Rb = Epi::PERM ? ((R & ~31) + perm32(R & 31)) : R;
        voffA[i] = (unsigned)(R * K + C) * 2u; voffB[i] = (unsigned)(Rb * K + C) * 2u; }
    const size_t kstep = (size_t)(BK * 2);
    const size_t hstep = (size_t)HALF * K * 2;
    const size_t tstep = 2 * hstep;
    const unsigned ldsw = (unsigned)wid * 1024u;
    const int aoff = lds_byte(wr * 64 + fr, fq * 8), boff = lds_byte(wc * 32 + fr, fq * 8);
#define PG8_SA(b, h) (((b) * 2 + (h)) * HTB)
#define PG8_SB(b, h) ((4 + (b) * 2 + (h)) * HTB)
#define PG8_STAGE(bufoff, gbase, voff) do { _Pragma("unroll") for (int _i = 0; _i < 2; ++_i) \
        __builtin_amdgcn_global_load_lds((const unsigned*)((const char*)(gbase) + (voff)[_i]), (PG8_LAS unsigned*)(lds + (bufoff) + ldsw + _i * 8192), 16, 0, 0); } while (0)
#define PG8_LDA(dst, b, h) do { _Pragma("unroll") for (int m = 0; m < 4; ++m) _Pragma("unroll") for (int k = 0; k < 2; ++k) dst[m][k] = *(const PG8_LAS bf16x8*)(lds + PG8_SA(b, h) + aoff + m * 2048 + k * 1024); } while (0)
#define PG8_LDB(dst, b, h) do { _Pragma("unroll") for (int n = 0; n < 2; ++n) _Pragma("unroll") for (int k = 0; k < 2; ++k) dst[n][k] = *(const PG8_LAS bf16x8*)(lds + PG8_SB(b, h) + boff + n * 2048 + k * 1024); } while (0)
#define PG8_MMA(ai, bj, At, Bt) do { __builtin_amdgcn_s_setprio(1); _Pragma("unroll") for (int m = 0; m < 4; ++m) _Pragma("unroll") for (int n = 0; n < 2; ++n) _Pragma("unroll") for (int k = 0; k < 2; ++k) \
        acc[ai][bj][m][n] = __builtin_amdgcn_mfma_f32_16x16x32_bf16(Bt[n][k], At[m][k], acc[ai][bj][m][n], 0, 0, 0); __builtin_amdgcn_s_setprio(0); } while (0)
#define PG8_WAIT_V(n) asm volatile("s_waitcnt vmcnt(" #n ")" ::: "memory")
#define PG8_WAIT_L(n) asm volatile("s_waitcnt lgkmcnt(" #n ")" ::: "memory")
#define PG8_BAR __builtin_amdgcn_s_barrier()
#define PG8_SCHED __builtin_amdgcn_sched_barrier(0)
    Unit cur, nxt; int ui = 0;
    if (!S.next(0, cur)) return;
    f32x4 acc[2][2][4][2];
#pragma unroll
    for (int a = 0; a < 2; ++a)
#pragma unroll
        for (int b = 0; b < 2; ++b)
#pragma unroll
            for (int m = 0; m < 4; ++m)
#pragma unroll
                for (int n = 0; n < 2; ++n) acc[a][b][m][n] = (f32x4){0.f, 0.f, 0.f, 0.f};
    bf16x8 At[4][2], B0[2][2], B1[2][2];
    const char* cA = (const char*)g.A + (size_t)cur.pm * tstep; const char* cB = (const char*)g.Bt + (size_t)cur.pn * tstep;
    S.a_ready(cur);
    if constexpr (SP2) {
        PG8_STAGE(PG8_SB(0, 0), cB, voffB); PG8_STAGE(PG8_SB(0, 1), cB + hstep, voffB); PG8_STAGE(PG8_SA(0, 0), cA, voffA); PG8_STAGE(PG8_SA(0, 1), cA + hstep, voffA);
        if (wr == 1) PG8_BAR;
        PG8_WAIT_V(2); PG8_BAR;
        PG8_STAGE(PG8_SB(1, 0), cB + kstep, voffB); PG8_STAGE(PG8_SA(1, 0), cA + kstep, voffA); PG8_STAGE(PG8_SB(1, 1), cB + hstep + kstep, voffB);
        PG8_WAIT_V(6); PG8_BAR;
    } else {
        PG8_STAGE(PG8_SB(0, 0), cB, voffB); PG8_STAGE(PG8_SA(0, 0), cA, voffA); PG8_STAGE(PG8_SB(0, 1), cB + hstep, voffB); PG8_STAGE(PG8_SA(0, 1), cA + hstep, voffA);
        if (wr == 1) PG8_BAR;
        PG8_WAIT_V(4); PG8_BAR;
        PG8_STAGE(PG8_SB(1, 0), cB + kstep, voffB); PG8_STAGE(PG8_SA(1, 0), cA + kstep, voffA); PG8_STAGE(PG8_SB(1, 1), cB + hstep + kstep, voffB);
        PG8_WAIT_V(6); PG8_BAR;
    }
    for (;;) {
        const bool has_next = S.next(ui + 1, nxt);
        const char* nA = has_next ? (const char*)g.A + (size_t)nxt.pm * tstep : cA; const char* nB = has_next ? (const char*)g.Bt + (size_t)nxt.pn * tstep : cB;
        for (int t = 0; t < nt; t += 2) {
            const bool last = (t == nt - 2);
            const char* a1 = cA + (size_t)(t + 1) * kstep;
            const char* a2 = last ? nA : cA + (size_t)(t + 2) * kstep; const char* b2 = last ? nB : cB + (size_t)(t + 2) * kstep;
            const char* a3 = a2 + kstep; const char* b3 = b2 + kstep;
            if (last && has_next) S.a_ready(nxt);
            if constexpr (SP2) {
            PG8_LDB(B0, 0, 0); PG8_LDB(B1, 0, 1); PG8_SCHED; PG8_LDA(At, 0, 0); PG8_STAGE(PG8_SA(1, 1), a1 + hstep, voffA);
            PG8_WAIT_V(8); PG8_WAIT_L(0); PG8_BAR; PG8_MMA(0, 0, At, B0); PG8_MMA(0, 1, At, B1); PG8_BAR; PG8_SCHED;
            PG8_LDA(At, 0, 1); PG8_STAGE(PG8_SB(0, 0), b2, voffB); PG8_STAGE(PG8_SB(0, 1), b2 + hstep, voffB); PG8_STAGE(PG8_SA(0, 0), a2, voffA);
            PG8_WAIT_V(8); PG8_WAIT_L(0); PG8_BAR; PG8_MMA(1, 0, At, B0); PG8_MMA(1, 1, At, B1); PG8_BAR; PG8_SCHED;
            PG8_LDB(B0, 1, 0); PG8_LDB(B1, 1, 1); PG8_SCHED; PG8_LDA(At, 1, 0); PG8_STAGE(PG8_SA(0, 1), a2 + hstep, voffA);
            PG8_WAIT_V(8); PG8_WAIT_L(0); PG8_BAR; PG8_MMA(0, 0, At, B0); PG8_MMA(0, 1, At, B1); PG8_BAR; PG8_SCHED;
            PG8_LDA(At, 1, 1); PG8_STAGE(PG8_SB(1, 0), b3, voffB); PG8_STAGE(PG8_SB(1, 1), b3 + hstep, voffB); PG8_STAGE(PG8_SA(1, 0), a3, voffA);
            PG8_WAIT_V(8); PG8_WAIT_L(0); PG8_BAR; PG8_MMA(1, 0, At, B0); PG8_MMA(1, 1, At, B1); PG8_BAR; PG8_SCHED;
            } else {
            PG8_LDB(B0, 0, 0); PG8_SCHED; PG8_LDA(At, 0, 0); PG8_STAGE(PG8_SA(1, 1), a1 + hstep, voffA);
            PG8_WAIT_L(8); PG8_BAR; PG8_WAIT_L(0); PG8_MMA(0, 0, At, B0); PG8_BAR; PG8_SCHED;
            PG8_LDB(B1, 0, 1); PG8_STAGE(PG8_SB(0, 0), b2, voffB);
            PG8_BAR; PG8_WAIT_L(0); PG8_MMA(0, 1, At, B1); PG8_BAR;
            PG8_LDA(At, 0, 1); PG8_STAGE(PG8_SA(0, 0), a2, voffA);
            PG8_BAR; PG8_WAIT_L(0); PG8_MMA(1, 0, At, B0); PG8_BAR; PG8_SCHED;
            PG8_STAGE(PG8_SB(0, 1), b2 + hstep, voffB);
            PG8_WAIT_V(6); PG8_BAR; PG8_MMA(1, 1, At, B1); PG8_BAR;
            PG8_LDB(B0, 1, 0); PG8_SCHED; PG8_LDA(At, 1, 0); PG8_STAGE(PG8_SA(0, 1), a2 + hstep, voffA);
            PG8_WAIT_L(8); PG8_BAR; PG8_WAIT_L(0); PG8_MMA(0, 0, At, B0); PG8_BAR; PG8_SCHED;
            PG8_LDB(B1, 1, 1); PG8_STAGE(PG8_SB(1, 0), b3, voffB);
            PG8_BAR; PG8_WAIT_L(0); PG8_MMA(0, 1, At, B1); PG8_BAR;
            PG8_LDA(At, 1, 1); PG8_STAGE(PG8_SA(1, 0), a3, voffA);
            PG8_BAR; PG8_WAIT_L(0); PG8_MMA(1, 0, At, B0); PG8_BAR; PG8_SCHED;
            PG8_STAGE(PG8_SB(1, 1), b3 + hstep, voffB);
            PG8_WAIT_V(6); PG8_BAR; PG8_MMA(1, 1, At, B1); PG8_BAR;
            }
        }
        if constexpr (ALIGN_EPI) { if (wr == 0) PG8_BAR; }
        if constexpr (!Epi::AFTER_DRAIN) { E(acc, cur, wr, wc, fr, fq); S.done(cur); }
        if (!has_next) break;
#pragma unroll
        for (int a = 0; a < 2; ++a)
#pragma unroll
            for (int b = 0; b < 2; ++b)
#pragma unroll
                for (int m = 0; m < 4; ++m)
#pragma unroll
                    for (int n = 0; n < 2; ++n) acc[a][b][m][n] = (f32x4){0.f, 0.f, 0.f, 0.f};
        cur = nxt; cA = nA; cB = nB; ++ui;
        if constexpr (ALIGN_EPI) { if (wr == 1) PG8_BAR; }
    }
    PG8_WAIT_V(0);
    if constexpr (!ALIGN_EPI) { if (wr == 0) PG8_BAR; }
    PG8_BAR;
    if constexpr (Epi::AFTER_DRAIN) { E.fused(acc, cur, wr, wc, fr, fq, lds, wid, lane); S.done(cur); }
#undef PG8_SA
#undef PG8_SB
#undef PG8_STAGE
#undef PG8_LDA
#undef PG8_LDB
#undef PG8_MMA
#undef PG8_WAIT_V
#undef PG8_WAIT_L
#undef PG8_BAR
#undef PG8_SCHED
}
}
constexpr int M = 16384, D = 1024, FF = 2816, NGU = 5632, NIN = 3840, SEQ = 4096;
constexpr int WIN_COLS = 3592;
constexpr size_t MiB = 1u << 20;
constexpr size_t WS_CTL = 0, CTL_BYTES = 65536;
constexpr size_t WS_WIN = MiB / 4, WS_WOUT = 8 * MiB, WS_WGU2 = 10 * MiB, WS_WD2 = 21 * MiB;
constexpr size_t WS_XN = 27 * MiB;
constexpr size_t WS_ACT = 59 * MiB;
constexpr size_t WS_QH = 123 * MiB, WS_KVH = 139 * MiB;
constexpr int P2LD = 2048;
constexpr size_t WS_BD = 171 * MiB;
constexpr size_t WS_EG = 172 * MiB;
constexpr size_t WS_DN = 184 * MiB;
constexpr size_t WS_WGU1 = 184 * MiB, WS_WD1 = 195 * MiB;
constexpr size_t WS_QG = WS_DN, WS_KD = WS_DN + 16 * MiB, WS_U = WS_DN + 32 * MiB, WS_W = WS_DN + 48 * MiB, WS_A = WS_DN + 64 * MiB;
constexpr size_t WS_END = 256 * MiB;
constexpr int LDS_BYTES = 147456;
constexpr int NWAVES = 8;

#define GAS __attribute__((address_space(1)))
#define LAS __attribute__((address_space(3)))
typedef unsigned short bf16;
typedef unsigned v4u __attribute__((ext_vector_type(4)));
typedef unsigned v2u __attribute__((ext_vector_type(2)));
typedef float f32x4 __attribute__((ext_vector_type(4)));
typedef float f32x2 __attribute__((ext_vector_type(2)));
#define LDS_WAIT() asm volatile("s_waitcnt lgkmcnt(0)" ::: "memory")
__device__ __forceinline__ unsigned f2bf(float f) { unsigned u = __builtin_bit_cast(unsigned, f); return (u + 0x7fffu + ((u >> 16) & 1u)) >> 16; }
__device__ __forceinline__ unsigned pk2(float lo, float hi) { return f2bf(lo) | (f2bf(hi) << 16); }
__device__ __forceinline__ float bflo(unsigned u) { return __uint_as_float(u << 16); }
__device__ __forceinline__ float bfhi(unsigned u) { return __uint_as_float(u & 0xffff0000u); }
__device__ __forceinline__ float bf2f(bf16 v) { return __uint_as_float(((unsigned)v) << 16); }
__device__ __forceinline__ float wave_sum(float v) {
#pragma unroll
    for (int o = 1; o < 64; o <<= 1) v += __shfl_xor(v, o);
    return v;
}
__device__ __forceinline__ float wave_max(float v) {
#pragma unroll
    for (int o = 1; o < 64; o <<= 1) v = fmaxf(v, __shfl_xor(v, o));
    return v;
}

__device__ __forceinline__ int opq(int v) { asm volatile("" : "+v"(v)); return v; }
struct Args { const float* in[17]; float* out; unsigned char* ws; };

__device__ __forceinline__ void transpose_item(const float* src, int srcN, int srccol0, bf16* dst, int dstK, int dstrow0, int k0, LAS float* scr, int lane, const float* gain = nullptr, int nvalid = 32) {
    const int c4 = (lane & 7) * 4, r0 = lane >> 3;
    f32x4 v[8];
#pragma unroll
    for (int i = 0; i < 8; ++i) v[i] = (c4 < nvalid) ? *(const f32x4*)(src + (size_t)(k0 + r0 + 8 * i) * srcN + srccol0 + c4) : (f32x4){0.f, 0.f, 0.f, 0.f};
    if (gain) {
#pragma unroll
        for (int i = 0; i < 8; ++i) v[i] = v[i] * gain[k0 + r0 + 8 * i]; }
#pragma unroll
    for (int i = 0; i < 8; ++i) { LAS float* p = scr + (r0 + 8 * i) * 33 + c4; p[0] = v[i][0]; p[1] = v[i][1]; p[2] = v[i][2]; p[3] = v[i][3]; }
    LDS_WAIT(); asm volatile("" ::: "memory");
    const int c = lane & 7;
#pragma unroll
    for (int j = 0; j < 4; ++j) { const int n = (lane >> 3) + 8 * j; const LAS float* s = scr + (8 * c) * 33 + n;
        v4u o; o.x = pk2(s[0 * 33], s[1 * 33]); o.y = pk2(s[2 * 33], s[3 * 33]); o.z = pk2(s[4 * 33], s[5 * 33]); o.w = pk2(s[6 * 33], s[7 * 33]);
        *(v4u*)(dst + (size_t)(dstrow0 + n) * dstK + k0 + 8 * c) = o; }
    LDS_WAIT(); asm volatile("" ::: "memory");
}
__device__ __forceinline__ void tr_gu(const float* gate, const float* up, bf16* dst, int r, LAS float* scr, int lane, const float* gain = nullptr) {
    const int nblk = NGU / 32, kb = r / nblk, nb = r % nblk, dstrow0 = nb * 32, pn = dstrow0 >> 8, within = dstrow0 & 255;
    transpose_item(within < 128 ? gate : up, FF, pn * 128 + (within & 127), dst, D, dstrow0, kb * 64, scr, lane, gain);
}
__device__ __forceinline__ void tr_plain(const float* src, int K, int N, bf16* dst, int r, LAS float* scr, int lane) {
    const int nblk = N / 32, kb = r / nblk, nb = r % nblk;
    transpose_item(src, N, nb * 32, dst, K, nb * 32, kb * 64, scr, lane);
}
__device__ __forceinline__ void tr_win(const float* src, bf16* dst, int r, LAS float* scr, int lane, const float* gain) {
    const int nblk = NIN / 32, kb = r / nblk, nb = r % nblk, dstrow0 = nb * 32;
    const int srccol0 = dstrow0 < 3072 ? dstrow0 : (dstrow0 < 3584 ? dstrow0 + 8 : 3072), nvalid = dstrow0 < 3584 ? 32 : (dstrow0 == 3584 ? 8 : 0);
    transpose_item(src, WIN_COLS, srccol0, dst, D, dstrow0, kb * 64, scr, lane, gain, nvalid);
}

__device__ __forceinline__ void rms_row(const float* xrow, const float* gain, int lane, f32x4 (&v)[4]) {
    const f32x4* xr = (const f32x4*)xrow + lane; const f32x4* gr = (const f32x4*)gain + lane;
    float s = 0.f;
#pragma unroll
    for (int j = 0; j < 4; ++j) { v[j] = xr[64 * j]; s += (v[j].x * v[j].x + v[j].y * v[j].y) + (v[j].z * v[j].z + v[j].w * v[j].w); }
    const float rs = 1.0f / sqrtf(wave_sum(s) * (1.f / D) + 1e-6f);
#pragma unroll
    for (int j = 0; j < 4; ++j) { const f32x4 g = gr[64 * j]; v[j] = v[j] * rs * g; }
}
__device__ __forceinline__ void store_row_bf16(bf16* orow, int lane, const f32x4 (&v)[4]) {
    v2u* o8 = (v2u*)orow + lane;
#pragma unroll
    for (int j = 0; j < 4; ++j) { v2u w; w.x = pk2(v[j].x, v[j].y); w.y = pk2(v[j].z, v[j].w); o8[64 * j] = w; }
}

__device__ __forceinline__ int kperm(int x) { return 8 * ((x & 15) >> 2) + 4 * (x >> 4) + (x & 3); }
typedef short bf16x8 __attribute__((ext_vector_type(8)));
typedef __bf16 bf16x2_t __attribute__((ext_vector_type(2)));
__device__ __forceinline__ unsigned cvtpk(float lo, float hi) { f32x2 v = {lo, hi}; bf16x2_t b = __builtin_convertvector(v, bf16x2_t); return __builtin_bit_cast(unsigned, b); }
constexpr int PQ = 0, PK = 17408, PVB = 34816, PKB = 53248, PAS = 71680, PTS = 88320, PMS = 104960, PTB = 121600, PGC = 130816;
__device__ __forceinline__ void dn_prep_item(const Args& a, LAS unsigned char* L8, int ch, int tid, int lane, int wave) {
    unsigned char* ws = a.ws;
    const bf16* PROJ = (const bf16*)(ws + WS_ACT);
    const float* BD = (const float*)(ws + WS_BD);
    const float* conv_w = a.in[7]; const float* a_log = a.in[8]; const float* dt_bias = a.in[9];
    const int bh = ch >> 6, n = ch & 63, b = bh >> 2, h = bh & 3;
    const int tok0 = b * SEQ + n * 64;
    LAS float* As = (LAS float*)(L8 + PAS); LAS float* Ts = (LAS float*)(L8 + PTS); LAS float* Ms = (LAS float*)(L8 + PMS);
    LAS float* gcs = (LAS float*)(L8 + PGC); LAS float* bts = gcs + 64;
    const int jl = lane & 15, kq = lane >> 4;
    unsigned raw[11][3];
#pragma unroll
    for (int i = 0; i < 11; ++i) { const int s = n * 64 + wave * 8 - 3 + i;
#pragma unroll
        for (int sec = 0; sec < 3; ++sec) raw[i][sec] = (s >= 0) ? *(const unsigned*)(PROJ + (size_t)(tok0 + wave * 8 - 3 + i) * P2LD + sec * 512 + h * 128 + 2 * lane) : 0u; }
    if (wave == 0) {
        const int tok = tok0 + lane;
        const float braw = BD[(size_t)tok * 8 + h], draw = BD[(size_t)tok * 8 + 4 + h] + dt_bias[h];
        const float sp = fmaxf(draw, 0.f) + log1pf(__expf(-fabsf(draw)));
        float g = -expf(a_log[h]) * sp;
#pragma unroll
        for (int o = 1; o < 64; o <<= 1) { const float t = __shfl_up(g, o); if (lane >= o) g += t; }
        gcs[lane] = g; bts[lane] = 1.0f / (1.0f + __expf(-braw));
        if (lane == 63) ((float*)(ws + WS_EG))[ch] = expf(g);
    }
    for (int i = tid; i < 64 * 65; i += 512) Ts[i] = 0.f;
    __syncthreads();
    {
        float cw[3][4][2];
#pragma unroll
        for (int sec = 0; sec < 3; ++sec)
#pragma unroll
            for (int j = 0; j < 4; ++j) { const f32x2 w = *(const f32x2*)(conv_w + j * 1536 + sec * 512 + h * 128 + 2 * lane); cw[sec][j][0] = w.x; cw[sec][j][1] = w.y; }
        const float glast = gcs[63];
        bf16* QG = (bf16*)(ws + WS_QG) + (size_t)ch * 8192; bf16* KD = (bf16*)(ws + WS_KD) + (size_t)ch * 8192;
#pragma unroll
        for (int rr = 0; rr < 8; ++rr) {
            const int r = wave * 8 + rr;
            float val[3][2];
#pragma unroll
            for (int sec = 0; sec < 3; ++sec) { float v0 = 0.f, v1 = 0.f;
#pragma unroll
                for (int j = 0; j < 4; ++j) { v0 += bflo(raw[rr + j][sec]) * cw[sec][j][0]; v1 += bfhi(raw[rr + j][sec]) * cw[sec][j][1]; }
                val[sec][0] = v0 / (1.f + __expf(-v0)); val[sec][1] = v1 / (1.f + __expf(-v1)); }
            const float ssq = wave_sum(val[0][0] * val[0][0] + val[0][1] * val[0][1]);
            const float ssk = wave_sum(val[1][0] * val[1][0] + val[1][1] * val[1][1]);
            const float rq = (1.0f / sqrtf(ssq + 1e-6f)) * 0.08838834764831845f, rk = 1.0f / sqrtf(ssk + 1e-6f);
            const float q0 = val[0][0] * rq, q1 = val[0][1] * rq, k0 = val[1][0] * rk, k1 = val[1][1] * rk;
            const float gr = gcs[r], be = bts[r], eq = __expf(gr), ek = __expf(glast - gr), bek = be * eq;
            *(LAS unsigned*)(L8 + PQ + r * 272 + 4 * lane) = cvtpk(q0, q1);
            *(LAS unsigned*)(L8 + PK + r * 272 + 4 * lane) = cvtpk(k0, k1);
            const unsigned vb = cvtpk(val[2][0] * be, val[2][1] * be), kb = cvtpk(k0 * bek, k1 * bek);
            *(LAS bf16*)(L8 + PVB + (2 * lane) * 144 + 2 * r) = (bf16)(vb & 0xffffu); *(LAS bf16*)(L8 + PVB + (2 * lane + 1) * 144 + 2 * r) = (bf16)(vb >> 16);
            *(LAS bf16*)(L8 + PKB + (2 * lane) * 144 + 2 * r) = (bf16)(kb & 0xffffu); *(LAS bf16*)(L8 + PKB + (2 * lane + 1) * 144 + 2 * r) = (bf16)(kb >> 16);
            const int d = 2 * lane;
            *(unsigned*)(QG + r * 128 + (d & 96) + kperm(d & 31)) = cvtpk(q0 * eq, q1 * eq);
            const int tp = (r & 32) + kperm(r & 31); const unsigned kd = cvtpk(k0 * ek, k1 * ek);
            KD[d * 64 + tp] = (bf16)(kd & 0xffffu); KD[(d + 1) * 64 + tp] = (bf16)(kd >> 16);
        }
    }
    __syncthreads();
    {
        bf16* Aout = (bf16*)(ws + WS_A) + (size_t)ch * 4096;
#pragma unroll
        for (int t2 = 0; t2 < 2; ++t2) {
            const int idx = 2 * wave + t2, ct = idx >> 2, jt = idx & 3;
            f32x4 acc1 = {0.f, 0.f, 0.f, 0.f}, acc2 = {0.f, 0.f, 0.f, 0.f};
#pragma unroll
            for (int ks = 0; ks < 4; ++ks) {
                const bf16x8 kc = *(const LAS bf16x8*)(L8 + PK + (16 * ct + jl) * 272 + (32 * ks + 8 * kq) * 2);
                const bf16x8 kj = *(const LAS bf16x8*)(L8 + PK + (16 * jt + jl) * 272 + (32 * ks + 8 * kq) * 2);
                const bf16x8 qc = *(const LAS bf16x8*)(L8 + PQ + (16 * ct + jl) * 272 + (32 * ks + 8 * kq) * 2);
                acc1 = __builtin_amdgcn_mfma_f32_16x16x32_bf16(kc, kj, acc1, 0, 0, 0);
                acc2 = __builtin_amdgcn_mfma_f32_16x16x32_bf16(kj, qc, acc2, 0, 0, 0);
            }
            { const int j = 16 * jt + jl; const float gj = gcs[j];
#pragma unroll
              for (int e = 0; e < 4; ++e) { const int c = 16 * ct + 4 * kq + e; As[c * 65 + j] = (j < c) ? bts[c] * acc1[e] * __expf(gcs[c] - gj) : 0.f; } }
            { const int c = 16 * ct + jl; const float gc_ = gcs[c]; float pv[4];
#pragma unroll
              for (int e = 0; e < 4; ++e) { const int j = 16 * jt + 4 * kq + e; pv[e] = (j <= c) ? acc2[e] * __expf(gc_ - gcs[j]) : 0.f; }
              v2u w; w.x = cvtpk(pv[0], pv[1]); w.y = cvtpk(pv[2], pv[3]);
              *(v2u*)(Aout + c * 64 + 32 * (jt >> 1) + 8 * kq + 4 * (jt & 1)) = w; }
        }
    }
    __syncthreads();
    if (wave == 0) {
        const int bb = lane >> 4, col = lane & 15;
        float xv[16];
#pragma unroll
        for (int c = 0; c < 16; ++c) { float s = (c == col) ? 1.f : 0.f;
#pragma unroll
            for (int j = 0; j < c; ++j) s -= As[(16 * bb + c) * 65 + 16 * bb + j] * xv[j];
            xv[c] = s; }
#pragma unroll
        for (int c = 0; c < 16; ++c) Ts[(16 * bb + c) * 65 + 16 * bb + col] = xv[c];
    }
    __syncthreads();
    {
        const int pr = tid >> 8, i = (tid >> 4) & 15, jj = tid & 15, hb = 32 * pr + 16, lb = 32 * pr;
        float s = 0.f;
#pragma unroll
        for (int k = 0; k < 16; ++k) s += As[(hb + i) * 65 + lb + k] * Ts[(lb + k) * 65 + lb + jj];
        Ms[(hb + i) * 65 + lb + jj] = s;
        __syncthreads();
        float t = 0.f;
#pragma unroll
        for (int k = 0; k < 16; ++k) t += Ts[(hb + i) * 65 + hb + k] * Ms[(hb + k) * 65 + lb + jj];
        Ts[(hb + i) * 65 + lb + jj] = -t;
    }
    __syncthreads();
    {
        const int i = tid >> 4, j0 = (tid & 15) * 2;
        float s0 = 0.f, s1 = 0.f;
#pragma unroll 8
        for (int k = 0; k < 32; ++k) { const float av = As[(32 + i) * 65 + k]; s0 += av * Ts[k * 65 + j0]; s1 += av * Ts[k * 65 + j0 + 1]; }
        Ms[(32 + i) * 65 + j0] = s0; Ms[(32 + i) * 65 + j0 + 1] = s1;
        __syncthreads();
        float t0 = 0.f, t1 = 0.f;
#pragma unroll 8
        for (int k = 0; k < 32; ++k) { const float tv = Ts[(32 + i) * 65 + 32 + k]; t0 += tv * Ms[(32 + k) * 65 + j0]; t1 += tv * Ms[(32 + k) * 65 + j0 + 1]; }
        __syncthreads();
        Ts[(32 + i) * 65 + j0] = -t0; Ts[(32 + i) * 65 + j0 + 1] = -t1;
    }
    __syncthreads();
#pragma unroll
    for (int i = 0; i < 4; ++i) { const int idx2 = tid + 512 * i, r = idx2 >> 5, c = (idx2 & 31) * 2;
        *(LAS unsigned*)(L8 + PTB + r * 144 + 2 * c) = cvtpk(Ts[r * 65 + c], Ts[r * 65 + c + 1]); }
    __syncthreads();
    {
        bf16* U = (bf16*)(ws + WS_U) + (size_t)ch * 8192; bf16* W = (bf16*)(ws + WS_W) + (size_t)ch * 8192;
        const int mt = wave & 3, ntb = 4 * (wave >> 2);
        bf16x8 ta[2];
#pragma unroll
        for (int ks = 0; ks < 2; ++ks) ta[ks] = *(const LAS bf16x8*)(L8 + PTB + (16 * mt + jl) * 144 + (32 * ks + 8 * kq) * 2);
#pragma unroll
        for (int q = 0; q < 4; ++q) { const int nt = ntb + q; f32x4 acc = {0.f, 0.f, 0.f, 0.f};
#pragma unroll
            for (int ks = 0; ks < 2; ++ks) { const bf16x8 vb = *(const LAS bf16x8*)(L8 + PVB + (16 * nt + jl) * 144 + (32 * ks + 8 * kq) * 2);
                acc = __builtin_amdgcn_mfma_f32_16x16x32_bf16(ta[ks], vb, acc, 0, 0, 0); }
            v2u w; w.x = cvtpk(acc[0], acc[1]); w.y = cvtpk(acc[2], acc[3]);
            *(v2u*)(U + (16 * nt + jl) * 64 + 16 * mt + 4 * kq) = w; }
        bf16x8 ka[2];
#pragma unroll
        for (int ks = 0; ks < 2; ++ks) ka[ks] = *(const LAS bf16x8*)(L8 + PKB + (16 * wave + jl) * 144 + (32 * ks + 8 * kq) * 2);
#pragma unroll
        for (int ctile = 0; ctile < 4; ++ctile) { f32x4 acc = {0.f, 0.f, 0.f, 0.f};
#pragma unroll
            for (int ks = 0; ks < 2; ++ks) { const bf16x8 tb = *(const LAS bf16x8*)(L8 + PTB + (16 * ctile + jl) * 144 + (32 * ks + 8 * kq) * 2);
                acc = __builtin_amdgcn_mfma_f32_16x16x32_bf16(ka[ks], tb, acc, 0, 0, 0); }
            v2u w; w.x = cvtpk(-acc[0], -acc[1]); w.y = cvtpk(-acc[2], -acc[3]);
            *(v2u*)(W + (16 * ctile + jl) * 128 + 32 * (wave >> 1) + 8 * kq + 4 * (wave & 1)) = w; }
    }
    __syncthreads();
}

__device__ __forceinline__ bf16x8 pack8(const f32x4& a, const f32x4& b) { v4u w; w.x = cvtpk(a[0], a[1]); w.y = cvtpk(a[2], a[3]); w.z = cvtpk(b[0], b[1]); w.w = cvtpk(b[2], b[3]); return __builtin_bit_cast(bf16x8, w); }
constexpr int SC_W = 0, SC_QG = 17408, SC_KDT = 34816, SC_A = 53248, SC_U = 62464, SC_BUF = 67072;
constexpr int SC_OUT = 2 * SC_BUF;
struct ScanRegs { v4u st[15]; };
__device__ __forceinline__ void sc_load(ScanRegs& R, const unsigned char* ws, int chx, int t, int qtr) {
    const unsigned vo = (unsigned)t * 16u;
    const unsigned char* pw = ws + WS_W + (size_t)chx * 16384; const unsigned char* pq = ws + WS_QG + (size_t)chx * 16384; const unsigned char* pk = ws + WS_KD + (size_t)chx * 16384;
    const unsigned char* pa = ws + WS_A + (size_t)chx * 8192; const unsigned char* pu = ws + WS_U + (size_t)chx * 16384 + qtr * 4096;
#define SC_LDG(k, p) do { R.st[k] = *(const v4u*)(p); __builtin_amdgcn_sched_barrier(0); } while (0)
    __builtin_amdgcn_sched_barrier(0);
    SC_LDG(0, pw + vo); SC_LDG(1, pw + 4096 + vo); SC_LDG(2, pw + 8192 + vo); SC_LDG(3, pw + 12288 + vo);
    SC_LDG(4, pq + vo); SC_LDG(5, pq + 4096 + vo); SC_LDG(6, pq + 8192 + vo); SC_LDG(7, pq + 12288 + vo);
    SC_LDG(8, pk + vo); SC_LDG(9, pk + 4096 + vo); SC_LDG(10, pk + 8192 + vo); SC_LDG(11, pk + 12288 + vo);
    SC_LDG(12, pa + vo); SC_LDG(13, pa + 4096 + vo); SC_LDG(14, pu + vo);
#undef SC_LDG
}
__device__ __forceinline__ void sc_write(const ScanRegs& R, LAS unsigned char* B_, int t) {
    LAS unsigned char* w16 = B_ + (t >> 4) * 272 + (t & 15) * 16;
    LAS unsigned char* k8 = B_ + (t >> 3) * 144 + (t & 7) * 16;
#define SC_STL(k, p) do { *(LAS v4u*)(p) = R.st[k]; __builtin_amdgcn_sched_barrier(0); } while (0)
    __builtin_amdgcn_sched_barrier(0);
    SC_STL(0, w16 + SC_W); SC_STL(1, w16 + SC_W + 16 * 272); SC_STL(2, w16 + SC_W + 32 * 272); SC_STL(3, w16 + SC_W + 48 * 272);
    SC_STL(4, w16 + SC_QG); SC_STL(5, w16 + SC_QG + 16 * 272); SC_STL(6, w16 + SC_QG + 32 * 272); SC_STL(7, w16 + SC_QG + 48 * 272);
    SC_STL(8, k8 + SC_KDT); SC_STL(9, k8 + SC_KDT + 32 * 144); SC_STL(10, k8 + SC_KDT + 64 * 144); SC_STL(11, k8 + SC_KDT + 96 * 144);
    SC_STL(12, k8 + SC_A); SC_STL(13, k8 + SC_A + 32 * 144); SC_STL(14, k8 + SC_U);
#undef SC_STL
}
#define SC_BARRIER() do { asm volatile("s_waitcnt lgkmcnt(0)" ::: "memory"); __builtin_amdgcn_s_barrier(); asm volatile("" ::: "memory"); } while (0)
__device__ __forceinline__ void sc_step_compute(LAS unsigned char* L8, int n, int jl, int kq, int wcol, float egv, f32x4 (&Sacc)[8]) {
    const float eg = __builtin_bit_cast(float, __builtin_amdgcn_readlane(__builtin_bit_cast(int, egv), n));
    const LAS unsigned char* B = L8 + (n & 1) * SC_BUF;
    bf16x8 sb[4];
#pragma unroll
    for (int ks = 0; ks < 4; ++ks) sb[ks] = pack8(Sacc[2 * ks], Sacc[2 * ks + 1]);
    f32x4 vn[4], oa[4];
#pragma unroll
    for (int mt = 0; mt < 4; ++mt) { const v2u u = *(const LAS v2u*)(B + SC_U + (wcol + jl) * 144 + (16 * mt + 4 * kq) * 2);
        vn[mt] = (f32x4){bflo(u.x), bfhi(u.x), bflo(u.y), bfhi(u.y)}; oa[mt] = (f32x4){0.f, 0.f, 0.f, 0.f}; }
    const LAS unsigned char* pW = B + SC_W + jl * 272 + kq * 16; const LAS unsigned char* pQ = B + SC_QG + jl * 272 + kq * 16;
    const LAS unsigned char* pK = B + SC_KDT + jl * 144 + kq * 16; const LAS unsigned char* pA = B + SC_A + jl * 144 + kq * 16;
#define SC_LD_WQ(dst, mt) do { _Pragma("unroll") for (int ks = 0; ks < 4; ++ks) { dst[ks] = *(const LAS bf16x8*)(pW + (mt) * 16 * 272 + ks * 64); dst[4 + ks] = *(const LAS bf16x8*)(pQ + (mt) * 16 * 272 + ks * 64); } } while (0)
#define SC_LD_K(dst, t0) do { _Pragma("unroll") for (int t = 0; t < 4; ++t) _Pragma("unroll") for (int k2 = 0; k2 < 2; ++k2) dst[2 * t + k2] = *(const LAS bf16x8*)(pK + ((t0) + t) * 16 * 144 + k2 * 64); } while (0)
#define SC_LD_A(dst) do { _Pragma("unroll") for (int mt = 0; mt < 4; ++mt) _Pragma("unroll") for (int k2 = 0; k2 < 2; ++k2) dst[2 * mt + k2] = *(const LAS bf16x8*)(pA + mt * 16 * 144 + k2 * 64); } while (0)
#define SC_MM_WQ(src, mt) do { _Pragma("unroll") for (int ks = 0; ks < 4; ++ks) { vn[mt] = __builtin_amdgcn_mfma_f32_16x16x32_bf16(src[ks], sb[ks], vn[mt], 0, 0, 0); oa[mt] = __builtin_amdgcn_mfma_f32_16x16x32_bf16(src[4 + ks], sb[ks], oa[mt], 0, 0, 0); } } while (0)
#define SC_MM_K(src, t0) do { _Pragma("unroll") for (int k2 = 0; k2 < 2; ++k2) _Pragma("unroll") for (int t = 0; t < 4; ++t) Sacc[(t0) + t] = __builtin_amdgcn_mfma_f32_16x16x32_bf16(src[2 * t + k2], vb[k2], Sacc[(t0) + t], 0, 0, 0); } while (0)
#define SC_MM_A(src) do { _Pragma("unroll") for (int k2 = 0; k2 < 2; ++k2) _Pragma("unroll") for (int mt = 0; mt < 4; ++mt) oa[mt] = __builtin_amdgcn_mfma_f32_16x16x32_bf16(src[2 * mt + k2], vb[k2], oa[mt], 0, 0, 0); } while (0)
#define SC_SB() __builtin_amdgcn_sched_barrier(0)
    bf16x8 fa[8], fb[8];
    SC_LD_WQ(fa, 0); SC_LD_WQ(fb, 1); SC_SB();
    SC_MM_WQ(fa, 0); SC_SB(); SC_LD_WQ(fa, 2); SC_SB();
    SC_MM_WQ(fb, 1); SC_SB(); SC_LD_WQ(fb, 3); SC_SB();
    SC_MM_WQ(fa, 2); SC_SB(); SC_LD_K(fa, 0); SC_SB();
    SC_MM_WQ(fb, 3); SC_SB(); SC_LD_K(fb, 4); SC_SB();
    bf16x8 vb[2];
    vb[0] = pack8(vn[0], vn[1]); vb[1] = pack8(vn[2], vn[3]);
#pragma unroll
    for (int T = 0; T < 8; ++T) Sacc[T] = Sacc[T] * eg;
    SC_SB();
    SC_MM_K(fa, 0); SC_SB(); SC_LD_A(fa); SC_SB();
    SC_MM_K(fb, 4); SC_SB();
    SC_MM_A(fa);
#undef SC_LD_WQ
#undef SC_LD_K
#undef SC_LD_A
#undef SC_MM_WQ
#undef SC_MM_K
#undef SC_MM_A
#undef SC_SB
    LAS unsigned char* ob = L8 + SC_OUT + (n & 1) * 4096 + (4 * kq) * 64 + (wcol + jl) * 2;
#pragma unroll
    for (int mt = 0; mt < 4; ++mt)
#pragma unroll
        for (int e = 0; e < 4; ++e) *(LAS bf16*)(ob + (16 * mt + e) * 64) = (bf16)f2bf(oa[mt][e]);
    SC_BARRIER();
}
__device__ __forceinline__ void sc_out_tile(LAS unsigned char* L8, bf16* MIX, int b, int h, int qtr, int n, int l_) {
    const LAS unsigned char* ob = L8 + SC_OUT + (n & 1) * 4096 + l_ * 64;
    const v4u w0 = *(const LAS v4u*)ob, w1 = *(const LAS v4u*)(ob + 16), w2 = *(const LAS v4u*)(ob + 32), w3 = *(const LAS v4u*)(ob + 48);
    bf16* gp = MIX + (size_t)(b * SEQ + n * 64 + l_) * 1024 + 512 + h * 128 + qtr * 32;
    *(v4u*)gp = w0; *(v4u*)(gp + 8) = w1; *(v4u*)(gp + 16) = w2; *(v4u*)(gp + 24) = w3;
}
__device__ __forceinline__ void dn_scan_mfma(const Args& a, LAS unsigned char* L8, int item, int tid, int lane, int wave) {
    unsigned char* ws = a.ws;
    const int xcd_ = item & 7, slot_ = item >> 3;
    const int bh = xcd_ * 2 + (slot_ >> 2), qtr = slot_ & 3, b = bh >> 2, h = bh & 3;
    if (wave < 2) {
        const int jl = lane & 15, kq = lane >> 4;
        f32x4 Sacc[8];
#pragma unroll
        for (int T = 0; T < 8; ++T) Sacc[T] = (f32x4){0.f, 0.f, 0.f, 0.f};
        const float egv = ((const float*)(ws + WS_EG))[bh * 64 + lane];
        asm volatile("s_waitcnt vmcnt(0)" ::: "memory");
        SC_BARRIER();
        for (int n = 0; n < 64; ++n) sc_step_compute(L8, n, jl, kq, wave * 16, egv, Sacc);
    } else if (wave < 6) {
        ScanRegs R0, R1, R2; const int t = tid - 128, c0 = bh * 64;
        sc_load(R0, ws, c0, t, qtr); sc_write(R0, L8, t);
        sc_load(R1, ws, c0 + 1, t, qtr); sc_load(R2, ws, c0 + 2, t, qtr); sc_load(R0, ws, c0 + 3, t, qtr);
        SC_BARRIER();
        for (int n = 0; n < 63; n += 3) {
            sc_write(R1, L8 + ((n + 1) & 1) * SC_BUF, t);
            sc_load(R1, ws, c0 + (n + 4 < 63 ? n + 4 : 63), t, qtr);
            SC_BARRIER();
            sc_write(R2, L8 + ((n + 2) & 1) * SC_BUF, t);
            sc_load(R2, ws, c0 + (n + 5 < 63 ? n + 5 : 63), t, qtr);
            SC_BARRIER();
            sc_write(R0, L8 + ((n + 3) & 1) * SC_BUF, t);
            sc_load(R0, ws, c0 + (n + 6 < 63 ? n + 6 : 63), t, qtr);
            SC_BARRIER();
        }
        SC_BARRIER();
    } else if (wave == 6) {
        SC_BARRIER();
        for (int n = 0; n < 64; ++n) SC_BARRIER();
    } else {
        bf16* MIX = (bf16*)(ws + WS_XN);
        SC_BARRIER();
        for (int n = 0; n < 64; ++n) { if (n > 0) sc_out_tile(L8, MIX, b, h, qtr, n - 1, lane); SC_BARRIER(); }
        sc_out_tile(L8, MIX, b, h, qtr, 63, lane);
    }
    __syncthreads();
}

typedef float f32x16 __attribute__((ext_vector_type(16)));
typedef short s16x4 __attribute__((ext_vector_type(4)));
__device__ __forceinline__ s16x4 vtr(const LAS unsigned char* p) { return __builtin_bit_cast(s16x4, __builtin_amdgcn_ds_read_tr16_b64_v4i16((LAS s16x4*)p)); }
constexpr int KVP = 144;
constexpr int KV_BYTES = 384 * KVP;
constexpr size_t WS_ML = 173 * MiB;
constexpr size_t WS_SS = 176 * MiB;
constexpr size_t WS_XNB2 = 184 * MiB;
__device__ __forceinline__ void attn_item(const bf16* Qh, const bf16* KVh, bf16* PROJ, float* ML, LAS unsigned char* L8, int item, int tid, int lane, int wave) {
    asm volatile("" : "+v"(lane));
    const int bh = item / 48, rem = item - bh * 48, p = rem >> 4, sub = rem & 15;
    const int b = bh >> 3, h = bh & 7;
    const int dsh = 2 * p, dil = 1 << dsh, nsh = 4 - dsh;
    const int r = sub >> nsh, qb = sub & ((1 << nsh) - 1);
    const int base = 256 * qb;
    const bf16* KVb = KVh + (size_t)(bh * 4096 + r) * 128;
#pragma unroll
    for (int i = 0; i < 12; ++i) { const int id = tid + 512 * i, row = id >> 4, ch = id & 15, idx = base - 128 + row;
        v4u kv = (v4u){0u, 0u, 0u, 0u};
        if (idx >= 0) kv = *(const v4u*)(KVb + (size_t)(dil * idx) * 128 + ch * 8);
        *(LAS v4u*)(L8 + ((ch & 8) ? KV_BYTES : 0) + row * KVP + (ch & 7) * 16) = kv; }
    const int ql = lane & 31, kh = lane >> 5;
    const int tq = r + dil * (base + 32 * wave + ql);
    const size_t tokq = (size_t)b * SEQ + tq;
    bf16x8 qf[4];
#pragma unroll
    for (int s = 0; s < 4; ++s) qf[s] = *(const bf16x8*)(Qh + ((size_t)bh * 4096 + tq) * 64 + 16 * s + 8 * kh);
    __syncthreads();
    f32x16 sc[5];
    {
        const LAS unsigned char* Kp = L8 + (32 * wave + ql) * KVP + kh * 16;
        bf16x8 kf[2][4];
#pragma unroll
        for (int s = 0; s < 4; ++s) kf[0][s] = *(const LAS bf16x8*)(Kp + s * 32);
#pragma unroll
        for (int kt = 0; kt < 5; ++kt) {
            if (kt + 1 < 5) {
#pragma unroll
                for (int s = 0; s < 4; ++s) kf[(kt + 1) & 1][s] = *(const LAS bf16x8*)(Kp + (kt + 1) * 32 * KVP + s * 32); }
            __builtin_amdgcn_sched_barrier(0);
            f32x16 acc = {};
#pragma unroll
            for (int s = 0; s < 4; ++s) acc = __builtin_amdgcn_mfma_f32_32x32x16_bf16(kf[kt & 1][s], qf[s], acc, 0, 0, 0);
            sc[kt] = acc;
            __builtin_amdgcn_sched_barrier(0);
        }
    }
    const float LOG2E = 1.4426950408889634f;
    const float c1 = 0.125f * LOG2E, c2 = exp2f(-(float)(h + 1)) * (float)dil * LOG2E;
    const float Al = -c2 * (float)(128 + ql - 4 * kh);
    float mx = -INFINITY;
#pragma unroll
    for (int kt = 0; kt < 5; ++kt)
#pragma unroll
        for (int rr = 0; rr < 16; ++rr) { const int kc = (rr & 3) + 8 * (rr >> 2);
            float v = fmaf(sc[kt][rr], c1, fmaf(c2, (float)(32 * kt + kc), Al));
            if (kt == 0) v = (kc + 4 * kh >= ql) ? v : -INFINITY;
            if (kt == 4) v = (kc + 4 * kh <= ql) ? v : -INFINITY;
            sc[kt][rr] = v; }
    if (base == 0) {
#pragma unroll
        for (int kt = 0; kt < 4; ++kt)
#pragma unroll
            for (int rr = 0; rr < 16; ++rr) { const int kidx = -128 + 32 * (wave + kt) + (rr & 3) + 8 * (rr >> 2) + 4 * kh; sc[kt][rr] = (kidx >= 0) ? sc[kt][rr] : -INFINITY; }
    }
#pragma unroll
    for (int kt = 0; kt < 5; ++kt)
#pragma unroll
        for (int rr = 0; rr < 16; ++rr) mx = fmaxf(mx, sc[kt][rr]);
    mx = fmaxf(mx, __shfl_xor(mx, 32));
    float lsum = 0.f;
#pragma unroll
    for (int kt = 0; kt < 5; ++kt)
#pragma unroll
        for (int rr = 0; rr < 16; ++rr) { const float pv = __builtin_amdgcn_exp2f(sc[kt][rr] - mx); sc[kt][rr] = pv; lsum += pv; }
    lsum += __shfl_xor(lsum, 32);
    f32x16 o[2]; o[0] = (f32x16){}; o[1] = (f32x16){};
    {
        const int q4 = (lane & 15) >> 2, pp = lane & 3, blk = (lane >> 4) & 1;
        const LAS unsigned char* Vb = L8 + KV_BYTES + (32 * wave + 4 * kh + q4) * KVP + (16 * blk + 4 * pp) * 2;
        s16x4 vf[3][4];
#define AT_LDV(set, step) do { const LAS unsigned char* vr_ = Vb + (16 * (step)) * KVP; vf[set][0] = vtr(vr_); vf[set][1] = vtr(vr_ + 8 * KVP); vf[set][2] = vtr(vr_ + 64); vf[set][3] = vtr(vr_ + 8 * KVP + 64); } while (0)
        AT_LDV(0, 0); AT_LDV(1, 1);
#pragma unroll
        for (int st = 0; st < 10; ++st) {
            if (st + 2 < 10) AT_LDV((st + 2) % 3, st + 2);
            __builtin_amdgcn_sched_barrier(0);
            const int kt = st >> 1, s2 = st & 1;
            v4u pw; pw.x = cvtpk(sc[kt][8 * s2 + 0], sc[kt][8 * s2 + 1]); pw.y = cvtpk(sc[kt][8 * s2 + 2], sc[kt][8 * s2 + 3]); pw.z = cvtpk(sc[kt][8 * s2 + 4], sc[kt][8 * s2 + 5]); pw.w = cvtpk(sc[kt][8 * s2 + 6], sc[kt][8 * s2 + 7]);
            const bf16x8 pb = __builtin_bit_cast(bf16x8, pw);
            const s16x4 l0 = vf[st % 3][0], h0 = vf[st % 3][1], l1 = vf[st % 3][2], h1 = vf[st % 3][3];
            o[0] = __builtin_amdgcn_mfma_f32_32x32x16_bf16((bf16x8){l0[0], l0[1], l0[2], l0[3], h0[0], h0[1], h0[2], h0[3]}, pb, o[0], 0, 0, 0);
            o[1] = __builtin_amdgcn_mfma_f32_32x32x16_bf16((bf16x8){l1[0], l1[1], l1[2], l1[3], h1[0], h1[1], h1[2], h1[3]}, pb, o[1], 0, 0, 0);
            __builtin_amdgcn_sched_barrier(0);
        }
#undef AT_LDV
    }
    const float inv = 1.0f / lsum;
    bf16* dst = PROJ + tokq * P2LD + p * 512 + h * 64 + 4 * kh;
#pragma unroll
    for (int c = 0; c < 2; ++c)
#pragma unroll
        for (int g = 0; g < 4; ++g) { v2u w; w.x = cvtpk(o[c][4 * g + 0] * inv, o[c][4 * g + 1] * inv); w.y = cvtpk(o[c][4 * g + 2] * inv, o[c][4 * g + 3] * inv);
            *(v2u*)(dst + 32 * c + 8 * g) = w; }
    if (kh == 0) { float* ml = ML + ((tokq * 8 + h) * 3 + p) * 2; *(f32x2*)ml = (f32x2){mx, lsum}; }
    __syncthreads();
}

#define XB_TMO      128
#define XB_XCNT(j)  (256  + 64 * (j))
#define XB_XSUB(j)  (1280 + 64 * (j))
#define XB_XGEN(j)  (2304 + 64 * (j))
#define XB_TOP      3328
#define XB_TOPGEN   3392
#define XCD_BAR_WORDS 3456
#define XB_SPIN_CAP (1u << 18)

__device__ __forceinline__ unsigned xb_ld(unsigned* p)              { return __hip_atomic_load(p, __ATOMIC_RELAXED, __HIP_MEMORY_SCOPE_AGENT); }
__device__ __forceinline__ unsigned xb_add(unsigned* p, unsigned v) { return __hip_atomic_fetch_add(p, v, __ATOMIC_RELAXED, __HIP_MEMORY_SCOPE_AGENT); }
__device__ __forceinline__ unsigned xb_xcc_id() { return (unsigned)__builtin_amdgcn_s_getreg((3 << 11) | 20) & 0xFu; }
#define XB_SPIN(cond, bar) do { unsigned _sp = 0; while (cond) { __builtin_amdgcn_s_sleep(1); \
    if ((++_sp & 255u) == 0u) { if (xb_ld(&(bar)[XB_TMO])) break; if (_sp > XB_SPIN_CAP) { atomicAdd(&(bar)[XB_TMO], 1u); break; } } } } while (0)

struct XcdBarrier {
    unsigned* bar; unsigned x;
    volatile LAS unsigned* st;
};

__device__ __forceinline__ XcdBarrier xcd_barrier_post(unsigned* bar, volatile LAS unsigned* st) {
    XcdBarrier b; b.bar = bar; b.x = xb_xcc_id(); b.st = st;
    if (threadIdx.x == 0) (void)xb_add(&bar[XB_XCNT(b.x)], 1u);
    return b;
}
__device__ __forceinline__ void xcd_barrier_complete(unsigned* bar, unsigned x, unsigned& nloc, unsigned& nx) {
    const unsigned G = gridDim.x * gridDim.y * gridDim.z;
    unsigned sum, cnt, mine, sp = 0u;
    for (;;) {
        sum = 0u; cnt = 0u; mine = 0u;
#pragma unroll
        for (unsigned j = 0; j < 16; ++j) { const unsigned c = xb_ld(&bar[XB_XCNT(j)]); sum += c; cnt += (c > 0u) ? 1u : 0u; mine = (j == x) ? c : mine; }
        if (sum == G) break;
        __builtin_amdgcn_s_sleep(1);
        if ((++sp & 255u) == 0u) { if (xb_ld(&bar[XB_TMO])) break; if (sp > XB_SPIN_CAP) { atomicAdd(&bar[XB_TMO], 1u); break; } }
    }
    nloc = mine > 0u ? mine : 1u; nx = cnt > 0u ? cnt : 1u;
}

__device__ __forceinline__ void xcd_barrier(const XcdBarrier& b) {
    asm volatile("s_waitcnt vmcnt(0)" ::: "memory");
    __syncthreads();
    if (threadIdx.x == 0) {
        unsigned* bar = b.bar;
        __builtin_amdgcn_s_waitcnt(0);
        unsigned nloc = b.st[0], nx = b.st[1];
        if (nloc == 0u) { xcd_barrier_complete(bar, b.x, nloc, nx); b.st[0] = nloc; b.st[1] = nx; }
        const unsigned old = xb_add(&bar[XB_XSUB(b.x)], 1u);
        const unsigned gen = old / nloc;
        if (old + 1u == (gen + 1u) * nloc) {
            __builtin_amdgcn_fence(__ATOMIC_RELEASE, "agent");
            asm volatile("s_waitcnt vmcnt(0)" ::: "memory");
            const unsigned og = xb_add(&bar[XB_TOP], 1u);
            const unsigned tg = og / nx;
            if (og + 1u == (tg + 1u) * nx) xb_add(&bar[XB_TOPGEN], 1u);
            else XB_SPIN(xb_ld(&bar[XB_TOPGEN]) == tg, bar);
            __builtin_amdgcn_fence(__ATOMIC_ACQUIRE, "agent");
            xb_add(&bar[XB_XGEN(b.x)], 1u);
            asm volatile("s_waitcnt vmcnt(0)" ::: "memory");
        } else {
            XB_SPIN(xb_ld(&bar[XB_XGEN(b.x)]) == gen, bar);
            __builtin_amdgcn_fence(__ATOMIC_ACQUIRE, "agent");
            asm volatile("s_waitcnt vmcnt(0)" ::: "memory");
        }
    }
    __syncthreads();
}

__global__ void __launch_bounds__(NWAVES * 64, 2) fwd_megakernel(Args a) {
    extern __shared__ __attribute__((aligned(16))) unsigned char lds[];
    cg::grid_group grid = cg::this_grid();
    LAS unsigned char* L8 = (LAS unsigned char*)lds;
    LAS float* L = (LAS float*)lds;
    const int tid = threadIdx.x, lane = tid & 63, wave = __builtin_amdgcn_readfirstlane(tid >> 6);
    const int G = gridDim.x, gw = blockIdx.x * NWAVES + wave, NGW = G * NWAVES;
    unsigned char* ws = a.ws;
    unsigned* ctl = (unsigned*)(ws + WS_CTL);
    const float* x = a.in[0];
    bf16* XN = (bf16*)(ws + WS_XN); bf16* ACT = (bf16*)(ws + WS_ACT); bf16* PROJ = ACT; bf16* MIX = XN;
    bf16* Wgu1 = (bf16*)(ws + WS_WGU1); bf16* Wd1 = (bf16*)(ws + WS_WD1); bf16* Win = (bf16*)(ws + WS_WIN); bf16* Wout = (bf16*)(ws + WS_WOUT);
    bf16* Wgu2 = (bf16*)(ws + WS_WGU2); bf16* Wd2 = (bf16*)(ws + WS_WD2);
    float* out = a.out;
    volatile LAS unsigned* xbst = (volatile LAS unsigned*)(L8 + LDS_BYTES - 64);
    if (tid < 2) xbst[tid] = 0u;
    __syncthreads();
    XcdBarrier bar = xcd_barrier_post(ctl + 1024, xbst);
#define GSYNC() xcd_barrier(bar)

    {
        const int lane = opq(tid) & 63;
        LAS float* scr = L + wave * 4096;
        constexpr int I_GU = (D / 64) * (NGU / 32), I_D = (FF / 64) * (D / 32), I_IN = (D / 64) * (NIN / 32), I_O = (D / 64) * (D / 32);
        for (int it = gw; it < I_GU; it += NGW) tr_gu(a.in[2], a.in[3], Wgu1, it, scr, lane);
        for (int m = gw; m < M; m += NGW) { f32x4 v[4]; rms_row(x + (size_t)m * D, a.in[1], lane, v); store_row_bf16(XN + (size_t)m * D, lane, v); }
    }
    GSYNC();
    if (a.ws == nullptr) grid.sync();
    {
        pg8::Gemm g{XN, Wgu1, M, NGU, D}; pg8::StaticOrder S; S.init(M, NGU, G, (int)blockIdx.x);
        pg8::EpiSwiGLU<false> E{ACT, FF, nullptr};
        pg8::gemm_phase<pg8::EpiSwiGLU<false>, pg8::StaticOrder, true, true>(L8, g, S, E);
        {
            constexpr int I_D = (FF / 64) * (D / 32), I_IN = (D / 64) * (NIN / 32), I_O = (D / 64) * (D / 32);
            const int rem = ((M / 256) * (NGU / 256)) % G, nbf = rem ? G - rem : G, jf = rem ? (int)blockIdx.x - rem : (int)blockIdx.x;
            if (jf >= 0) { const int lane_f = opq(tid) & 63; LAS float* scr = L + wave * 4096;
                for (int it = jf * NWAVES + wave; it < I_D + I_IN + I_O; it += nbf * NWAVES) { int r = it;
                    if (r < I_D) { tr_plain(a.in[4], FF, D, Wd1, r, scr, lane_f); continue; } r -= I_D;
                    if (r < I_IN) { tr_win(a.in[6], Win, r, scr, lane_f, a.in[5]); continue; } r -= I_IN;
                    tr_plain(a.in[11], D, D, Wout, r, scr, lane_f); } }
        }
    }
    GSYNC();
    {
        pg8::Gemm g{ACT, Wd1, M, D, FF}; pg8::StaticOrder S; S.init(M, D, G, (int)blockIdx.x);
        pg8::EpiRes<true> E{x, out, D, 0.5f, XN, (float*)(ws + WS_SS)};
        pg8::gemm_phase<pg8::EpiRes<true>, pg8::StaticOrder, true, true>(L8, g, S, E);
    }
    GSYNC();
    {
        pg8::Gemm g{XN, Win, M, NIN, D}; pg8::StaticOrder S; S.init(M, NIN, G, (int)blockIdx.x);
        pg8::EpiProj E{(bf16*)(ws + WS_QH), (bf16*)(ws + WS_KVH), PROJ, (float*)(ws + WS_BD), (const float*)(ws + WS_SS)};
        pg8::gemm_phase<pg8::EpiProj, pg8::StaticOrder, true, true>(L8, g, S, E);
        {
            constexpr int I_GU = (D / 64) * (NGU / 32), I_D = (FF / 64) * (D / 32);
            const int rem = ((M / 256) * (NIN / 256)) % G, nbf = rem ? G - rem : G, jf = rem ? (int)blockIdx.x - rem : (int)blockIdx.x;
            if (jf >= 0) { const int lane_f = opq(tid) & 63; LAS float* scr = L + wave * 4096;
                for (int it = jf * NWAVES + wave; it < I_GU + I_D; it += nbf * NWAVES) {
                    if (it < I_GU) tr_gu(a.in[13], a.in[14], Wgu2, it, scr, lane_f, a.in[12]); else tr_plain(a.in[15], FF, D, Wd2, it - I_GU, scr, lane_f); } }
        }
    }
    GSYNC();
    { const int tid_ = opq(tid); for (int ch = blockIdx.x; ch < 1024; ch += G) dn_prep_item(a, L8, ch, tid_, tid_ & 63, wave); }
    GSYNC();
    {
        const int tid_ = opq(tid), lane = tid_ & 63;
        for (int it = blockIdx.x; it < 64; it += G) dn_scan_mfma(a, L8, it, tid_, lane, wave);
        float* ML = (float*)(ws + WS_ML);
        if ((int)blockIdx.x >= 64 || G <= 64) {
            const int nb = (G > 64) ? G - 64 : G, j0 = (G > 64) ? (int)blockIdx.x - 64 : (int)blockIdx.x;
            for (int item = j0; item < 1536; item += nb) attn_item((const bf16*)(ws + WS_QH), (const bf16*)(ws + WS_KVH), PROJ, ML, L8, item, tid, lane, wave);
        }
    }
    GSYNC();
    {
        const int lane = opq(tid) & 63;
        const float* dn_norm = a.in[10];
        for (int m = gw; m < M; m += NGW) {
            bf16* op = MIX + (size_t)m * 1024 + 512 + 8 * lane; const bf16* gp = PROJ + (size_t)m * P2LD + 1536 + 8 * lane;
            const v4u ow = *(const v4u*)op, gwv = *(const v4u*)gp;
            float o[8] = {bflo(ow.x), bfhi(ow.x), bflo(ow.y), bfhi(ow.y), bflo(ow.z), bfhi(ow.z), bflo(ow.w), bfhi(ow.w)};
            float gt[8] = {bflo(gwv.x), bfhi(gwv.x), bflo(gwv.y), bfhi(gwv.y), bflo(gwv.z), bfhi(gwv.z), bflo(gwv.w), bfhi(gwv.w)};
            float ss = 0.f;
#pragma unroll
            for (int i = 0; i < 8; ++i) ss += o[i] * o[i];
            ss += __shfl_xor(ss, 1); ss += __shfl_xor(ss, 2); ss += __shfl_xor(ss, 4); ss += __shfl_xor(ss, 8);
            const float rs = 1.0f / sqrtf(ss * (1.f / 128.f) + 1e-6f);
            const int d0 = (8 * lane) & 127;
            float r[8];
#pragma unroll
            for (int i = 0; i < 8; ++i) r[i] = o[i] * rs * dn_norm[d0 + i] * (gt[i] / (1.f + __expf(-gt[i])));
            v4u w; w.x = pk2(r[0], r[1]); w.y = pk2(r[2], r[3]); w.z = pk2(r[4], r[5]); w.w = pk2(r[6], r[7]);
            *(v4u*)op = w;
            {
                const int ha = lane >> 3;
                const float* ml = (const float*)(ws + WS_ML) + ((size_t)m * 8 + ha) * 6;
                const f32x2 a0 = *(const f32x2*)ml, a1 = *(const f32x2*)(ml + 2), a2 = *(const f32x2*)(ml + 4);
                const float mm = fmaxf(a0.x, fmaxf(a1.x, a2.x));
                const float w0 = a0.y * __builtin_amdgcn_exp2f(a0.x - mm), w1 = a1.y * __builtin_amdgcn_exp2f(a1.x - mm), w2 = a2.y * __builtin_amdgcn_exp2f(a2.x - mm);
                const float iw = 1.0f / (w0 + w1 + w2);
                const bf16* pp = PROJ + (size_t)m * P2LD + 8 * lane;
                const v4u p0 = *(const v4u*)pp, p1 = *(const v4u*)(pp + 512), p2 = *(const v4u*)(pp + 1024);
                float rr[8];
                rr[0] = w0 * bflo(p0.x) + w1 * bflo(p1.x) + w2 * bflo(p2.x); rr[1] = w0 * bfhi(p0.x) + w1 * bfhi(p1.x) + w2 * bfhi(p2.x);
                rr[2] = w0 * bflo(p0.y) + w1 * bflo(p1.y) + w2 * bflo(p2.y); rr[3] = w0 * bfhi(p0.y) + w1 * bfhi(p1.y) + w2 * bfhi(p2.y);
                rr[4] = w0 * bflo(p0.z) + w1 * bflo(p1.z) + w2 * bflo(p2.z); rr[5] = w0 * bfhi(p0.z) + w1 * bfhi(p1.z) + w2 * bfhi(p2.z);
                rr[6] = w0 * bflo(p0.w) + w1 * bflo(p1.w) + w2 * bflo(p2.w); rr[7] = w0 * bfhi(p0.w) + w1 * bfhi(p1.w) + w2 * bfhi(p2.w);
                v4u wa; wa.x = pk2(rr[0] * iw, rr[1] * iw); wa.y = pk2(rr[2] * iw, rr[3] * iw); wa.z = pk2(rr[4] * iw, rr[5] * iw); wa.w = pk2(rr[6] * iw, rr[7] * iw);
                *(v4u*)(MIX + (size_t)m * 1024 + 8 * lane) = wa;
            }
        }
    }
    GSYNC();
    {
        pg8::Gemm g{MIX, Wout, M, D, D}; pg8::StaticOrder S; S.init(M, D, G, (int)blockIdx.x);
        pg8::EpiRes<true> E{out, out, D, 1.0f, (bf16*)(ws + WS_XNB2), (float*)(ws + WS_SS)};
        pg8::gemm_phase<pg8::EpiRes<true>, pg8::StaticOrder, true, true>(L8, g, S, E);
    }
    GSYNC();
    {
        pg8::Gemm g{(const bf16*)(ws + WS_XNB2), Wgu2, M, NGU, D}; pg8::StaticOrder S; S.init(M, NGU, G, (int)blockIdx.x);
        pg8::EpiSwiGLU<true> E{ACT, FF, (const float*)(ws + WS_SS)};
        pg8::gemm_phase<pg8::EpiSwiGLU<true>, pg8::StaticOrder, true, true>(L8, g, S, E);
    }
    GSYNC();
    {
        pg8::Gemm g{ACT, Wd2, M, D, FF}; pg8::StaticOrder S; S.init(M, D, G, (int)blockIdx.x);
        pg8::EpiRes<false> E{out, out, D, 0.5f, nullptr, nullptr};
        pg8::gemm_phase<pg8::EpiRes<false>, pg8::StaticOrder, true, true>(L8, g, S, E);
    }
    GSYNC();
    const int lnf = opq(tid) & 63;
    for (int m = gw; m < M; m += NGW) {
        f32x4 v[4]; rms_row(out + (size_t)m * D, a.in[16], lnf, v);
        f32x4* o = (f32x4*)(out + (size_t)m * D) + lnf;
#pragma unroll
        for (int j = 0; j < 4; ++j) o[64 * j] = v[j];
    }
}

extern "C" void kernel_launch(void* const* d_in, const int* in_sizes, int n_in, void* d_out, int out_size, void* d_ws, size_t ws_size, hipStream_t stream) {
    static int grid = 0;
    if (grid == 0) {
        if (n_in != 17 || in_sizes[0] != M * D || out_size != M * D || ws_size < WS_END) { fprintf(stderr, "kernel_launch: unexpected shapes (n_in %d in0 %d out %d ws %zu)\n", n_in, n_in > 0 ? in_sizes[0] : -1, out_size, ws_size); grid = -1; return; }
        int dev = 0, cus = 0, per_cu = 0;
        hipGetDevice(&dev); hipDeviceGetAttribute(&cus, hipDeviceAttributeMultiprocessorCount, dev);
        if (hipFuncSetAttribute((const void*)fwd_megakernel, hipFuncAttributeMaxDynamicSharedMemorySize, LDS_BYTES) != hipSuccess) { fprintf(stderr, "kernel_launch: hipFuncSetAttribute failed\n"); grid = -1; return; }
        if (hipOccupancyMaxActiveBlocksPerMultiprocessor(&per_cu, (const void*)fwd_megakernel, NWAVES * 64, LDS_BYTES) != hipSuccess || per_cu < 1) { fprintf(stderr, "kernel_launch: occupancy query says %d blocks/CU\n", per_cu); (void)hipGetLastError(); per_cu = 1; }
        grid = cus * 1;
        fprintf(stderr, "kernel_launch: cus %d per_cu %d grid %d\n", cus, per_cu, grid);
    }
    if (grid < 0) return;
    hipMemsetAsync((char*)d_ws + WS_CTL, 0, CTL_BYTES, stream);
    Args a{};
    for (int i = 0; i < 17; ++i) a.in[i] = (const float*)d_in[i];
    a.out = (float*)d_out; a.ws = (unsigned char*)d_ws;
    void* args[] = {&a};
    hipError_t e = hipLaunchCooperativeKernel((const void*)fwd_megakernel, dim3(grid), dim3(NWAVES * 64), args, LDS_BYTES, stream);
    if (e != hipSuccess) fprintf(stderr, "cooperative launch failed: %s (grid %d)\n", hipGetErrorString(e), grid);
}
```

```cpp
#include <hip/hip_runtime.h>
#include <hip/hip_cooperative_groups.h>
#include <cstdio>
#include <cstdint>
namespace cg = cooperative_groups;
namespace pg8 {
#define PG8_LAS __attribute__((address_space(3)))
typedef unsigned short bf16_t;
typedef short bf16x8 __attribute__((ext_vector_type(8)));
typedef float f32x4 __attribute__((ext_vector_type(4)));
typedef unsigned u32x4 __attribute__((ext_vector_type(4)));
constexpr int BM = 256, BK = 64, HALF = 128, HTB = HALF * BK * 2  , STAGE_BYTES = 8 * HTB, NXCD = 8, WGM = 8;

__host__ __device__ __forceinline__ int lds_byte(int r, int c) { const int st = (r >> 4) * 2 + (c >> 5), rr = r & 15, cc = c & 31, ob = rr * 64 + cc * 2; return st * 1024 + (ob ^ (((ob >> 9) & 1) << 5)); }
__host__ __device__ __forceinline__ void stage_rc(int b, int& R, int& C) { const int st = b / 1024, sb = b % 1024, swz = sb ^ (((sb >> 9) & 1) << 5); R = (st >> 1) * 16 + swz / 64; C = (st & 1) * 32 + (swz % 64) / 2; }
__host__ __device__ __forceinline__ int perm32(int rho) { const int n = rho >> 4, i = rho & 15; return 8 * (i >> 2) + 4 * n + (i & 3); }

struct Unit { int pm, pn; };
struct Gemm { const bf16_t* A; const bf16_t* Bt; int M, N, K; };

struct StaticOrder {
    int nM, nN, nwg, G, c;
    __host__ __device__ void init(int M, int N, int G_, int c_) { nM = M / BM; nN = N / BM; nwg = nM * nN; G = G_; c = c_; }
    __host__ __device__ bool next(int i, Unit& u) const {
        const long L = (long)i * G + c; if (L >= nwg) return false;
        int wgid = (int)L; { const int q = nwg / NXCD, r = nwg % NXCD, xcd = wgid % NXCD, off = wgid / NXCD; wgid = (xcd < r ? xcd * (q + 1) : r * (q + 1) + (xcd - r) * q) + off; }
        const int nig = WGM * nN, gid = wgid / nig, fm = gid * WGM, gsz = (nM - fm) < WGM ? (nM - fm) : WGM;
        u.pm = fm + ((wgid % nig) % gsz); u.pn = (wgid % nig) / gsz; return true;
    }
    __device__ __forceinline__ void a_ready(const Unit&) const {}
    __device__ __forceinline__ void done(const Unit&) const {}
};

__device__ __forceinline__ unsigned cvt_pk_bf16(float lo, float hi) { unsigned r; asm volatile("v_cvt_pk_bf16_f32 %0, %1, %2" : "=v"(r) : "v"(lo), "v"(hi)); return r; }
__device__ __forceinline__ float silu_f(float g) { return g * __builtin_amdgcn_rcpf(1.0f + __expf(-g)); }
__device__ __forceinline__ float row_rs(const float* SS, int row) {
    const f32x4* sp = (const f32x4*)(SS + (size_t)row * 16); const f32x4 a = sp[0], b = sp[1], c = sp[2], d = sp[3];
    const float s = ((a[0] + a[1]) + (a[2] + a[3])) + ((b[0] + b[1]) + (b[2] + b[3])) + ((c[0] + c[1]) + (c[2] + c[3])) + ((d[0] + d[1]) + (d[2] + d[3]));
    return 1.0f / sqrtf(s * (1.0f / 1024.0f) + 1e-6f);
}
template <bool RS> struct EpiSwiGLU {
    static constexpr bool PERM = true, AFTER_DRAIN = false;
    bf16_t* O; int ldc; const float* SS;
    __device__ __forceinline__ void operator()(const f32x4 (&acc)[2][2][4][2], const Unit& u, int wr, int wc, int fr, int fq) const {
        const int row0 = u.pm * BM + wr * 64 + fr; const int col0 = u.pn * 128 + wc * 32 + 8 * fq;
#pragma unroll
        for (int ai = 0; ai < 2; ++ai)
#pragma unroll
            for (int m = 0; m < 4; ++m) { const int row = row0 + ai * HALF + m * 16; bf16_t* rowp = O + (size_t)row * ldc + col0;
                const float rs = RS ? row_rs(SS, row) : 1.0f;
                const f32x4 g0 = acc[ai][0][m][0] * rs, g1 = acc[ai][0][m][1] * rs, u0 = acc[ai][1][m][0] * rs, u1 = acc[ai][1][m][1] * rs;
                u32x4 w;
                w.x = cvt_pk_bf16(silu_f(g0[0]) * u0[0], silu_f(g0[1]) * u0[1]); w.y = cvt_pk_bf16(silu_f(g0[2]) * u0[2], silu_f(g0[3]) * u0[3]);
                w.z = cvt_pk_bf16(silu_f(g1[0]) * u1[0], silu_f(g1[1]) * u1[1]); w.w = cvt_pk_bf16(silu_f(g1[2]) * u1[2], silu_f(g1[3]) * u1[3]);
                *(u32x4*)rowp = w; }
    }
};
template <bool XB> struct EpiRes {
    static constexpr bool PERM = false, AFTER_DRAIN = false;
    const float* base; float* out; int ldc; float scale; bf16_t* xb; float* SS;
    __device__ __forceinline__ void operator()(const f32x4 (&acc)[2][2][4][2], const Unit& u, int wr, int wc, int fr, int fq) const {
        const int row0 = u.pm * BM + wr * 64 + fr; const int col0 = u.pn * BM + wc * 32 + 4 * fq;
#pragma unroll
        for (int ai = 0; ai < 2; ++ai)
#pragma unroll
            for (int m = 0; m < 4; ++m) { const int row = row0 + ai * HALF + m * 16; const size_t off = (size_t)row * ldc + col0; float ss = 0.f;
#pragma unroll
                for (int bj = 0; bj < 2; ++bj)
#pragma unroll
                    for (int n = 0; n < 2; ++n) { const f32x4 b = *(const f32x4*)(base + off + bj * HALF + n * 16); const f32x4 v = b + acc[ai][bj][m][n] * scale; *(f32x4*)(out + off + bj * HALF + n * 16) = v;
                        if (XB) { ss += (v[0] * v[0] + v[1] * v[1]) + (v[2] * v[2] + v[3] * v[3]);
                            unsigned lo = cvt_pk_bf16(v[0], v[1]), hi = cvt_pk_bf16(v[2], v[3]); unsigned long long pk = ((unsigned long long)hi << 32) | lo;
                            *(unsigned long long*)(xb + off + bj * HALF + n * 16) = pk; } }
                if (XB) { ss += __shfl_xor(ss, 16); ss += __shfl_xor(ss, 32); if (fq == 0) SS[(size_t)row * 16 + u.pn * 4 + wc] = ss; }
                asm volatile("" ::: "memory"); }
    }
};
struct EpiProj {
    static constexpr bool PERM = true, AFTER_DRAIN = false;
    bf16_t* Qh; bf16_t* KVh; bf16_t* P2; float* BD; const float* SS;
    __device__ __forceinline__ void operator()(const f32x4 (&acc)[2][2][4][2], const Unit& u, int wr, int wc, int fr, int fq) const {
        const int row0 = u.pm * BM + wr * 64 + fr;
        if (u.pn == 14) {
            if (wc == 0 && fq == 0) {
#pragma unroll
                for (int ai = 0; ai < 2; ++ai)
#pragma unroll
                    for (int m = 0; m < 4; ++m) { const int row = row0 + ai * HALF + m * 16; const float rs = row_rs(SS, row);
                        *(f32x4*)(BD + (size_t)row * 8) = acc[ai][0][m][0] * rs; *(f32x4*)(BD + (size_t)row * 8 + 4) = acc[ai][0][m][1] * rs; }
            }
            return;
        }
#pragma unroll
        for (int ai = 0; ai < 2; ++ai)
#pragma unroll
            for (int m = 0; m < 4; ++m) { const int row = row0 + ai * HALF + m * 16, bb = row >> 12, t = row & 4095; const float rs = row_rs(SS, row);
#pragma unroll
                for (int bj = 0; bj < 2; ++bj) { const int col = u.pn * BM + bj * HALF + wc * 32 + 8 * fq;
                    bf16_t* dst;
                    if (u.pn < 6) { const int sec = col >> 9, hc = col & 511, hh = hc >> 6, d = hc & 63; const size_t rt = (size_t)(bb * 8 + hh) * 4096 + t;
                        dst = (sec == 0) ? Qh + rt * 64 + d : KVh + rt * 128 + (sec - 1) * 64 + d; }
                    else dst = P2 + (size_t)row * 2048 + (col - 1536);
                    const f32x4 v0 = acc[ai][bj][m][0] * rs, v1 = acc[ai][bj][m][1] * rs; u32x4 w;
                    w.x = cvt_pk_bf16(v0[0], v0[1]); w.y = cvt_pk_bf16(v0[2], v0[3]); w.z = cvt_pk_bf16(v1[0], v1[1]); w.w = cvt_pk_bf16(v1[2], v1[3]);
                    *(u32x4*)dst = w; } }
    }
};
struct EpiStoreBf16 {
    static constexpr bool PERM = true, AFTER_DRAIN = false;
    bf16_t* O; int ldc;
    __device__ __forceinline__ void operator()(const f32x4 (&acc)[2][2][4][2], const Unit& u, int wr, int wc, int fr, int fq) const {
        const int row0 = u.pm * BM + wr * 64 + fr; const int col0 = u.pn * BM + wc * 32 + 8 * fq;
#pragma unroll
        for (int ai = 0; ai < 2; ++ai)
#pragma unroll
            for (int m = 0; m < 4; ++m) { bf16_t* rowp = O + (size_t)(row0 + ai * HALF + m * 16) * ldc + col0;
#pragma unroll
                for (int bj = 0; bj < 2; ++bj) { const f32x4 v0 = acc[ai][bj][m][0], v1 = acc[ai][bj][m][1]; u32x4 w;
                    w.x = cvt_pk_bf16(v0[0], v0[1]); w.y = cvt_pk_bf16(v0[2], v0[3]); w.z = cvt_pk_bf16(v1[0], v1[1]); w.w = cvt_pk_bf16(v1[2], v1[3]);
                    *(u32x4*)(rowp + bj * HALF) = w; } }
    }
};
template <class Epi, class Sched, bool ALIGN_EPI = false, bool SP2 = false>
__device__ __forceinline__ void gemm_phase(PG8_LAS unsigned char* lds, const Gemm g, const Sched& S, const Epi& E) {
    int tid_o = threadIdx.x; asm volatile("" : "+v"(tid_o));
    const int tid = tid_o, wid = __builtin_amdgcn_readfirstlane(tid >> 6), lane = tid & 63, wr = wid >> 2, wc = wid & 3, fr = lane & 15, fq = lane >> 4;
    const int K = g.K, nt = K / BK;
    unsigned voffA[2], voffB[2];
#pragma unroll
    for (int i = 0; i < 2; ++i) { int R, C; stage_rc(tid * 16 + i * 8192, R, C); const int Rb = Epi::PERM ? ((R & ~31) + perm32(R & 31)) : R;
        voffA[i] = (unsigned)(R * K + C) * 2u; voffB[i] = (unsigned)(Rb * K + C) * 2u; }
    const size_t kstep = (size_t)(BK * 2);
    const size_t hstep = (size_t)HALF * K * 2;
    const size_t tstep = 2 * hstep;
    const unsigned ldsw = (unsigned)wid * 1024u;
    const int aoff = lds_byte(wr * 64 + fr, fq * 8), boff = lds_byte(wc * 32 + fr, fq * 8);
#define PG8_SA(b, h) (((b) * 2 + (h)) * HTB)
#define PG8_SB(b, h) ((4 + (b) * 2 + (h)) * HTB)
#define PG8_STAGE(bufoff, gbase, voff) do { _Pragma("unroll") for (int _i = 0; _i < 2; ++_i) \
        __builtin_amdgcn_global_load_lds((const unsigned*)((const char*)(gbase) + (voff)[_i]), (PG8_LAS unsigned*)(lds + (bufoff) + ldsw + _i * 8192), 16, 0, 0); } while (0)
#define PG8_LDA(dst, b, h) do { _Pragma("unroll") for (int m = 0; m < 4; ++m) _Pragma("unroll") for (int k = 0; k < 2; ++k) dst[m][k] = *(const PG8_LAS bf16x8*)(lds + PG8_SA(b, h) + aoff + m * 2048 + k * 1024); } while (0)
#define PG8_LDB(dst, b, h) do { _Pragma("unroll") for (int n = 0; n < 2; ++n) _Pragma("unroll") for (int k = 0; k < 2; ++k) dst[n][k] = *(const PG8_LAS bf16x8*)(lds + PG8_SB(b, h) + boff + n * 2048 + k * 1024); } while (0)
#define PG8_MMA(ai, bj, At, Bt) do { __builtin_amdgcn_s_setprio(1); _Pragma("unroll") for (int m = 0; m < 4; ++m) _Pragma("unroll") for (int n = 0; n < 2; ++n) _Pragma("unroll") for (int k = 0; k < 2; ++k) \
        acc[ai][bj][m][n] = __builtin_amdgcn_mfma_f32_16x16x32_bf16(Bt[n][k], At[m][k], acc[ai][bj][m][n], 0, 0, 0); __builtin_amdgcn_s_setprio(0); } while (0)
#define PG8_WAIT_V(n) asm volatile("s_waitcnt vmcnt(" #n ")" ::: "memory")
#define PG8_WAIT_L(n) asm volatile("s_waitcnt lgkmcnt(" #n ")" ::: "memory")
#define PG8_BAR __builtin_amdgcn_s_barrier()
#define PG8_SCHED __builtin_amdgcn_sched_barrier(0)
    Unit cur, nxt; int ui = 0;
    if (!S.next(0, cur)) return;
    f32x4 acc[2][2][4][2];
#pragma unroll
    for (int a = 0; a < 2; ++a)
#pragma unroll
        for (int b = 0; b < 2; ++b)
#pragma unroll
            for (int m = 0; m < 4; ++m)
#pragma unroll
                for (int n = 0; n < 2; ++n) acc[a][b][m][n] = (f32x4){0.f, 0.f, 0.f, 0.f};
    bf16x8 At[4][2], B0[2][2], B1[2][2];
    const char* cA = (const char*)g.A + (size_t)cur.pm * tstep; const char* cB = (const char*)g.Bt + (size_t)cur.pn * tstep;
    S.a_ready(cur);
    if constexpr (SP2) {
        PG8_STAGE(PG8_SB(0, 0), cB, voffB); PG8_STAGE(PG8_SB(0, 1), cB + hstep, voffB); PG8_STAGE(PG8_SA(0, 0), cA, voffA); PG8_STAGE(PG8_SA(0, 1), cA + hstep, voffA);
        if (wr == 1) PG8_BAR;
        PG8_WAIT_V(2); PG8_BAR;
        PG8_STAGE(PG8_SB(1, 0), cB + kstep, voffB); PG8_STAGE(PG8_SA(1, 0), cA + kstep, voffA); PG8_STAGE(PG8_SB(1, 1), cB + hstep + kstep, voffB);
        PG8_WAIT_V(6); PG8_BAR;
    } else {
        PG8_STAGE(PG8_SB(0, 0), cB, voffB); PG8_STAGE(PG8_SA(0, 0), cA, voffA); PG8_STAGE(PG8_SB(0, 1), cB + hstep, voffB); PG8_STAGE(PG8_SA(0, 1), cA + hstep, voffA);
        if (wr == 1) PG8_BAR;
        PG8_WAIT_V(4); PG8_BAR;
        PG8_STAGE(PG8_SB(1, 0), cB + kstep, voffB); PG8_STAGE(PG8_SA(1, 0), cA + kstep, voffA); PG8_STAGE(PG8_SB(1, 1), cB + hstep + kstep, voffB);
        PG8_WAIT_V(6); PG8_BAR;
    }
    for (;;) {
        const bool has_next = S.next(ui + 1, nxt);
        const char* nA = has_next ? (const char*)g.A + (size_t)nxt.pm * tstep : cA; const char* nB = has_next ? (const char*)g.Bt + (size_t)nxt.pn * tstep : cB;
        for (int t = 0; t < nt; t += 2) {
            const bool last = (t == nt - 2);
            const char* a1 = cA + (size_t)(t + 1) * kstep;
            const char* a2 = last ? nA : cA + (size_t)(t + 2) * kstep; const char* b2 = last ? nB : cB + (size_t)(t + 2) * kstep;
            const char* a3 = a2 + kstep; const char* b3 = b2 + kstep;
            if (last && has_next) S.a_ready(nxt);
            if constexpr (SP2) {
            PG8_LDB(B0, 0, 0); PG8_LDB(B1, 0, 1); PG8_SCHED; PG8_LDA(At, 0, 0); PG8_STAGE(PG8_SA(1, 1), a1 + hstep, voffA);
            PG8_WAIT_V(8); PG8_WAIT_L(0); PG8_BAR; PG8_MMA(0, 0, At, B0); PG8_MMA(0, 1, At, B1); PG8_BAR; PG8_SCHED;
            PG8_LDA(At, 0, 1); PG8_STAGE(PG8_SB(0, 0), b2, voffB); PG8_STAGE(PG8_SB(0, 1), b2 + hstep, voffB); PG8_STAGE(PG8_SA(0, 0), a2, voffA);
            PG8_WAIT_V(8); PG8_WAIT_L(0); PG8_BAR; PG8_MMA(1, 0, At, B0); PG8_MMA(1, 1, At, B1); PG8_BAR; PG8_SCHED;
            PG8_LDB(B0, 1, 0); PG8_LDB(B1, 1, 1); PG8_SCHED; PG8_LDA(At, 1, 0); PG8_STAGE(PG8_SA(0, 1), a2 + hstep, voffA);
            PG8_WAIT_V(8); PG8_WAIT_L(0); PG8_BAR; PG8_MMA(0, 0, At, B0); PG8_MMA(0, 1, At, B1); PG8_BAR; PG8_SCHED;
            PG8_LDA(At, 1, 1); PG8_STAGE(PG8_SB(1, 0), b3, voffB); PG8_STAGE(PG8_SB(1, 1), b3 + hstep, voffB); PG8_STAGE(PG8_SA(1, 0), a3, voffA);
            PG8_WAIT_V(8); PG8_WAIT_L(0); PG8_BAR; PG8_MMA(1, 0, At, B0); PG8_MMA(1, 1, At, B1); PG8_BAR; PG8_SCHED;
            } else {
            PG8_LDB(B0, 0, 0); PG8_SCHED; PG8_LDA(At, 0, 0); PG8_STAGE(PG8_SA(1, 1), a1 + hstep, voffA);
            PG8_WAIT_L(8); PG8_BAR; PG8_WAIT_L(0); PG8_MMA(0, 0, At, B0); PG8_BAR; PG8_SCHED;
            PG8_LDB(B1, 0, 1); PG8_STAGE(PG8_SB(0, 0), b2, voffB);
            PG8_BAR; PG8_WAIT_L(0); PG8_MMA(0, 1, At, B1); PG8_BAR;
            PG8_LDA(At, 0, 1); PG8_STAGE(PG8_SA(0, 0), a2, voffA);
            PG8_BAR; PG8_WAIT_L(0); PG8_MMA(1, 0, At, B0); PG8_BAR; PG8_SCHED;
            PG8_STAGE(PG8_SB(0, 1), b2 + hstep, voffB);
            PG8_WAIT_V(6); PG8_BAR; PG8_MMA(1, 1, At, B1); PG8_BAR;
            PG8_LDB(B0, 1, 0); PG8_SCHED; PG8_LDA(At, 1, 0); PG8_STAGE(PG8_SA(0, 1), a2 + hstep, voffA);
            PG8_WAIT_L(8); PG8_BAR; PG8_WAIT_L(0); PG8_MMA(0, 0, At, B0); PG8_BAR; PG8_SCHED;
            PG8_LDB(B1, 1, 1); PG8_STAGE(PG8_SB(1, 0), b3, voffB);
            PG8_BAR; PG8_WAIT_L(0); PG8_MMA(0, 1, At, B1); PG8_BAR;
            PG8_LDA(At, 1, 1); PG8_STAGE(PG8_SA(1, 0), a3, voffA);
            PG8_BAR; PG8_WAIT_L(0); PG8_MMA(1, 0, At, B0); PG8_BAR; PG8_SCHED;
            PG8_STAGE(PG8_SB(1, 1), b3 + hstep, voffB);
            PG8_WAIT_V(6); PG8_BAR; PG8_MMA(1, 1, At, B1); PG8_BAR;
            }
        }
        if constexpr (ALIGN_EPI) { if (wr == 0) PG8_BAR; }
        if constexpr (!Epi::AFTER_DRAIN) { E(acc, cur, wr, wc, fr, fq); S.done(cur); }
        if (!has_next) break;
#pragma unroll
        for (int a = 0; a < 2; ++a)
#pragma unroll
            for (int b = 0; b < 2; ++b)
#pragma unroll
                for (int m = 0; m < 4; ++m)
#pragma unroll
                    for (int n = 0; n < 2; ++n) acc[a][b][m][n] = (f32x4){0.f, 0.f, 0.f, 0.f};
        cur = nxt; cA = nA; cB = nB; ++ui;
        if constexpr (ALIGN_EPI) { if (wr == 1) PG8_BAR; }
    }
    PG8_WAIT_V(0);
    if constexpr (!ALIGN_EPI) { if (wr == 0) PG8_BAR; }
    PG8_BAR;
    if constexpr (Epi::AFTER_DRAIN) { E.fused(acc, cur, wr, wc, fr, fq, lds, wid, lane); S.done(cur); }
#undef PG8_SA
#undef PG8_SB
#undef PG8_STAGE
#undef PG8_LDA
#undef PG8_LDB
#undef PG8_MMA
#undef PG8_WAIT_V
#undef PG8_WAIT_L
#undef PG8_BAR
#undef PG8_SCHED
}
}
constexpr int M = 16384, D = 1024, FF = 2816, NGU = 5632, NIN = 3840, SEQ = 4096;
constexpr int WIN_COLS = 3592;
constexpr size_t MiB = 1u << 20;
constexpr size_t WS_CTL = 0, CTL_BYTES = 65536;
constexpr size_t WS_WIN = MiB / 4, WS_WOUT = 8 * MiB, WS_WGU2 = 10 * MiB, WS_WD2 = 21 * MiB;
constexpr size_t WS_XN = 27 * MiB;
constexpr size_t WS_ACT = 59 * MiB;
constexpr size_t WS_QH = 123 * MiB, WS_KVH = 139 * MiB;
constexpr int P2LD = 2048;
constexpr size_t WS_BD = 171 * MiB;
constexpr size_t WS_EG = 172 * MiB;
constexpr size_t WS_DN = 184 * MiB;
constexpr size_t WS_WGU1 = 184 * MiB, WS_WD1 = 195 * MiB;
constexpr size_t WS_QG = WS_DN, WS_KD = WS_DN + 16 * MiB, WS_U = WS_DN + 32 * MiB, WS_W = WS_DN + 48 * MiB, WS_A = WS_DN + 64 * MiB;
constexpr size_t WS_END = 256 * MiB;
constexpr int LDS_BYTES = 147456;
constexpr int NWAVES = 8;

#define GAS __attribute__((address_space(1)))
#define LAS __attribute__((address_space(3)))
typedef unsigned short bf16;
typedef unsigned v4u __attribute__((ext_vector_type(4)));
typedef unsigned v2u __attribute__((ext_vector_type(2)));
typedef float f32x4 __attribute__((ext_vector_type(4)));
typedef float f32x2 __attribute__((ext_vector_type(2)));
#define LDS_WAIT() asm volatile("s_waitcnt lgkmcnt(0)" ::: "memory")
__device__ __forceinline__ unsigned f2bf(float f) { unsigned u = __builtin_bit_cast(unsigned, f); return (u + 0x7fffu + ((u >> 16) & 1u)) >> 16; }
__device__ __forceinline__ unsigned pk2(float lo, float hi) { return f2bf(lo) | (f2bf(hi) << 16); }
__device__ __forceinline__ float bflo(unsigned u) { return __uint_as_float(u << 16); }
__device__ __forceinline__ float bfhi(unsigned u) { return __uint_as_float(u & 0xffff0000u); }
__device__ __forceinline__ float bf2f(bf16 v) { return __uint_as_float(((unsigned)v) << 16); }
__device__ __forceinline__ float wave_sum(float v) {
#pragma unroll
    for (int o = 1; o < 64; o <<= 1) v += __shfl_xor(v, o);
    return v;
}
__device__ __forceinline__ float wave_max(float v) {
#pragma unroll
    for (int o = 1; o < 64; o <<= 1) v = fmaxf(v, __shfl_xor(v, o));
    return v;
}

__device__ __forceinline__ int opq(int v) { asm volatile("" : "+v"(v)); return v; }
struct Args { const float* in[17]; float* out; unsigned char* ws; };

__device__ __forceinline__ void transpose_item(const float* src, int srcN, int srccol0, bf16* dst, int dstK, int dstrow0, int k0, LAS float* scr, int lane, const float* gain = nullptr, int nvalid = 32) {
    const int c4 = (lane & 7) * 4, r0 = lane >> 3;
    f32x4 v[8];
#pragma unroll
    for (int i = 0; i < 8; ++i) v[i] = (c4 < nvalid) ? *(const f32x4*)(src + (size_t)(k0 + r0 + 8 * i) * srcN + srccol0 + c4) : (f32x4){0.f, 0.f, 0.f, 0.f};
    if (gain) {
#pragma unroll
        for (int i = 0; i < 8; ++i) v[i] = v[i] * gain[k0 + r0 + 8 * i]; }
#pragma unroll
    for (int i = 0; i < 8; ++i) { LAS float* p = scr + (r0 + 8 * i) * 33 + c4; p[0] = v[i][0]; p[1] = v[i][1]; p[2] = v[i][2]; p[3] = v[i][3]; }
    LDS_WAIT(); asm volatile("" ::: "memory");
    const int c = lane & 7;
#pragma unroll
    for (int j = 0; j < 4; ++j) { const int n = (lane >> 3) + 8 * j; const LAS float* s = scr + (8 * c) * 33 + n;
        v4u o; o.x = pk2(s[0 * 33], s[1 * 33]); o.y = pk2(s[2 * 33], s[3 * 33]); o.z = pk2(s[4 * 33], s[5 * 33]); o.w = pk2(s[6 * 33], s[7 * 33]);
        *(v4u*)(dst + (size_t)(dstrow0 + n) * dstK + k0 + 8 * c) = o; }
    LDS_WAIT(); asm volatile("" ::: "memory");
}
__device__ __forceinline__ void tr_gu(const float* gate, const float* up, bf16* dst, int r, LAS float* scr, int lane, const float* gain = nullptr) {
    const int nblk = NGU / 32, kb = r / nblk, nb = r % nblk, dstrow0 = nb * 32, pn = dstrow0 >> 8, within = dstrow0 & 255;
    transpose_item(within < 128 ? gate : up, FF, pn * 128 + (within & 127), dst, D, dstrow0, kb * 64, scr, lane, gain);
}
__device__ __forceinline__ void tr_plain(const float* src, int K, int N, bf16* dst, int r, LAS float* scr, int lane) {
    const int nblk = N / 32, kb = r / nblk, nb = r % nblk;
    transpose_item(src, N, nb * 32, dst, K, nb * 32, kb * 64, scr, lane);
}
__device__ __forceinline__ void tr_win(const float* src, bf16* dst, int r, LAS float* scr, int lane, const float* gain) {
    const int nblk = NIN / 32, kb = r / nblk, nb = r % nblk, dstrow0 = nb * 32;
    const int srccol0 = dstrow0 < 3072 ? dstrow0 : (dstrow0 < 3584 ? dstrow0 + 8 : 3072), nvalid = dstrow0 < 3584 ? 32 : (dstrow0 == 3584 ? 8 : 0);
    transpose_item(src, WIN_COLS, srccol0, dst, D, dstrow0, kb * 64, scr, lane, gain, nvalid);
}

__device__ __forceinline__ void rms_row(const float* xrow, const float* gain, int lane, f32x4 (&v)[4]) {
    const f32x4* xr = (const f32x4*)xrow + lane; const f32x4* gr = (const f32x4*)gain + lane;
    float s = 0.f;
#pragma unroll
    for (int j = 0; j < 4; ++j) { v[j] = xr[64 * j]; s += (v[j].x * v[j].x + v[j].y * v[j].y) + (v[j].z * v[j].z + v[j].w * v[j].w); }
    const float rs = 1.0f / sqrtf(wave_sum(s) * (1.f / D) + 1e-6f);
#pragma unroll
    for (int j = 0; j < 4; ++j) { const f32x4 g = gr[64 * j]; v[j] = v[j] * rs * g; }
}
__device__ __forceinline__ void store_row_bf16(bf16* orow, int lane, const f32x4 (&v)[4]) {
    v2u* o8 = (v2u*)orow + lane;
#pragma unroll
    for (int j = 0; j < 4; ++j) { v2u w; w.x = pk2(v[j].x, v[j].y); w.y = pk2(v[j].z, v[j].w); o8[64 * j] = w; }
}

__device__ __forceinline__ int kperm(int x) { return 8 * ((x & 15) >> 2) + 4 * (x >> 4) + (x & 3); }
typedef short bf16x8 __attribute__((ext_vector_type(8)));
typedef __bf16 bf16x2_t __attribute__((ext_vector_type(2)));
__device__ __forceinline__ unsigned cvtpk(float lo, float hi) { f32x2 v = {lo, hi}; bf16x2_t b = __builtin_convertvector(v, bf16x2_t); return __builtin_bit_cast(unsigned, b); }
constexpr int PP = 68;
constexpr int PQ = 0, PK = 17408, PVB = 34816, PKB = 53248, PAS = 71680, PTS = 89088, PMS = 106496, PTB = 123904, PGC = 133120;
__device__ __forceinline__ void dn_prep_item(const Args& a, LAS unsigned char* L8, int ch, int tid, int lane, int wave) {
    asm volatile("" : "+v"(tid), "+v"(lane));
    unsigned char* ws = a.ws;
    const bf16* PROJ = (const bf16*)(ws + WS_ACT);
    const float* BD = (const float*)(ws + WS_BD);
    const float* conv_w = a.in[7]; const float* a_log = a.in[8]; const float* dt_bias = a.in[9];
    const int bh = ch >> 6, n = ch & 63, b = bh >> 2, h = bh & 3;
    const int tok0 = b * SEQ + n * 64;
    LAS float* As = (LAS float*)(L8 + PAS); LAS float* Ts = (LAS float*)(L8 + PTS); LAS float* Ms = (LAS float*)(L8 + PMS);
    LAS float* gcs = (LAS float*)(L8 + PGC); LAS float* bts = gcs + 64;
    const int jl = lane & 15, kq = lane >> 4;
    unsigned raw[11][3];
#pragma unroll
    for (int i = 0; i < 11; ++i) { const int s = n * 64 + wave * 8 - 3 + i;
#pragma unroll
        for (int sec = 0; sec < 3; ++sec) raw[i][sec] = (s >= 0) ? *(const unsigned*)(PROJ + (size_t)(tok0 + wave * 8 - 3 + i) * P2LD + sec * 512 + h * 128 + 2 * lane) : 0u; }
    float cw[3][4][2];
#pragma unroll
    for (int sec = 0; sec < 3; ++sec)
#pragma unroll
        for (int j = 0; j < 4; ++j) { const f32x2 w = *(const f32x2*)(conv_w + j * 1536 + sec * 512 + h * 128 + 2 * lane); cw[sec][j][0] = w.x; cw[sec][j][1] = w.y; }
    float gpre, beta_l;
    {
        const int tok = tok0 + lane;
        const float braw = BD[(size_t)tok * 8 + h], draw = BD[(size_t)tok * 8 + 4 + h] + dt_bias[h];
        const float sp = fmaxf(draw, 0.f) + log1pf(__expf(-fabsf(draw)));
        float g = -expf(a_log[h]) * sp;
#pragma unroll
        for (int o = 1; o < 64; o <<= 1) { const float t = __shfl_up(g, o); if (lane >= o) g += t; }
        gpre = g; beta_l = 1.0f / (1.0f + __expf(-braw));
        if (wave == 0) { gcs[lane] = g; bts[lane] = beta_l; if (lane == 63) ((float*)(ws + WS_EG))[ch] = expf(g); }
    }
    for (int i = tid; i < 64 * PP; i += 512) Ts[i] = 0.f;
    {
        const float glast = __builtin_bit_cast(float, __builtin_amdgcn_readlane(__builtin_bit_cast(int, gpre), 63));
        bf16* QG = (bf16*)(ws + WS_QG) + (size_t)ch * 8192; bf16* KD = (bf16*)(ws + WS_KD) + (size_t)ch * 8192;
        unsigned vbp[8], kbp[8], kdp[8];
#pragma unroll
        for (int rr = 0; rr < 8; ++rr) {
            const int r = wave * 8 + rr;
            float val[3][2];
#pragma unroll
            for (int sec = 0; sec < 3; ++sec) { float v0 = 0.f, v1 = 0.f;
#pragma unroll
                for (int j = 0; j < 4; ++j) { v0 += bflo(raw[rr + j][sec]) * cw[sec][j][0]; v1 += bfhi(raw[rr + j][sec]) * cw[sec][j][1]; }
                val[sec][0] = v0 / (1.f + __expf(-v0)); val[sec][1] = v1 / (1.f + __expf(-v1)); }
            const float ssq = wave_sum(val[0][0] * val[0][0] + val[0][1] * val[0][1]);
            const float ssk = wave_sum(val[1][0] * val[1][0] + val[1][1] * val[1][1]);
            const float rq = (1.0f / sqrtf(ssq + 1e-6f)) * 0.08838834764831845f, rk = 1.0f / sqrtf(ssk + 1e-6f);
            const float q0 = val[0][0] * rq, q1 = val[0][1] * rq, k0 = val[1][0] * rk, k1 = val[1][1] * rk;
            const float gr = __builtin_bit_cast(float, __builtin_amdgcn_readlane(__builtin_bit_cast(int, gpre), r)), be = __builtin_bit_cast(float, __builtin_amdgcn_readlane(__builtin_bit_cast(int, beta_l), r));
            const float eq = __expf(gr), ek = __expf(glast - gr), bek = be * eq;
            *(LAS unsigned*)(L8 + PQ + r * 272 + 4 * lane) = cvtpk(q0, q1);
            *(LAS unsigned*)(L8 + PK + r * 272 + 4 * lane) = cvtpk(k0, k1);
            vbp[rr] = cvtpk(val[2][0] * be, val[2][1] * be); kbp[rr] = cvtpk(k0 * bek, k1 * bek); kdp[rr] = cvtpk(k0 * ek, k1 * ek);
            const int d = 2 * lane;
            *(unsigned*)(QG + r * 128 + (d & 96) + kperm(d & 31)) = cvtpk(q0 * eq, q1 * eq);
        }
#define PREP_LO4(p) (v4u){((p)[0] & 0xffffu) | ((p)[1] << 16), ((p)[2] & 0xffffu) | ((p)[3] << 16), ((p)[4] & 0xffffu) | ((p)[5] << 16), ((p)[6] & 0xffffu) | ((p)[7] << 16)}
#define PREP_HI4(p) (v4u){((p)[0] >> 16) | ((p)[1] & 0xffff0000u), ((p)[2] >> 16) | ((p)[3] & 0xffff0000u), ((p)[4] >> 16) | ((p)[5] & 0xffff0000u), ((p)[6] >> 16) | ((p)[7] & 0xffff0000u)}
        *(LAS v4u*)(L8 + PVB + (2 * lane) * 144 + 16 * wave) = PREP_LO4(vbp); *(LAS v4u*)(L8 + PVB + (2 * lane + 1) * 144 + 16 * wave) = PREP_HI4(vbp);
        *(LAS v4u*)(L8 + PKB + (2 * lane) * 144 + 16 * wave) = PREP_LO4(kbp); *(LAS v4u*)(L8 + PKB + (2 * lane + 1) * 144 + 16 * wave) = PREP_HI4(kbp);
        const int r0 = wave * 8, tpA = (r0 & 32) + kperm(r0 & 31), tpB = (r0 & 32) + kperm((r0 + 4) & 31);
        const v4u klo = PREP_LO4(kdp), khi = PREP_HI4(kdp);
        bf16* kd0 = KD + (2 * lane) * 64; bf16* kd1 = KD + (2 * lane + 1) * 64;
        *(v2u*)(kd0 + tpA) = (v2u){klo.x, klo.y}; *(v2u*)(kd0 + tpB) = (v2u){klo.z, klo.w};
        *(v2u*)(kd1 + tpA) = (v2u){khi.x, khi.y}; *(v2u*)(kd1 + tpB) = (v2u){khi.z, khi.w};
#undef PREP_LO4
#undef PREP_HI4
    }
    __syncthreads();
    {
        bf16* Aout = (bf16*)(ws + WS_A) + (size_t)ch * 4096;
#pragma unroll
        for (int t2 = 0; t2 < 2; ++t2) {
            const int idx = 2 * wave + t2, ct = idx >> 2, jt = idx & 3;
            f32x4 acc1 = {0.f, 0.f, 0.f, 0.f}, acc2 = {0.f, 0.f, 0.f, 0.f};
#pragma unroll
            for (int ks = 0; ks < 4; ++ks) {
                const bf16x8 kc = *(const LAS bf16x8*)(L8 + PK + (16 * ct + jl) * 272 + (32 * ks + 8 * kq) * 2);
                const bf16x8 kj = *(const LAS bf16x8*)(L8 + PK + (16 * jt + jl) * 272 + (32 * ks + 8 * kq) * 2);
                const bf16x8 qc = *(const LAS bf16x8*)(L8 + PQ + (16 * ct + jl) * 272 + (32 * ks + 8 * kq) * 2);
                acc1 = __builtin_amdgcn_mfma_f32_16x16x32_bf16(kc, kj, acc1, 0, 0, 0);
                acc2 = __builtin_amdgcn_mfma_f32_16x16x32_bf16(kj, qc, acc2, 0, 0, 0);
            }
            { const int j = 16 * jt + jl; const float gj = gcs[j];
#pragma unroll
              for (int e = 0; e < 4; ++e) { const int c = 16 * ct + 4 * kq + e; As[c * PP + j] = (j < c) ? bts[c] * acc1[e] * __expf(gcs[c] - gj) : 0.f; } }
            { const int c = 16 * ct + jl; const float gc_ = gcs[c]; float pv[4];
#pragma unroll
              for (int e = 0; e < 4; ++e) { const int j = 16 * jt + 4 * kq + e; pv[e] = (j <= c) ? acc2[e] * __expf(gc_ - gcs[j]) : 0.f; }
              v2u w; w.x = cvtpk(pv[0], pv[1]); w.y = cvtpk(pv[2], pv[3]);
              *(v2u*)(Aout + c * 64 + 32 * (jt >> 1) + 8 * kq + 4 * (jt & 1)) = w; }
        }
    }
    __syncthreads();
    if (wave == 0) {
        const int bb = lane >> 4, col = lane & 15;
        const LAS float* Ab = As + (16 * bb) * PP + 16 * bb;
        float xv[16];
        xv[0] = (col == 0) ? 1.f : 0.f;
        {
            f32x4 ar[9][2];
#pragma unroll
            for (int c = 1; c <= 8; ++c)
#pragma unroll
                for (int q = 0; q < 2; ++q) if (4 * q < c) ar[c][q] = *(const LAS f32x4*)(Ab + c * PP + 4 * q);
            __builtin_amdgcn_sched_barrier(0);
#pragma unroll
            for (int c = 1; c <= 8; ++c) { float s = (c == col) ? 1.f : 0.f;
#pragma unroll
                for (int j = 0; j < c; ++j) s -= ar[c][j >> 2][j & 3] * xv[j];
                xv[c] = s; }
        }
        __builtin_amdgcn_sched_barrier(0);
        {
            f32x4 ar[7][4];
#pragma unroll
            for (int c = 9; c < 16; ++c)
#pragma unroll
                for (int q = 0; q < 4; ++q) if (4 * q < c) ar[c - 9][q] = *(const LAS f32x4*)(Ab + c * PP + 4 * q);
            __builtin_amdgcn_sched_barrier(0);
#pragma unroll
            for (int c = 9; c < 16; ++c) { float s = (c == col) ? 1.f : 0.f;
#pragma unroll
                for (int j = 0; j < c; ++j) s -= ar[c - 9][j >> 2][j & 3] * xv[j];
                xv[c] = s; }
        }
#pragma unroll
        for (int c = 0; c < 16; ++c) Ts[(16 * bb + c) * PP + 16 * bb + col] = xv[c];
    }
    __syncthreads();
    {
        const int pr = tid >> 8, i = (tid >> 4) & 15, jj = tid & 15, hb = 32 * pr + 16, lb = 32 * pr;
        f32x4 a4[4]; float tc[16];
#pragma unroll
        for (int q = 0; q < 4; ++q) a4[q] = *(const LAS f32x4*)(As + (hb + i) * PP + lb + 4 * q);
#pragma unroll
        for (int k = 0; k < 16; ++k) tc[k] = Ts[(lb + k) * PP + lb + jj];
        __builtin_amdgcn_sched_barrier(0);
        float s = 0.f;
#pragma unroll
        for (int k = 0; k < 16; ++k) s += a4[k >> 2][k & 3] * tc[k];
        Ms[(hb + i) * PP + lb + jj] = s;
#pragma unroll
        for (int q = 0; q < 4; ++q) a4[q] = *(const LAS f32x4*)(Ts + (hb + i) * PP + hb + 4 * q);
        __syncthreads();
#pragma unroll
        for (int k = 0; k < 16; ++k) tc[k] = Ms[(hb + k) * PP + lb + jj];
        __builtin_amdgcn_sched_barrier(0);
        float t = 0.f;
#pragma unroll
        for (int k = 0; k < 16; ++k) t += a4[k >> 2][k & 3] * tc[k];
        Ts[(hb + i) * PP + lb + jj] = -t;
    }
    __syncthreads();
    {
        const int i = tid >> 4, j0 = (tid & 15) * 2;
        f32x4 a8[8]; f32x2 tc[32];
#pragma unroll
        for (int q = 0; q < 8; ++q) a8[q] = *(const LAS f32x4*)(As + (32 + i) * PP + 4 * q);
#pragma unroll
        for (int k = 0; k < 32; ++k) tc[k] = *(const LAS f32x2*)(Ts + k * PP + j0);
        __builtin_amdgcn_sched_barrier(0);
        float s0 = 0.f, s1 = 0.f;
#pragma unroll
        for (int k = 0; k < 32; ++k) { const float av = a8[k >> 2][k & 3]; s0 += av * tc[k].x; s1 += av * tc[k].y; }
        *(LAS f32x2*)(Ms + (32 + i) * PP + j0) = (f32x2){s0, s1};
#pragma unroll
        for (int q = 0; q < 8; ++q) a8[q] = *(const LAS f32x4*)(Ts + (32 + i) * PP + 32 + 4 * q);
        __syncthreads();
#pragma unroll
        for (int k = 0; k < 32; ++k) tc[k] = *(const LAS f32x2*)(Ms + (32 + k) * PP + j0);
        __builtin_amdgcn_sched_barrier(0);
        float t0 = 0.f, t1 = 0.f;
#pragma unroll
        for (int k = 0; k < 32; ++k) { const float tv = a8[k >> 2][k & 3]; t0 += tv * tc[k].x; t1 += tv * tc[k].y; }
        *(LAS f32x2*)(Ts + (32 + i) * PP + j0) = (f32x2){-t0, -t1};
    }
    __syncthreads();
#pragma unroll
    for (int i = 0; i < 4; ++i) { const int idx2 = tid + 512 * i, r = idx2 >> 5, c = (idx2 & 31) * 2; const f32x2 tv = *(const LAS f32x2*)(Ts + r * PP + c);
        *(LAS unsigned*)(L8 + PTB + r * 144 + 2 * c) = cvtpk(tv.x, tv.y); }
    __syncthreads();
    {
        bf16* U = (bf16*)(ws + WS_U) + (size_t)ch * 8192; bf16* W = (bf16*)(ws + WS_W) + (size_t)ch * 8192;
        const int mt = wave & 3, ntb = 4 * (wave >> 2);
        bf16x8 ta[2];
#pragma unroll
        for (int ks = 0; ks < 2; ++ks) ta[ks] = *(const LAS bf16x8*)(L8 + PTB + (16 * mt + jl) * 144 + (32 * ks + 8 * kq) * 2);
#pragma unroll
        for (int q = 0; q < 4; ++q) { const int nt = ntb + q; f32x4 acc = {0.f, 0.f, 0.f, 0.f};
#pragma unroll
            for (int ks = 0; ks < 2; ++ks) { const bf16x8 vb = *(const LAS bf16x8*)(L8 + PVB + (16 * nt + jl) * 144 + (32 * ks + 8 * kq) * 2);
                acc = __builtin_amdgcn_mfma_f32_16x16x32_bf16(ta[ks], vb, acc, 0, 0, 0); }
            v2u w; w.x = cvtpk(acc[0], acc[1]); w.y = cvtpk(acc[2], acc[3]);
            *(v2u*)(U + (16 * nt + jl) * 64 + 16 * mt + 4 * kq) = w; }
        bf16x8 ka[2];
#pragma unroll
        for (int ks = 0; ks < 2; ++ks) ka[ks] = *(const LAS bf16x8*)(L8 + PKB + (16 * wave + jl) * 144 + (32 * ks + 8 * kq) * 2);
#pragma unroll
        for (int ctile = 0; ctile < 4; ++ctile) { f32x4 acc = {0.f, 0.f, 0.f, 0.f};
#pragma unroll
            for (int ks = 0; ks < 2; ++ks) { const bf16x8 tb = *(const LAS bf16x8*)(L8 + PTB + (16 * ctile + jl) * 144 + (32 * ks + 8 * kq) * 2);
                acc = __builtin_amdgcn_mfma_f32_16x16x32_bf16(ka[ks], tb, acc, 0, 0, 0); }
            v2u w; w.x = cvtpk(-acc[0], -acc[1]); w.y = cvtpk(-acc[2], -acc[3]);
            *(v2u*)(W + (16 * ctile + jl) * 128 + 32 * (wave >> 1) + 8 * kq + 4 * (wave & 1)) = w; }
    }
    __syncthreads();
}

__device__ __forceinline__ bf16x8 pack8(const f32x4& a, const f32x4& b) { v4u w; w.x = cvtpk(a[0], a[1]); w.y = cvtpk(a[2], a[3]); w.z = cvtpk(b[0], b[1]); w.w = cvtpk(b[2], b[3]); return __builtin_bit_cast(bf16x8, w); }
constexpr int SC_W = 0, SC_QG = 17408, SC_KDT = 34816, SC_A = 53248, SC_U = 62464, SC_BUF = 67072;
constexpr int SC_OUT = 2 * SC_BUF;
struct ScanRegs { v4u st[15]; };
__device__ __forceinline__ void sc_load(ScanRegs& R, const unsigned char* ws, int chx, int t, int qtr) {
    const unsigned vo = (unsigned)t * 16u;
    const unsigned char* pw = ws + WS_W + (size_t)chx * 16384; const unsigned char* pq = ws + WS_QG + (size_t)chx * 16384; const unsigned char* pk = ws + WS_KD + (size_t)chx * 16384;
    const unsigned char* pa = ws + WS_A + (size_t)chx * 8192; const unsigned char* pu = ws + WS_U + (size_t)chx * 16384 + qtr * 4096;
#define SC_LDG(k, p) do { R.st[k] = *(const v4u*)(p); __builtin_amdgcn_sched_barrier(0); } while (0)
    __builtin_amdgcn_sched_barrier(0);
    SC_LDG(0, pw + vo); SC_LDG(1, pw + 4096 + vo); SC_LDG(2, pw + 8192 + vo); SC_LDG(3, pw + 12288 + vo);
    SC_LDG(4, pq + vo); SC_LDG(5, pq + 4096 + vo); SC_LDG(6, pq + 8192 + vo); SC_LDG(7, pq + 12288 + vo);
    SC_LDG(8, pk + vo); SC_LDG(9, pk + 4096 + vo); SC_LDG(10, pk + 8192 + vo); SC_LDG(11, pk + 12288 + vo);
    SC_LDG(12, pa + vo); SC_LDG(13, pa + 4096 + vo); SC_LDG(14, pu + vo);
#undef SC_LDG
}
__device__ __forceinline__ void sc_write(const ScanRegs& R, LAS unsigned char* B_, int t) {
    LAS unsigned char* w16 = B_ + (t >> 4) * 272 + (t & 15) * 16;
    LAS unsigned char* k8 = B_ + (t >> 3) * 144 + (t & 7) * 16;
#define SC_STL(k, p) do { *(LAS v4u*)(p) = R.st[k]; __builtin_amdgcn_sched_barrier(0); } while (0)
    __builtin_amdgcn_sched_barrier(0);
    SC_STL(0, w16 + SC_W); SC_STL(1, w16 + SC_W + 16 * 272); SC_STL(2, w16 + SC_W + 32 * 272); SC_STL(3, w16 + SC_W + 48 * 272);
    SC_STL(4, w16 + SC_QG); SC_STL(5, w16 + SC_QG + 16 * 272); SC_STL(6, w16 + SC_QG + 32 * 272); SC_STL(7, w16 + SC_QG + 48 * 272);
    SC_STL(8, k8 + SC_KDT); SC_STL(9, k8 + SC_KDT + 32 * 144); SC_STL(10, k8 + SC_KDT + 64 * 144); SC_STL(11, k8 + SC_KDT + 96 * 144);
    SC_STL(12, k8 + SC_A); SC_STL(13, k8 + SC_A + 32 * 144); SC_STL(14, k8 + SC_U);
#undef SC_STL
}
#define SC_BARRIER() do { asm volatile("s_waitcnt lgkmcnt(0)" ::: "memory"); __builtin_amdgcn_s_barrier(); asm volatile("" ::: "memory"); } while (0)
__device__ __forceinline__ void sc_step_compute(LAS unsigned char* L8, int n, int jl, int kq, int wcol, float egv, f32x4 (&Sacc)[8]) {
    const float eg = __builtin_bit_cast(float, __builtin_amdgcn_readlane(__builtin_bit_cast(int, egv), n));
    const LAS unsigned char* B = L8 + (n & 1) * SC_BUF;
    bf16x8 sb[4];
#pragma unroll
    for (int ks = 0; ks < 4; ++ks) sb[ks] = pack8(Sacc[2 * ks], Sacc[2 * ks + 1]);
    f32x4 vn[4], oa[4];
#pragma unroll
    for (int mt = 0; mt < 4; ++mt) { const v2u u = *(const LAS v2u*)(B + SC_U + (wcol + jl) * 144 + (16 * mt + 4 * kq) * 2);
        vn[mt] = (f32x4){bflo(u.x), bfhi(u.x), bflo(u.y), bfhi(u.y)}; oa[mt] = (f32x4){0.f, 0.f, 0.f, 0.f}; }
    const LAS unsigned char* pW = B + SC_W + jl * 272 + kq * 16; const LAS unsigned char* pQ = B + SC_QG + jl * 272 + kq * 16;
    const LAS unsigned char* pK = B + SC_KDT + jl * 144 + kq * 16; const LAS unsigned char* pA = B + SC_A + jl * 144 + kq * 16;
#define SC_LD_WQ(dst, mt) do { _Pragma("unroll") for (int ks = 0; ks < 4; ++ks) { dst[ks] = *(const LAS bf16x8*)(pW + (mt) * 16 * 272 + ks * 64); dst[4 + ks] = *(const LAS bf16x8*)(pQ + (mt) * 16 * 272 + ks * 64); } } while (0)
#define SC_LD_K(dst, t0) do { _Pragma("unroll") for (int t = 0; t < 4; ++t) _Pragma("unroll") for (int k2 = 0; k2 < 2; ++k2) dst[2 * t + k2] = *(const LAS bf16x8*)(pK + ((t0) + t) * 16 * 144 + k2 * 64); } while (0)
#define SC_LD_A(dst) do { _Pragma("unroll") for (int mt = 0; mt < 4; ++mt) _Pragma("unroll") for (int k2 = 0; k2 < 2; ++k2) dst[2 * mt + k2] = *(const LAS bf16x8*)(pA + mt * 16 * 144 + k2 * 64); } while (0)
#define SC_MM_WQ(src, mt) do { _Pragma("unroll") for (int ks = 0; ks < 4; ++ks) { vn[mt] = __builtin_amdgcn_mfma_f32_16x16x32_bf16(src[ks], sb[ks], vn[mt], 0, 0, 0); oa[mt] = __builtin_amdgcn_mfma_f32_16x16x32_bf16(src[4 + ks], sb[ks], oa[mt], 0, 0, 0); } } while (0)
#define SC_MM_K(src, t0) do { _Pragma("unroll") for (int k2 = 0; k2 < 2; ++k2) _Pragma("unroll") for (int t = 0; t < 4; ++t) Sacc[(t0) + t] = __builtin_amdgcn_mfma_f32_16x16x32_bf16(src[2 * t + k2], vb[k2], Sacc[(t0) + t], 0, 0, 0); } while (0)
#define SC_MM_A(src) do { _Pragma("unroll") for (int k2 = 0; k2 < 2; ++k2) _Pragma("unroll") for (int mt = 0; mt < 4; ++mt) oa[mt] = __builtin_amdgcn_mfma_f32_16x16x32_bf16(src[2 * mt + k2], vb[k2], oa[mt], 0, 0, 0); } while (0)
#define SC_SB() __builtin_amdgcn_sched_barrier(0)
    bf16x8 fa[8], fb[8];
    SC_LD_WQ(fa, 0); SC_LD_WQ(fb, 1); SC_SB();
    SC_MM_WQ(fa, 0); SC_SB(); SC_LD_WQ(fa, 2); SC_SB();
    SC_MM_WQ(fb, 1); SC_SB(); SC_LD_WQ(fb, 3); SC_SB();
    SC_MM_WQ(fa, 2); SC_SB(); SC_LD_K(fa, 0); SC_SB();
    SC_MM_WQ(fb, 3); SC_SB(); SC_LD_K(fb, 4); SC_SB();
    bf16x8 vb[2];
    vb[0] = pack8(vn[0], vn[1]); vb[1] = pack8(vn[2], vn[3]);
#pragma unroll
    for (int T = 0; T < 8; ++T) Sacc[T] = Sacc[T] * eg;
    SC_SB();
    SC_MM_K(fa, 0); SC_SB(); SC_LD_A(fa); SC_SB();
    SC_MM_K(fb, 4); SC_SB();
    SC_MM_A(fa);
#undef SC_LD_WQ
#undef SC_LD_K
#undef SC_LD_A
#undef SC_MM_WQ
#undef SC_MM_K
#undef SC_MM_A
#undef SC_SB
    LAS unsigned char* ob = L8 + SC_OUT + (n & 1) * 4096 + (4 * kq) * 64 + (wcol + jl) * 2;
#pragma unroll
    for (int mt = 0; mt < 4; ++mt)
#pragma unroll
        for (int e = 0; e < 4; ++e) *(LAS bf16*)(ob + (16 * mt + e) * 64) = (bf16)f2bf(oa[mt][e]);
    SC_BARRIER();
}
__device__ __forceinline__ void sc_out_tile(LAS unsigned char* L8, bf16* MIX, int b, int h, int qtr, int n, int l_) {
    const LAS unsigned char* ob = L8 + SC_OUT + (n & 1) * 4096 + l_ * 64;
    const v4u w0 = *(const LAS v4u*)ob, w1 = *(const LAS v4u*)(ob + 16), w2 = *(const LAS v4u*)(ob + 32), w3 = *(const LAS v4u*)(ob + 48);
    bf16* gp = MIX + (size_t)(b * SEQ + n * 64 + l_) * 1024 + 512 + h * 128 + qtr * 32;
    *(v4u*)gp = w0; *(v4u*)(gp + 8) = w1; *(v4u*)(gp + 16) = w2; *(v4u*)(gp + 24) = w3;
}
__device__ __forceinline__ void dn_scan_mfma(const Args& a, LAS unsigned char* L8, int item, int tid, int lane, int wave) {
    unsigned char* ws = a.ws;
    const int xcd_ = item & 7, slot_ = item >> 3;
    const int bh = xcd_ * 2 + (slot_ >> 2), qtr = slot_ & 3, b = bh >> 2, h = bh & 3;
    if (wave < 2) {
        const int jl = lane & 15, kq = lane >> 4;
        f32x4 Sacc[8];
#pragma unroll
        for (int T = 0; T < 8; ++T) Sacc[T] = (f32x4){0.f, 0.f, 0.f, 0.f};
        const float egv = ((const float*)(ws + WS_EG))[bh * 64 + lane];
        asm volatile("s_waitcnt vmcnt(0)" ::: "memory");
        SC_BARRIER();
        for (int n = 0; n < 64; ++n) sc_step_compute(L8, n, jl, kq, wave * 16, egv, Sacc);
    } else if (wave < 6) {
        ScanRegs R0, R1, R2; const int t = tid - 128, c0 = bh * 64;
        sc_load(R0, ws, c0, t, qtr); sc_write(R0, L8, t);
        sc_load(R1, ws, c0 + 1, t, qtr); sc_load(R2, ws, c0 + 2, t, qtr); sc_load(R0, ws, c0 + 3, t, qtr);
        SC_BARRIER();
        for (int n = 0; n < 63; n += 3) {
            sc_write(R1, L8 + ((n + 1) & 1) * SC_BUF, t);
            sc_load(R1, ws, c0 + (n + 4 < 63 ? n + 4 : 63), t, qtr);
            SC_BARRIER();
            sc_write(R2, L8 + ((n + 2) & 1) * SC_BUF, t);
            sc_load(R2, ws, c0 + (n + 5 < 63 ? n + 5 : 63), t, qtr);
            SC_BARRIER();
            sc_write(R0, L8 + ((n + 3) & 1) * SC_BUF, t);
            sc_load(R0, ws, c0 + (n + 6 < 63 ? n + 6 : 63), t, qtr);
            SC_BARRIER();
        }
        SC_BARRIER();
    } else if (wave == 6) {
        SC_BARRIER();
        for (int n = 0; n < 64; ++n) SC_BARRIER();
    } else {
        bf16* MIX = (bf16*)(ws + WS_XN);
        SC_BARRIER();
        for (int n = 0; n < 64; ++n) { if (n > 0) sc_out_tile(L8, MIX, b, h, qtr, n - 1, lane); SC_BARRIER(); }
        sc_out_tile(L8, MIX, b, h, qtr, 63, lane);
    }
    __syncthreads();
}

typedef float f32x16 __attribute__((ext_vector_type(16)));
typedef short s16x4 __attribute__((ext_vector_type(4)));
__device__ __forceinline__ s16x4 vtr(const LAS unsigned char* p) { return __builtin_bit_cast(s16x4, __builtin_amdgcn_ds_read_tr16_b64_v4i16((LAS s16x4*)p)); }
constexpr int KVP = 144;
constexpr int KV_BYTES = 384 * KVP;
constexpr size_t WS_ML = 173 * MiB;
constexpr size_t WS_SS = 176 * MiB;
constexpr size_t WS_XNB2 = 184 * MiB;
__device__ __forceinline__ void attn_item(const bf16* Qh, const bf16* KVh, bf16* PROJ, float* ML, LAS unsigned char* L8, int item, int tid, int lane, int wave) {
    asm volatile("" : "+v"(lane));
    const int bh = item / 48, rem = item - bh * 48, p = rem >> 4, sub = rem & 15;
    const int b = bh >> 3, h = bh & 7;
    const int dsh = 2 * p, dil = 1 << dsh, nsh = 4 - dsh;
    const int r = sub >> nsh, qb = sub & ((1 << nsh) - 1);
    const int base = 256 * qb;
    const bf16* KVb = KVh + (size_t)(bh * 4096 + r) * 128;
#pragma unroll
    for (int i = 0; i < 12; ++i) { const int id = tid + 512 * i, row = id >> 4, ch = id & 15, idx = base - 128 + row;
        v4u kv = (v4u){0u, 0u, 0u, 0u};
        if (idx >= 0) kv = *(const v4u*)(KVb + (size_t)(dil * idx) * 128 + ch * 8);
        *(LAS v4u*)(L8 + ((ch & 8) ? KV_BYTES : 0) + row * KVP + (ch & 7) * 16) = kv; }
    const int ql = lane & 31, kh = lane >> 5;
    const int tq = r + dil * (base + 32 * wave + ql);
    const size_t tokq = (size_t)b * SEQ + tq;
    bf16x8 qf[4];
#pragma unroll
    for (int s = 0; s < 4; ++s) qf[s] = *(const bf16x8*)(Qh + ((size_t)bh * 4096 + tq) * 64 + 16 * s + 8 * kh);
    __syncthreads();
    f32x16 sc[5];
    {
        const LAS unsigned char* Kp = L8 + (32 * wave + ql) * KVP + kh * 16;
        bf16x8 kf[2][4];
#pragma unroll
        for (int s = 0; s < 4; ++s) kf[0][s] = *(const LAS bf16x8*)(Kp + s * 32);
#pragma unroll
        for (int kt = 0; kt < 5; ++kt) {
            if (kt + 1 < 5) {
#pragma unroll
                for (int s = 0; s < 4; ++s) kf[(kt + 1) & 1][s] = *(const LAS bf16x8*)(Kp + (kt + 1) * 32 * KVP + s * 32); }
            __builtin_amdgcn_sched_barrier(0);
            f32x16 acc = {};
#pragma unroll
            for (int s = 0; s < 4; ++s) acc = __builtin_amdgcn_mfma_f32_32x32x16_bf16(kf[kt & 1][s], qf[s], acc, 0, 0, 0);
            sc[kt] = acc;
            __builtin_amdgcn_sched_barrier(0);
        }
    }
    const float LOG2E = 1.4426950408889634f;
    const float c1 = 0.125f * LOG2E, c2 = exp2f(-(float)(h + 1)) * (float)dil * LOG2E;
    const float Al = -c2 * (float)(128 + ql - 4 * kh);
    float mx = -INFINITY;
#pragma unroll
    for (int kt = 0; kt < 5; ++kt)
#pragma unroll
        for (int rr = 0; rr < 16; ++rr) { const int kc = (rr & 3) + 8 * (rr >> 2);
            float v = fmaf(sc[kt][rr], c1, fmaf(c2, (float)(32 * kt + kc), Al));
            if (kt == 0) v = (kc + 4 * kh >= ql) ? v : -INFINITY;
            if (kt == 4) v = (kc + 4 * kh <= ql) ? v : -INFINITY;
            sc[kt][rr] = v; }
    if (base == 0) {
#pragma unroll
        for (int kt = 0; kt < 4; ++kt)
#pragma unroll
            for (int rr = 0; rr < 16; ++rr) { const int kidx = -128 + 32 * (wave + kt) + (rr & 3) + 8 * (rr >> 2) + 4 * kh; sc[kt][rr] = (kidx >= 0) ? sc[kt][rr] : -INFINITY; }
    }
#pragma unroll
    for (int kt = 0; kt < 5; ++kt)
#pragma unroll
        for (int rr = 0; rr < 16; ++rr) mx = fmaxf(mx, sc[kt][rr]);
    mx = fmaxf(mx, __shfl_xor(mx, 32));
    float lsum = 0.f;
#pragma unroll
    for (int kt = 0; kt < 5; ++kt)
#pragma unroll
        for (int rr = 0; rr < 16; ++rr) { const float pv = __builtin_amdgcn_exp2f(sc[kt][rr] - mx); sc[kt][rr] = pv; lsum += pv; }
    lsum += __shfl_xor(lsum, 32);
    f32x16 o[2]; o[0] = (f32x16){}; o[1] = (f32x16){};
    {
        const int q4 = (lane & 15) >> 2, pp = lane & 3, blk = (lane >> 4) & 1;
        const LAS unsigned char* Vb = L8 + KV_BYTES + (32 * wave + 4 * kh + q4) * KVP + (16 * blk + 4 * pp) * 2;
        s16x4 vf[3][4];
#define AT_LDV(set, step) do { const LAS unsigned char* vr_ = Vb + (16 * (step)) * KVP; vf[set][0] = vtr(vr_); vf[set][1] = vtr(vr_ + 8 * KVP); vf[set][2] = vtr(vr_ + 64); vf[set][3] = vtr(vr_ + 8 * KVP + 64); } while (0)
        AT_LDV(0, 0); AT_LDV(1, 1);
#pragma unroll
        for (int st = 0; st < 10; ++st) {
            if (st + 2 < 10) AT_LDV((st + 2) % 3, st + 2);
            __builtin_amdgcn_sched_barrier(0);
            const int kt = st >> 1, s2 = st & 1;
            v4u pw; pw.x = cvtpk(sc[kt][8 * s2 + 0], sc[kt][8 * s2 + 1]); pw.y = cvtpk(sc[kt][8 * s2 + 2], sc[kt][8 * s2 + 3]); pw.z = cvtpk(sc[kt][8 * s2 + 4], sc[kt][8 * s2 + 5]); pw.w = cvtpk(sc[kt][8 * s2 + 6], sc[kt][8 * s2 + 7]);
            const bf16x8 pb = __builtin_bit_cast(bf16x8, pw);
            const s16x4 l0 = vf[st % 3][0], h0 = vf[st % 3][1], l1 = vf[st % 3][2], h1 = vf[st % 3][3];
            o[0] = __builtin_amdgcn_mfma_f32_32x32x16_bf16((bf16x8){l0[0], l0[1], l0[2], l0[3], h0[0], h0[1], h0[2], h0[3]}, pb, o[0], 0, 0, 0);
            o[1] = __builtin_amdgcn_mfma_f32_32x32x16_bf16((bf16x8){l1[0], l1[1], l1[2], l1[3], h1[0], h1[1], h1[2], h1[3]}, pb, o[1], 0, 0, 0);
            __builtin_amdgcn_sched_barrier(0);
        }
#undef AT_LDV
    }
    const float inv = 1.0f / lsum;
    bf16* dst = PROJ + tokq * P2LD + p * 512 + h * 64 + 4 * kh;
#pragma unroll
    for (int c = 0; c < 2; ++c)
#pragma unroll
        for (int g = 0; g < 4; ++g) { v2u w; w.x = cvtpk(o[c][4 * g + 0] * inv, o[c][4 * g + 1] * inv); w.y = cvtpk(o[c][4 * g + 2] * inv, o[c][4 * g + 3] * inv);
            *(v2u*)(dst + 32 * c + 8 * g) = w; }
    if (kh == 0) { float* ml = ML + ((tokq * 8 + h) * 3 + p) * 2; *(f32x2*)ml = (f32x2){mx, lsum}; }
    __syncthreads();
}

#define XB_TMO      128
#define XB_XCNT(j)  (256  + 64 * (j))
#define XB_XSUB(j)  (1280 + 64 * (j))
#define XB_XGEN(j)  (2304 + 64 * (j))
#define XB_TOP      3328
#define XB_TOPGEN   3392
#define XCD_BAR_WORDS 3456
#define XB_SPIN_CAP (1u << 18)

__device__ __forceinline__ unsigned xb_ld(unsigned* p)              { return __hip_atomic_load(p, __ATOMIC_RELAXED, __HIP_MEMORY_SCOPE_AGENT); }
__device__ __forceinline__ unsigned xb_add(unsigned* p, unsigned v) { return __hip_atomic_fetch_add(p, v, __ATOMIC_RELAXED, __HIP_MEMORY_SCOPE_AGENT); }
__device__ __forceinline__ unsigned xb_xcc_id() { return (unsigned)__builtin_amdgcn_s_getreg((3 << 11) | 20) & 0xFu; }
#define XB_SPIN(cond, bar) do { unsigned _sp = 0; while (cond) { __builtin_amdgcn_s_sleep(1); \
    if ((++_sp & 255u) == 0u) { if (xb_ld(&(bar)[XB_TMO])) break; if (_sp > XB_SPIN_CAP) { atomicAdd(&(bar)[XB_TMO], 1u); break; } } } } while (0)

struct XcdBarrier {
    unsigned* bar; unsigned x;
    volatile LAS unsigned* st;
};

__device__ __forceinline__ XcdBarrier xcd_barrier_post(unsigned* bar, volatile LAS unsigned* st) {
    XcdBarrier b; b.bar = bar; b.x = xb_xcc_id(); b.st = st;
    if (threadIdx.x == 0) (void)xb_add(&bar[XB_XCNT(b.x)], 1u);
    return b;
}
__device__ __forceinline__ void xcd_barrier_complete(unsigned* bar, unsigned x, unsigned& nloc, unsigned& nx) {
    const unsigned G = gridDim.x * gridDim.y * gridDim.z;
    unsigned sum, cnt, mine, sp = 0u;
    for (;;) {
        sum = 0u; cnt = 0u; mine = 0u;
#pragma unroll
        for (unsigned j = 0; j < 16; ++j) { const unsigned c = xb_ld(&bar[XB_XCNT(j)]); sum += c; cnt += (c > 0u) ? 1u : 0u; mine = (j == x) ? c : mine; }
        if (sum == G) break;
        __builtin_amdgcn_s_sleep(1);
        if ((++sp & 255u) == 0u) { if (xb_ld(&bar[XB_TMO])) break; if (sp > XB_SPIN_CAP) { atomicAdd(&bar[XB_TMO], 1u); break; } }
    }
    nloc = mine > 0u ? mine : 1u; nx = cnt > 0u ? cnt : 1u;
}

__device__ __forceinline__ void xcd_barrier(const XcdBarrier& b) {
    asm volatile("s_waitcnt vmcnt(0)" ::: "memory");
    __syncthreads();
    if (threadIdx.x == 0) {
        unsigned* bar = b.bar;
        __builtin_amdgcn_s_waitcnt(0);
        unsigned nloc = b.st[0], nx = b.st[1];
        if (nloc == 0u) { xcd_barrier_complete(bar, b.x, nloc, nx); b.st[0] = nloc; b.st[1] = nx; }
        const unsigned old = xb_add(&bar[XB_XSUB(b.x)], 1u);
        const unsigned gen = old / nloc;
        if (old + 1u == (gen + 1u) * nloc) {
            __builtin_amdgcn_fence(__ATOMIC_RELEASE, "agent");
            asm volatile("s_waitcnt vmcnt(0)" ::: "memory");
            const unsigned og = xb_add(&bar[XB_TOP], 1u);
            const unsigned tg = og / nx;
            if (og + 1u == (tg + 1u) * nx) xb_add(&bar[XB_TOPGEN], 1u);
            else XB_SPIN(xb_ld(&bar[XB_TOPGEN]) == tg, bar);
            __builtin_amdgcn_fence(__ATOMIC_ACQUIRE, "agent");
            xb_add(&bar[XB_XGEN(b.x)], 1u);
            asm volatile("s_waitcnt vmcnt(0)" ::: "memory");
        } else {
            XB_SPIN(xb_ld(&bar[XB_XGEN(b.x)]) == gen, bar);
            __builtin_amdgcn_fence(__ATOMIC_ACQUIRE, "agent");
            asm volatile("s_waitcnt vmcnt(0)" ::: "memory");
        }
    }
    __syncthreads();
}

__global__ void __launch_bounds__(NWAVES * 64, 2) fwd_megakernel(Args a) {
    extern __shared__ __attribute__((aligned(16))) unsigned char lds[];
    cg::grid_group grid = cg::this_grid();
    LAS unsigned char* L8 = (LAS unsigned char*)lds;
    LAS float* L = (LAS float*)lds;
    const int tid = threadIdx.x, lane = tid & 63, wave = __builtin_amdgcn_readfirstlane(tid >> 6);
    const int G = gridDim.x, gw = blockIdx.x * NWAVES + wave, NGW = G * NWAVES;
    unsigned char* ws = a.ws;
    unsigned* ctl = (unsigned*)(ws + WS_CTL);
    const float* x = a.in[0];
    bf16* XN = (bf16*)(ws + WS_XN); bf16* ACT = (bf16*)(ws + WS_ACT); bf16* PROJ = ACT; bf16* MIX = XN;
    bf16* Wgu1 = (bf16*)(ws + WS_WGU1); bf16* Wd1 = (bf16*)(ws + WS_WD1); bf16* Win = (bf16*)(ws + WS_WIN); bf16* Wout = (bf16*)(ws + WS_WOUT);
    bf16* Wgu2 = (bf16*)(ws + WS_WGU2); bf16* Wd2 = (bf16*)(ws + WS_WD2);
    float* out = a.out;
    volatile LAS unsigned* xbst = (volatile LAS unsigned*)(L8 + LDS_BYTES - 64);
    if (tid < 2) xbst[tid] = 0u;
    __syncthreads();
    XcdBarrier bar = xcd_barrier_post(ctl + 1024, xbst);
#define GSYNC() xcd_barrier(bar)

    {
        const int lane = opq(tid) & 63;
        LAS float* scr = L + wave * 4096;
        constexpr int I_GU = (D / 64) * (NGU / 32), I_D = (FF / 64) * (D / 32), I_IN = (D / 64) * (NIN / 32), I_O = (D / 64) * (D / 32);
        for (int it = gw; it < I_GU; it += NGW) tr_gu(a.in[2], a.in[3], Wgu1, it, scr, lane);
        for (int m = gw; m < M; m += NGW) { f32x4 v[4]; rms_row(x + (size_t)m * D, a.in[1], lane, v); store_row_bf16(XN + (size_t)m * D, lane, v); }
    }
    GSYNC();
    if (a.ws == nullptr) grid.sync();
    {
        pg8::Gemm g{XN, Wgu1, M, NGU, D}; pg8::StaticOrder S; S.init(M, NGU, G, (int)blockIdx.x);
        pg8::EpiSwiGLU<false> E{ACT, FF, nullptr};
        pg8::gemm_phase<pg8::EpiSwiGLU<false>, pg8::StaticOrder, true, true>(L8, g, S, E);
        {
            constexpr int I_D = (FF / 64) * (D / 32), I_IN = (D / 64) * (NIN / 32), I_O = (D / 64) * (D / 32);
            const int rem = ((M / 256) * (NGU / 256)) % G, nbf = rem ? G - rem : G, jf = rem ? (int)blockIdx.x - rem : (int)blockIdx.x;
            if (jf >= 0) { const int lane_f = opq(tid) & 63; LAS float* scr = L + wave * 4096;
                for (int it = jf * NWAVES + wave; it < I_D + I_IN + I_O; it += nbf * NWAVES) { int r = it;
                    if (r < I_D) { tr_plain(a.in[4], FF, D, Wd1, r, scr, lane_f); continue; } r -= I_D;
                    if (r < I_IN) { tr_win(a.in[6], Win, r, scr, lane_f, a.in[5]); continue; } r -= I_IN;
                    tr_plain(a.in[11], D, D, Wout, r, scr, lane_f); } }
        }
    }
    GSYNC();
    {
        pg8::Gemm g{ACT, Wd1, M, D, FF}; pg8::StaticOrder S; S.init(M, D, G, (int)blockIdx.x);
        pg8::EpiRes<true> E{x, out, D, 0.5f, XN, (float*)(ws + WS_SS)};
        pg8::gemm_phase<pg8::EpiRes<true>, pg8::StaticOrder, true, true>(L8, g, S, E);
    }
    GSYNC();
    {
        pg8::Gemm g{XN, Win, M, NIN, D}; pg8::StaticOrder S; S.init(M, NIN, G, (int)blockIdx.x);
        pg8::EpiProj E{(bf16*)(ws + WS_QH), (bf16*)(ws + WS_KVH), PROJ, (float*)(ws + WS_BD), (const float*)(ws + WS_SS)};
        pg8::gemm_phase<pg8::EpiProj, pg8::StaticOrder, true, true>(L8, g, S, E);
        {
            constexpr int I_GU = (D / 64) * (NGU / 32), I_D = (FF / 64) * (D / 32);
            const int rem = ((M / 256) * (NIN / 256)) % G, nbf = rem ? G - rem : G, jf = rem ? (int)blockIdx.x - rem : (int)blockIdx.x;
            if (jf >= 0) { const int lane_f = opq(tid) & 63; LAS float* scr = L + wave * 4096;
                for (int it = jf * NWAVES + wave; it < I_GU + I_D; it += nbf * NWAVES) {
                    if (it < I_GU) tr_gu(a.in[13], a.in[14], Wgu2, it, scr, lane_f, a.in[12]); else tr_plain(a.in[15], FF, D, Wd2, it - I_GU, scr, lane_f); } }
        }
    }
    GSYNC();
    { const int tid_ = opq(tid); for (int ch = blockIdx.x; ch < 1024; ch += G) dn_prep_item(a, L8, ch, tid_, tid_ & 63, wave); }
    GSYNC();
    {
        const int tid_ = opq(tid), lane = tid_ & 63;
        for (int it = blockIdx.x; it < 64; it += G) dn_scan_mfma(a, L8, it, tid_, lane, wave);
        float* ML = (float*)(ws + WS_ML);
        if ((int)blockIdx.x >= 64 || G <= 64) {
            const int nb = (G > 64) ? G - 64 : G, j0 = (G > 64) ? (int)blockIdx.x - 64 : (int)blockIdx.x;
            for (int item = j0; item < 1536; item += nb) attn_item((const bf16*)(ws + WS_QH), (const bf16*)(ws + WS_KVH), PROJ, ML, L8, item, tid, lane, wave);
        }
    }
    GSYNC();
    {
        const int lane = opq(tid) & 63;
        const float* dn_norm = a.in[10];
        for (int m = gw; m < M; m += NGW) {
            bf16* op = MIX + (size_t)m * 1024 + 512 + 8 * lane; const bf16* gp = PROJ + (size_t)m * P2LD + 1536 + 8 * lane;
            const v4u ow = *(const v4u*)op, gwv = *(const v4u*)gp;
            float o[8] = {bflo(ow.x), bfhi(ow.x), bflo(ow.y), bfhi(ow.y), bflo(ow.z), bfhi(ow.z), bflo(ow.w), bfhi(ow.w)};
            float gt[8] = {bflo(gwv.x), bfhi(gwv.x), bflo(gwv.y), bfhi(gwv.y), bflo(gwv.z), bfhi(gwv.z), bflo(gwv.w), bfhi(gwv.w)};
            float ss = 0.f;
#pragma unroll
            for (int i = 0; i < 8; ++i) ss += o[i] * o[i];
            ss += __shfl_xor(ss, 1); ss += __shfl_xor(ss, 2); ss += __shfl_xor(ss, 4); ss += __shfl_xor(ss, 8);
            const float rs = 1.0f / sqrtf(ss * (1.f / 128.f) + 1e-6f);
            const int d0 = (8 * lane) & 127;
            float r[8];
#pragma unroll
            for (int i = 0; i < 8; ++i) r[i] = o[i] * rs * dn_norm[d0 + i] * (gt[i] / (1.f + __expf(-gt[i])));
            v4u w; w.x = pk2(r[0], r[1]); w.y = pk2(r[2], r[3]); w.z = pk2(r[4], r[5]); w.w = pk2(r[6], r[7]);
            *(v4u*)op = w;
            {
                const int ha = lane >> 3;
                const float* ml = (const float*)(ws + WS_ML) + ((size_t)m * 8 + ha) * 6;
                const f32x2 a0 = *(const f32x2*)ml, a1 = *(const f32x2*)(ml + 2), a2 = *(const f32x2*)(ml + 4);
                const float mm = fmaxf(a0.x, fmaxf(a1.x, a2.x));
                const float w0 = a0.y * __builtin_amdgcn_exp2f(a0.x - mm), w1 = a1.y * __builtin_amdgcn_exp2f(a1.x - mm), w2 = a2.y * __builtin_amdgcn_exp2f(a2.x - mm);
                const float iw = 1.0f / (w0 + w1 + w2);
                const bf16* pp = PROJ + (size_t)m * P2LD + 8 * lane;
                const v4u p0 = *(const v4u*)pp, p1 = *(const v4u*)(pp + 512), p2 = *(const v4u*)(pp + 1024);
                float rr[8];
                rr[0] = w0 * bflo(p0.x) + w1 * bflo(p1.x) + w2 * bflo(p2.x); rr[1] = w0 * bfhi(p0.x) + w1 * bfhi(p1.x) + w2 * bfhi(p2.x);
                rr[2] = w0 * bflo(p0.y) + w1 * bflo(p1.y) + w2 * bflo(p2.y); rr[3] = w0 * bfhi(p0.y) + w1 * bfhi(p1.y) + w2 * bfhi(p2.y);
                rr[4] = w0 * bflo(p0.z) + w1 * bflo(p1.z) + w2 * bflo(p2.z); rr[5] = w0 * bfhi(p0.z) + w1 * bfhi(p1.z) + w2 * bfhi(p2.z);
                rr[6] = w0 * bflo(p0.w) + w1 * bflo(p1.w) + w2 * bflo(p2.w); rr[7] = w0 * bfhi(p0.w) + w1 * bfhi(p1.w) + w2 * bfhi(p2.w);
                v4u wa; wa.x = pk2(rr[0] * iw, rr[1] * iw); wa.y = pk2(rr[2] * iw, rr[3] * iw); wa.z = pk2(rr[4] * iw, rr[5] * iw); wa.w = pk2(rr[6] * iw, rr[7] * iw);
                *(v4u*)(MIX + (size_t)m * 1024 + 8 * lane) = wa;
            }
        }
    }
    GSYNC();
    {
        pg8::Gemm g{MIX, Wout, M, D, D}; pg8::StaticOrder S; S.init(M, D, G, (int)blockIdx.x);
        pg8::EpiRes<true> E{out, out, D, 1.0f, (bf16*)(ws + WS_XNB2), (float*)(ws + WS_SS)};
        pg8::gemm_phase<pg8::EpiRes<true>, pg8::StaticOrder, true, true>(L8, g, S, E);
    }
    GSYNC();
    {
        pg8::Gemm g{(const bf16*)(ws + WS_XNB2), Wgu2, M, NGU, D}; pg8::StaticOrder S; S.init(M, NGU, G, (int)blockIdx.x);
        pg8::EpiSwiGLU<true> E{ACT, FF, (const float*)(ws + WS_SS)};
        pg8::gemm_phase<pg8::EpiSwiGLU<true>, pg8::StaticOrder, true, true>(L8, g, S, E);
    }
    GSYNC();
    {
        pg8::Gemm g{ACT, Wd2, M, D, FF}; pg8::StaticOrder S; S.init(M, D, G, (int)blockIdx.x);
        pg8::EpiRes<false> E{out, out, D, 0.5f, nullptr, nullptr};
        pg8::gemm_phase<pg8::EpiRes<false>, pg8::StaticOrder, true, true>(L8, g, S, E);
    }
    GSYNC();
    const int lnf = opq(tid) & 63;
    for (int m = gw; m < M; m += NGW) {
        f32x4 v[4]; rms_row(out + (size_t)m * D, a.in[16], lnf, v);
        f32x4* o = (f32x4*)(out + (size_t)m * D) + lnf;
#pragma unroll
        for (int j = 0; j < 4; ++j) o[64 * j] = v[j];
    }
}

extern "C" void kernel_launch(void* const* d_in, const int* in_sizes, int n_in, void* d_out, int out_size, void* d_ws, size_t ws_size, hipStream_t stream) {
    static int grid = 0;
    if (grid == 0) {
        if (n_in != 17 || in_sizes[0] != M * D || out_size != M * D || ws_size < WS_END) { fprintf(stderr, "kernel_launch: unexpected shapes (n_in %d in0 %d out %d ws %zu)\n", n_in, n_in > 0 ? in_sizes[0] : -1, out_size, ws_size); grid = -1; return; }
        int dev = 0, cus = 0, per_cu = 0;
        hipGetDevice(&dev); hipDeviceGetAttribute(&cus, hipDeviceAttributeMultiprocessorCount, dev);
        if (hipFuncSetAttribute((const void*)fwd_megakernel, hipFuncAttributeMaxDynamicSharedMemorySize, LDS_BYTES) != hipSuccess) { fprintf(stderr, "kernel_launch: hipFuncSetAttribute failed\n"); grid = -1; return; }
        if (hipOccupancyMaxActiveBlocksPerMultiprocessor(&per_cu, (const void*)fwd_megakernel, NWAVES * 64, LDS_BYTES) != hipSuccess || per_cu < 1) { fprintf(stderr, "kernel_launch: occupancy query says %d blocks/CU\n", per_cu); (void)hipGetLastError(); per_cu = 1; }
        grid = cus * 1;
        fprintf(stderr, "kernel_launch: cus %d per_cu %d grid %d\n", cus, per_cu, grid);
    }
    if (grid < 0) return;
    hipMemsetAsync((char*)d_ws + WS_CTL, 0, CTL_BYTES, stream);
    Args a{};
    for (int i = 0; i < 17; ++i) a.in[i] = (const float*)d_in[i];
    a.out = (float*)d_out; a.ws = (unsigned char*)d_ws;
    void* args[] = {&a};
    hipError_t e = hipLaunchCooperativeKernel((const void*)fwd_megakernel, dim3(grid), dim3(NWAVES * 64), args, LDS_BYTES, stream);
    if (e != hipSuccess) fprintf(stderr, "cooperative launch failed: %s (grid %d)\n", hipGetErrorString(e), grid);
}
```

```cpp
#include <hip/hip_runtime.h>
#include <hip/hip_cooperative_groups.h>
#include <cstdio>
#include <cstdint>
namespace cg = cooperative_groups;
namespace pg8 {
#define PG8_LAS __attribute__((address_space(3)))
typedef unsigned short bf16_t;
typedef short bf16x8 __attribute__((ext_vector_type(8)));
typedef float f32x4 __attribute__((ext_vector_type(4)));
typedef unsigned u32x4 __attribute__((ext_vector_type(4)));
constexpr int BM = 256, BK = 64, HALF = 128, HTB = HALF * BK * 2  , STAGE_BYTES = 8 * HTB, NXCD = 8, WGM = 8;

__host__ __device__ __forceinline__ int lds_byte(int r, int c) { const int st = (r >> 4) * 2 + (c >> 5), rr = r & 15, cc = c & 31, ob = rr * 64 + cc * 2; return st * 1024 + (ob ^ (((ob >> 9) & 1) << 5)); }
__host__ __device__ __forceinline__ void stage_rc(int b, int& R, int& C) { const int st = b / 1024, sb = b % 1024, swz = sb ^ (((sb >> 9) & 1) << 5); R = (st >> 1) * 16 + swz / 64; C = (st & 1) * 32 + (swz % 64) / 2; }
__host__ __device__ __forceinline__ int perm32(int rho) { const int n = rho >> 4, i = rho & 15; return 8 * (i >> 2) + 4 * n + (i & 3); }

struct Unit { int pm, pn; };
struct Gemm { const bf16_t* A; const bf16_t* Bt; int M, N, K; };

struct StaticOrder {
    int nM, nN, nwg, G, c;
    __host__ __device__ void init(int M, int N, int G_, int c_) { nM = M / BM; nN = N / BM; nwg = nM * nN; G = G_; c = c_; }
    __host__ __device__ bool next(int i, Unit& u) const {
        const long L = (long)i * G + c; if (L >= nwg) return false;
        int wgid = (int)L; { const int q = nwg / NXCD, r = nwg % NXCD, xcd = wgid % NXCD, off = wgid / NXCD; wgid = (xcd < r ? xcd * (q + 1) : r * (q + 1) + (xcd - r) * q) + off; }
        const int nig = WGM * nN, gid = wgid / nig, fm = gid * WGM, gsz = (nM - fm) < WGM ? (nM - fm) : WGM;
        u.pm = fm + ((wgid % nig) % gsz); u.pn = (wgid % nig) / gsz; return true;
    }
    __device__ __forceinline__ void a_ready(const Unit&) const {}
    __device__ __forceinline__ void done(const Unit&) const {}
};

__device__ __forceinline__ unsigned cvt_pk_bf16(float lo, float hi) { unsigned r; asm volatile("v_cvt_pk_bf16_f32 %0, %1, %2" : "=v"(r) : "v"(lo), "v"(hi)); return r; }
__device__ __forceinline__ float silu_f(float g) { return g * __builtin_amdgcn_rcpf(1.0f + __expf(-g)); }
__device__ __forceinline__ float row_rs(const float* SS, int row) {
    const f32x4* sp = (const f32x4*)(SS + (size_t)row * 16); const f32x4 a = sp[0], b = sp[1], c = sp[2], d = sp[3];
    const float s = ((a[0] + a[1]) + (a[2] + a[3])) + ((b[0] + b[1]) + (b[2] + b[3])) + ((c[0] + c[1]) + (c[2] + c[3])) + ((d[0] + d[1]) + (d[2] + d[3]));
    return 1.0f / sqrtf(s * (1.0f / 1024.0f) + 1e-6f);
}
template <bool RS> struct EpiSwiGLU {
    static constexpr bool PERM = true, AFTER_DRAIN = false;
    bf16_t* O; int ldc; const float* SS;
    __device__ __forceinline__ void operator()(const f32x4 (&acc)[2][2][4][2], const Unit& u, int wr, int wc, int fr, int fq) const {
        const int row0 = u.pm * BM + wr * 64 + fr; const int col0 = u.pn * 128 + wc * 32 + 8 * fq;
#pragma unroll
        for (int ai = 0; ai < 2; ++ai)
#pragma unroll
            for (int m = 0; m < 4; ++m) { const int row = row0 + ai * HALF + m * 16; bf16_t* rowp = O + (size_t)row * ldc + col0;
                const float rs = RS ? row_rs(SS, row) : 1.0f;
                const f32x4 g0 = acc[ai][0][m][0] * rs, g1 = acc[ai][0][m][1] * rs, u0 = acc[ai][1][m][0] * rs, u1 = acc[ai][1][m][1] * rs;
                u32x4 w;
                w.x = cvt_pk_bf16(silu_f(g0[0]) * u0[0], silu_f(g0[1]) * u0[1]); w.y = cvt_pk_bf16(silu_f(g0[2]) * u0[2], silu_f(g0[3]) * u0[3]);
                w.z = cvt_pk_bf16(silu_f(g1[0]) * u1[0], silu_f(g1[1]) * u1[1]); w.w = cvt_pk_bf16(silu_f(g1[2]) * u1[2], silu_f(g1[3]) * u1[3]);
                *(u32x4*)rowp = w; }
    }
};
template <bool XB> struct EpiRes {
    static constexpr bool PERM = false, AFTER_DRAIN = false;
    const float* base; float* out; int ldc; float scale; bf16_t* xb; float* SS;
    __device__ __forceinline__ void operator()(const f32x4 (&acc)[2][2][4][2], const Unit& u, int wr, int wc, int fr, int fq) const {
        const int row0 = u.pm * BM + wr * 64 + fr; const int col0 = u.pn * BM + wc * 32 + 4 * fq;
#pragma unroll
        for (int ai = 0; ai < 2; ++ai)
#pragma unroll
            for (int m = 0; m < 4; ++m) { const int row = row0 + ai * HALF + m * 16; const size_t off = (size_t)row * ldc + col0; float ss = 0.f;
#pragma unroll
                for (int bj = 0; bj < 2; ++bj)
#pragma unroll
                    for (int n = 0; n < 2; ++n) { const f32x4 b = *(const f32x4*)(base + off + bj * HALF + n * 16); const f32x4 v = b + acc[ai][bj][m][n] * scale; *(f32x4*)(out + off + bj * HALF + n * 16) = v;
                        if (XB) { ss += (v[0] * v[0] + v[1] * v[1]) + (v[2] * v[2] + v[3] * v[3]);
                            unsigned lo = cvt_pk_bf16(v[0], v[1]), hi = cvt_pk_bf16(v[2], v[3]); unsigned long long pk = ((unsigned long long)hi << 32) | lo;
                            *(unsigned long long*)(xb + off + bj * HALF + n * 16) = pk; } }
                if (XB) { ss += __shfl_xor(ss, 16); ss += __shfl_xor(ss, 32); if (fq == 0) SS[(size_t)row * 16 + u.pn * 4 + wc] = ss; }
                asm volatile("" ::: "memory"); }
    }
};
struct EpiProj {
    static constexpr bool PERM = true, AFTER_DRAIN = false;
    bf16_t* Qh; bf16_t* KVh; bf16_t* P2; float* BD; const float* SS;
    __device__ __forceinline__ void operator()(const f32x4 (&acc)[2][2][4][2], const Unit& u, int wr, int wc, int fr, int fq) const {
        const int row0 = u.pm * BM + wr * 64 + fr;
        if (u.pn == 14) {
            if (wc == 0 && fq == 0) {
#pragma unroll
                for (int ai = 0; ai < 2; ++ai)
#pragma unroll
                    for (int m = 0; m < 4; ++m) { const int row = row0 + ai * HALF + m * 16; const float rs = row_rs(SS, row);
                        *(f32x4*)(BD + (size_t)row * 8) = acc[ai][0][m][0] * rs; *(f32x4*)(BD + (size_t)row * 8 + 4) = acc[ai][0][m][1] * rs; }
            }
            return;
        }
#pragma unroll
        for (int ai = 0; ai < 2; ++ai)
#pragma unroll
            for (int m = 0; m < 4; ++m) { const int row = row0 + ai * HALF + m * 16, bb = row >> 12, t = row & 4095; const float rs = row_rs(SS, row);
#pragma unroll
                for (int bj = 0; bj < 2; ++bj) { const int col = u.pn * BM + bj * HALF + wc * 32 + 8 * fq;
                    bf16_t* dst;
                    if (u.pn < 6) { const int sec = col >> 9, hc = col & 511, hh = hc >> 6, d = hc & 63; const size_t rt = (size_t)(bb * 8 + hh) * 4096 + t;
                        dst = (sec == 0) ? Qh + rt * 64 + d : KVh + rt * 128 + (sec - 1) * 64 + d; }
                    else dst = P2 + (size_t)row * 2048 + (col - 1536);
                    const f32x4 v0 = acc[ai][bj][m][0] * rs, v1 = acc[ai][bj][m][1] * rs; u32x4 w;
                    w.x = cvt_pk_bf16(v0[0], v0[1]); w.y = cvt_pk_bf16(v0[2], v0[3]); w.z = cvt_pk_bf16(v1[0], v1[1]); w.w = cvt_pk_bf16(v1[2], v1[3]);
                    *(u32x4*)dst = w; } }
    }
};
struct EpiStoreBf16 {
    static constexpr bool PERM = true, AFTER_DRAIN = false;
    bf16_t* O; int ldc;
    __device__ __forceinline__ void operator()(const f32x4 (&acc)[2][2][4][2], const Unit& u, int wr, int wc, int fr, int fq) const {
        const int row0 = u.pm * BM + wr * 64 + fr; const int col0 = u.pn * BM + wc * 32 + 8 * fq;
#pragma unroll
        for (int ai = 0; ai < 2; ++ai)
#pragma unroll
            for (int m = 0; m < 4; ++m) { bf16_t* rowp = O + (size_t)(row0 + ai * HALF + m * 16) * ldc + col0;
#pragma unroll
                for (int bj = 0; bj < 2; ++bj) { const f32x4 v0 = acc[ai][bj][m][0], v1 = acc[ai][bj][m][1]; u32x4 w;
                    w.x = cvt_pk_bf16(v0[0], v0[1]); w.y = cvt_pk_bf16(v0[2], v0[3]); w.z = cvt_pk_bf16(v1[0], v1[1]); w.w = cvt_pk_bf16(v1[2], v1[3]);
                    *(u32x4*)(rowp + bj * HALF) = w; } }
    }
};
template <class Epi, class Sched, bool ALIGN_EPI = false, bool SP2 = false>
__device__ __forceinline__ void gemm_phase(PG8_LAS unsigned char* lds, const Gemm g, const Sched& S, const Epi& E) {
    int tid_o = threadIdx.x; asm volatile("" : "+v"(tid_o));
    const int tid = tid_o, wid = __builtin_amdgcn_readfirstlane(tid >> 6), lane = tid & 63, wr = wid >> 2, wc = wid & 3, fr = lane & 15, fq = lane >> 4;
    const int K = g.K, nt = K / BK;
    unsigned voffA[2], voffB[2];
#pragma unroll
    for (int i = 0; i < 2; ++i) { int R, C; stage_rc(tid * 16 + i * 8192, R, C); const int Rb = Epi::PERM ? ((R & ~31) + perm32(R & 31)) : R;
        voffA[i] = (unsigned)(R * K + C) * 2u; voffB[i] = (unsigned)(Rb * K + C) * 2u; }
    const size_t kstep = (size_t)(BK * 2);
    const size_t hstep = (size_t)HALF * K * 2;
    const size_t tstep = 2 * hstep;
    const unsigned ldsw = (unsigned)wid * 1024u;
    const int aoff = lds_byte(wr * 64 + fr, fq * 8), boff = lds_byte(wc * 32 + fr, fq * 8);
#define PG8_SA(b, h) (((b) * 2 + (h)) * HTB)
#define PG8_SB(b, h) ((4 + (b) * 2 + (h)) * HTB)
#define PG8_STAGE(bufoff, gbase, voff) do { _Pragma("unroll") for (int _i = 0; _i < 2; ++_i) \
        __builtin_amdgcn_global_load_lds((const unsigned*)((const char*)(gbase) + (voff)[_i]), (PG8_LAS unsigned*)(lds + (bufoff) + ldsw + _i * 8192), 16, 0, 0); } while (0)
#define PG8_LDA(dst, b, h) do { _Pragma("unroll") for (int m = 0; m < 4; ++m) _Pragma("unroll") for (int k = 0; k < 2; ++k) dst[m][k] = *(const PG8_LAS bf16x8*)(lds + PG8_SA(b, h) + aoff + m * 2048 + k * 1024); } while (0)
#define PG8_LDB(dst, b, h) do { _Pragma("unroll") for (int n = 0; n < 2; ++n) _Pragma("unroll") for (int k = 0; k < 2; ++k) dst[n][k] = *(const PG8_LAS bf16x8*)(lds + PG8_SB(b, h) + boff + n * 2048 + k * 1024); } while (0)
#define PG8_MMA(ai, bj, At, Bt) do { __builtin_amdgcn_s_setprio(1); _Pragma("unroll") for (int m = 0; m < 4; ++m) _Pragma("unroll") for (int n = 0; n < 2; ++n) _Pragma("unroll") for (int k = 0; k < 2; ++k) \
        acc[ai][bj][m][n] = __builtin_amdgcn_mfma_f32_16x16x32_bf16(Bt[n][k], At[m][k], acc[ai][bj][m][n], 0, 0, 0); __builtin_amdgcn_s_setprio(0); } while (0)
#define PG8_WAIT_V(n) asm volatile("s_waitcnt vmcnt(" #n ")" ::: "memory")
#define PG8_WAIT_L(n) asm volatile("s_waitcnt lgkmcnt(" #n ")" ::: "memory")
#define PG8_BAR __builtin_amdgcn_s_barrier()
#define PG8_SCHED __builtin_amdgcn_sched_barrier(0)
    Unit cur, nxt; int ui = 0;
    if (!S.next(0, cur)) return;
    f32x4 acc[2][2][4][2];
#pragma unroll
    for (int a = 0; a < 2; ++a)
#pragma unroll
        for (int b = 0; b < 2; ++b)
#pragma unroll
            for (int m = 0; m < 4; ++m)
#pragma unroll
                for (int n = 0; n < 2; ++n) acc[a][b][m][n] = (f32x4){0.f, 0.f, 0.f, 0.f};
    bf16x8 At[4][2], B0[2][2], B1[2][2];
    const char* cA = (const char*)g.A + (size_t)cur.pm * tstep; const char* cB = (const char*)g.Bt + (size_t)cur.pn * tstep;
    S.a_ready(cur);
    if constexpr (SP2) {
        PG8_STAGE(PG8_SB(0, 0), cB, voffB); PG8_STAGE(PG8_SB(0, 1), cB + hstep, voffB); PG8_STAGE(PG8_SA(0, 0), cA, voffA); PG8_STAGE(PG8_SA(0, 1), cA + hstep, voffA);
        if (wr == 1) PG8_BAR;
        PG8_WAIT_V(2); PG8_BAR;
        PG8_STAGE(PG8_SB(1, 0), cB + kstep, voffB); PG8_STAGE(PG8_SA(1, 0), cA + kstep, voffA); PG8_STAGE(PG8_SB(1, 1), cB + hstep + kstep, voffB);
        PG8_WAIT_V(6); PG8_BAR;
    } else {
        PG8_STAGE(PG8_SB(0, 0), cB, voffB); PG8_STAGE(PG8_SA(0, 0), cA, voffA); PG8_STAGE(PG8_SB(0, 1), cB + hstep, voffB); PG8_STAGE(PG8_SA(0, 1), cA + hstep, voffA);
        if (wr == 1) PG8_BAR;
        PG8_WAIT_V(4); PG8_BAR;
        PG8_STAGE(PG8_SB(1, 0), cB + kstep, voffB); PG8_STAGE(PG8_SA(1, 0), cA + kstep, voffA); PG8_STAGE(PG8_SB(1, 1), cB + hstep + kstep, voffB);
        PG8_WAIT_V(6); PG8_BAR;
    }
    for (;;) {
        const bool has_next = S.next(ui + 1, nxt);
        const char* nA = has_next ? (const char*)g.A + (size_t)nxt.pm * tstep : cA; const char* nB = has_next ? (const char*)g.Bt + (size_t)nxt.pn * tstep : cB;
        for (int t = 0; t < nt; t += 2) {
            const bool last = (t == nt - 2);
            const char* a1 = cA + (size_t)(t + 1) * kstep;
            const char* a2 = last ? nA : cA + (size_t)(t + 2) * kstep; const char* b2 = last ? nB : cB + (size_t)(t + 2) * kstep;
            const char* a3 = a2 + kstep; const char* b3 = b2 + kstep;
            if (last && has_next) S.a_ready(nxt);
            if constexpr (SP2) {
            PG8_LDB(B0, 0, 0); PG8_LDB(B1, 0, 1); PG8_SCHED; PG8_LDA(At, 0, 0); PG8_STAGE(PG8_SA(1, 1), a1 + hstep, voffA);
            PG8_WAIT_V(8); PG8_WAIT_L(0); PG8_BAR; PG8_MMA(0, 0, At, B0); PG8_MMA(0, 1, At, B1); PG8_BAR; PG8_SCHED;
            PG8_LDA(At, 0, 1); PG8_STAGE(PG8_SB(0, 0), b2, voffB); PG8_STAGE(PG8_SB(0, 1), b2 + hstep, voffB); PG8_STAGE(PG8_SA(0, 0), a2, voffA);
            PG8_WAIT_V(8); PG8_WAIT_L(0); PG8_BAR; PG8_MMA(1, 0, At, B0); PG8_MMA(1, 1, At, B1); PG8_BAR; PG8_SCHED;
            PG8_LDB(B0, 1, 0); PG8_LDB(B1, 1, 1); PG8_SCHED; PG8_LDA(At, 1, 0); PG8_STAGE(PG8_SA(0, 1), a2 + hstep, voffA);
            PG8_WAIT_V(8); PG8_WAIT_L(0); PG8_BAR; PG8_MMA(0, 0, At, B0); PG8_MMA(0, 1, At, B1); PG8_BAR; PG8_SCHED;
            PG8_LDA(At, 1, 1); PG8_STAGE(PG8_SB(1, 0), b3, voffB); PG8_STAGE(PG8_SB(1, 1), b3 + hstep, voffB); PG8_STAGE(PG8_SA(1, 0), a3, voffA);
            PG8_WAIT_V(8); PG8_WAIT_L(0); PG8_BAR; PG8_MMA(1, 0, At, B0); PG8_MMA(1, 1, At, B1); PG8_BAR; PG8_SCHED;
            } else {
            PG8_LDB(B0, 0, 0); PG8_SCHED; PG8_LDA(At, 0, 0); PG8_STAGE(PG8_SA(1, 1), a1 + hstep, voffA);
            PG8_WAIT_L(8); PG8_BAR; PG8_WAIT_L(0); PG8_MMA(0, 0, At, B0); PG8_BAR; PG8_SCHED;
            PG8_LDB(B1, 0, 1); PG8_STAGE(PG8_SB(0, 0), b2, voffB);
            PG8_BAR; PG8_WAIT_L(0); PG8_MMA(0, 1, At, B1); PG8_BAR;
            PG8_LDA(At, 0, 1); PG8_STAGE(PG8_SA(0, 0), a2, voffA);
            PG8_BAR; PG8_WAIT_L(0); PG8_MMA(1, 0, At, B0); PG8_BAR; PG8_SCHED;
            PG8_STAGE(PG8_SB(0, 1), b2 + hstep, voffB);
            PG8_WAIT_V(6); PG8_BAR; PG8_MMA(1, 1, At, B1); PG8_BAR;
            PG8_LDB(B0, 1, 0); PG8_SCHED; PG8_LDA(At, 1, 0); PG8_STAGE(PG8_SA(0, 1), a2 + hstep, voffA);
            PG8_WAIT_L(8); PG8_BAR; PG8_WAIT_L(0); PG8_MMA(0, 0, At, B0); PG8_BAR; PG8_SCHED;
            PG8_LDB(B1, 1, 1); PG8_STAGE(PG8_SB(1, 0), b3, voffB);
            PG8_BAR; PG8_WAIT_L(0); PG8_MMA(0, 1, At, B1); PG8_BAR;
            PG8_LDA(At, 1, 1); PG8_STAGE(PG8_SA(1, 0), a3, voffA);
            PG8_BAR; PG8_WAIT_L(0); PG8_MMA(1, 0, At, B0); PG8_BAR; PG8_SCHED;
            PG8_STAGE(PG8_SB(1, 1), b3 + hstep, voffB);
            PG8_WAIT_V(6); PG8_BAR; PG8_MMA(1, 1, At, B1); PG8_BAR;
            }
        }
        if constexpr (ALIGN_EPI) { if (wr == 0) PG8_BAR; }
        if constexpr (!Epi::AFTER_DRAIN) { E(acc, cur, wr, wc, fr, fq); S.done(cur); }
        if (!has_next) break;
#pragma unroll
        for (int a = 0; a < 2; ++a)
#pragma unroll
            for (int b = 0; b < 2; ++b)
#pragma unroll
                for (int m = 0; m < 4; ++m)
#pragma unroll
                    for (int n = 0; n < 2; ++n) acc[a][b][m][n] = (f32x4){0.f, 0.f, 0.f, 0.f};
        cur = nxt; cA = nA; cB = nB; ++ui;
        if constexpr (ALIGN_EPI) { if (wr == 1) PG8_BAR; }
    }
    PG8_WAIT_V(0);
    if constexpr (!ALIGN_EPI) { if (wr == 0) PG8_BAR; }
    PG8_BAR;
    if constexpr (Epi::AFTER_DRAIN) { E.fused(acc, cur, wr, wc, fr, fq, lds, wid, lane); S.done(cur); }
#undef PG8_SA
#undef PG8_SB
#undef PG8_STAGE
#undef PG8_LDA
#undef PG8_LDB
#undef PG8_MMA
#undef PG8_WAIT_V
#undef PG8_WAIT_L
#undef PG8_BAR
#undef PG8_SCHED
}
}
constexpr int M = 16384, D = 1024, FF = 2816, NGU = 5632, NIN = 3840, SEQ = 4096;
constexpr int WIN_COLS = 3592;
constexpr size_t MiB = 1u << 20;
constexpr size_t WS_CTL = 0, CTL_BYTES = 65536;
constexpr size_t WS_WIN = MiB / 4, WS_WOUT = 8 * MiB, WS_WGU2 = 10 * MiB, WS_WD2 = 21 * MiB;
constexpr size_t WS_XN = 27 * MiB;
constexpr size_t WS_ACT = 59 * MiB;
constexpr size_t WS_QH = 123 * MiB, WS_KVH = 139 * MiB;
constexpr int P2LD = 2048;
constexpr size_t WS_BD = 171 * MiB;
constexpr size_t WS_EG = 172 * MiB;
constexpr size_t WS_DN = 184 * MiB;
constexpr size_t WS_WGU1 = 184 * MiB, WS_WD1 = 195 * MiB;
constexpr size_t WS_QG = WS_DN, WS_KD = WS_DN + 16 * MiB, WS_U = WS_DN + 32 * MiB, WS_W = WS_DN + 48 * MiB, WS_A = WS_DN + 64 * MiB;
constexpr size_t WS_END = 256 * MiB;
constexpr int LDS_BYTES = 147456;
constexpr int NWAVES = 8;

#define GAS __attribute__((address_space(1)))
#define LAS __attribute__((address_space(3)))
typedef unsigned short bf16;
typedef unsigned v4u __attribute__((ext_vector_type(4)));
typedef unsigned v2u __attribute__((ext_vector_type(2)));
typedef float f32x4 __attribute__((ext_vector_type(4)));
typedef float f32x2 __attribute__((ext_vector_type(2)));
#define LDS_WAIT() asm volatile("s_waitcnt lgkmcnt(0)" ::: "memory")
__device__ __forceinline__ unsigned f2bf(float f) { unsigned u = __builtin_bit_cast(unsigned, f); return (u + 0x7fffu + ((u >> 16) & 1u)) >> 16; }
__device__ __forceinline__ unsigned pk2(float lo, float hi) { return f2bf(lo) | (f2bf(hi) << 16); }
__device__ __forceinline__ float bflo(unsigned u) { return __uint_as_float(u << 16); }
__device__ __forceinline__ float bfhi(unsigned u) { return __uint_as_float(u & 0xffff0000u); }
__device__ __forceinline__ float bf2f(bf16 v) { return __uint_as_float(((unsigned)v) << 16); }
__device__ __forceinline__ float wave_sum(float v) {
#pragma unroll
    for (int o = 1; o < 64; o <<= 1) v += __shfl_xor(v, o);
    return v;
}
__device__ __forceinline__ float wave_max(float v) {
#pragma unroll
    for (int o = 1; o < 64; o <<= 1) v = fmaxf(v, __shfl_xor(v, o));
    return v;
}

__device__ __forceinline__ int opq(int v) { asm volatile("" : "+v"(v)); return v; }
struct Args { const float* in[17]; float* out; unsigned char* ws; };

__device__ __forceinline__ void transpose_item(const float* src, int srcN, int srccol0, bf16* dst, int dstK, int dstrow0, int k0, LAS float* scr, int lane, const float* gain = nullptr, int nvalid = 32) {
    const int c4 = (lane & 7) * 4, r0 = lane >> 3;
    f32x4 v[8];
#pragma unroll
    for (int i = 0; i < 8; ++i) v[i] = (c4 < nvalid) ? *(const f32x4*)(src + (size_t)(k0 + r0 + 8 * i) * srcN + srccol0 + c4) : (f32x4){0.f, 0.f, 0.f, 0.f};
    if (gain) {
#pragma unroll
        for (int i = 0; i < 8; ++i) v[i] = v[i] * gain[k0 + r0 + 8 * i]; }
#pragma unroll
    for (int i = 0; i < 8; ++i) { LAS float* p = scr + (r0 + 8 * i) * 33 + c4; p[0] = v[i][0]; p[1] = v[i][1]; p[2] = v[i][2]; p[3] = v[i][3]; }
    LDS_WAIT(); asm volatile("" ::: "memory");
    const int c = lane & 7;
#pragma unroll
    for (int j = 0; j < 4; ++j) { const int n = (lane >> 3) + 8 * j; const LAS float* s = scr + (8 * c) * 33 + n;
        v4u o; o.x = pk2(s[0 * 33], s[1 * 33]); o.y = pk2(s[2 * 33], s[3 * 33]); o.z = pk2(s[4 * 33], s[5 * 33]); o.w = pk2(s[6 * 33], s[7 * 33]);
        *(v4u*)(dst + (size_t)(dstrow0 + n) * dstK + k0 + 8 * c) = o; }
    LDS_WAIT(); asm volatile("" ::: "memory");
}
__device__ __forceinline__ void tr_gu(const float* gate, const float* up, bf16* dst, int r, LAS float* scr, int lane, const float* gain = nullptr) {
    const int nblk = NGU / 32, kb = r / nblk, nb = r % nblk, dstrow0 = nb * 32, pn = dstrow0 >> 8, within = dstrow0 & 255;
    transpose_item(within < 128 ? gate : up, FF, pn * 128 + (within & 127), dst, D, dstrow0, kb * 64, scr, lane, gain);
}
__device__ __forceinline__ void tr_plain(const float* src, int K, int N, bf16* dst, int r, LAS float* scr, int lane) {
    const int nblk = N / 32, kb = r / nblk, nb = r % nblk;
    transpose_item(src, N, nb * 32, dst, K, nb * 32, kb * 64, scr, lane);
}
__device__ __forceinline__ void tr_win(const float* src, bf16* dst, int r, LAS float* scr, int lane, const float* gain) {
    const int nblk = NIN / 32, kb = r / nblk, nb = r % nblk, dstrow0 = nb * 32;
    const int srccol0 = dstrow0 < 3072 ? dstrow0 : (dstrow0 < 3584 ? dstrow0 + 8 : 3072), nvalid = dstrow0 < 3584 ? 32 : (dstrow0 == 3584 ? 8 : 0);
    transpose_item(src, WIN_COLS, srccol0, dst, D, dstrow0, kb * 64, scr, lane, gain, nvalid);
}

__device__ __forceinline__ void rms_row(const float* xrow, const float* gain, int lane, f32x4 (&v)[4]) {
    const f32x4* xr = (const f32x4*)xrow + lane; const f32x4* gr = (const f32x4*)gain + lane;
    float s = 0.f;
#pragma unroll
    for (int j = 0; j < 4; ++j) { v[j] = xr[64 * j]; s += (v[j].x * v[j].x + v[j].y * v[j].y) + (v[j].z * v[j].z + v[j].w * v[j].w); }
    const float rs = 1.0f / sqrtf(wave_sum(s) * (1.f / D) + 1e-6f);
#pragma unroll
    for (int j = 0; j < 4; ++j) { const f32x4 g = gr[64 * j]; v[j] = v[j] * rs * g; }
}
__device__ __forceinline__ void store_row_bf16(bf16* orow, int lane, const f32x4 (&v)[4]) {
    v2u* o8 = (v2u*)orow + lane;
#pragma unroll
    for (int j = 0; j < 4; ++j) { v2u w; w.x = pk2(v[j].x, v[j].y); w.y = pk2(v[j].z, v[j].w); o8[64 * j] = w; }
}

__device__ __forceinline__ int kperm(int x) { return 8 * ((x & 15) >> 2) + 4 * (x >> 4) + (x & 3); }
typedef short bf16x8 __attribute__((ext_vector_type(8)));
typedef __bf16 bf16x2_t __attribute__((ext_vector_type(2)));
__device__ __forceinline__ unsigned cvtpk(float lo, float hi) { f32x2 v = {lo, hi}; bf16x2_t b = __builtin_convertvector(v, bf16x2_t); return __builtin_bit_cast(unsigned, b); }
constexpr int PP = 68;
constexpr int PQ = 0, PK = 17408, PVB = 34816, PKB = 53248, PAS = 71680, PTS = 89088, PMS = 106496, PTB = 123904, PGC = 133120;
struct PrepIn { unsigned raw[11][3]; float cw[3][4][2]; float braw, draw; };
__device__ __forceinline__ void prep_load(PrepIn& P, const Args& a, int ch, int lane, int wave) {
    asm volatile("" : "+v"(lane));
    const unsigned char* ws = a.ws; const bf16* PROJ = (const bf16*)(ws + WS_ACT); const float* BD = (const float*)(ws + WS_BD); const float* conv_w = a.in[7];
    const int bh = ch >> 6, n = ch & 63, b = bh >> 2, h = bh & 3, tok0 = b * SEQ + n * 64;
#pragma unroll
    for (int i = 0; i < 11; ++i) { const int s = n * 64 + wave * 8 - 3 + i;
#pragma unroll
        for (int sec = 0; sec < 3; ++sec) P.raw[i][sec] = (s >= 0) ? *(const unsigned*)(PROJ + (size_t)(tok0 + wave * 8 - 3 + i) * P2LD + sec * 512 + h * 128 + 2 * lane) : 0u; }
#pragma unroll
    for (int sec = 0; sec < 3; ++sec)
#pragma unroll
        for (int j = 0; j < 4; ++j) { const f32x2 w = *(const f32x2*)(conv_w + j * 1536 + sec * 512 + h * 128 + 2 * lane); P.cw[sec][j][0] = w.x; P.cw[sec][j][1] = w.y; }
    P.braw = BD[(size_t)(tok0 + lane) * 8 + h]; P.draw = BD[(size_t)(tok0 + lane) * 8 + 4 + h];
}
__device__ __forceinline__ void dn_prep_item(PrepIn& P, const Args& a, LAS unsigned char* L8, int ch, int ch_next, int tid, int lane, int wave) {
    asm volatile("" : "+v"(tid), "+v"(lane));
    unsigned char* ws = a.ws;
    const bf16* PROJ = (const bf16*)(ws + WS_ACT);
    const float* BD = (const float*)(ws + WS_BD);
    const float* conv_w = a.in[7]; const float* a_log = a.in[8]; const float* dt_bias = a.in[9];
    const int bh = ch >> 6, n = ch & 63, b = bh >> 2, h = bh & 3;
    const int tok0 = b * SEQ + n * 64;
    LAS float* As = (LAS float*)(L8 + PAS); LAS float* Ts = (LAS float*)(L8 + PTS); LAS float* Ms = (LAS float*)(L8 + PMS);
    LAS float* gcs = (LAS float*)(L8 + PGC); LAS float* bts = gcs + 64;
    const int jl = lane & 15, kq = lane >> 4;
    float gpre, beta_l;
    {
        const float braw = P.braw, draw = P.draw + dt_bias[h];
        const float sp = fmaxf(draw, 0.f) + log1pf(__expf(-fabsf(draw)));
        float g = -expf(a_log[h]) * sp;
#pragma unroll
        for (int o = 1; o < 64; o <<= 1) { const float t = __shfl_up(g, o); if (lane >= o) g += t; }
        gpre = g; beta_l = 1.0f / (1.0f + __expf(-braw));
        if (wave == 0) { gcs[lane] = g; bts[lane] = beta_l; if (lane == 63) ((float*)(ws + WS_EG))[ch] = expf(g); }
    }
    for (int i = tid; i < 64 * PP; i += 512) Ts[i] = 0.f;
    {
        const float glast = __builtin_bit_cast(float, __builtin_amdgcn_readlane(__builtin_bit_cast(int, gpre), 63));
        bf16* QG = (bf16*)(ws + WS_QG) + (size_t)ch * 8192; bf16* KD = (bf16*)(ws + WS_KD) + (size_t)ch * 8192;
        unsigned vbp[8], kbp[8], kdp[8];
#pragma unroll
        for (int rr = 0; rr < 8; ++rr) {
            const int r = wave * 8 + rr;
            float val[3][2];
#pragma unroll
            for (int sec = 0; sec < 3; ++sec) { float v0 = 0.f, v1 = 0.f;
#pragma unroll
                for (int j = 0; j < 4; ++j) { v0 += bflo(P.raw[rr + j][sec]) * P.cw[sec][j][0]; v1 += bfhi(P.raw[rr + j][sec]) * P.cw[sec][j][1]; }
                val[sec][0] = v0 * __builtin_amdgcn_rcpf(1.f + __expf(-v0)); val[sec][1] = v1 * __builtin_amdgcn_rcpf(1.f + __expf(-v1)); }
            const float ssq = wave_sum(val[0][0] * val[0][0] + val[0][1] * val[0][1]);
            const float ssk = wave_sum(val[1][0] * val[1][0] + val[1][1] * val[1][1]);
            const float rq = __builtin_amdgcn_rsqf(ssq + 1e-6f) * 0.08838834764831845f, rk = __builtin_amdgcn_rsqf(ssk + 1e-6f);
            const float q0 = val[0][0] * rq, q1 = val[0][1] * rq, k0 = val[1][0] * rk, k1 = val[1][1] * rk;
            const float gr = __builtin_bit_cast(float, __builtin_amdgcn_readlane(__builtin_bit_cast(int, gpre), r)), be = __builtin_bit_cast(float, __builtin_amdgcn_readlane(__builtin_bit_cast(int, beta_l), r));
            const float eq = __expf(gr), ek = __expf(glast - gr), bek = be * eq;
            *(LAS unsigned*)(L8 + PQ + r * 272 + 4 * lane) = cvtpk(q0, q1);
            *(LAS unsigned*)(L8 + PK + r * 272 + 4 * lane) = cvtpk(k0, k1);
            vbp[rr] = cvtpk(val[2][0] * be, val[2][1] * be); kbp[rr] = cvtpk(k0 * bek, k1 * bek); kdp[rr] = cvtpk(k0 * ek, k1 * ek);
            const int d = 2 * lane;
            *(unsigned*)(QG + r * 128 + (d & 96) + kperm(d & 31)) = cvtpk(q0 * eq, q1 * eq);
        }
        if (ch_next < 1024) prep_load(P, a, ch_next, lane, wave);
#define PREP_LO4(p) (v4u){((p)[0] & 0xffffu) | ((p)[1] << 16), ((p)[2] & 0xffffu) | ((p)[3] << 16), ((p)[4] & 0xffffu) | ((p)[5] << 16), ((p)[6] & 0xffffu) | ((p)[7] << 16)}
#define PREP_HI4(p) (v4u){((p)[0] >> 16) | ((p)[1] & 0xffff0000u), ((p)[2] >> 16) | ((p)[3] & 0xffff0000u), ((p)[4] >> 16) | ((p)[5] & 0xffff0000u), ((p)[6] >> 16) | ((p)[7] & 0xffff0000u)}
        *(LAS v4u*)(L8 + PVB + (2 * lane) * 144 + 16 * wave) = PREP_LO4(vbp); *(LAS v4u*)(L8 + PVB + (2 * lane + 1) * 144 + 16 * wave) = PREP_HI4(vbp);
        *(LAS v4u*)(L8 + PKB + (2 * lane) * 144 + 16 * wave) = PREP_LO4(kbp); *(LAS v4u*)(L8 + PKB + (2 * lane + 1) * 144 + 16 * wave) = PREP_HI4(kbp);
        const int r0 = wave * 8, tpA = (r0 & 32) + kperm(r0 & 31), tpB = (r0 & 32) + kperm((r0 + 4) & 31);
        const v4u klo = PREP_LO4(kdp), khi = PREP_HI4(kdp);
        bf16* kd0 = KD + (2 * lane) * 64; bf16* kd1 = KD + (2 * lane + 1) * 64;
        *(v2u*)(kd0 + tpA) = (v2u){klo.x, klo.y}; *(v2u*)(kd0 + tpB) = (v2u){klo.z, klo.w};
        *(v2u*)(kd1 + tpA) = (v2u){khi.x, khi.y}; *(v2u*)(kd1 + tpB) = (v2u){khi.z, khi.w};
#undef PREP_LO4
#undef PREP_HI4
    }
    __syncthreads();
    {
        bf16* Aout = (bf16*)(ws + WS_A) + (size_t)ch * 4096;
#pragma unroll
        for (int t2 = 0; t2 < 2; ++t2) {
            const int idx = 2 * wave + t2, ct = idx >> 2, jt = idx & 3;
            f32x4 acc1 = {0.f, 0.f, 0.f, 0.f}, acc2 = {0.f, 0.f, 0.f, 0.f};
#pragma unroll
            for (int ks = 0; ks < 4; ++ks) {
                const bf16x8 kc = *(const LAS bf16x8*)(L8 + PK + (16 * ct + jl) * 272 + (32 * ks + 8 * kq) * 2);
                const bf16x8 kj = *(const LAS bf16x8*)(L8 + PK + (16 * jt + jl) * 272 + (32 * ks + 8 * kq) * 2);
                const bf16x8 qc = *(const LAS bf16x8*)(L8 + PQ + (16 * ct + jl) * 272 + (32 * ks + 8 * kq) * 2);
                acc1 = __builtin_amdgcn_mfma_f32_16x16x32_bf16(kc, kj, acc1, 0, 0, 0);
                acc2 = __builtin_amdgcn_mfma_f32_16x16x32_bf16(kj, qc, acc2, 0, 0, 0);
            }
            { const int j = 16 * jt + jl; const float gj = gcs[j];
#pragma unroll
              for (int e = 0; e < 4; ++e) { const int c = 16 * ct + 4 * kq + e; As[c * PP + j] = (j < c) ? bts[c] * acc1[e] * __expf(gcs[c] - gj) : 0.f; } }
            { const int c = 16 * ct + jl; const float gc_ = gcs[c]; float pv[4];
#pragma unroll
              for (int e = 0; e < 4; ++e) { const int j = 16 * jt + 4 * kq + e; pv[e] = (j <= c) ? acc2[e] * __expf(gc_ - gcs[j]) : 0.f; }
              v2u w; w.x = cvtpk(pv[0], pv[1]); w.y = cvtpk(pv[2], pv[3]);
              *(v2u*)(Aout + c * 64 + 32 * (jt >> 1) + 8 * kq + 4 * (jt & 1)) = w; }
        }
    }
    __syncthreads();
    if (wave == 0) {
        const int bb = lane >> 4, col = lane & 15;
        const LAS float* Ab = As + (16 * bb) * PP + 16 * bb;
        float xv[16];
        xv[0] = (col == 0) ? 1.f : 0.f;
        {
            f32x4 ar[9][2];
#pragma unroll
            for (int c = 1; c <= 8; ++c)
#pragma unroll
                for (int q = 0; q < 2; ++q) if (4 * q < c) ar[c][q] = *(const LAS f32x4*)(Ab + c * PP + 4 * q);
            __builtin_amdgcn_sched_barrier(0);
#pragma unroll
            for (int c = 1; c <= 8; ++c) { float s = (c == col) ? 1.f : 0.f;
#pragma unroll
                for (int j = 0; j < c; ++j) s -= ar[c][j >> 2][j & 3] * xv[j];
                xv[c] = s; }
        }
        __builtin_amdgcn_sched_barrier(0);
        {
            f32x4 ar[7][4];
#pragma unroll
            for (int c = 9; c < 16; ++c)
#pragma unroll
                for (int q = 0; q < 4; ++q) if (4 * q < c) ar[c - 9][q] = *(const LAS f32x4*)(Ab + c * PP + 4 * q);
            __builtin_amdgcn_sched_barrier(0);
#pragma unroll
            for (int c = 9; c < 16; ++c) { float s = (c == col) ? 1.f : 0.f;
#pragma unroll
                for (int j = 0; j < c; ++j) s -= ar[c - 9][j >> 2][j & 3] * xv[j];
                xv[c] = s; }
        }
#pragma unroll
        for (int c = 0; c < 16; ++c) Ts[(16 * bb + c) * PP + 16 * bb + col] = xv[c];
    }
    __syncthreads();
    {
        const int pr = tid >> 8, i = (tid >> 4) & 15, jj = tid & 15, hb = 32 * pr + 16, lb = 32 * pr;
        f32x4 a4[4]; float tc[16];
#pragma unroll
        for (int q = 0; q < 4; ++q) a4[q] = *(const LAS f32x4*)(As + (hb + i) * PP + lb + 4 * q);
#pragma unroll
        for (int k = 0; k < 16; ++k) tc[k] = Ts[(lb + k) * PP + lb + jj];
        __builtin_amdgcn_sched_barrier(0);
        float s = 0.f;
#pragma unroll
        for (int k = 0; k < 16; ++k) s += a4[k >> 2][k & 3] * tc[k];
        Ms[(hb + i) * PP + lb + jj] = s;
#pragma unroll
        for (int q = 0; q < 4; ++q) a4[q] = *(const LAS f32x4*)(Ts + (hb + i) * PP + hb + 4 * q);
        __syncthreads();
#pragma unroll
        for (int k = 0; k < 16; ++k) tc[k] = Ms[(hb + k) * PP + lb + jj];
        __builtin_amdgcn_sched_barrier(0);
        float t = 0.f;
#pragma unroll
        for (int k = 0; k < 16; ++k) t += a4[k >> 2][k & 3] * tc[k];
        Ts[(hb + i) * PP + lb + jj] = -t;
    }
    __syncthreads();
    {
        const int i = tid >> 4, j0 = (tid & 15) * 2;
        f32x4 a8[8]; f32x2 tc[32];
#pragma unroll
        for (int q = 0; q < 8; ++q) a8[q] = *(const LAS f32x4*)(As + (32 + i) * PP + 4 * q);
#pragma unroll
        for (int k = 0; k < 32; ++k) tc[k] = *(const LAS f32x2*)(Ts + k * PP + j0);
        __builtin_amdgcn_sched_barrier(0);
        float s0 = 0.f, s1 = 0.f;
#pragma unroll
        for (int k = 0; k < 32; ++k) { const float av = a8[k >> 2][k & 3]; s0 += av * tc[k].x; s1 += av * tc[k].y; }
        *(LAS f32x2*)(Ms + (32 + i) * PP + j0) = (f32x2){s0, s1};
#pragma unroll
        for (int q = 0; q < 8; ++q) a8[q] = *(const LAS f32x4*)(Ts + (32 + i) * PP + 32 + 4 * q);
        __syncthreads();
#pragma unroll
        for (int k = 0; k < 32; ++k) tc[k] = *(const LAS f32x2*)(Ms + (32 + k) * PP + j0);
        __builtin_amdgcn_sched_barrier(0);
        float t0 = 0.f, t1 = 0.f;
#pragma unroll
        for (int k = 0; k < 32; ++k) { const float tv = a8[k >> 2][k & 3]; t0 += tv * tc[k].x; t1 += tv * tc[k].y; }
        *(LAS f32x2*)(Ts + (32 + i) * PP + j0) = (f32x2){-t0, -t1};
    }
    __syncthreads();
#pragma unroll
    for (int i = 0; i < 4; ++i) { const int idx2 = tid + 512 * i, r = idx2 >> 5, c = (idx2 & 31) * 2; const f32x2 tv = *(const LAS f32x2*)(Ts + r * PP + c);
        *(LAS unsigned*)(L8 + PTB + r * 144 + 2 * c) = cvtpk(tv.x, tv.y); }
    __syncthreads();
    {
        bf16* U = (bf16*)(ws + WS_U) + (size_t)ch * 8192; bf16* W = (bf16*)(ws + WS_W) + (size_t)ch * 8192;
        const int mt = wave & 3, ntb = 4 * (wave >> 2);
        bf16x8 ta[2];
#pragma unroll
        for (int ks = 0; ks < 2; ++ks) ta[ks] = *(const LAS bf16x8*)(L8 + PTB + (16 * mt + jl) * 144 + (32 * ks + 8 * kq) * 2);
#pragma unroll
        for (int q = 0; q < 4; ++q) { const int nt = ntb + q; f32x4 acc = {0.f, 0.f, 0.f, 0.f};
#pragma unroll
            for (int ks = 0; ks < 2; ++ks) { const bf16x8 vb = *(const LAS bf16x8*)(L8 + PVB + (16 * nt + jl) * 144 + (32 * ks + 8 * kq) * 2);
                acc = __builtin_amdgcn_mfma_f32_16x16x32_bf16(ta[ks], vb, acc, 0, 0, 0); }
            v2u w; w.x = cvtpk(acc[0], acc[1]); w.y = cvtpk(acc[2], acc[3]);
            *(v2u*)(U + (16 * nt + jl) * 64 + 16 * mt + 4 * kq) = w; }
        bf16x8 ka[2];
#pragma unroll
        for (int ks = 0; ks < 2; ++ks) ka[ks] = *(const LAS bf16x8*)(L8 + PKB + (16 * wave + jl) * 144 + (32 * ks + 8 * kq) * 2);
#pragma unroll
        for (int ctile = 0; ctile < 4; ++ctile) { f32x4 acc = {0.f, 0.f, 0.f, 0.f};
#pragma unroll
            for (int ks = 0; ks < 2; ++ks) { const bf16x8 tb = *(const LAS bf16x8*)(L8 + PTB + (16 * ctile + jl) * 144 + (32 * ks + 8 * kq) * 2);
                acc = __builtin_amdgcn_mfma_f32_16x16x32_bf16(ka[ks], tb, acc, 0, 0, 0); }
            v2u w; w.x = cvtpk(-acc[0], -acc[1]); w.y = cvtpk(-acc[2], -acc[3]);
            *(v2u*)(W + (16 * ctile + jl) * 128 + 32 * (wave >> 1) + 8 * kq + 4 * (wave & 1)) = w; }
    }
    __syncthreads();
}

__device__ __forceinline__ bf16x8 pack8(const f32x4& a, const f32x4& b) { v4u w; w.x = cvtpk(a[0], a[1]); w.y = cvtpk(a[2], a[3]); w.z = cvtpk(b[0], b[1]); w.w = cvtpk(b[2], b[3]); return __builtin_bit_cast(bf16x8, w); }
constexpr int SC_W = 0, SC_QG = 17408, SC_KDT = 34816, SC_A = 53248, SC_U = 62464, SC_BUF = 67072;
constexpr int SC_OUT = 2 * SC_BUF;
struct ScanRegs { v4u st[15]; };
__device__ __forceinline__ void sc_load(ScanRegs& R, const unsigned char* ws, int chx, int t, int qtr) {
    const unsigned vo = (unsigned)t * 16u;
    const unsigned char* pw = ws + WS_W + (size_t)chx * 16384; const unsigned char* pq = ws + WS_QG + (size_t)chx * 16384; const unsigned char* pk = ws + WS_KD + (size_t)chx * 16384;
    const unsigned char* pa = ws + WS_A + (size_t)chx * 8192; const unsigned char* pu = ws + WS_U + (size_t)chx * 16384 + qtr * 4096;
#define SC_LDG(k, p) do { R.st[k] = *(const v4u*)(p); __builtin_amdgcn_sched_barrier(0); } while (0)
    __builtin_amdgcn_sched_barrier(0);
    SC_LDG(0, pw + vo); SC_LDG(1, pw + 4096 + vo); SC_LDG(2, pw + 8192 + vo); SC_LDG(3, pw + 12288 + vo);
    SC_LDG(4, pq + vo); SC_LDG(5, pq + 4096 + vo); SC_LDG(6, pq + 8192 + vo); SC_LDG(7, pq + 12288 + vo);
    SC_LDG(8, pk + vo); SC_LDG(9, pk + 4096 + vo); SC_LDG(10, pk + 8192 + vo); SC_LDG(11, pk + 12288 + vo);
    SC_LDG(12, pa + vo); SC_LDG(13, pa + 4096 + vo); SC_LDG(14, pu + vo);
#undef SC_LDG
}
__device__ __forceinline__ void sc_write(const ScanRegs& R, LAS unsigned char* B_, int t) {
    LAS unsigned char* w16 = B_ + (t >> 4) * 272 + (t & 15) * 16;
    LAS unsigned char* k8 = B_ + (t >> 3) * 144 + (t & 7) * 16;
#define SC_STL(k, p) do { *(LAS v4u*)(p) = R.st[k]; __builtin_amdgcn_sched_barrier(0); } while (0)
    __builtin_amdgcn_sched_barrier(0);
    SC_STL(0, w16 + SC_W); SC_STL(1, w16 + SC_W + 16 * 272); SC_STL(2, w16 + SC_W + 32 * 272); SC_STL(3, w16 + SC_W + 48 * 272);
    SC_STL(4, w16 + SC_QG); SC_STL(5, w16 + SC_QG + 16 * 272); SC_STL(6, w16 + SC_QG + 32 * 272); SC_STL(7, w16 + SC_QG + 48 * 272);
    SC_STL(8, k8 + SC_KDT); SC_STL(9, k8 + SC_KDT + 32 * 144); SC_STL(10, k8 + SC_KDT + 64 * 144); SC_STL(11, k8 + SC_KDT + 96 * 144);
    SC_STL(12, k8 + SC_A); SC_STL(13, k8 + SC_A + 32 * 144); SC_STL(14, k8 + SC_U);
#undef SC_STL
}
#define SC_BARRIER() do { asm volatile("s_waitcnt lgkmcnt(0)" ::: "memory"); __builtin_amdgcn_s_barrier(); asm volatile("" ::: "memory"); } while (0)
__device__ __forceinline__ void sc_step_compute(LAS unsigned char* L8, int n, int jl, int kq, int wcol, float egv, f32x4 (&Sacc)[8]) {
    const float eg = __builtin_bit_cast(float, __builtin_amdgcn_readlane(__builtin_bit_cast(int, egv), n));
    const LAS unsigned char* B = L8 + (n & 1) * SC_BUF;
    bf16x8 sb[4];
#pragma unroll
    for (int ks = 0; ks < 4; ++ks) sb[ks] = pack8(Sacc[2 * ks], Sacc[2 * ks + 1]);
    f32x4 vn[4], oa[4];
#pragma unroll
    for (int mt = 0; mt < 4; ++mt) { const v2u u = *(const LAS v2u*)(B + SC_U + (wcol + jl) * 144 + (16 * mt + 4 * kq) * 2);
        vn[mt] = (f32x4){bflo(u.x), bfhi(u.x), bflo(u.y), bfhi(u.y)}; oa[mt] = (f32x4){0.f, 0.f, 0.f, 0.f}; }
    const LAS unsigned char* pW = B + SC_W + jl * 272 + kq * 16; const LAS unsigned char* pQ = B + SC_QG + jl * 272 + kq * 16;
    const LAS unsigned char* pK = B + SC_KDT + jl * 144 + kq * 16; const LAS unsigned char* pA = B + SC_A + jl * 144 + kq * 16;
#define SC_LD_WQ(dst, mt) do { _Pragma("unroll") for (int ks = 0; ks < 4; ++ks) { dst[ks] = *(const LAS bf16x8*)(pW + (mt) * 16 * 272 + ks * 64); dst[4 + ks] = *(const LAS bf16x8*)(pQ + (mt) * 16 * 272 + ks * 64); } } while (0)
#define SC_LD_K(dst, t0) do { _Pragma("unroll") for (int t = 0; t < 4; ++t) _Pragma("unroll") for (int k2 = 0; k2 < 2; ++k2) dst[2 * t + k2] = *(const LAS bf16x8*)(pK + ((t0) + t) * 16 * 144 + k2 * 64); } while (0)
#define SC_LD_A(dst) do { _Pragma("unroll") for (int mt = 0; mt < 4; ++mt) _Pragma("unroll") for (int k2 = 0; k2 < 2; ++k2) dst[2 * mt + k2] = *(const LAS bf16x8*)(pA + mt * 16 * 144 + k2 * 64); } while (0)
#define SC_MM_WQ(src, mt) do { _Pragma("unroll") for (int ks = 0; ks < 4; ++ks) { vn[mt] = __builtin_amdgcn_mfma_f32_16x16x32_bf16(src[ks], sb[ks], vn[mt], 0, 0, 0); oa[mt] = __builtin_amdgcn_mfma_f32_16x16x32_bf16(src[4 + ks], sb[ks], oa[mt], 0, 0, 0); } } while (0)
#define SC_MM_K(src, t0) do { _Pragma("unroll") for (int k2 = 0; k2 < 2; ++k2) _Pragma("unroll") for (int t = 0; t < 4; ++t) Sacc[(t0) + t] = __builtin_amdgcn_mfma_f32_16x16x32_bf16(src[2 * t + k2], vb[k2], Sacc[(t0) + t], 0, 0, 0); } while (0)
#define SC_MM_A(src) do { _Pragma("unroll") for (int k2 = 0; k2 < 2; ++k2) _Pragma("unroll") for (int mt = 0; mt < 4; ++mt) oa[mt] = __builtin_amdgcn_mfma_f32_16x16x32_bf16(src[2 * mt + k2], vb[k2], oa[mt], 0, 0, 0); } while (0)
#define SC_SB() __builtin_amdgcn_sched_barrier(0)
    bf16x8 fa[8], fb[8];
    SC_LD_WQ(fa, 0); SC_LD_WQ(fb, 1); SC_SB();
    SC_MM_WQ(fa, 0); SC_SB(); SC_LD_WQ(fa, 2); SC_SB();
    SC_MM_WQ(fb, 1); SC_SB(); SC_LD_WQ(fb, 3); SC_SB();
    SC_MM_WQ(fa, 2); SC_SB(); SC_LD_K(fa, 0); SC_SB();
    SC_MM_WQ(fb, 3); SC_SB(); SC_LD_K(fb, 4); SC_SB();
    bf16x8 vb[2];
    vb[0] = pack8(vn[0], vn[1]); vb[1] = pack8(vn[2], vn[3]);
#pragma unroll
    for (int T = 0; T < 8; ++T) Sacc[T] = Sacc[T] * eg;
    SC_SB();
    SC_MM_K(fa, 0); SC_SB(); SC_LD_A(fa); SC_SB();
    SC_MM_K(fb, 4); SC_SB();
    SC_MM_A(fa);
#undef SC_LD_WQ
#undef SC_LD_K
#undef SC_LD_A
#undef SC_MM_WQ
#undef SC_MM_K
#undef SC_MM_A
#undef SC_SB
    LAS unsigned char* ob = L8 + SC_OUT + (n & 1) * 4096 + (4 * kq) * 64 + (wcol + jl) * 2;
#pragma unroll
    for (int mt = 0; mt < 4; ++mt)
#pragma unroll
        for (int e = 0; e < 4; ++e) *(LAS bf16*)(ob + (16 * mt + e) * 64) = (bf16)f2bf(oa[mt][e]);
    SC_BARRIER();
}
__device__ __forceinline__ void sc_out_tile(LAS unsigned char* L8, bf16* MIX, int b, int h, int qtr, int n, int l_) {
    const LAS unsigned char* ob = L8 + SC_OUT + (n & 1) * 4096 + l_ * 64;
    const v4u w0 = *(const LAS v4u*)ob, w1 = *(const LAS v4u*)(ob + 16), w2 = *(const LAS v4u*)(ob + 32), w3 = *(const LAS v4u*)(ob + 48);
    bf16* gp = MIX + (size_t)(b * SEQ + n * 64 + l_) * 1024 + 512 + h * 128 + qtr * 32;
    *(v4u*)gp = w0; *(v4u*)(gp + 8) = w1; *(v4u*)(gp + 16) = w2; *(v4u*)(gp + 24) = w3;
}
__device__ __forceinline__ void dn_scan_mfma(const Args& a, LAS unsigned char* L8, int item, int tid, int lane, int wave) {
    unsigned char* ws = a.ws;
    const int xcd_ = item & 7, slot_ = item >> 3;
    const int bh = xcd_ * 2 + (slot_ >> 2), qtr = slot_ & 3, b = bh >> 2, h = bh & 3;
    if (wave < 2) {
        const int jl = lane & 15, kq = lane >> 4;
        f32x4 Sacc[8];
#pragma unroll
        for (int T = 0; T < 8; ++T) Sacc[T] = (f32x4){0.f, 0.f, 0.f, 0.f};
        const float egv = ((const float*)(ws + WS_EG))[bh * 64 + lane];
        asm volatile("s_waitcnt vmcnt(0)" ::: "memory");
        SC_BARRIER();
        for (int n = 0; n < 64; ++n) sc_step_compute(L8, n, jl, kq, wave * 16, egv, Sacc);
    } else if (wave < 6) {
        ScanRegs R0, R1, R2; const int t = tid - 128, c0 = bh * 64;
        sc_load(R0, ws, c0, t, qtr); sc_write(R0, L8, t);
        sc_load(R1, ws, c0 + 1, t, qtr); sc_load(R2, ws, c0 + 2, t, qtr); sc_load(R0, ws, c0 + 3, t, qtr);
        SC_BARRIER();
        for (int n = 0; n < 63; n += 3) {
            sc_write(R1, L8 + ((n + 1) & 1) * SC_BUF, t);
            sc_load(R1, ws, c0 + (n + 4 < 63 ? n + 4 : 63), t, qtr);
            SC_BARRIER();
            sc_write(R2, L8 + ((n + 2) & 1) * SC_BUF, t);
            sc_load(R2, ws, c0 + (n + 5 < 63 ? n + 5 : 63), t, qtr);
            SC_BARRIER();
            sc_write(R0, L8 + ((n + 3) & 1) * SC_BUF, t);
            sc_load(R0, ws, c0 + (n + 6 < 63 ? n + 6 : 63), t, qtr);
            SC_BARRIER();
        }
        SC_BARRIER();
    } else if (wave == 6) {
        SC_BARRIER();
        for (int n = 0; n < 64; ++n) SC_BARRIER();
    } else {
        bf16* MIX = (bf16*)(ws + WS_XN);
        SC_BARRIER();
        for (int n = 0; n < 64; ++n) { if (n > 0) sc_out_tile(L8, MIX, b, h, qtr, n - 1, lane); SC_BARRIER(); }
        sc_out_tile(L8, MIX, b, h, qtr, 63, lane);
    }
    __syncthreads();
}

typedef float f32x16 __attribute__((ext_vector_type(16)));
typedef short s16x4 __attribute__((ext_vector_type(4)));
__device__ __forceinline__ s16x4 vtr(const LAS unsigned char* p) { return __builtin_bit_cast(s16x4, __builtin_amdgcn_ds_read_tr16_b64_v4i16((LAS s16x4*)p)); }
constexpr int KVP = 144;
constexpr int KV_BYTES = 384 * KVP;
constexpr size_t WS_ML = 173 * MiB;
constexpr size_t WS_SS = 176 * MiB;
constexpr size_t WS_XNB2 = 184 * MiB;
__device__ __forceinline__ void attn_item(const bf16* Qh, const bf16* KVh, bf16* PROJ, float* ML, LAS unsigned char* L8, int item, int tid, int lane, int wave) {
    asm volatile("" : "+v"(lane));
    const int bh = item / 48, rem = item - bh * 48, p = rem >> 4, sub = rem & 15;
    const int b = bh >> 3, h = bh & 7;
    const int dsh = 2 * p, dil = 1 << dsh, nsh = 4 - dsh;
    const int r = sub >> nsh, qb = sub & ((1 << nsh) - 1);
    const int base = 256 * qb;
    const bf16* KVb = KVh + (size_t)(bh * 4096 + r) * 128;
#pragma unroll
    for (int i = 0; i < 12; ++i) { const int id = tid + 512 * i, row = id >> 4, ch = id & 15, idx = base - 128 + row;
        v4u kv = (v4u){0u, 0u, 0u, 0u};
        if (idx >= 0) kv = *(const v4u*)(KVb + (size_t)(dil * idx) * 128 + ch * 8);
        *(LAS v4u*)(L8 + ((ch & 8) ? KV_BYTES : 0) + row * KVP + (ch & 7) * 16) = kv; }
    const int ql = lane & 31, kh = lane >> 5;
    const int tq = r + dil * (base + 32 * wave + ql);
    const size_t tokq = (size_t)b * SEQ + tq;
    bf16x8 qf[4];
#pragma unroll
    for (int s = 0; s < 4; ++s) qf[s] = *(const bf16x8*)(Qh + ((size_t)bh * 4096 + tq) * 64 + 16 * s + 8 * kh);
    __syncthreads();
    f32x16 sc[5];
    {
        const LAS unsigned char* Kp = L8 + (32 * wave + ql) * KVP + kh * 16;
        bf16x8 kf[2][4];
#pragma unroll
        for (int s = 0; s < 4; ++s) kf[0][s] = *(const LAS bf16x8*)(Kp + s * 32);
#pragma unroll
        for (int kt = 0; kt < 5; ++kt) {
            if (kt + 1 < 5) {
#pragma unroll
                for (int s = 0; s < 4; ++s) kf[(kt + 1) & 1][s] = *(const LAS bf16x8*)(Kp + (kt + 1) * 32 * KVP + s * 32); }
            __builtin_amdgcn_sched_barrier(0);
            f32x16 acc = {};
#pragma unroll
            for (int s = 0; s < 4; ++s) acc = __builtin_amdgcn_mfma_f32_32x32x16_bf16(kf[kt & 1][s], qf[s], acc, 0, 0, 0);
            sc[kt] = acc;
            __builtin_amdgcn_sched_barrier(0);
        }
    }
    const float LOG2E = 1.4426950408889634f;
    const float c1 = 0.125f * LOG2E, c2 = exp2f(-(float)(h + 1)) * (float)dil * LOG2E;
    const float Al = -c2 * (float)(128 + ql - 4 * kh);
    float mx = -INFINITY;
#pragma unroll
    for (int kt = 0; kt < 5; ++kt)
#pragma unroll
        for (int rr = 0; rr < 16; ++rr) { const int kc = (rr & 3) + 8 * (rr >> 2);
            float v = fmaf(sc[kt][rr], c1, fmaf(c2, (float)(32 * kt + kc), Al));
            if (kt == 0) v = (kc + 4 * kh >= ql) ? v : -INFINITY;
            if (kt == 4) v = (kc + 4 * kh <= ql) ? v : -INFINITY;
            sc[kt][rr] = v; }
    if (base == 0) {
#pragma unroll
        for (int kt = 0; kt < 4; ++kt)
#pragma unroll
            for (int rr = 0; rr < 16; ++rr) { const int kidx = -128 + 32 * (wave + kt) + (rr & 3) + 8 * (rr >> 2) + 4 * kh; sc[kt][rr] = (kidx >= 0) ? sc[kt][rr] : -INFINITY; }
    }
#pragma unroll
    for (int kt = 0; kt < 5; ++kt)
#pragma unroll
        for (int rr = 0; rr < 16; ++rr) mx = fmaxf(mx, sc[kt][rr]);
    mx = fmaxf(mx, __shfl_xor(mx, 32));
    float lsum = 0.f;
#pragma unroll
    for (int kt = 0; kt < 5; ++kt)
#pragma unroll
        for (int rr = 0; rr < 16; ++rr) { const float pv = __builtin_amdgcn_exp2f(sc[kt][rr] - mx); sc[kt][rr] = pv; lsum += pv; }
    lsum += __shfl_xor(lsum, 32);
    f32x16 o[2]; o[0] = (f32x16){}; o[1] = (f32x16){};
    {
        const int q4 = (lane & 15) >> 2, pp = lane & 3, blk = (lane >> 4) & 1;
        const LAS unsigned char* Vb = L8 + KV_BYTES + (32 * wave + 4 * kh + q4) * KVP + (16 * blk + 4 * pp) * 2;
        s16x4 vf[3][4];
#define AT_LDV(set, step) do { const LAS unsigned char* vr_ = Vb + (16 * (step)) * KVP; vf[set][0] = vtr(vr_); vf[set][1] = vtr(vr_ + 8 * KVP); vf[set][2] = vtr(vr_ + 64); vf[set][3] = vtr(vr_ + 8 * KVP + 64); } while (0)
        AT_LDV(0, 0); AT_LDV(1, 1);
#pragma unroll
        for (int st = 0; st < 10; ++st) {
            if (st + 2 < 10) AT_LDV((st + 2) % 3, st + 2);
            __builtin_amdgcn_sched_barrier(0);
            const int kt = st >> 1, s2 = st & 1;
            v4u pw; pw.x = cvtpk(sc[kt][8 * s2 + 0], sc[kt][8 * s2 + 1]); pw.y = cvtpk(sc[kt][8 * s2 + 2], sc[kt][8 * s2 + 3]); pw.z = cvtpk(sc[kt][8 * s2 + 4], sc[kt][8 * s2 + 5]); pw.w = cvtpk(sc[kt][8 * s2 + 6], sc[kt][8 * s2 + 7]);
            const bf16x8 pb = __builtin_bit_cast(bf16x8, pw);
            const s16x4 l0 = vf[st % 3][0], h0 = vf[st % 3][1], l1 = vf[st % 3][2], h1 = vf[st % 3][3];
            o[0] = __builtin_amdgcn_mfma_f32_32x32x16_bf16((bf16x8){l0[0], l0[1], l0[2], l0[3], h0[0], h0[1], h0[2], h0[3]}, pb, o[0], 0, 0, 0);
            o[1] = __builtin_amdgcn_mfma_f32_32x32x16_bf16((bf16x8){l1[0], l1[1], l1[2], l1[3], h1[0], h1[1], h1[2], h1[3]}, pb, o[1], 0, 0, 0);
            __builtin_amdgcn_sched_barrier(0);
        }
#undef AT_LDV
    }
    const float inv = 1.0f / lsum;
    bf16* dst = PROJ + tokq * P2LD + p * 512 + h * 64 + 4 * kh;
#pragma unroll
    for (int c = 0; c < 2; ++c)
#pragma unroll
        for (int g = 0; g < 4; ++g) { v2u w; w.x = cvtpk(o[c][4 * g + 0] * inv, o[c][4 * g + 1] * inv); w.y = cvtpk(o[c][4 * g + 2] * inv, o[c][4 * g + 3] * inv);
            *(v2u*)(dst + 32 * c + 8 * g) = w; }
    if (kh == 0) { float* ml = ML + ((tokq * 8 + h) * 3 + p) * 2; *(f32x2*)ml = (f32x2){mx, lsum}; }
    __syncthreads();
}

#define XB_TMO      128
#define XB_XCNT(j)  (256  + 64 * (j))
#define XB_XSUB(j)  (1280 + 64 * (j))
#define XB_XGEN(j)  (2304 + 64 * (j))
#define XB_TOP      3328
#define XB_TOPGEN   3392
#define XCD_BAR_WORDS 3456
#define XB_SPIN_CAP (1u << 18)

__device__ __forceinline__ unsigned xb_ld(unsigned* p)              { return __hip_atomic_load(p, __ATOMIC_RELAXED, __HIP_MEMORY_SCOPE_AGENT); }
__device__ __forceinline__ unsigned xb_add(unsigned* p, unsigned v) { return __hip_atomic_fetch_add(p, v, __ATOMIC_RELAXED, __HIP_MEMORY_SCOPE_AGENT); }
__device__ __forceinline__ unsigned xb_xcc_id() { return (unsigned)__builtin_amdgcn_s_getreg((3 << 11) | 20) & 0xFu; }
#define XB_SPIN(cond, bar) do { unsigned _sp = 0; while (cond) { __builtin_amdgcn_s_sleep(1); \
    if ((++_sp & 255u) == 0u) { if (xb_ld(&(bar)[XB_TMO])) break; if (_sp > XB_SPIN_CAP) { atomicAdd(&(bar)[XB_TMO], 1u); break; } } } } while (0)

struct XcdBarrier {
    unsigned* bar; unsigned x;
    volatile LAS unsigned* st;
};

__device__ __forceinline__ XcdBarrier xcd_barrier_post(unsigned* bar, volatile LAS unsigned* st) {
    XcdBarrier b; b.bar = bar; b.x = xb_xcc_id(); b.st = st;
    if (threadIdx.x == 0) (void)xb_add(&bar[XB_XCNT(b.x)], 1u);
    return b;
}
__device__ __forceinline__ void xcd_barrier_complete(unsigned* bar, unsigned x, unsigned& nloc, unsigned& nx) {
    const unsigned G = gridDim.x * gridDim.y * gridDim.z;
    unsigned sum, cnt, mine, sp = 0u;
    for (;;) {
        sum = 0u; cnt = 0u; mine = 0u;
#pragma unroll
        for (unsigned j = 0; j < 16; ++j) { const unsigned c = xb_ld(&bar[XB_XCNT(j)]); sum += c; cnt += (c > 0u) ? 1u : 0u; mine = (j == x) ? c : mine; }
        if (sum == G) break;
        __builtin_amdgcn_s_sleep(1);
        if ((++sp & 255u) == 0u) { if (xb_ld(&bar[XB_TMO])) break; if (sp > XB_SPIN_CAP) { atomicAdd(&bar[XB_TMO], 1u); break; } }
    }
    nloc = mine > 0u ? mine : 1u; nx = cnt > 0u ? cnt : 1u;
}

__device__ __forceinline__ void xcd_barrier(const XcdBarrier& b) {
    asm volatile("s_waitcnt vmcnt(0)" ::: "memory");
    __syncthreads();
    if (threadIdx.x == 0) {
        unsigned* bar = b.bar;
        __builtin_amdgcn_s_waitcnt(0);
        unsigned nloc = b.st[0], nx = b.st[1];
        if (nloc == 0u) { xcd_barrier_complete(bar, b.x, nloc, nx); b.st[0] = nloc; b.st[1] = nx; }
        const unsigned old = xb_add(&bar[XB_XSUB(b.x)], 1u);
        const unsigned gen = old / nloc;
        if (old + 1u == (gen + 1u) * nloc) {
            __builtin_amdgcn_fence(__ATOMIC_RELEASE, "agent");
            asm volatile("s_waitcnt vmcnt(0)" ::: "memory");
            const unsigned og = xb_add(&bar[XB_TOP], 1u);
            const unsigned tg = og / nx;
            if (og + 1u == (tg + 1u) * nx) xb_add(&bar[XB_TOPGEN], 1u);
            else XB_SPIN(xb_ld(&bar[XB_TOPGEN]) == tg, bar);
            __builtin_amdgcn_fence(__ATOMIC_ACQUIRE, "agent");
            xb_add(&bar[XB_XGEN(b.x)], 1u);
            asm volatile("s_waitcnt vmcnt(0)" ::: "memory");
        } else {
            XB_SPIN(xb_ld(&bar[XB_XGEN(b.x)]) == gen, bar);
            __builtin_amdgcn_fence(__ATOMIC_ACQUIRE, "agent");
            asm volatile("s_waitcnt vmcnt(0)" ::: "memory");
        }
    }
    __syncthreads();
}

__global__ void __launch_bounds__(NWAVES * 64, 2) fwd_megakernel(Args a) {
    extern __shared__ __attribute__((aligned(16))) unsigned char lds[];
    cg::grid_group grid = cg::this_grid();
    LAS unsigned char* L8 = (LAS unsigned char*)lds;
    LAS float* L = (LAS float*)lds;
    const int tid = threadIdx.x, lane = tid & 63, wave = __builtin_amdgcn_readfirstlane(tid >> 6);
    const int G = gridDim.x, gw = blockIdx.x * NWAVES + wave, NGW = G * NWAVES;
    unsigned char* ws = a.ws;
    unsigned* ctl = (unsigned*)(ws + WS_CTL);
    const float* x = a.in[0];
    bf16* XN = (bf16*)(ws + WS_XN); bf16* ACT = (bf16*)(ws + WS_ACT); bf16* PROJ = ACT; bf16* MIX = XN;
    bf16* Wgu1 = (bf16*)(ws + WS_WGU1); bf16* Wd1 = (bf16*)(ws + WS_WD1); bf16* Win = (bf16*)(ws + WS_WIN); bf16* Wout = (bf16*)(ws + WS_WOUT);
    bf16* Wgu2 = (bf16*)(ws + WS_WGU2); bf16* Wd2 = (bf16*)(ws + WS_WD2);
    float* out = a.out;
    volatile LAS unsigned* xbst = (volatile LAS unsigned*)(L8 + LDS_BYTES - 64);
    if (tid < 2) xbst[tid] = 0u;
    __syncthreads();
    XcdBarrier bar = xcd_barrier_post(ctl + 1024, xbst);
#define GSYNC() xcd_barrier(bar)

    {
        const int lane = opq(tid) & 63;
        LAS float* scr = L + wave * 4096;
        constexpr int I_GU = (D / 64) * (NGU / 32), I_D = (FF / 64) * (D / 32), I_IN = (D / 64) * (NIN / 32), I_O = (D / 64) * (D / 32);
        for (int it = gw; it < I_GU; it += NGW) tr_gu(a.in[2], a.in[3], Wgu1, it, scr, lane);
        for (int m = gw; m < M; m += NGW) { f32x4 v[4]; rms_row(x + (size_t)m * D, a.in[1], lane, v); store_row_bf16(XN + (size_t)m * D, lane, v); }
    }
    GSYNC();
    if (a.ws == nullptr) grid.sync();
    {
        pg8::Gemm g{XN, Wgu1, M, NGU, D}; pg8::StaticOrder S; S.init(M, NGU, G, (int)blockIdx.x);
        pg8::EpiSwiGLU<false> E{ACT, FF, nullptr};
        pg8::gemm_phase<pg8::EpiSwiGLU<false>, pg8::StaticOrder, true, true>(L8, g, S, E);
        {
            constexpr int I_D = (FF / 64) * (D / 32), I_IN = (D / 64) * (NIN / 32), I_O = (D / 64) * (D / 32);
            const int rem = ((M / 256) * (NGU / 256)) % G, nbf = rem ? G - rem : G, jf = rem ? (int)blockIdx.x - rem : (int)blockIdx.x;
            if (jf >= 0) { const int lane_f = opq(tid) & 63; LAS float* scr = L + wave * 4096;
                for (int it = jf * NWAVES + wave; it < I_D + I_IN + I_O; it += nbf * NWAVES) { int r = it;
                    if (r < I_D) { tr_plain(a.in[4], FF, D, Wd1, r, scr, lane_f); continue; } r -= I_D;
                    if (r < I_IN) { tr_win(a.in[6], Win, r, scr, lane_f, a.in[5]); continue; } r -= I_IN;
                    tr_plain(a.in[11], D, D, Wout, r, scr, lane_f); } }
        }
    }
    GSYNC();
    {
        pg8::Gemm g{ACT, Wd1, M, D, FF}; pg8::StaticOrder S; S.init(M, D, G, (int)blockIdx.x);
        pg8::EpiRes<true> E{x, out, D, 0.5f, XN, (float*)(ws + WS_SS)};
        pg8::gemm_phase<pg8::EpiRes<true>, pg8::StaticOrder, true, true>(L8, g, S, E);
    }
    GSYNC();
    {
        pg8::Gemm g{XN, Win, M, NIN, D}; pg8::StaticOrder S; S.init(M, NIN, G, (int)blockIdx.x);
        pg8::EpiProj E{(bf16*)(ws + WS_QH), (bf16*)(ws + WS_KVH), PROJ, (float*)(ws + WS_BD), (const float*)(ws + WS_SS)};
        pg8::gemm_phase<pg8::EpiProj, pg8::StaticOrder, true, true>(L8, g, S, E);
        {
            constexpr int I_GU = (D / 64) * (NGU / 32), I_D = (FF / 64) * (D / 32);
            const int rem = ((M / 256) * (NIN / 256)) % G, nbf = rem ? G - rem : G, jf = rem ? (int)blockIdx.x - rem : (int)blockIdx.x;
            if (jf >= 0) { const int lane_f = opq(tid) & 63; LAS float* scr = L + wave * 4096;
                for (int it = jf * NWAVES + wave; it < I_GU + I_D; it += nbf * NWAVES) {
                    if (it < I_GU) tr_gu(a.in[13], a.in[14], Wgu2, it, scr, lane_f, a.in[12]); else tr_plain(a.in[15], FF, D, Wd2, it - I_GU, scr, lane_f); } }
        }
    }
    GSYNC();
    { const int tid_ = opq(tid); PrepIn Pin; if ((int)blockIdx.x < 1024) prep_load(Pin, a, blockIdx.x, tid_ & 63, wave);
      for (int ch = blockIdx.x; ch < 1024; ch += G) dn_prep_item(Pin, a, L8, ch, ch + G, tid_, tid_ & 63, wave); }
    GSYNC();
    {
        const int tid_ = opq(tid), lane = tid_ & 63;
        for (int it = blockIdx.x; it < 64; it += G) dn_scan_mfma(a, L8, it, tid_, lane, wave);
        float* ML = (float*)(ws + WS_ML);
        if ((int)blockIdx.x >= 64 || G <= 64) {
            const int nb = (G > 64) ? G - 64 : G, j0 = (G > 64) ? (int)blockIdx.x - 64 : (int)blockIdx.x;
            for (int item = j0; item < 1536; item += nb) attn_item((const bf16*)(ws + WS_QH), (const bf16*)(ws + WS_KVH), PROJ, ML, L8, item, tid, lane, wave);
        }
    }
    GSYNC();
    {
        const int lane = opq(tid) & 63;
        const float* dn_norm = a.in[10];
        for (int m = gw; m < M; m += NGW) {
            bf16* op = MIX + (size_t)m * 1024 + 512 + 8 * lane; const bf16* gp = PROJ + (size_t)m * P2LD + 1536 + 8 * lane;
            const v4u ow = *(const v4u*)op, gwv = *(const v4u*)gp;
            float o[8] = {bflo(ow.x), bfhi(ow.x), bflo(ow.y), bfhi(ow.y), bflo(ow.z), bfhi(ow.z), bflo(ow.w), bfhi(ow.w)};
            float gt[8] = {bflo(gwv.x), bfhi(gwv.x), bflo(gwv.y), bfhi(gwv.y), bflo(gwv.z), bfhi(gwv.z), bflo(gwv.w), bfhi(gwv.w)};
            float ss = 0.f;
#pragma unroll
            for (int i = 0; i < 8; ++i) ss += o[i] * o[i];
            ss += __shfl_xor(ss, 1); ss += __shfl_xor(ss, 2); ss += __shfl_xor(ss, 4); ss += __shfl_xor(ss, 8);
            const float rs = 1.0f / sqrtf(ss * (1.f / 128.f) + 1e-6f);
            const int d0 = (8 * lane) & 127;
            float r[8];
#pragma unroll
            for (int i = 0; i < 8; ++i) r[i] = o[i] * rs * dn_norm[d0 + i] * (gt[i] / (1.f + __expf(-gt[i])));
            v4u w; w.x = pk2(r[0], r[1]); w.y = pk2(r[2], r[3]); w.z = pk2(r[4], r[5]); w.w = pk2(r[6], r[7]);
            *(v4u*)op = w;
            {
                const int ha = lane >> 3;
                const float* ml = (const float*)(ws + WS_ML) + ((size_t)m * 8 + ha) * 6;
                const f32x2 a0 = *(const f32x2*)ml, a1 = *(const f32x2*)(ml + 2), a2 = *(const f32x2*)(ml + 4);
                const float mm = fmaxf(a0.x, fmaxf(a1.x, a2.x));
                const float w0 = a0.y * __builtin_amdgcn_exp2f(a0.x - mm), w1 = a1.y * __builtin_amdgcn_exp2f(a1.x - mm), w2 = a2.y * __builtin_amdgcn_exp2f(a2.x - mm);
                const float iw = 1.0f / (w0 + w1 + w2);
                const bf16* pp = PROJ + (size_t)m * P2LD + 8 * lane;
                const v4u p0 = *(const v4u*)pp, p1 = *(const v4u*)(pp + 512), p2 = *(const v4u*)(pp + 1024);
                float rr[8];
                rr[0] = w0 * bflo(p0.x) + w1 * bflo(p1.x) + w2 * bflo(p2.x); rr[1] = w0 * bfhi(p0.x) + w1 * bfhi(p1.x) + w2 * bfhi(p2.x);
                rr[2] = w0 * bflo(p0.y) + w1 * bflo(p1.y) + w2 * bflo(p2.y); rr[3] = w0 * bfhi(p0.y) + w1 * bfhi(p1.y) + w2 * bfhi(p2.y);
                rr[4] = w0 * bflo(p0.z) + w1 * bflo(p1.z) + w2 * bflo(p2.z); rr[5] = w0 * bfhi(p0.z) + w1 * bfhi(p1.z) + w2 * bfhi(p2.z);
                rr[6] = w0 * bflo(p0.w) + w1 * bflo(p1.w) + w2 * bflo(p2.w); rr[7] = w0 * bfhi(p0.w) + w1 * bfhi(p1.w) + w2 * bfhi(p2.w);
                v4u wa; wa.x = pk2(rr[0] * iw, rr[1] * iw); wa.y = pk2(rr[2] * iw, rr[3] * iw); wa.z = pk2(rr[4] * iw, rr[5] * iw); wa.w = pk2(rr[6] * iw, rr[7] * iw);
                *(v4u*)(MIX + (size_t)m * 1024 + 8 * lane) = wa;
            }
        }
    }
    GSYNC();
    {
        pg8::Gemm g{MIX, Wout, M, D, D}; pg8::StaticOrder S; S.init(M, D, G, (int)blockIdx.x);
        pg8::EpiRes<true> E{out, out, D, 1.0f, (bf16*)(ws + WS_XNB2), (float*)(ws + WS_SS)};
        pg8::gemm_phase<pg8::EpiRes<true>, pg8::StaticOrder, true, true>(L8, g, S, E);
    }
    GSYNC();
    {
        pg8::Gemm g{(const bf16*)(ws + WS_XNB2), Wgu2, M, NGU, D}; pg8::StaticOrder S; S.init(M, NGU, G, (int)blockIdx.x);
        pg8::EpiSwiGLU<true> E{ACT, FF, (const float*)(ws + WS_SS)};
        pg8::gemm_phase<pg8::EpiSwiGLU<true>, pg8::StaticOrder, true, true>(L8, g, S, E);
    }
    GSYNC();
    {
        pg8::Gemm g{ACT, Wd2, M, D, FF}; pg8::StaticOrder S; S.init(M, D, G, (int)blockIdx.x);
        pg8::EpiRes<false> E{out, out, D, 0.5f, nullptr, nullptr};
        pg8::gemm_phase<pg8::EpiRes<false>, pg8::StaticOrder, true, true>(L8, g, S, E);
    }
    GSYNC();
    const int lnf = opq(tid) & 63;
    for (int m = gw; m < M; m += NGW) {
        f32x4 v[4]; rms_row(out + (size_t)m * D, a.in[16], lnf, v);
        f32x4* o = (f32x4*)(out + (size_t)m * D) + lnf;
#pragma unroll
        for (int j = 0; j < 4; ++j) o[64 * j] = v[j];
    }
}

extern "C" void kernel_launch(void* const* d_in, const int* in_sizes, int n_in, void* d_out, int out_size, void* d_ws, size_t ws_size, hipStream_t stream) {
    static int grid = 0;
    if (grid == 0) {
        if (n_in != 17 || in_sizes[0] != M * D || out_size != M * D || ws_size < WS_END) { fprintf(stderr, "kernel_launch: unexpected shapes (n_in %d in0 %d out %d ws %zu)\n", n_in, n_in > 0 ? in_sizes[0] : -1, out_size, ws_size); grid = -1; return; }
        int dev = 0, cus = 0, per_cu = 0;
        hipGetDevice(&dev); hipDeviceGetAttribute(&cus, hipDeviceAttributeMultiprocessorCount, dev);
        if (hipFuncSetAttribute((const void*)fwd_megakernel, hipFuncAttributeMaxDynamicSharedMemorySize, LDS_BYTES) != hipSuccess) { fprintf(stderr, "kernel_launch: hipFuncSetAttribute failed\n"); grid = -1; return; }
        if (hipOccupancyMaxActiveBlocksPerMultiprocessor(&per_cu, (const void*)fwd_megakernel, NWAVES * 64, LDS_BYTES) != hipSuccess || per_cu < 1) { fprintf(stderr, "kernel_launch: occupancy query says %d blocks/CU\n", per_cu); (void)hipGetLastError(); per_cu = 1; }
        grid = cus * 1;
        fprintf(stderr, "kernel_launch: cus %d per_cu %d grid %d\n", cus, per_cu, grid);
    }
    if (grid < 0) return;
    hipMemsetAsync((char*)d_ws + WS_CTL, 0, CTL_BYTES, stream);
    Args a{};
    for (int i = 0; i < 17; ++i) a.in[i] = (const float*)d_in[i];
    a.out = (float*)d_out; a.ws = (unsigned char*)d_ws;
    void* args[] = {&a};
    hipError_t e = hipLaunchCooperativeKernel((const void*)fwd_megakernel, dim3(grid), dim3(NWAVES * 64), args, LDS_BYTES, stream);
    if (e != hipSuccess) fprintf(stderr, "cooperative launch failed: %s (grid %d)\n", hipGetErrorString(e), grid);
}
```
